# Optimizing an MI355X kernel written in HIP

```python
import jax, jax.numpy as jnp
from jax import lax
import numpy as np

D_MODEL = 1024
BATCH = 8
SEQ = 2048
DEPTH = 1

PLE_DIM = 256
EPS = 1e-6
GLA_HEADS = 4
GLA_DK = 64
GLA_DV = 128
GLA_LOWRANK = 16
GLA_TAU = 16.0
GLA_CHUNK = 64
FOX_HEADS = 8
FOX_DH = 64
FOX_BLOCK = 128
D_FF = 2816
CONV_W = 3

GLA_QK_W = GLA_HEADS * GLA_DK
GLA_V_W = GLA_HEADS * GLA_DV
FOX_W = FOX_HEADS * FOX_DH
MIX_W = GLA_V_W + FOX_W
IN_SPLIT_SIZES = (GLA_QK_W, GLA_QK_W, GLA_V_W, GLA_V_W, GLA_LOWRANK, FOX_W, FOX_W, FOX_W, FOX_HEADS)
IN_W = 2 * GLA_QK_W + 2 * GLA_V_W + GLA_LOWRANK + 3 * FOX_W + FOX_HEADS

kernel_name = "hymba_gla_fox_convffn_ple"


def rms_norm(x, gain):
    xf = x.astype(jnp.float32)
    y = xf * lax.rsqrt(jnp.mean(xf * xf, axis=-1, keepdims=True) + EPS)
    return (y * gain.astype(jnp.float32)).astype(x.dtype)


def split_cols(t, sizes):
    offs = np.cumsum(sizes)[:-1].tolist()
    return jnp.split(t, offs, axis=-1)


def gla_mixer(q, k, v, lr, og, lr_w, lr_b, onorm_g):
    B, S, _ = q.shape
    N = S // GLA_CHUNK
    f32 = jnp.float32
    log_a = jax.nn.log_sigmoid((lr @ lr_w + lr_b).astype(f32)) / GLA_TAU

    def chunks(t, d):
        return t.astype(f32).reshape(B, N, GLA_CHUNK, GLA_HEADS, d).transpose(0, 3, 1, 2, 4)

    qc = chunks(q, GLA_DK) * (GLA_DK ** -0.5)
    kc = chunks(k, GLA_DK)
    vc = chunks(v, GLA_DV)
    b = jnp.cumsum(chunks(log_a, GLA_DK), axis=3)
    b_last = b[:, :, :, -1:, :]
    qe = qc * jnp.exp(b)
    ke = kc * jnp.exp(-b)
    kd = kc * jnp.exp(b_last - b)
    causal = jnp.tril(jnp.ones((GLA_CHUNK, GLA_CHUNK), dtype=bool))
    A = jnp.where(causal, jnp.einsum('bhnck,bhnsk->bhncs', qe, ke), 0.0)
    o_intra = jnp.einsum('bhncs,bhnsv->bhncv', A, vc)
    dS = jnp.einsum('bhnck,bhncv->nbhkv', kd, vc)
    decay = jnp.exp(b_last[:, :, :, 0, :]).transpose(2, 0, 1, 3)

    def step(state, inp):
        d, ds = inp
        return state * d[..., None] + ds, state

    s0 = jnp.zeros((B, GLA_HEADS, GLA_DK, GLA_DV), f32)
    _, s_prev = lax.scan(step, s0, (decay, dS))
    o_inter = jnp.einsum('bhnck,nbhkv->bhncv', qe, s_prev)
    o = (o_intra + o_inter).transpose(0, 2, 3, 1, 4).reshape(B, S, GLA_HEADS, GLA_DV)
    o = rms_norm(o, onorm_g) * jax.nn.silu(og.astype(f32).reshape(B, S, GLA_HEADS, GLA_DV))
    return o.reshape(B, S, GLA_V_W).astype(q.dtype)


def fox_mixer(q, k, v, f_logit, b_f, qn_g, kn_g):
    B, S, _ = q.shape
    f32 = jnp.float32
    qh = rms_norm(q.reshape(B, S, FOX_HEADS, FOX_DH), qn_g).transpose(0, 2, 1, 3)
    kh = rms_norm(k.reshape(B, S, FOX_HEADS, FOX_DH), kn_g).transpose(0, 2, 1, 3)
    vh = v.reshape(B, S, FOX_HEADS, FOX_DH).transpose(0, 2, 1, 3)
    c = jnp.cumsum(jax.nn.log_sigmoid((f_logit + b_f).astype(f32)), axis=1).transpose(0, 2, 1)
    scale = FOX_DH ** -0.5
    outs = []
    for i in range(S // FOX_BLOCK):
        q0, end = i * FOX_BLOCK, (i + 1) * FOX_BLOCK
        qs = qh[:, :, q0:end]
        ks = kh[:, :, :end]
        vs = vh[:, :, :end]
        logits = jnp.einsum('bhqd,bhkd->bhqk', qs, ks).astype(f32) * scale
        logits = logits + c[:, :, q0:end, None] - c[:, :, None, :end]
        qpos = q0 + jnp.arange(FOX_BLOCK)
        kpos = jnp.arange(end)
        logits = jnp.where(kpos[None, :] <= qpos[:, None], logits, -jnp.inf)
        probs = jax.nn.softmax(logits, axis=-1)
        outs.append(jnp.einsum('bhqk,bhkd->bhqd', probs.astype(vs.dtype), vs))
    o = jnp.concatenate(outs, axis=2)
    return o.transpose(0, 2, 1, 3).reshape(B, S, FOX_W)


def conv_ffn(h, w_up, conv_w, conv_b, w_down):
    S = h.shape[1]
    u = h @ w_up
    u_pad = jnp.pad(u, ((0, 0), (CONV_W - 1, 0), (0, 0)))
    u_c = conv_b + sum(u_pad[:, j:j + S] * conv_w[j] for j in range(CONV_W))
    gate, val = jnp.split(u_c, 2, axis=-1)
    return (jax.nn.silu(gate) * val) @ w_down


def setup_inputs(seed: int = 0) -> dict:
    key = jax.random.key(seed)
    ks = jax.random.split(key, 24)
    f32 = jnp.float32

    def nrm(k, shape, scale):
        return jax.random.normal(k, shape, f32) * scale

    L = DEPTH
    return {
        "x": nrm(ks[0], (BATCH, SEQ, D_MODEL), 1.0),
        "p": nrm(ks[1], (DEPTH, BATCH, SEQ, PLE_DIM), 1.0),
        "norm1_g": 1.0 + nrm(ks[2], (L, D_MODEL), 0.02),
        "w_in": nrm(ks[3], (L, D_MODEL, IN_W), D_MODEL ** -0.5),
        "gla_lr_w": nrm(ks[4], (L, GLA_LOWRANK, GLA_QK_W), GLA_LOWRANK ** -0.5),
        "gla_lr_b": nrm(ks[5], (L, GLA_QK_W), 0.1),
        "gla_onorm_g": 1.0 + nrm(ks[6], (L, GLA_DV), 0.02),
        "fox_b_f": nrm(ks[7], (L, FOX_HEADS), 0.1),
        "fox_qnorm_g": 1.0 + nrm(ks[8], (L, FOX_DH), 0.02),
        "fox_knorm_g": 1.0 + nrm(ks[9], (L, FOX_DH), 0.02),
        "w_o": nrm(ks[10], (L, MIX_W, D_MODEL), MIX_W ** -0.5),
        "norm2_g": 1.0 + nrm(ks[11], (L, D_MODEL), 0.02),
        "w_up": nrm(ks[12], (L, D_MODEL, 2 * D_FF), D_MODEL ** -0.5),
        "conv_w": nrm(ks[13], (L, CONV_W, 2 * D_FF), CONV_W ** -0.5),
        "conv_b": nrm(ks[14], (L, 2 * D_FF), 0.02),
        "w_down": nrm(ks[15], (L, D_FF, D_MODEL), D_FF ** -0.5),
        "norm3_g": 1.0 + nrm(ks[16], (L, D_MODEL), 0.02),
        "w_pe": nrm(ks[17], (L, PLE_DIM, D_MODEL), PLE_DIM ** -0.5),
        "pe_norm_g": 1.0 + nrm(ks[18], (L, D_MODEL), 0.02),
        "w_pg": nrm(ks[19], (L, D_MODEL, D_MODEL), D_MODEL ** -0.5),
        "b_pg": nrm(ks[20], (L, D_MODEL), 0.02),
    }


def reference(x, p, norm1_g, w_in, gla_lr_w, gla_lr_b, gla_onorm_g, fox_b_f, fox_qnorm_g,
              fox_knorm_g, w_o, norm2_g, w_up, conv_w, conv_b, w_down, norm3_g, w_pe,
              pe_norm_g, w_pg, b_pg):
    for i in range(DEPTH):
        h = rms_norm(x, norm1_g[i])
        proj = h @ w_in[i]
        g_q, g_k, g_v, g_og, g_lr, f_q, f_k, f_v, f_f = split_cols(proj, IN_SPLIT_SIZES)
        y_gla = gla_mixer(g_q, g_k, g_v, g_lr, g_og, gla_lr_w[i], gla_lr_b[i], gla_onorm_g[i])
        y_fox = fox_mixer(f_q, f_k, f_v, f_f, fox_b_f[i], fox_qnorm_g[i], fox_knorm_g[i])
        x = x + jnp.concatenate([y_gla, y_fox], axis=-1) @ w_o[i]
        x = x + conv_ffn(rms_norm(x, norm2_g[i]), w_up[i], conv_w[i], conv_b[i], w_down[i])
        e = rms_norm(p[i] @ w_pe[i], pe_norm_g[i])
        gate = jax.nn.sigmoid(rms_norm(x, norm3_g[i]) @ w_pg[i] + b_pg[i])
        x = x + gate * e
    return x
```

```cpp
#include <hip/hip_runtime.h>
#include <hip/hip_cooperative_groups.h>
#include <cstdio>
#include <cstdint>
namespace cg = cooperative_groups;
__device__ __forceinline__ int lane_id() { int l; asm volatile("v_mbcnt_lo_u32_b32 %0, -1, 0\n\tv_mbcnt_hi_u32_b32 %0, -1, %0" : "=v"(l)); return l; }
namespace pg8 {
#define PG8_LAS __attribute__((address_space(3)))
typedef unsigned short bf16_t;
typedef short bf16x8 __attribute__((ext_vector_type(8)));
typedef float f32x4 __attribute__((ext_vector_type(4)));
typedef unsigned u32x4 __attribute__((ext_vector_type(4)));
constexpr int BM = 256, BK = 64, HALF = 128, HTB = HALF * BK * 2  , STAGE_BYTES = 8 * HTB, NXCD = 8, WGM = 8;

__host__ __device__ __forceinline__ int lds_byte(int r, int c) { const int st = (r >> 4) * 2 + (c >> 5), rr = r & 15, cc = c & 31, ob = rr * 64 + cc * 2; return st * 1024 + (ob ^ (((ob >> 9) & 1) << 5)); }
__host__ __device__ __forceinline__ void stage_rc(int b, int& R, int& C) { const int st = b / 1024, sb = b % 1024, swz = sb ^ (((sb >> 9) & 1) << 5); R = (st >> 1) * 16 + swz / 64; C = (st & 1) * 32 + (swz % 64) / 2; }
__host__ __device__ __forceinline__ int perm32(int rho) { const int n = rho >> 4, i = rho & 15; return 8 * (i >> 2) + 4 * n + (i & 3); }

struct Unit { int pm, pn, arow; };
struct Gemm { const bf16_t* A; const bf16_t* Bt; int M, N, K; };

struct StaticOrder {
    int nM, nN, nwg, G, c, mstride, moff;
    __host__ __device__ void init(int nM_, int nN_, int G_, int c_, int mstride_ = 256, int moff_ = 0) { nM = nM_; nN = nN_; nwg = nM * nN; G = G_; c = c_; mstride = mstride_; moff = moff_; }
    __host__ __device__ bool next(int i, Unit& u) const {
        const long L = (long)i * G + c; if (L >= nwg) return false;
        int wgid = (int)L; { const int q = nwg / NXCD, r = nwg % NXCD, xcd = wgid % NXCD, off = wgid / NXCD; wgid = (xcd < r ? xcd * (q + 1) : r * (q + 1) + (xcd - r) * q) + off; }
        const int nig = WGM * nN, gid = wgid / nig, fm = gid * WGM, gsz = (nM - fm) < WGM ? (nM - fm) : WGM;
        u.pm = fm + ((wgid % nig) % gsz); u.pn = (wgid % nig) / gsz; u.arow = u.pm * mstride + moff; return true;
    }
    __device__ __forceinline__ void a_ready(const Unit&) const {}
    __device__ __forceinline__ void done(const Unit&) const {}
};

__device__ __forceinline__ unsigned cvt_pk_bf16(float lo, float hi) { unsigned r; asm volatile("v_cvt_pk_bf16_f32 %0, %1, %2" : "=v"(r) : "v"(lo), "v"(hi)); return r; }
typedef float f32x2 __attribute__((ext_vector_type(2)));
typedef float f32x2 __attribute__((ext_vector_type(2)));
template <class Epi, class Sched, bool ALIGN_EPI = false, bool SP2 = false>
__device__ __forceinline__ void gemm_phase(PG8_LAS unsigned char* lds, const Gemm g, const Sched& S, const Epi& E, int wave_sgpr) {
    const int wid = wave_sgpr, lane = lane_id(), tid = wid * 64 + lane, wr = wid >> 2, wc = wid & 3, fr = lane & 15, fq = lane >> 4;
    const int K = g.K, nt = K / BK;
    unsigned voffA[2], voffB[2];
#pragma unroll
    for (int i = 0; i < 2; ++i) { int R, C; stage_rc(tid * 16 + i * 8192, R, C); const int Rb = Epi::PERM ? ((R & ~31) + perm32(R & 31)) : R;
        voffA[i] = (unsigned)(R * K + C) * 2u; voffB[i] = (unsigned)(Rb * K + C) * 2u; }
    const size_t kstep = (size_t)(BK * 2);
    const size_t hstep = (size_t)HALF * K * 2;
    const size_t tstep = 2 * hstep;
    const unsigned ldsw = (unsigned)wid * 1024u;
    const int aoff = lds_byte(wr * 64 + fr, fq * 8), boff = lds_byte(wc * 32 + fr, fq * 8);
#define PG8_SA(b, h) (((b) * 2 + (h)) * HTB)
#define PG8_SB(b, h) ((4 + (b) * 2 + (h)) * HTB)
#define PG8_STAGE(bufoff, gbase, voff) do { _Pragma("unroll") for (int _i = 0; _i < 2; ++_i) \
        __builtin_amdgcn_global_load_lds((const unsigned*)((const char*)(gbase) + (voff)[_i]), (PG8_LAS unsigned*)(lds + (bufoff) + ldsw + _i * 8192), 16, 0, 0); } while (0)
#define PG8_LDA(dst, b, h) do { _Pragma("unroll") for (int m = 0; m < 4; ++m) _Pragma("unroll") for (int k = 0; k < 2; ++k) dst[m][k] = *(const PG8_LAS bf16x8*)(lds + PG8_SA(b, h) + aoff + m * 2048 + k * 1024); } while (0)
#define PG8_LDB(dst, b, h) do { _Pragma("unroll") for (int n = 0; n < 2; ++n) _Pragma("unroll") for (int k = 0; k < 2; ++k) dst[n][k] = *(const PG8_LAS bf16x8*)(lds + PG8_SB(b, h) + boff + n * 2048 + k * 1024); } while (0)
#define PG8_MMA(ai, bj, At, Bt) do { __builtin_amdgcn_s_setprio(1); _Pragma("unroll") for (int m = 0; m < 4; ++m) _Pragma("unroll") for (int n = 0; n < 2; ++n) _Pragma("unroll") for (int k = 0; k < 2; ++k) \
        acc[ai][bj][m][n] = __builtin_amdgcn_mfma_f32_16x16x32_bf16(Bt[n][k], At[m][k], acc[ai][bj][m][n], 0, 0, 0); __builtin_amdgcn_s_setprio(0); } while (0)
#define PG8_WAIT_V(n) asm volatile("s_waitcnt vmcnt(" #n ")" ::: "memory")
#define PG8_WAIT_L(n) asm volatile("s_waitcnt lgkmcnt(" #n ")" ::: "memory")
#define PG8_BAR __builtin_amdgcn_s_barrier()
#define PG8_SCHED __builtin_amdgcn_sched_barrier(0)
    Unit cur, nxt; int ui = 0;
    if (!S.next(0, cur)) return;
    f32x4 acc[2][2][4][2];
#pragma unroll
    for (int a = 0; a < 2; ++a)
#pragma unroll
        for (int b = 0; b < 2; ++b)
#pragma unroll
            for (int m = 0; m < 4; ++m)
#pragma unroll
                for (int n = 0; n < 2; ++n) acc[a][b][m][n] = (f32x4){0.f, 0.f, 0.f, 0.f};
    bf16x8 At[4][2], B0[2][2], B1[2][2];
    const char* cA = (const char*)g.A + (long)cur.arow * (long)(K * 2); const char* cB = (const char*)g.Bt + (size_t)cur.pn * tstep;
    S.a_ready(cur);
    if constexpr (SP2) {
        PG8_STAGE(PG8_SB(0, 0), cB, voffB); PG8_STAGE(PG8_SB(0, 1), cB + hstep, voffB); PG8_STAGE(PG8_SA(0, 0), cA, voffA); PG8_STAGE(PG8_SA(0, 1), cA + hstep, voffA);
        if (wr == 1) PG8_BAR;
        PG8_WAIT_V(2); PG8_BAR;
        PG8_STAGE(PG8_SB(1, 0), cB + kstep, voffB); PG8_STAGE(PG8_SA(1, 0), cA + kstep, voffA); PG8_STAGE(PG8_SB(1, 1), cB + hstep + kstep, voffB);
        PG8_WAIT_V(6); PG8_BAR;
    } else {
        PG8_STAGE(PG8_SB(0, 0), cB, voffB); PG8_STAGE(PG8_SA(0, 0), cA, voffA); PG8_STAGE(PG8_SB(0, 1), cB + hstep, voffB); PG8_STAGE(PG8_SA(0, 1), cA + hstep, voffA);
        if (wr == 1) PG8_BAR;
        PG8_WAIT_V(4); PG8_BAR;
        PG8_STAGE(PG8_SB(1, 0), cB + kstep, voffB); PG8_STAGE(PG8_SA(1, 0), cA + kstep, voffA); PG8_STAGE(PG8_SB(1, 1), cB + hstep + kstep, voffB);
        PG8_WAIT_V(6); PG8_BAR;
    }
    for (;;) {
        const bool has_next = S.next(ui + 1, nxt);
        const char* nA = has_next ? (const char*)g.A + (long)nxt.arow * (long)(K * 2) : cA; const char* nB = has_next ? (const char*)g.Bt + (size_t)nxt.pn * tstep : cB;
        for (int t = 0; t < nt; t += 2) {
            const bool last = (t == nt - 2);
            const char* a1 = cA + (size_t)(t + 1) * kstep;
            const char* a2 = last ? nA : cA + (size_t)(t + 2) * kstep; const char* b2 = last ? nB : cB + (size_t)(t + 2) * kstep;
            const char* a3 = a2 + kstep; const char* b3 = b2 + kstep;
            if (last && has_next) S.a_ready(nxt);
            if constexpr (SP2) {
            PG8_LDB(B0, 0, 0); PG8_LDB(B1, 0, 1); PG8_SCHED; PG8_LDA(At, 0, 0); PG8_STAGE(PG8_SA(1, 1), a1 + hstep, voffA);
            PG8_WAIT_V(8); PG8_WAIT_L(0); PG8_BAR; PG8_MMA(0, 0, At, B0); PG8_MMA(0, 1, At, B1); PG8_BAR; PG8_SCHED;
            PG8_LDA(At, 0, 1); PG8_STAGE(PG8_SB(0, 0), b2, voffB); PG8_STAGE(PG8_SB(0, 1), b2 + hstep, voffB); PG8_STAGE(PG8_SA(0, 0), a2, voffA);
            PG8_WAIT_V(8); PG8_WAIT_L(0); PG8_BAR; PG8_MMA(1, 0, At, B0); PG8_MMA(1, 1, At, B1); PG8_BAR; PG8_SCHED;
            PG8_LDB(B0, 1, 0); PG8_LDB(B1, 1, 1); PG8_SCHED; PG8_LDA(At, 1, 0); PG8_STAGE(PG8_SA(0, 1), a2 + hstep, voffA);
            PG8_WAIT_V(8); PG8_WAIT_L(0); PG8_BAR; PG8_MMA(0, 0, At, B0); PG8_MMA(0, 1, At, B1); PG8_BAR; PG8_SCHED;
            PG8_LDA(At, 1, 1); PG8_STAGE(PG8_SB(1, 0), b3, voffB); PG8_STAGE(PG8_SB(1, 1), b3 + hstep, voffB); PG8_STAGE(PG8_SA(1, 0), a3, voffA);
            PG8_WAIT_V(8); PG8_WAIT_L(0); PG8_BAR; PG8_MMA(1, 0, At, B0); PG8_MMA(1, 1, At, B1); PG8_BAR; PG8_SCHED;
            } else {
            PG8_LDB(B0, 0, 0); PG8_SCHED; PG8_LDA(At, 0, 0); PG8_STAGE(PG8_SA(1, 1), a1 + hstep, voffA);
            PG8_WAIT_L(8); PG8_BAR; PG8_WAIT_L(0); PG8_MMA(0, 0, At, B0); PG8_BAR; PG8_SCHED;
            PG8_LDB(B1, 0, 1); PG8_STAGE(PG8_SB(0, 0), b2, voffB);
            PG8_BAR; PG8_WAIT_L(0); PG8_MMA(0, 1, At, B1); PG8_BAR;
            PG8_LDA(At, 0, 1); PG8_STAGE(PG8_SA(0, 0), a2, voffA);
            PG8_BAR; PG8_WAIT_L(0); PG8_MMA(1, 0, At, B0); PG8_BAR; PG8_SCHED;
            PG8_STAGE(PG8_SB(0, 1), b2 + hstep, voffB);
            PG8_WAIT_V(6); PG8_BAR; PG8_MMA(1, 1, At, B1); PG8_BAR;
            PG8_LDB(B0, 1, 0); PG8_SCHED; PG8_LDA(At, 1, 0); PG8_STAGE(PG8_SA(0, 1), a2 + hstep, voffA);
            PG8_WAIT_L(8); PG8_BAR; PG8_WAIT_L(0); PG8_MMA(0, 0, At, B0); PG8_BAR; PG8_SCHED;
            PG8_LDB(B1, 1, 1); PG8_STAGE(PG8_SB(1, 0), b3, voffB);
            PG8_BAR; PG8_WAIT_L(0); PG8_MMA(0, 1, At, B1); PG8_BAR;
            PG8_LDA(At, 1, 1); PG8_STAGE(PG8_SA(1, 0), a3, voffA);
            PG8_BAR; PG8_WAIT_L(0); PG8_MMA(1, 0, At, B0); PG8_BAR; PG8_SCHED;
            PG8_STAGE(PG8_SB(1, 1), b3 + hstep, voffB);
            PG8_WAIT_V(6); PG8_BAR; PG8_MMA(1, 1, At, B1); PG8_BAR;
            }
        }
        if constexpr (ALIGN_EPI) { if (wr == 0) PG8_BAR; }
        if constexpr (!Epi::AFTER_DRAIN) { E(acc, cur, wr, wc, fr, fq); S.done(cur); }
        if (!has_next) break;
#pragma unroll
        for (int a = 0; a < 2; ++a)
#pragma unroll
            for (int b = 0; b < 2; ++b)
#pragma unroll
                for (int m = 0; m < 4; ++m)
#pragma unroll
                    for (int n = 0; n < 2; ++n) acc[a][b][m][n] = (f32x4){0.f, 0.f, 0.f, 0.f};
        cur = nxt; cA = nA; cB = nB; ++ui;
        if constexpr (ALIGN_EPI) { if (wr == 1) PG8_BAR; }
    }
    PG8_WAIT_V(0);
    if constexpr (!ALIGN_EPI) { if (wr == 0) PG8_BAR; }
    PG8_BAR;
    if constexpr (Epi::AFTER_DRAIN) { E.fused(acc, cur, wr, wc, fr, fq, lds, wid, lane); S.done(cur); }
#undef PG8_SA
#undef PG8_SB
#undef PG8_STAGE
#undef PG8_LDA
#undef PG8_LDB
#undef PG8_MMA
#undef PG8_WAIT_V
#undef PG8_WAIT_L
#undef PG8_BAR
#undef PG8_SCHED
}
}
namespace pg8 {
constexpr float RMS_EPS = 1e-6f;
typedef unsigned u32x2 __attribute__((ext_vector_type(2)));
template <int CTRL> __device__ __forceinline__ float dpp_mov(float old, float src) {
    return __builtin_bit_cast(float, __builtin_amdgcn_update_dpp(__builtin_bit_cast(int, old), __builtin_bit_cast(int, src), CTRL, 0xf, 0xf, false)); }
__device__ __forceinline__ float bf_lo(unsigned w) { return __builtin_bit_cast(float, w << 16); }
__device__ __forceinline__ float bf_hi(unsigned w) { return __builtin_bit_cast(float, w & 0xffff0000u); }

struct EpiScaleBf16 {
    static constexpr bool PERM = true, AFTER_DRAIN = false;
    bf16_t* O; int ldc; const float* rs;
    __device__ __forceinline__ void operator()(const f32x4 (&acc)[2][2][4][2], const Unit& u, int wr, int wc, int fr, int fq) const {
        const int row0 = u.pm * BM + wr * 64 + fr, col0 = u.pn * BM + wc * 32 + 8 * fq;
#pragma unroll
        for (int ai = 0; ai < 2; ++ai)
#pragma unroll
            for (int m = 0; m < 4; ++m) { const int r = row0 + ai * HALF + m * 16; const float s = rs[r]; bf16_t* rowp = O + (size_t)r * ldc + col0;
#pragma unroll
                for (int bj = 0; bj < 2; ++bj) { const f32x4 v0 = acc[ai][bj][m][0] * s, v1 = acc[ai][bj][m][1] * s;
                    u32x4 w; w.x = cvt_pk_bf16(v0[0], v0[1]); w.y = cvt_pk_bf16(v0[2], v0[3]); w.z = cvt_pk_bf16(v1[0], v1[1]); w.w = cvt_pk_bf16(v1[2], v1[3]);
                    *(u32x4*)(rowp + bj * HALF) = w; } }
    }
};
struct EpiRes {
    static constexpr bool PERM = true, AFTER_DRAIN = false;
    const float* base; float* outf; bf16_t* outb; float* ss; int ldc;
    __device__ __forceinline__ void operator()(const f32x4 (&acc)[2][2][4][2], const Unit& u, int wr, int wc, int fr, int fq) const {
        const int row0 = u.pm * BM + wr * 64 + fr, col0 = u.pn * BM + wc * 32 + 8 * fq;
#pragma unroll
        for (int ai = 0; ai < 2; ++ai)
#pragma unroll
            for (int m = 0; m < 4; ++m) { const int r = row0 + ai * HALF + m * 16; float q = 0.f;
#pragma unroll
                for (int bj = 0; bj < 2; ++bj) { const size_t off = (size_t)r * ldc + col0 + bj * HALF;
                    f32x4 v0 = acc[ai][bj][m][0], v1 = acc[ai][bj][m][1];
                    if (base) { v0 += *(const f32x4*)(base + off); v1 += *(const f32x4*)(base + off + 4); }
                    if (outf) { *(f32x4*)(outf + off) = v0; *(f32x4*)(outf + off + 4) = v1; }
                    u32x4 w; w.x = cvt_pk_bf16(v0[0], v0[1]); w.y = cvt_pk_bf16(v0[2], v0[3]); w.z = cvt_pk_bf16(v1[0], v1[1]); w.w = cvt_pk_bf16(v1[2], v1[3]);
                    *(u32x4*)(outb + off) = w;
                    q += (v0[0] * v0[0] + v0[1] * v0[1]) + (v0[2] * v0[2] + v0[3] * v0[3]) + (v1[0] * v1[0] + v1[1] * v1[1]) + (v1[2] * v1[2] + v1[3] * v1[3]); }
                q += __shfl_xor(q, 16); q += __shfl_xor(q, 32);
                if (fq == 0) atomicAdd(ss + r, q); }
    }
};
struct EpiGate {
    static constexpr bool PERM = true, AFTER_DRAIN = false;
    const float* x2; float* out; const bf16_t* E; const float* ss3; const float* ssE; const float* bpg; const float* peg; int ldc;
    __device__ __forceinline__ void operator()(const f32x4 (&acc)[2][2][4][2], const Unit& u, int wr, int wc, int fr, int fq) const {
        const int row0 = u.pm * BM + wr * 64 + fr, col0 = u.pn * BM + wc * 32 + 8 * fq;
        f32x4 bp[2][2], pg[2][2];
#pragma unroll
        for (int bj = 0; bj < 2; ++bj)
#pragma unroll
            for (int n = 0; n < 2; ++n) { bp[bj][n] = *(const f32x4*)(bpg + col0 + bj * HALF + 4 * n); pg[bj][n] = *(const f32x4*)(peg + col0 + bj * HALF + 4 * n); }
#pragma unroll
        for (int ai = 0; ai < 2; ++ai)
#pragma unroll
            for (int m = 0; m < 4; ++m) { const int r = row0 + ai * HALF + m * 16;
                const float r3 = rsqrtf(ss3[r] * (1.f / 1024.f) + RMS_EPS), rE = rsqrtf(ssE[r] * (1.f / 1024.f) + RMS_EPS);
#pragma unroll
                for (int bj = 0; bj < 2; ++bj) { const size_t off = (size_t)r * ldc + col0 + bj * HALF;
                    const u32x4 ew = *(const u32x4*)(E + off);
                    const float ev[8] = {bf_lo(ew.x), bf_hi(ew.x), bf_lo(ew.y), bf_hi(ew.y), bf_lo(ew.z), bf_hi(ew.z), bf_lo(ew.w), bf_hi(ew.w)};
#pragma unroll
                    for (int n = 0; n < 2; ++n) { const f32x4 xv = *(const f32x4*)(x2 + off + 4 * n); f32x4 o;
#pragma unroll
                        for (int i = 0; i < 4; ++i) { const float z = acc[ai][bj][m][n][i] * r3 + bp[bj][n][i]; const float g = 1.f / (1.f + __expf(-z));
                            o[i] = xv[i] + g * (ev[4 * n + i] * rE * pg[bj][n][i]); }
                        *(f32x4*)(out + off + 4 * n) = o; } } }
    }
};
struct EpiUp {
    static constexpr bool PERM = true, AFTER_DRAIN = false;
    bf16_t* act; const float* ss2; const float* cw; const float* cb; PG8_LAS float* xch;
    __device__ __forceinline__ void operator()(f32x4 (&acc)[2][2][4][2], const Unit& u, int wr, int wc, int fr, int fq) const {
        constexpr int FF = 2816, MROWS = 16384;
#pragma unroll
        for (int ai = 0; ai < 2; ++ai)
#pragma unroll
            for (int m = 0; m < 4; ++m) { const int gr = u.arow + ai * HALF + wr * 64 + m * 16 + fr;
                const float s = (gr >= 0 && gr < MROWS) ? rsqrtf(ss2[gr] * (1.f / 1024.f) + RMS_EPS) : 0.f;
#pragma unroll
                for (int bj = 0; bj < 2; ++bj)
#pragma unroll
                    for (int n = 0; n < 2; ++n) acc[ai][bj][m][n] *= s; }
        const int cl0 = wc * 32 + 8 * fq;
        if (fr >= 14) {
#pragma unroll
            for (int ai = 0; ai < 2; ++ai)
#pragma unroll
                for (int bj = 0; bj < 2; ++bj)
#pragma unroll
                    for (int n = 0; n < 2; ++n) *(PG8_LAS f32x4*)(xch + ((ai * 2 + wr) * 2 + (fr - 14)) * 256 + bj * HALF + cl0 + 4 * n) = acc[ai][bj][3][n];
        }
        asm volatile("s_waitcnt lgkmcnt(0)\n\ts_barrier" ::: "memory");
        const int ch0 = u.pn * HALF + cl0;
#pragma unroll
        for (int n = 0; n < 2; ++n) {
            f32x4 w0[2], w1[2], w2[2], bb[2];
#pragma unroll
            for (int bj = 0; bj < 2; ++bj) { const int c = bj * FF + ch0 + 4 * n;
                w0[bj] = *(const f32x4*)(cw + c); w1[bj] = *(const f32x4*)(cw + 2 * FF + c); w2[bj] = *(const f32x4*)(cw + 4 * FF + c); bb[bj] = *(const f32x4*)(cb + c); }
#pragma unroll
            for (int ai = 0; ai < 2; ++ai) {
                const int g = ai * 2 + wr;
#pragma unroll
                for (int m = 0; m < 4; ++m) {
                    const int rt = ai * HALF + wr * 64 + m * 16 + fr, gr = u.arow + rt, t = gr & 2047;
                    f32x4 cv[2];
#pragma unroll
                    for (int bj = 0; bj < 2; ++bj) {
                        const f32x4 cur = acc[ai][bj][m][n]; f32x4 prev;
                        if (m > 0) prev = acc[ai][bj][m - 1][n];
                        else { prev = (f32x4){0.f, 0.f, 0.f, 0.f}; if (g > 0 && fr >= 14) prev = *(const PG8_LAS f32x4*)(xch + ((g - 1) * 2 + (fr - 14)) * 256 + bj * HALF + cl0 + 4 * n); }
                        f32x4 p1, p2;
#pragma unroll
                        for (int i = 0; i < 4; ++i) {
                            const float r1 = dpp_mov<0x121>(0.f, prev[i]), r2 = dpp_mov<0x122>(0.f, prev[i]);
                            p1[i] = dpp_mov<0x111>(r1, cur[i]); p2[i] = dpp_mov<0x112>(r2, cur[i]);
                        }
                        if (t == 0) { p1 = (f32x4){0.f, 0.f, 0.f, 0.f}; }
                        if (t <= 1) { p2 = (f32x4){0.f, 0.f, 0.f, 0.f}; }
                        cv[bj] = bb[bj] + w2[bj] * cur + w1[bj] * p1 + w0[bj] * p2;
                    }
                    float a4[4];
#pragma unroll
                    for (int i = 0; i < 4; ++i) { const float gv = cv[0][i]; a4[i] = gv / (1.f + __expf(-gv)) * cv[1][i]; }
                    u32x2 w; w.x = cvt_pk_bf16(a4[0], a4[1]); w.y = cvt_pk_bf16(a4[2], a4[3]);
                    if (rt >= 2 && gr < MROWS) *(u32x2*)(act + (size_t)gr * FF + ch0 + 4 * n) = w;
                }
            }
        }
    }
};
}
#include <hip/hip_bf16.h>
#include <cmath>
namespace attn_body {
using bf16=__hip_bfloat16;
using bf16x8=__attribute__((ext_vector_type(8)))short;
using s16x4=__attribute__((ext_vector_type(4)))short;
using f32x16=__attribute__((ext_vector_type(16)))float;
using u32x4=__attribute__((ext_vector_type(4)))unsigned;
constexpr int BATCH=8,NHEAD=8,SEQ=2048,D=64,DM=3072,OM=1024;
constexpr int NW=8,QBLK=32,QB=QBLK*NW,KVBLK=64,NQB=SEQ/QB;
constexpr int ATTN_PITCH=DM, ATTN_UNIT_ROWS=QB;
__device__ __forceinline__ int crow(int r,int hi){return (r&3)+8*(r>>2)+4*hi;}
#define SBAR() __builtin_amdgcn_sched_barrier(0)
__device__ __forceinline__ void cmask(f32x16&p0,f32x16&p1,int jb,int qrel,int hi){
  const float NEG=-INFINITY; int kb=64*jb+4*hi;
  #pragma unroll
  for(int r=0;r<16;++r){int kv=kb+(r&3)+8*(r>>2); if(kv>qrel)p0[r]=NEG; if(kv+32>qrel)p1[r]=NEG;}
}

constexpr int NSLOT=3, SLOTB=8192;
constexpr int LDS_K=0, LDS_V=NSLOT*SLOTB, LDS_WS=2*NSLOT*SLOTB, LDS_OST=LDS_WS+NW*64*4, LDS_CB=LDS_OST+NW*4096, LDS_BYTES=LDS_CB+8192;
constexpr float C2=0.125f*1.4426950408889634f;
__device__ __forceinline__ void glds16(const void*gsrc,unsigned lds_dst){unsigned keep;
  asm volatile("s_mov_b32 %0, m0\n\ts_mov_b32 m0, %2\n\ts_nop 0\n\tglobal_load_lds_dwordx4 %1, off\n\ts_mov_b32 m0, %0":"=&s"(keep):"v"(gsrc),"s"(lds_dst):"memory");}
__device__ __forceinline__ float max3f(float a,float b,float c){float r;asm("v_max3_f32 %0, %1, %2, %3":"=v"(r):"v"(a),"v"(b),"v"(c));return r;}
__device__ __forceinline__ float max2f(float a,float b){float r;asm("v_max_f32_e32 %0, %1, %2":"=v"(r):"v"(a),"v"(b));return r;}
__device__ __forceinline__ float fadd_s(float a,float b){float r;asm("v_add_f32_e32 %0, %1, %2":"=v"(r):"v"(a),"v"(b));return r;}
__device__ __forceinline__ float fsub_s(float a,float b){float r;asm("v_sub_f32_e32 %0, %1, %2":"=v"(r):"v"(a),"v"(b));return r;}
typedef float f32x2_t __attribute__((ext_vector_type(2))); typedef __bf16 bf16x2_t __attribute__((ext_vector_type(2)));
__device__ __forceinline__ unsigned cvtpk_s(float lo,float hi){f32x2_t v={lo,hi};bf16x2_t b=__builtin_convertvector(v,bf16x2_t);return __builtin_bit_cast(unsigned,b);}
#define WAIT_BAR(N) asm volatile("s_waitcnt vmcnt(" #N ") lgkmcnt(0)\n\ts_barrier":::"memory")

__device__ __forceinline__ void qkt(f32x16&p0,f32x16&p1,const char*Kslot,const bf16x8*qr,const f32x16&negm,int r32,int hi){
  const char*kb=Kslot+hi*1024+r32*16;
  #pragma unroll
  for(int d0=0;d0<4;++d0){
    const bf16x8 b0=*reinterpret_cast<const bf16x8*>(kb+d0*2048);
    const bf16x8 b1=*reinterpret_cast<const bf16x8*>(kb+d0*2048+512);
    if(d0==0){p0=__builtin_amdgcn_mfma_f32_32x32x16_bf16(b0,qr[0],negm,0,0,0);p1=__builtin_amdgcn_mfma_f32_32x32x16_bf16(b1,qr[0],negm,0,0,0);}
    else{p0=__builtin_amdgcn_mfma_f32_32x32x16_bf16(b0,qr[d0],p0,0,0,0);p1=__builtin_amdgcn_mfma_f32_32x32x16_bf16(b1,qr[d0],p1,0,0,0);}}
}
typedef __attribute__((address_space(3))) const char* lds_cptr;
typedef short v4i16_t __attribute__((ext_vector_type(4)));
__device__ __forceinline__ void kload8(bf16x8*kf,lds_cptr kp){
  kf[0]=*(const __attribute__((address_space(3))) bf16x8*)(kp);      kf[1]=*(const __attribute__((address_space(3))) bf16x8*)(kp+512);
  kf[2]=*(const __attribute__((address_space(3))) bf16x8*)(kp+2048); kf[3]=*(const __attribute__((address_space(3))) bf16x8*)(kp+2560);
  kf[4]=*(const __attribute__((address_space(3))) bf16x8*)(kp+4096); kf[5]=*(const __attribute__((address_space(3))) bf16x8*)(kp+4608);
  kf[6]=*(const __attribute__((address_space(3))) bf16x8*)(kp+6144); kf[7]=*(const __attribute__((address_space(3))) bf16x8*)(kp+6656);
}
__device__ __forceinline__ void kload2(bf16x8*kf,lds_cptr kp,int j){ kf[2*j]=*(const __attribute__((address_space(3))) bf16x8*)(kp+j*2048); kf[2*j+1]=*(const __attribute__((address_space(3))) bf16x8*)(kp+j*2048+512); }
__device__ __forceinline__ s16x4 vtr(lds_cptr p){ return __builtin_bit_cast(s16x4,__builtin_amdgcn_ds_read_tr16_b64_v4i16((__attribute__((address_space(3))) v4i16_t*)p)); }
__device__ __forceinline__ float rowmax(const f32x16&p0,const f32x16&p1){
  float a=max3f(p0[0],p0[1],p1[0]),b=max3f(p0[2],p0[3],p1[1]);a=max3f(a,p1[2],p1[3]);
  #pragma unroll
  for(int r=4;r<16;r+=4){a=max3f(a,p0[r],p0[r+1]);b=max3f(b,p0[r+2],p0[r+3]);a=max3f(a,p1[r],p1[r+1]);b=max3f(b,p1[r+2],p1[r+3]);}
  const float m=max2f(a,b);
  auto rr=__builtin_amdgcn_permlane32_swap(__float_as_uint(m),__float_as_uint(m),false,false);
  return max2f(__uint_as_float(rr[0]),__uint_as_float(rr[1]));
}
__device__ __forceinline__ void pv(f32x16*o,int vb,bf16x8 pa0,bf16x8 pa1,bf16x8 pa2,bf16x8 pa3){
  #pragma unroll
  for(int d0=0;d0<2;++d0){s16x4 lo[4],hi[4];
    #pragma unroll
    for(int ks=0;ks<4;++ks){
      asm volatile("ds_read_b64_tr_b16 %0,%1 offset:%c2":"=&v"(lo[ks]):"v"(vb),"i"(d0*4096+ks*1024):"memory");
      asm volatile("ds_read_b64_tr_b16 %0,%1 offset:%c2":"=&v"(hi[ks]):"v"(vb),"i"(d0*4096+ks*1024+512):"memory");}
    asm volatile("s_waitcnt lgkmcnt(0)":::"memory");SBAR();
    #define PK(k) (bf16x8){lo[k][0],lo[k][1],lo[k][2],lo[k][3],hi[k][0],hi[k][1],hi[k][2],hi[k][3]}
    o[d0]=__builtin_amdgcn_mfma_f32_32x32x16_bf16(pa0,PK(0),o[d0],0,0,0);
    o[d0]=__builtin_amdgcn_mfma_f32_32x32x16_bf16(pa1,PK(1),o[d0],0,0,0);
    o[d0]=__builtin_amdgcn_mfma_f32_32x32x16_bf16(pa2,PK(2),o[d0],0,0,0);
    o[d0]=__builtin_amdgcn_mfma_f32_32x32x16_bf16(pa3,PK(3),o[d0],0,0,0);
    #undef PK
  }
}

#ifndef ATTN_STORE16
#define ATTN_STORE16(p,v) (*(u32x4*)(p)=(v))
#endif
template<int THRL> __device__ __forceinline__ void attn_unit(int b,int h,int qb,const bf16*Q,const bf16*__restrict__ K,const bf16*__restrict__ V,bf16*O,const float*__restrict__ CB,char*shm){
  const int tid=threadIdx.x,lane=tid&63,r32=lane&31,hi=lane>>5; const int wid=__builtin_amdgcn_readfirstlane(tid>>6);
  const long rowbase=(long)b*SEQ; const int q0=qb*QB;
  const bf16*Qw=Q+(rowbase+q0+wid*QBLK)*DM+h*D;
  const bf16*Kh=K+rowbase*DM+h*D,*Vh=V+rowbase*DM+h*D;
  const lds_cptr shm3=(lds_cptr)shm; const unsigned lds0=(unsigned)(uintptr_t)shm;
  float*wsf=(float*)(shm+LDS_WS)+wid*64;
  const bf16*ksrc=Kh+(long)lane*DM+wid*8;
  const bf16*vsrc=Vh+(long)(16*(wid&3)+(lane>>2))*DM+(wid>>2)*32+(lane&3)*8;
  const unsigned kdst=lds0+LDS_K+wid*1024, vdst=lds0+LDS_V+wid*1024;
  #define DMA_K(t,slot) glds16(ksrc+(long)(t)*KVBLK*DM,(unsigned)__builtin_amdgcn_readfirstlane(kdst+(slot)))
  #define DMA_V(t,slot) glds16(vsrc+(long)(t)*KVBLK*DM,(unsigned)__builtin_amdgcn_readfirstlane(vdst+(slot)))
  const int vb0=(int)(lds0+LDS_V)+((lane>>4)&1)*32+(lane&3)*8+(4*hi+((lane&15)>>2))*64;
  const char*Kbase=shm+LDS_K; bf16x8 kf[8];
  const lds_cptr kp0=shm3+LDS_K+hi*1024+r32*16; const lds_cptr vp0=shm3+LDS_V+((lane>>4)&1)*32+(lane&3)*8+(4*hi+((lane&15)>>2))*64;
  const int NT=(q0+QB)/KVBLK;
  typedef __attribute__((address_space(3))) float* lds_fptr; typedef float f32x4_t __attribute__((ext_vector_type(4)));
  const lds_fptr cbl=(lds_fptr)(shm3+LDS_CB);
  { const float*cg_=CB+(long)(b*NHEAD+h)*SEQ; const float cref=cg_[q0];
    for(int i_=tid;i_<(q0+QB)/4;i_+=NW*64){ f32x4_t v_=*(const f32x4_t*)(cg_+4*i_); v_-=cref; *(__attribute__((address_space(3))) f32x4_t*)(cbl+4*i_)=v_; } }
  #define BIAS(P0,P1,t) do{ const lds_fptr cp_=cbl+64*(t)+4*hi; \
    _Pragma("unroll") for(int g_=0;g_<4;++g_){ { const f32x4_t c0_=*(const __attribute__((address_space(3))) f32x4_t*)(cp_+8*g_)+mhat; \
      _Pragma("unroll") for(int i_=0;i_<4;++i_){ P0[4*g_+i_]-=c0_[i_]; } } asm volatile("":::"memory"); \
      { const f32x4_t c1_=*(const __attribute__((address_space(3))) f32x4_t*)(cp_+32+8*g_)+mhat; \
      _Pragma("unroll") for(int i_=0;i_<4;++i_){ P1[4*g_+i_]-=c1_[i_]; } } asm volatile("":::"memory"); } }while(0)
  DMA_K(0,0);DMA_V(0,0);DMA_K(1,SLOTB);
  bf16x8 qr[4];
  #pragma unroll
  for(int d0=0;d0<4;++d0)qr[d0]=*reinterpret_cast<const bf16x8*>(&Qw[(long)r32*DM+d0*16+hi*8]);
  float mhat=0.f,l_reg=0.f;f32x16 o[2];o[0]=f32x16{};o[1]=f32x16{};f32x16 negm=f32x16{}; const f32x16 zero16=f32x16{};
  const int qrel=wid*QBLK+r32;
  #define CMASK(P0,P1,t) do{int jb_=(t)-(NT-4); if(jb_>=0)cmask(P0,P1,jb_,qrel,hi);}while(0)
  bool resc=false;
  #define START(P0,P1) do{ const float rm=rowmax(P0,P1); resc=false; \
    { const float dl=rm; mhat=fadd_s(mhat,dl); \
      _Pragma("unroll") for(int r=0;r<16;++r){P0[r]=fsub_s(P0[r],dl);P1[r]=fsub_s(P1[r],dl);} \
      _Pragma("unroll") for(int r=0;r<16;++r)negm[r]=-mhat;  } \
    _Pragma("unroll") for(int r=0;r<16;++r)P0[r]=__builtin_amdgcn_exp2f(P0[r]); }while(0)
  #define RESC() do{ if(resc){ asm volatile("s_waitcnt lgkmcnt(0)":::"memory"); \
      _Pragma("unroll") for(int d_=0;d_<2;++d_) _Pragma("unroll") for(int r=0;r<16;++r)o[d_][r]*=wsf[crow(r,hi)]; } }while(0)
  f32x16 pA0,pA1,pB0,pB1;
  int sl_prev=0,sl_cur=0,sl_next=SLOTB;
  #define ROT() do{sl_prev=sl_cur;sl_cur=sl_next;sl_next=(sl_next==(NSLOT-1)*SLOTB)?0:sl_next+SLOTB;}while(0)
  DMA_K(2,2*SLOTB);
  WAIT_BAR(3);
  qkt(pA0,pA1,Kbase,qr,zero16,r32,hi);asm volatile("s_nop 15\n\ts_nop 7":"+v"(pA0),"+v"(pA1));BIAS(pA0,pA1,0);CMASK(pA0,pA1,0);
  START(pA0,pA1);
  _Pragma("unroll") for(int r=0;r<16;++r)pA1[r]=__builtin_amdgcn_exp2f(pA1[r]);
  WAIT_BAR(0);
  DMA_K(3,0);DMA_V(1,SLOTB);
  ROT();
  kload8(kf,kp0+sl_cur);
  WAIT_BAR(2);
  s16x4 vlo[8],vhi[8]; u32x4 pw0,pw1,pw2,pw3;
  #define PKW(P,B) cvtpk_s(P[B],P[B+1])
  #define PAF(k) __builtin_bit_cast(bf16x8,pw##k)
  #define VFR(i) (bf16x8){vlo[i][0],vlo[i][1],vlo[i][2],vlo[i][3],vhi[i][0],vhi[i][1],vhi[i][2],vhi[i][3]}
  #define PIN(x) asm volatile("":"+v"(x))
  #define MX3(a,b,c) __builtin_fmaxf(__builtin_fmaxf((a),(b)),(c))
  #define GAPA(MF,A0,A1,A2,A3,W0,W1,PW) do{ MF; sacc+=A0; sacc+=A1; sacc+=A2; sacc+=A3; PIN(sacc); W0; W1; PIN(PW); SBAR(); }while(0)
  #define EX(v) __builtin_amdgcn_exp2f(v)
  #define GAPB(MF,X,B) do{ MF; X[B]=EX(X[B]); X[B+1]=EX(X[B+1]); X[B+2]=EX(X[B+2]); X[B+3]=EX(X[B+3]); PIN(X); SBAR(); }while(0)
  #define VRD(i) do{ vlo[i]=vtr(vp_+(((i)>>2)*4096+((i)&3)*1024)); vhi[i]=vtr(vp_+(((i)>>2)*4096+((i)&3)*1024+512)); }while(0)
  #define KRD(G,j) do{ if(G){ kload2(kf,kp0+sl_next,j); SBAR(); } }while(0)
  #define STEP(C0,C1,P0,P1,t,GK,GV,GL) do{ SBAR(); \
    const lds_cptr vp_=vp0+sl_prev; \
    VRD(0); SBAR(); float sacc=(P0[0]+P0[1]); \
    GAPA(C0=__builtin_amdgcn_mfma_f32_32x32x16_bf16(kf[0],qr[0],zero16,0,0,0), P0[2],P0[3],P0[4],P0[5],     pw0[0]=PKW(P0,0), pw0[1]=PKW(P0,2), pw0); \
    VRD(4); SBAR(); GAPA(C1=__builtin_amdgcn_mfma_f32_32x32x16_bf16(kf[1],qr[0],zero16,0,0,0), P0[6],P0[7],P0[8],P0[9],     pw0[2]=PKW(P0,4), pw0[3]=PKW(P0,6), pw0); \
    VRD(1); SBAR(); GAPA(C0=__builtin_amdgcn_mfma_f32_32x32x16_bf16(kf[2],qr[1],C0,0,0,0),   P0[10],P0[11],P0[12],P0[13], pw1[0]=PKW(P0,8), pw1[1]=PKW(P0,10), pw1); \
    VRD(5); SBAR(); GAPA(C1=__builtin_amdgcn_mfma_f32_32x32x16_bf16(kf[3],qr[1],C1,0,0,0),   P0[14],P0[15],P1[0],P1[1],   pw1[2]=PKW(P0,12),pw1[3]=PKW(P0,14), pw1); \
    VRD(2); SBAR(); GAPA(C0=__builtin_amdgcn_mfma_f32_32x32x16_bf16(kf[4],qr[2],C0,0,0,0),   P1[2],P1[3],P1[4],P1[5],     pw2[0]=PKW(P1,0), pw2[1]=PKW(P1,2), pw2); \
    VRD(6); SBAR(); GAPA(C1=__builtin_amdgcn_mfma_f32_32x32x16_bf16(kf[5],qr[2],C1,0,0,0),   P1[6],P1[7],P1[8],P1[9],     pw2[2]=PKW(P1,4), pw2[3]=PKW(P1,6), pw2); \
    VRD(3); SBAR(); GAPA(C0=__builtin_amdgcn_mfma_f32_32x32x16_bf16(kf[6],qr[3],C0,0,0,0),   P1[10],P1[11],P1[12],P1[13], pw3[0]=PKW(P1,8), pw3[1]=PKW(P1,10), pw3); \
    VRD(7); SBAR(); GAPA(C1=__builtin_amdgcn_mfma_f32_32x32x16_bf16(kf[7],qr[3],C1,0,0,0),   P1[14],P1[15],0.f,0.f,       pw3[2]=PKW(P1,12),pw3[3]=PKW(P1,14), pw3); \
    l_reg+=sacc; \
    if(GK){DMA_K((t)+3,sl_cur);} if(GV){DMA_V((t)+1,sl_next);} \
    BIAS(C0,C1,t); CMASK(C0,C1,t); \
    { float a=MX3(C0[0],C0[1],C1[0]),b=MX3(C0[2],C0[3],C1[1]); a=MX3(a,C1[2],C1[3]); \
      _Pragma("unroll") for(int r=4;r<16;r+=4){a=MX3(a,C0[r],C0[r+1]);b=MX3(b,C0[r+2],C0[r+3]);a=MX3(a,C1[r],C1[r+1]);b=MX3(b,C1[r+2],C1[r+3]);} \
      float rm=__builtin_fmaxf(a,b); { auto rr=__builtin_amdgcn_permlane32_swap(__float_as_uint(rm),__float_as_uint(rm),false,false); rm=__builtin_fmaxf(__uint_as_float(rr[0]),__uint_as_float(rr[1])); } \
      resc=false; \
      if(__builtin_expect(__any(rm>(float)THRL),0)){ const float dl=__builtin_fmaxf(rm,0.f); mhat+=dl; \
        _Pragma("unroll") for(int r=0;r<16;++r){C0[r]-=dl;C1[r]-=dl;} \
        _Pragma("unroll") for(int r=0;r<16;++r)negm[r]=-mhat;  \
        const float f=__builtin_amdgcn_exp2f(-dl); l_reg*=f; if(hi==0)wsf[r32]=f; resc=true; } } \
    SBAR(); \
    GAPB(o[0]=__builtin_amdgcn_mfma_f32_32x32x16_bf16(PAF(0),VFR(0),o[0],0,0,0), C0,0); \
    GAPB(o[1]=__builtin_amdgcn_mfma_f32_32x32x16_bf16(PAF(0),VFR(4),o[1],0,0,0), C0,4); \
    KRD(GL,0); GAPB(o[0]=__builtin_amdgcn_mfma_f32_32x32x16_bf16(PAF(1),VFR(1),o[0],0,0,0), C0,8); \
    KRD(GL,1); GAPB(o[1]=__builtin_amdgcn_mfma_f32_32x32x16_bf16(PAF(1),VFR(5),o[1],0,0,0), C0,12); \
    KRD(GL,2); GAPB(o[0]=__builtin_amdgcn_mfma_f32_32x32x16_bf16(PAF(2),VFR(2),o[0],0,0,0), C1,0); \
    KRD(GL,3); GAPB(o[1]=__builtin_amdgcn_mfma_f32_32x32x16_bf16(PAF(2),VFR(6),o[1],0,0,0), C1,4); \
    GAPB(o[0]=__builtin_amdgcn_mfma_f32_32x32x16_bf16(PAF(3),VFR(3),o[0],0,0,0), C1,8); \
    GAPB(o[1]=__builtin_amdgcn_mfma_f32_32x32x16_bf16(PAF(3),VFR(7),o[1],0,0,0), C1,12); \
    }while(0)
  int t=1;
  #undef CMASK
  #define CMASK(P0,P1,t) do{}while(0)
  for(;t+5<NT;t+=2){
    STEP(pB0,pB1,pA0,pA1,t,true,true,true);     WAIT_BAR(2); RESC(); ROT();
    STEP(pA0,pA1,pB0,pB1,t+1,true,true,true);   WAIT_BAR(2); RESC(); ROT();
  }
  #undef CMASK
  #define CMASK(P0,P1,t) do{int jb_=(t)-(NT-4); if(jb_>=0)cmask(P0,P1,jb_,qrel,hi);}while(0)
  #define ENDW(tt) do{ if((tt)+3<NT){WAIT_BAR(2);} else if((tt)+2<NT){WAIT_BAR(1);} else {WAIT_BAR(0);} }while(0)
  for(;t+1<NT;t+=2){
    STEP(pB0,pB1,pA0,pA1,t,(t+3<NT),(t+1<NT),(t+1<NT));       ENDW(t);   RESC(); ROT();
    STEP(pA0,pA1,pB0,pB1,t+1,(t+4<NT),(t+2<NT),(t+2<NT));     ENDW(t+1); RESC(); ROT();
  }
  STEP(pB0,pB1,pA0,pA1,NT-1,false,false,false); RESC();
  { float sacc=pB0[0]+pB0[1]; _Pragma("unroll") for(int r=2;r<16;++r)sacc+=pB0[r]; _Pragma("unroll") for(int r=0;r<16;++r)sacc+=pB1[r]; l_reg+=sacc;
    pw0=(u32x4){PKW(pB0,0),PKW(pB0,2),PKW(pB0,4),PKW(pB0,6)};pw1=(u32x4){PKW(pB0,8),PKW(pB0,10),PKW(pB0,12),PKW(pB0,14)};pw2=(u32x4){PKW(pB1,0),PKW(pB1,2),PKW(pB1,4),PKW(pB1,6)};pw3=(u32x4){PKW(pB1,8),PKW(pB1,10),PKW(pB1,12),PKW(pB1,14)};
    SBAR(); pv(o,vb0+sl_cur,PAF(0),PAF(1),PAF(2),PAF(3)); }
  #undef PKW
  #undef PAF
  #undef VFR
  #undef PIN
  #undef MX3
  #undef GAPA
  #undef GAPB
  #undef EX
  #undef VRD
  #undef KRD
  #undef STEP
  #undef ENDW
  {auto rr=__builtin_amdgcn_permlane32_swap(__float_as_uint(l_reg),__float_as_uint(l_reg),false,false);l_reg=__uint_as_float(rr[0])+__uint_as_float(rr[1]);}
  if(hi==0)wsf[32+r32]=l_reg;asm volatile("s_waitcnt lgkmcnt(0)":::"memory");
  float rli[16];
  #pragma unroll
  for(int r=0;r<16;++r)rli[r]=__builtin_amdgcn_rcpf(wsf[32+crow(r,hi)]);
  bf16*Ow=O+(rowbase+q0+wid*QBLK)*OM+h*D;
  { bf16*stg=(bf16*)(shm+LDS_OST)+wid*2048;
    #pragma unroll
    for(int r=0;r<16;++r){const int orow=crow(r,hi);
      #pragma unroll
      for(int d0=0;d0<2;++d0)stg[orow*64+d0*32+r32]=__float2bfloat16(o[d0][r]*rli[r]);}
    asm volatile("s_waitcnt lgkmcnt(0)":::"memory");
    #pragma unroll
    for(int i=0;i<4;++i){const int row=i*8+(lane>>3),ch=lane&7; const u32x4 v=*(const u32x4*)(stg+row*64+ch*8); ATTN_STORE16(Ow+(long)row*OM+ch*8,v);} }
  asm volatile("s_waitcnt lgkmcnt(0)\n\ts_barrier":::"memory");
  #undef DMA_K
  #undef DMA_V
  #undef CMASK
  #undef START
  #undef RESC
  #undef ROT
  #undef BIAS
}
constexpr int ATTN_LDS_BYTES=LDS_BYTES;
struct AttnTensors { const bf16* Q; const bf16* K; const bf16* V; bf16* O; const float* CB; };
struct AttnUnit { int bh; int qb; };
struct StaticOrder {
  int vcu,G;
  __device__ __forceinline__ explicit StaticOrder(int grid,int v):vcu(v),G(grid){}
  __device__ __forceinline__ bool next(int i,AttnUnit&u)const{ const int p=vcu+(i>>1)*G; if(p>=256)return false; const int s=p&3; u.bh=p>>2; u.qb=(i&1)?7-s:s; return true; }
  __device__ __forceinline__ void a_ready(const AttnUnit&)const{}
  __device__ __forceinline__ void done(const AttnUnit&)const{}
};
template<class Sched,int THRL=8> __device__ __forceinline__ void attn_phase(char*lds,const AttnTensors&T,const Sched&S){
  AttnUnit u;
  for(int i=0;S.next(i,u);++i){ S.a_ready(u); attn_unit<THRL>(u.bh/NHEAD,u.bh%NHEAD,u.qb,T.Q,T.K,T.V,T.O,T.CB,lds); S.done(u); }
}
#undef SBAR
#undef WAIT_BAR
}
#define LAS __attribute__((address_space(3)))
namespace mk {
typedef unsigned short bf16;
typedef unsigned u32x4 __attribute__((ext_vector_type(4)));
typedef unsigned u32x2 __attribute__((ext_vector_type(2)));
typedef float f32x4 __attribute__((ext_vector_type(4)));
typedef float f32x2 __attribute__((ext_vector_type(2)));
typedef float f32x16 __attribute__((ext_vector_type(16)));
typedef short bf16x8 __attribute__((ext_vector_type(8)));
constexpr int NWAVES = 8, NT = 512;
constexpr int M = 16384, SEQ = 2048, DM = 1024, INW = 3096, PROJW = 3072, FF = 2816, PLE = 256;
constexpr float EPS = 1e-6f, LOG2E = 1.4426950408889634f, C2 = 0.125f * LOG2E;
constexpr size_t MiB = 1u << 20;
constexpr size_t WS_WIN = 1 * MiB, WS_WSK = 7 * MiB, WS_WO = 8 * MiB, WS_WUP = 10 * MiB, WS_WD = 21 * MiB, WS_WPG = 27 * MiB, WS_WPE = 29 * MiB;
constexpr size_t WS_SMALL = 30 * MiB;
constexpr size_t WS_LRF = 31 * MiB, WS_PB = 33 * MiB, WS_QE = 41 * MiB, WS_XB = 50 * MiB  , WS_MIX = 83 * MiB, WS_PROJ = 115 * MiB, WS_END = 211 * MiB;
constexpr size_t WS_SPREV = WS_XB, WS_E = WS_MIX, WS_ACT = WS_PROJ;
constexpr int LDS_BYTES = 147456, XCH_OFF = 131072;

__device__ __forceinline__ unsigned f2bf(float f) { unsigned u = __builtin_bit_cast(unsigned, f); return (u + 0x7fffu + ((u >> 16) & 1u)) >> 16; }
__device__ __forceinline__ unsigned pk2(float lo, float hi) { return f2bf(lo) | (f2bf(hi) << 16); }
__device__ __forceinline__ float bf2f(unsigned short h) { return __builtin_bit_cast(float, (unsigned)h << 16); }
__device__ __forceinline__ float bflo(unsigned w) { return __builtin_bit_cast(float, w << 16); }
__device__ __forceinline__ float bfhi(unsigned w) { return __builtin_bit_cast(float, w & 0xffff0000u); }
__device__ __forceinline__ float logsig(float z) { return fminf(z, 0.f) - log1pf(__expf(-fabsf(z))); }
__device__ __forceinline__ int crow(int r, int hi) { return (r & 3) + 8 * (r >> 2) + 4 * hi; }
__device__ __forceinline__ float wave_sum(float v) {
#pragma unroll
    for (int o = 1; o < 64; o <<= 1) v += __shfl_xor(v, o);
    return v;
}
#define LDS_WAIT() asm volatile("s_waitcnt lgkmcnt(0)" ::: "memory")

struct Args { const float* in[21]; float* out; unsigned char* ws; };

__device__ __forceinline__ void tr_item(const float* W, int ldw, int k0, int srccol, const float* gain, bf16* WT, int ldk, int dstrow0, LAS float* scr, int lane) {
#pragma unroll 8
    for (int i = 0; i < 32; ++i) { const int kk = 2 * i + (lane >> 5); float v = srccol >= 0 ? W[(size_t)(k0 + kk) * ldw + srccol] : 0.f; if (gain) v *= gain[k0 + kk]; scr[kk * 33 + (lane & 31)] = v; }
    LDS_WAIT();
    const int c = lane & 7;
#pragma unroll
    for (int j = 0; j < 4; ++j) { const int n = (lane >> 3) + 8 * j; const LAS float* s = scr + (8 * c) * 33 + n;
        u32x4 o; o.x = pk2(s[0 * 33], s[1 * 33]); o.y = pk2(s[2 * 33], s[3 * 33]); o.z = pk2(s[4 * 33], s[5 * 33]); o.w = pk2(s[6 * 33], s[7 * 33]);
        *(u32x4*)(WT + (size_t)(dstrow0 + n) * ldk + k0 + 8 * c) = o; }
    LDS_WAIT();
}

__device__ __forceinline__ void p0_prologue(const Args& a, LAS unsigned char* lds, int vcu, int G, int wave, int lane, int tid) {
    unsigned char* ws = a.ws;
    LAS float* scr = (LAS float*)(lds + wave * 16384);
    const int gw = vcu * NWAVES + wave, NGW = G * NWAVES;
    constexpr int I_IN = 16 * 96, I_SK = 16, I_O = 16 * 32, I_UP = 16 * 176, I_D = 44 * 32, I_PG = 16 * 32, I_PE = 4 * 32;
    constexpr int NITEMS = I_IN + I_SK + I_O + I_UP + I_D + I_PG + I_PE;
    for (int it = gw; it < NITEMS; it += NGW) {
        int r = it; const int nl = lane & 31;
        if (r < I_IN) { const int kb = r / 96, nb = r % 96, n0 = 32 * nb; tr_item(a.in[3], INW, 64 * kb, n0 + (n0 >= 1536 ? 16 : 0) + nl, a.in[2], (bf16*)(ws + WS_WIN), DM, n0, scr, lane); continue; } r -= I_IN;
        if (r < I_SK) { const int sc = nl < 16 ? 1536 + nl : (nl < 24 ? 3088 + nl - 16 : -1); tr_item(a.in[3], INW, 64 * r, sc, a.in[2], (bf16*)(ws + WS_WSK), DM, 0, scr, lane); continue; } r -= I_SK;
        if (r < I_O) { const int kb = r / 32, nb = r % 32; tr_item(a.in[10], DM, 64 * kb, 32 * nb + nl, nullptr, (bf16*)(ws + WS_WO), DM, 32 * nb, scr, lane); continue; } r -= I_O;
        if (r < I_UP) { const int kb = r / 176, nb = r % 176, pn = nb >> 3, wi = nb & 7; const int sc0 = wi < 4 ? 128 * pn + 32 * wi : FF + 128 * pn + 32 * (wi - 4);
            tr_item(a.in[12], 2 * FF, 64 * kb, sc0 + nl, a.in[11], (bf16*)(ws + WS_WUP), DM, 32 * nb, scr, lane); continue; } r -= I_UP;
        if (r < I_D) { const int kb = r / 32, nb = r % 32; tr_item(a.in[15], DM, 64 * kb, 32 * nb + nl, nullptr, (bf16*)(ws + WS_WD), FF, 32 * nb, scr, lane); continue; } r -= I_D;
        if (r < I_PG) { const int kb = r / 32, nb = r % 32; tr_item(a.in[19], DM, 64 * kb, 32 * nb + nl, a.in[16], (bf16*)(ws + WS_WPG), DM, 32 * nb, scr, lane); continue; } r -= I_PG;
        { const int kb = r / 32, nb = r % 32; tr_item(a.in[17], DM, 64 * kb, 32 * nb + nl, nullptr, (bf16*)(ws + WS_WPE), PLE, 32 * nb, scr, lane); }
    }
    float* rstd1 = (float*)(ws + WS_SMALL); bf16* xb = (bf16*)(ws + WS_XB); bf16* pb = (bf16*)(ws + WS_PB);
    for (int m = gw; m < M; m += NGW) {
        const f32x4* xr = (const f32x4*)(a.in[0] + (size_t)m * DM) + lane; f32x4 v[4]; float s = 0.f;
#pragma unroll
        for (int j = 0; j < 4; ++j) { v[j] = xr[64 * j]; s += (v[j].x * v[j].x + v[j].y * v[j].y) + (v[j].z * v[j].z + v[j].w * v[j].w); }
        s = wave_sum(s); if (lane == 0) rstd1[m] = rsqrtf(s * (1.f / DM) + EPS);
        u32x2* o8 = (u32x2*)(xb + (size_t)m * DM) + lane;
#pragma unroll
        for (int j = 0; j < 4; ++j) o8[64 * j] = (u32x2){pk2(v[j].x, v[j].y), pk2(v[j].z, v[j].w)};
        const f32x4 pv = *((const f32x4*)(a.in[1] + (size_t)m * PLE) + lane);
        *((u32x2*)(pb + (size_t)m * PLE) + lane) = (u32x2){pk2(pv.x, pv.y), pk2(pv.z, pv.w)};
    }
    float* ssz = (float*)(ws + WS_SMALL) + M;
    for (int i = vcu * NT + tid; i < 3 * M; i += G * NT) ssz[i] = 0.f;
}

__device__ __forceinline__ void p1_skinny(const Args& a, LAS unsigned char* lds, int vcu, int G, int wave, int lane, int tid) {
    const bf16* xb = (const bf16*)(a.ws + WS_XB); const bf16* wsk = (const bf16*)(a.ws + WS_WSK); const float* rstd1 = (const float*)(a.ws + WS_SMALL); float* lrf = (float*)(a.ws + WS_LRF);
    LAS float* red = (LAS float*)lds;
    const int r32 = lane & 31, hi = lane >> 5;
    for (int rg = vcu; rg < M / 64; rg += G) {
        const int row0 = rg * 64; f32x16 acc0 = {}, acc1 = {};
#pragma unroll
        for (int ks = 0; ks < 8; ++ks) { const int k = wave * 128 + ks * 16 + 8 * hi;
            const bf16x8 a0 = *(const bf16x8*)(xb + (size_t)(row0 + r32) * DM + k), a1 = *(const bf16x8*)(xb + (size_t)(row0 + 32 + r32) * DM + k), b = *(const bf16x8*)(wsk + (size_t)r32 * DM + k);
            acc0 = __builtin_amdgcn_mfma_f32_32x32x16_bf16(a0, b, acc0, 0, 0, 0); acc1 = __builtin_amdgcn_mfma_f32_32x32x16_bf16(a1, b, acc1, 0, 0, 0); }
#pragma unroll
        for (int r = 0; r < 16; ++r) { red[(wave * 64 + crow(r, hi)) * 32 + r32] = acc0[r]; red[(wave * 64 + 32 + crow(r, hi)) * 32 + r32] = acc1[r]; }
        __syncthreads();
        { const int row = tid >> 3, c4 = tid & 7; f32x4 s = {0.f, 0.f, 0.f, 0.f};
#pragma unroll
            for (int w = 0; w < 8; ++w) s += *(const LAS f32x4*)(red + (w * 64 + row) * 32 + c4 * 4);
            s *= rstd1[row0 + row]; *(f32x4*)(lrf + (size_t)(row0 + row) * 32 + c4 * 4) = s; }
        __syncthreads();
    }
}

__device__ __forceinline__ bf16x8 ldfrag(const LAS bf16* base, int row, int ks, int hi) { return *(const LAS bf16x8*)(base + row * 72 + ks * 16 + 8 * hi); }
__device__ __forceinline__ void gla_local(const Args& a, LAS unsigned char* lds, int task, int wave, int lane, int tid) {
    unsigned char* ws = a.ws;
    const bf16* proj = (const bf16*)(ws + WS_PROJ); const float* lrf = (const float*)(ws + WS_LRF); bf16* qeg = (bf16*)(ws + WS_QE);
    float* decay = (float*)(ws + WS_SMALL) + 4 * M; float* ointra = a.out; float* dS = a.out + (size_t)M * 512;
    const int bh = task >> 5, n = task & 31, b = bh >> 2, h = bh & 3, tok0 = b * SEQ + n * 64;
    LAS bf16* QE = (LAS bf16*)lds; LAS bf16* KE = QE + 64 * 72; LAS bf16* KDT = KE + 64 * 72; LAS bf16* VT = KDT + 64 * 72; LAS bf16* AT = VT + 128 * 72; LAS float* SEG = (LAS float*)(AT + 64 * 72);
    const int r32 = lane & 31, hi = lane >> 5;
    {
        const int k = tid & 63, seg = tid >> 6;
        float w[16];
#pragma unroll
        for (int j = 0; j < 16; ++j) w[j] = a.in[4][j * 256 + h * 64 + k];
        const float bias = a.in[5][h * 64 + k];
        float bl[8]; float run = 0.f;
#pragma unroll
        for (int i = 0; i < 8; ++i) { const float* lr = lrf + (size_t)(tok0 + seg * 8 + i) * 32; float z = bias;
#pragma unroll
            for (int j = 0; j < 16; ++j) z += lr[j] * w[j];
            run += logsig(z) * (1.f / 16.f); bl[i] = run; }
        SEG[seg * 64 + k] = run; __syncthreads();
        float prefix = 0.f, total = 0.f;
#pragma unroll
        for (int s = 0; s < 8; ++s) { const float v = SEG[s * 64 + k]; total += v; if (s < seg) prefix += v; }
        unsigned short kdh[8];
#pragma unroll
        for (int i = 0; i < 8; ++i) { const int t = seg * 8 + i; const float bb = bl[i] + prefix; const bf16* pr = proj + (size_t)(tok0 + t) * PROJW;
            const float qv = bf2f(pr[h * 64 + k]), kv = bf2f(pr[256 + h * 64 + k]);
            const unsigned short qeb = (unsigned short)f2bf(qv * 0.125f * __expf(bb));
            QE[t * 72 + k] = qeb; KE[t * 72 + k] = (unsigned short)f2bf(kv * __expf(-bb)); qeg[(size_t)(tok0 + t) * 256 + h * 64 + k] = qeb;
            kdh[i] = (unsigned short)f2bf(kv * __expf(total - bb)); }
        u32x4 kp; kp.x = kdh[0] | ((unsigned)kdh[1] << 16); kp.y = kdh[2] | ((unsigned)kdh[3] << 16); kp.z = kdh[4] | ((unsigned)kdh[5] << 16); kp.w = kdh[6] | ((unsigned)kdh[7] << 16);
        *(LAS u32x4*)(KDT + k * 72 + seg * 8) = kp;
        if (seg == 0) decay[task * 64 + k] = __expf(total);
    }
    {
        const int v = tid & 127, sg = tid >> 7; unsigned short vv[16];
#pragma unroll
        for (int i = 0; i < 16; ++i) vv[i] = proj[(size_t)(tok0 + sg * 16 + i) * PROJW + 512 + h * 128 + v];
        u32x4 p0, p1; p0.x = vv[0] | ((unsigned)vv[1] << 16); p0.y = vv[2] | ((unsigned)vv[3] << 16); p0.z = vv[4] | ((unsigned)vv[5] << 16); p0.w = vv[6] | ((unsigned)vv[7] << 16);
        p1.x = vv[8] | ((unsigned)vv[9] << 16); p1.y = vv[10] | ((unsigned)vv[11] << 16); p1.z = vv[12] | ((unsigned)vv[13] << 16); p1.w = vv[14] | ((unsigned)vv[15] << 16);
        *(LAS u32x4*)(VT + v * 72 + sg * 16) = p0; *(LAS u32x4*)(VT + v * 72 + sg * 16 + 8) = p1;
    }
    __syncthreads();
    if (wave < 4) {
        const int ti = wave >> 1, si = wave & 1; f32x16 acc = {};
        if (si <= ti) {
#pragma unroll
            for (int ks = 0; ks < 4; ++ks) acc = __builtin_amdgcn_mfma_f32_32x32x16_bf16(ldfrag(QE, ti * 32 + r32, ks, hi), ldfrag(KE, si * 32 + r32, ks, hi), acc, 0, 0, 0);
        }
#pragma unroll
        for (int r = 0; r < 16; ++r) { const int trow = ti * 32 + crow(r, hi), scol = si * 32 + r32; AT[trow * 72 + scol] = (unsigned short)f2bf(scol <= trow ? acc[r] : 0.f); }
    }
    __syncthreads();
    {
        const int ti = wave >> 2, vi = wave & 3; f32x16 o = {}, ds = {};
#pragma unroll
        for (int ks = 0; ks < 4; ++ks) { const bf16x8 vb = ldfrag(VT, vi * 32 + r32, ks, hi);
            o = __builtin_amdgcn_mfma_f32_32x32x16_bf16(ldfrag(AT, ti * 32 + r32, ks, hi), vb, o, 0, 0, 0);
            ds = __builtin_amdgcn_mfma_f32_32x32x16_bf16(ldfrag(KDT, ti * 32 + r32, ks, hi), vb, ds, 0, 0, 0); }
#pragma unroll
        for (int r = 0; r < 16; ++r) { const int row = ti * 32 + crow(r, hi);
            ointra[(size_t)(tok0 + row) * 512 + h * 128 + vi * 32 + r32] = o[r];
            dS[(size_t)task * 8192 + row * 128 + vi * 32 + r32] = ds[r]; }
    }
    __syncthreads();
}

__device__ __forceinline__ void fox_prep(const Args& a, int vcu, int G, int wave, int lane) {
    unsigned char* ws = a.ws; bf16* proj = (bf16*)(ws + WS_PROJ);
    const int gw = vcu * NWAVES + wave, NGW = G * NWAVES;
    const int c8 = (lane & 7) * 8;
    for (int it = gw; it < 2 * M; it += NGW) {
        const int tok = it >> 1, which = it & 1;
        bf16* p = proj + (size_t)tok * PROJW + (which ? 2048 : 1536) + lane * 8;
        const u32x4 w = *(const u32x4*)p;
        float v[8] = {bflo(w.x), bfhi(w.x), bflo(w.y), bfhi(w.y), bflo(w.z), bfhi(w.z), bflo(w.w), bfhi(w.w)};
        float s = 0.f;
#pragma unroll
        for (int i = 0; i < 8; ++i) s += v[i] * v[i];
        s += __shfl_xor(s, 1); s += __shfl_xor(s, 2); s += __shfl_xor(s, 4);
        const float r = rsqrtf(s * (1.f / 64.f) + EPS) * (which ? 1.f : C2);
        const float* g = a.in[which ? 9 : 8] + c8; const f32x4 g0 = *(const f32x4*)g, g1 = *(const f32x4*)(g + 4);
        u32x4 o; o.x = pk2(v[0] * r * g0.x, v[1] * r * g0.y); o.y = pk2(v[2] * r * g0.z, v[3] * r * g0.w); o.z = pk2(v[4] * r * g1.x, v[5] * r * g1.y); o.w = pk2(v[6] * r * g1.z, v[7] * r * g1.w);
        *(u32x4*)p = o;
    }
    if (wave == 0) {
        const float* lrf = (const float*)(ws + WS_LRF); float* cb = (float*)(ws + WS_SMALL) + 4 * M + 65536;
        for (int bh = vcu; bh < 64; bh += G) {
            const int b = bh >> 3, h = bh & 7; const float bf = a.in[7][h];
            float loc[32]; float run = 0.f;
#pragma unroll
            for (int i = 0; i < 32; ++i) { run += logsig(lrf[(size_t)(b * SEQ + lane * 32 + i) * 32 + 16 + h] + bf); loc[i] = run; }
            float inc = run;
#pragma unroll
            for (int o = 1; o < 64; o <<= 1) { const float t = __shfl_up(inc, o); if (lane >= o) inc += t; }
            const float pre = inc - run;
#pragma unroll
            for (int i = 0; i < 32; ++i) cb[(size_t)bh * SEQ + lane * 32 + i] = (pre + loc[i]) * LOG2E;
        }
    }
}

__device__ __forceinline__ void gla_scan(const Args& a, int vcu, int G, int tid) {
    const float* decay = (const float*)(a.ws + WS_SMALL) + 4 * M; const float* dS = a.out + (size_t)M * 512; float* sprev = (float*)(a.ws + WS_SPREV);
    for (int e = (vcu * NT + tid) * 2; e < 32 * 8192; e += G * NT * 2) {
        const int bh = e >> 13, kv = e & 8191, k = kv >> 7; f32x2 st = {0.f, 0.f};
#pragma unroll 8
        for (int n = 0; n < 32; ++n) { const int task = bh * 32 + n; const size_t idx = (size_t)task * 8192 + kv;
            *(f32x2*)(sprev + idx) = st; const float d = decay[task * 64 + k]; const f32x2 ds = *(const f32x2*)(dS + idx); st = st * d + ds; }
    }
}

__device__ __forceinline__ void gla_final(const Args& a, LAS unsigned char* lds, int task, int wave, int lane, int tid) {
    unsigned char* ws = a.ws;
    const bf16* proj = (const bf16*)(ws + WS_PROJ); const bf16* qeg = (const bf16*)(ws + WS_QE); const float* sprev = (const float*)(ws + WS_SPREV);
    const float* ointra = a.out; bf16* mix = (bf16*)(ws + WS_MIX);
    const int bh = task >> 5, n = task & 31, b = bh >> 2, h = bh & 3, tok0 = b * SEQ + n * 64;
    LAS bf16* QE = (LAS bf16*)lds; LAS bf16* ST = QE + 64 * 72; LAS float* OL = (LAS float*)(lds + 27648);
    const int r32 = lane & 31, hi = lane >> 5;
    { const int t = tid >> 3, c = tid & 7; *(LAS u32x4*)(QE + t * 72 + c * 8) = *(const u32x4*)(qeg + (size_t)(tok0 + t) * 256 + h * 64 + c * 8); }
    { const int v = tid & 127, kg = tid >> 7; float f[16];
#pragma unroll
        for (int i = 0; i < 16; ++i) f[i] = sprev[(size_t)task * 8192 + (kg * 16 + i) * 128 + v];
        u32x4 p0, p1; p0.x = pk2(f[0], f[1]); p0.y = pk2(f[2], f[3]); p0.z = pk2(f[4], f[5]); p0.w = pk2(f[6], f[7]); p1.x = pk2(f[8], f[9]); p1.y = pk2(f[10], f[11]); p1.z = pk2(f[12], f[13]); p1.w = pk2(f[14], f[15]);
        *(LAS u32x4*)(ST + v * 72 + kg * 16) = p0; *(LAS u32x4*)(ST + v * 72 + kg * 16 + 8) = p1; }
    __syncthreads();
    { const int ti = wave >> 2, vi = wave & 3; f32x16 acc = {};
#pragma unroll
        for (int ks = 0; ks < 4; ++ks) acc = __builtin_amdgcn_mfma_f32_32x32x16_bf16(ldfrag(QE, ti * 32 + r32, ks, hi), ldfrag(ST, vi * 32 + r32, ks, hi), acc, 0, 0, 0);
#pragma unroll
        for (int r = 0; r < 16; ++r) { const int row = ti * 32 + crow(r, hi), col = vi * 32 + r32; OL[row * 132 + col] = acc[r] + ointra[(size_t)(tok0 + row) * 512 + h * 128 + col]; } }
    __syncthreads();
    { const int t = tid >> 3, j = tid & 7; f32x4 o[4]; float s = 0.f;
#pragma unroll
        for (int i = 0; i < 4; ++i) { o[i] = *(const LAS f32x4*)(OL + t * 132 + j * 16 + 4 * i); s += (o[i].x * o[i].x + o[i].y * o[i].y) + (o[i].z * o[i].z + o[i].w * o[i].w); }
        s += __shfl_xor(s, 1); s += __shfl_xor(s, 2); s += __shfl_xor(s, 4);
        const float r = rsqrtf(s * (1.f / 128.f) + EPS);
        const bf16* ogp = proj + (size_t)(tok0 + t) * PROJW + 1024 + h * 128 + j * 16; const u32x4 g0 = *(const u32x4*)ogp, g1 = *(const u32x4*)(ogp + 8);
        const float og[16] = {bflo(g0.x), bfhi(g0.x), bflo(g0.y), bfhi(g0.y), bflo(g0.z), bfhi(g0.z), bflo(g0.w), bfhi(g0.w), bflo(g1.x), bfhi(g1.x), bflo(g1.y), bfhi(g1.y), bflo(g1.z), bfhi(g1.z), bflo(g1.w), bfhi(g1.w)};
        float y[16];
#pragma unroll
        for (int i = 0; i < 4; ++i) { const f32x4 gn = *(const f32x4*)(a.in[6] + j * 16 + 4 * i);
#pragma unroll
            for (int c = 0; c < 4; ++c) { const float g = og[4 * i + c]; y[4 * i + c] = o[i][c] * r * gn[c] * (g / (1.f + __expf(-g))); } }
        u32x4 p0, p1; p0.x = pk2(y[0], y[1]); p0.y = pk2(y[2], y[3]); p0.z = pk2(y[4], y[5]); p0.w = pk2(y[6], y[7]); p1.x = pk2(y[8], y[9]); p1.y = pk2(y[10], y[11]); p1.z = pk2(y[12], y[13]); p1.w = pk2(y[14], y[15]);
        bf16* mp = mix + (size_t)(tok0 + t) * DM + h * 128 + j * 16; *(u32x4*)mp = p0; *(u32x4*)(mp + 8) = p1; }
    __syncthreads();
}

#ifndef MK_SKIP
#define MK_SKIP 0
#endif
#define RUN(k) (!((MK_SKIP >> (k)) & 1))
__global__ void __launch_bounds__(NT, 2) mk_fwd(Args a) {
    extern __shared__ __attribute__((aligned(16))) unsigned char lds_raw[];
    cg::grid_group grid = cg::this_grid();
    LAS unsigned char* lds = (LAS unsigned char*)lds_raw;
    const int wave = __builtin_amdgcn_readfirstlane(threadIdx.x >> 6);
#define lane (lane_id())
#define tid (wave * 64 + lane_id())
    const int G = gridDim.x, bx = blockIdx.x, vcu = (G % 8 == 0) ? (bx % 8) * (G / 8) + bx / 8 : bx;
    unsigned char* ws = a.ws;
    bf16* xb = (bf16*)(ws + WS_XB); float* small = (float*)(ws + WS_SMALL);
    float* ss2 = small + M; float* ss3 = small + 2 * M; float* ssE = small + 3 * M;

    if (RUN(0)) p0_prologue(a, lds, vcu, G, wave, lane, tid);
    grid.sync();
    if (RUN(1)) {   pg8::Gemm g{xb, (const bf16*)(ws + WS_WIN), M, PROJW, DM}; pg8::StaticOrder S; S.init(M / 256, PROJW / 256, G, bx);
        pg8::EpiScaleBf16 E{(bf16*)(ws + WS_PROJ), PROJW, small};
        pg8::gemm_phase<pg8::EpiScaleBf16, pg8::StaticOrder, true, true>(lds, g, S, E, wave);
        p1_skinny(a, lds, vcu, G, wave, lane, tid);
    }
    grid.sync();
    if (RUN(2)) for (int task = vcu; task < 1024; task += G) gla_local(a, lds, task, wave, lane, tid);
    if (RUN(9)) fox_prep(a, vcu, G, wave, lane);
    grid.sync();
    if (RUN(10)) gla_scan(a, vcu, G, tid);
    if (RUN(3)) {   const attn_body::bf16* pj = (const attn_body::bf16*)(ws + WS_PROJ);
        const attn_body::AttnTensors AT{pj + 1536, pj + 2048, pj + 2560, (attn_body::bf16*)(ws + WS_MIX) + 512, small + 4 * M + 65536};
        const attn_body::StaticOrder S(G, vcu);
        attn_body::attn_phase<attn_body::StaticOrder>((char*)lds_raw, AT, S);
    }
    grid.sync();
    if (RUN(4)) for (int task = vcu; task < 1024; task += G) gla_final(a, lds, task, wave, lane, tid);
    grid.sync();
    if (RUN(5)) {   pg8::Gemm g{(const bf16*)(ws + WS_MIX), (const bf16*)(ws + WS_WO), M, DM, DM}; pg8::StaticOrder S; S.init(M / 256, DM / 256, G, bx);
        pg8::EpiRes E{a.in[0], a.out, xb, ss2, DM};
        pg8::gemm_phase<pg8::EpiRes, pg8::StaticOrder, true, true>(lds, g, S, E, wave);
    }
    grid.sync();
    if (RUN(6)) {   pg8::Gemm g{xb, (const bf16*)(ws + WS_WUP), M, 2 * FF, DM}; pg8::StaticOrder S; S.init(65, 2 * FF / 256, G, bx, 254, -2);
        pg8::EpiUp E{(bf16*)(ws + WS_ACT), ss2, a.in[13], a.in[14], (LAS float*)(lds + XCH_OFF)};
        pg8::gemm_phase<pg8::EpiUp, pg8::StaticOrder, true, true>(lds, g, S, E, wave);
    }
    grid.sync();
    if (RUN(7)) {   pg8::Gemm g{(const bf16*)(ws + WS_ACT), (const bf16*)(ws + WS_WD), M, DM, FF}; pg8::StaticOrder S; S.init(M / 256, DM / 256, G, bx);
        pg8::EpiRes E{a.out, a.out, xb, ss3, DM};
        pg8::gemm_phase<pg8::EpiRes, pg8::StaticOrder, true, true>(lds, g, S, E, wave);
        pg8::Gemm g2{(const bf16*)(ws + WS_PB), (const bf16*)(ws + WS_WPE), M, DM, PLE};
        pg8::EpiRes E2{nullptr, nullptr, (bf16*)(ws + WS_E), ssE, DM};
        pg8::gemm_phase<pg8::EpiRes, pg8::StaticOrder, true, true>(lds, g2, S, E2, wave);
    }
    grid.sync();
    if (RUN(8)) {   pg8::Gemm g{xb, (const bf16*)(ws + WS_WPG), M, DM, DM}; pg8::StaticOrder S; S.init(M / 256, DM / 256, G, bx);
        pg8::EpiGate E{a.out, a.out, (const bf16*)(ws + WS_E), ss3, ssE, a.in[20], a.in[18], DM};
        pg8::gemm_phase<pg8::EpiGate, pg8::StaticOrder, true, true>(lds, g, S, E, wave);
    }
#undef lane
#undef tid
}
}

extern "C" void kernel_launch(void* const* d_in, const int* in_sizes, int n_in, void* d_out, int out_size, void* d_ws, size_t ws_size, hipStream_t stream) {
    static int grid = 0;
    if (grid == 0) {
        int dev = 0, cus = 0, per_cu = 0;
        hipGetDevice(&dev); hipDeviceGetAttribute(&cus, hipDeviceAttributeMultiprocessorCount, dev);
        hipFuncSetAttribute((const void*)mk::mk_fwd, hipFuncAttributeMaxDynamicSharedMemorySize, mk::LDS_BYTES);
        hipOccupancyMaxActiveBlocksPerMultiprocessor(&per_cu, (const void*)mk::mk_fwd, mk::NT, mk::LDS_BYTES);
        if (per_cu < 1) { fprintf(stderr, "kernel_launch: occupancy query says %d blocks per CU\n", per_cu); per_cu = 1; }
        grid = cus * per_cu;
        if (n_in != 21 || ws_size < mk::WS_END) { fprintf(stderr, "kernel_launch: unexpected n_in %d / ws %zu\n", n_in, ws_size); grid = -1; }
    }
    if (grid < 0) return;
    mk::Args a{};
    for (int i = 0; i < 21; ++i) a.in[i] = (const float*)d_in[i];
    a.out = (float*)d_out; a.ws = (unsigned char*)d_ws;
    void* args[] = {&a};
    hipError_t e = hipLaunchCooperativeKernel((const void*)mk::mk_fwd, dim3(grid), dim3(mk::NT), args, mk::LDS_BYTES, stream);
    if (e != hipSuccess) fprintf(stderr, "cooperative launch failed: %s (grid %d)\n", hipGetErrorString(e), grid);
}
```

```cpp
#include <hip/hip_runtime.h>
#include <hip/hip_cooperative_groups.h>
#include <cstdio>
#include <cstdint>
namespace cg = cooperative_groups;
__device__ __forceinline__ int lane_id() { int l; asm volatile("v_mbcnt_lo_u32_b32 %0, -1, 0\n\tv_mbcnt_hi_u32_b32 %0, -1, %0" : "=v"(l)); return l; }
namespace pg8 {
#define PG8_LAS __attribute__((address_space(3)))
typedef unsigned short bf16_t;
typedef short bf16x8 __attribute__((ext_vector_type(8)));
typedef float f32x4 __attribute__((ext_vector_type(4)));
typedef unsigned u32x4 __attribute__((ext_vector_type(4)));
constexpr int BM = 256, BK = 64, HALF = 128, HTB = HALF * BK * 2  , STAGE_BYTES = 8 * HTB, NXCD = 8, WGM = 8;

__host__ __device__ __forceinline__ int lds_byte(int r, int c) { const int st = (r >> 4) * 2 + (c >> 5), rr = r & 15, cc = c & 31, ob = rr * 64 + cc * 2; return st * 1024 + (ob ^ (((ob >> 9) & 1) << 5)); }
__host__ __device__ __forceinline__ void stage_rc(int b, int& R, int& C) { const int st = b / 1024, sb = b % 1024, swz = sb ^ (((sb >> 9) & 1) << 5); R = (st >> 1) * 16 + swz / 64; C = (st & 1) * 32 + (swz % 64) / 2; }
__host__ __device__ __forceinline__ int perm32(int rho) { const int n = rho >> 4, i = rho & 15; return 8 * (i >> 2) + 4 * n + (i & 3); }

struct Unit { int pm, pn, arow; };
struct Gemm { const bf16_t* A; const bf16_t* Bt; int M, N, K; };

struct StaticOrder {
    int nM, nN, nwg, G, c, mstride, moff;
    __host__ __device__ void init(int nM_, int nN_, int G_, int c_, int mstride_ = 256, int moff_ = 0) { nM = nM_; nN = nN_; nwg = nM * nN; G = G_; c = c_; mstride = mstride_; moff = moff_; }
    __host__ __device__ bool next(int i, Unit& u) const {
        const long L = (long)i * G + c; if (L >= nwg) return false;
        int wgid = (int)L; { const int q = nwg / NXCD, r = nwg % NXCD, xcd = wgid % NXCD, off = wgid / NXCD; wgid = (xcd < r ? xcd * (q + 1) : r * (q + 1) + (xcd - r) * q) + off; }
        const int nig = WGM * nN, gid = wgid / nig, fm = gid * WGM, gsz = (nM - fm) < WGM ? (nM - fm) : WGM;
        u.pm = fm + ((wgid % nig) % gsz); u.pn = (wgid % nig) / gsz; u.arow = u.pm * mstride + moff; return true;
    }
    __device__ __forceinline__ void a_ready(const Unit&) const {}
    __device__ __forceinline__ void done(const Unit&) const {}
};

__device__ __forceinline__ unsigned cvt_pk_bf16(float lo, float hi) { unsigned r; asm volatile("v_cvt_pk_bf16_f32 %0, %1, %2" : "=v"(r) : "v"(lo), "v"(hi)); return r; }
typedef float f32x2 __attribute__((ext_vector_type(2)));
typedef float f32x2 __attribute__((ext_vector_type(2)));
template <class Epi, class Sched, bool ALIGN_EPI = false, bool SP2 = false>
__device__ __forceinline__ void gemm_phase(PG8_LAS unsigned char* lds, const Gemm g, const Sched& S, const Epi& E, int wave_sgpr) {
    const int wid = wave_sgpr, lane = lane_id(), tid = wid * 64 + lane, wr = wid >> 2, wc = wid & 3, fr = lane & 15, fq = lane >> 4;
    const int K = g.K, nt = K / BK;
    unsigned voffA[2], voffB[2];
#pragma unroll
    for (int i = 0; i < 2; ++i) { int R, C; stage_rc(tid * 16 + i * 8192, R, C); const int Rb = Epi::PERM ? ((R & ~31) + perm32(R & 31)) : R;
        voffA[i] = (unsigned)(R * K + C) * 2u; voffB[i] = (unsigned)(Rb * K + C) * 2u; }
    const size_t kstep = (size_t)(BK * 2);
    const size_t hstep = (size_t)HALF * K * 2;
    const size_t tstep = 2 * hstep;
    const unsigned ldsw = (unsigned)wid * 1024u;
    const int aoff = lds_byte(wr * 64 + fr, fq * 8), boff = lds_byte(wc * 32 + fr, fq * 8);
#define PG8_SA(b, h) (((b) * 2 + (h)) * HTB)
#define PG8_SB(b, h) ((4 + (b) * 2 + (h)) * HTB)
#define PG8_STAGE(bufoff, gbase, voff) do { _Pragma("unroll") for (int _i = 0; _i < 2; ++_i) \
        __builtin_amdgcn_global_load_lds((const unsigned*)((const char*)(gbase) + (voff)[_i]), (PG8_LAS unsigned*)(lds + (bufoff) + ldsw + _i * 8192), 16, 0, 0); } while (0)
#define PG8_LDA(dst, b, h) do { _Pragma("unroll") for (int m = 0; m < 4; ++m) _Pragma("unroll") for (int k = 0; k < 2; ++k) dst[m][k] = *(const PG8_LAS bf16x8*)(lds + PG8_SA(b, h) + aoff + m * 2048 + k * 1024); } while (0)
#define PG8_LDB(dst, b, h) do { _Pragma("unroll") for (int n = 0; n < 2; ++n) _Pragma("unroll") for (int k = 0; k < 2; ++k) dst[n][k] = *(const PG8_LAS bf16x8*)(lds + PG8_SB(b, h) + boff + n * 2048 + k * 1024); } while (0)
#define PG8_MMA(ai, bj, At, Bt) do { __builtin_amdgcn_s_setprio(1); _Pragma("unroll") for (int m = 0; m < 4; ++m) _Pragma("unroll") for (int n = 0; n < 2; ++n) _Pragma("unroll") for (int k = 0; k < 2; ++k) \
        acc[ai][bj][m][n] = __builtin_amdgcn_mfma_f32_16x16x32_bf16(Bt[n][k], At[m][k], acc[ai][bj][m][n], 0, 0, 0); __builtin_amdgcn_s_setprio(0); } while (0)
#define PG8_WAIT_V(n) asm volatile("s_waitcnt vmcnt(" #n ")" ::: "memory")
#define PG8_WAIT_L(n) asm volatile("s_waitcnt lgkmcnt(" #n ")" ::: "memory")
#define PG8_BAR __builtin_amdgcn_s_barrier()
#define PG8_SCHED __builtin_amdgcn_sched_barrier(0)
    Unit cur, nxt; int ui = 0;
    if (!S.next(0, cur)) return;
    f32x4 acc[2][2][4][2];
#pragma unroll
    for (int a = 0; a < 2; ++a)
#pragma unroll
        for (int b = 0; b < 2; ++b)
#pragma unroll
            for (int m = 0; m < 4; ++m)
#pragma unroll
                for (int n = 0; n < 2; ++n) acc[a][b][m][n] = (f32x4){0.f, 0.f, 0.f, 0.f};
    bf16x8 At[4][2], B0[2][2], B1[2][2];
    const char* cA = (const char*)g.A + (long)cur.arow * (long)(K * 2); const char* cB = (const char*)g.Bt + (size_t)cur.pn * tstep;
    S.a_ready(cur);
    if constexpr (SP2) {
        PG8_STAGE(PG8_SB(0, 0), cB, voffB); PG8_STAGE(PG8_SB(0, 1), cB + hstep, voffB); PG8_STAGE(PG8_SA(0, 0), cA, voffA); PG8_STAGE(PG8_SA(0, 1), cA + hstep, voffA);
        if (wr == 1) PG8_BAR;
        PG8_WAIT_V(2); PG8_BAR;
        PG8_STAGE(PG8_SB(1, 0), cB + kstep, voffB); PG8_STAGE(PG8_SA(1, 0), cA + kstep, voffA); PG8_STAGE(PG8_SB(1, 1), cB + hstep + kstep, voffB);
        PG8_WAIT_V(6); PG8_BAR;
    } else {
        PG8_STAGE(PG8_SB(0, 0), cB, voffB); PG8_STAGE(PG8_SA(0, 0), cA, voffA); PG8_STAGE(PG8_SB(0, 1), cB + hstep, voffB); PG8_STAGE(PG8_SA(0, 1), cA + hstep, voffA);
        if (wr == 1) PG8_BAR;
        PG8_WAIT_V(4); PG8_BAR;
        PG8_STAGE(PG8_SB(1, 0), cB + kstep, voffB); PG8_STAGE(PG8_SA(1, 0), cA + kstep, voffA); PG8_STAGE(PG8_SB(1, 1), cB + hstep + kstep, voffB);
        PG8_WAIT_V(6); PG8_BAR;
    }
    for (;;) {
        const bool has_next = S.next(ui + 1, nxt);
        const char* nA = has_next ? (const char*)g.A + (long)nxt.arow * (long)(K * 2) : cA; const char* nB = has_next ? (const char*)g.Bt + (size_t)nxt.pn * tstep : cB;
        for (int t = 0; t < nt; t += 2) {
            const bool last = (t == nt - 2);
            const char* a1 = cA + (size_t)(t + 1) * kstep;
            const char* a2 = last ? nA : cA + (size_t)(t + 2) * kstep; const char* b2 = last ? nB : cB + (size_t)(t + 2) * kstep;
            const char* a3 = a2 + kstep; const char* b3 = b2 + kstep;
            if (last && has_next) S.a_ready(nxt);
            if constexpr (SP2) {
            PG8_LDB(B0, 0, 0); PG8_LDB(B1, 0, 1); PG8_SCHED; PG8_LDA(At, 0, 0); PG8_STAGE(PG8_SA(1, 1), a1 + hstep, voffA);
            PG8_WAIT_V(8); PG8_WAIT_L(0); PG8_BAR; PG8_MMA(0, 0, At, B0); PG8_MMA(0, 1, At, B1); PG8_BAR; PG8_SCHED;
            PG8_LDA(At, 0, 1); PG8_STAGE(PG8_SB(0, 0), b2, voffB); PG8_STAGE(PG8_SB(0, 1), b2 + hstep, voffB); PG8_STAGE(PG8_SA(0, 0), a2, voffA);
            PG8_WAIT_V(8); PG8_WAIT_L(0); PG8_BAR; PG8_MMA(1, 0, At, B0); PG8_MMA(1, 1, At, B1); PG8_BAR; PG8_SCHED;
            PG8_LDB(B0, 1, 0); PG8_LDB(B1, 1, 1); PG8_SCHED; PG8_LDA(At, 1, 0); PG8_STAGE(PG8_SA(0, 1), a2 + hstep, voffA);
            PG8_WAIT_V(8); PG8_WAIT_L(0); PG8_BAR; PG8_MMA(0, 0, At, B0); PG8_MMA(0, 1, At, B1); PG8_BAR; PG8_SCHED;
            PG8_LDA(At, 1, 1); PG8_STAGE(PG8_SB(1, 0), b3, voffB); PG8_STAGE(PG8_SB(1, 1), b3 + hstep, voffB); PG8_STAGE(PG8_SA(1, 0), a3, voffA);
            PG8_WAIT_V(8); PG8_WAIT_L(0); PG8_BAR; PG8_MMA(1, 0, At, B0); PG8_MMA(1, 1, At, B1); PG8_BAR; PG8_SCHED;
            } else {
            PG8_LDB(B0, 0, 0); PG8_SCHED; PG8_LDA(At, 0, 0); PG8_STAGE(PG8_SA(1, 1), a1 + hstep, voffA);
            PG8_WAIT_L(8); PG8_BAR; PG8_WAIT_L(0); PG8_MMA(0, 0, At, B0); PG8_BAR; PG8_SCHED;
            PG8_LDB(B1, 0, 1); PG8_STAGE(PG8_SB(0, 0), b2, voffB);
            PG8_BAR; PG8_WAIT_L(0); PG8_MMA(0, 1, At, B1); PG8_BAR;
            PG8_LDA(At, 0, 1); PG8_STAGE(PG8_SA(0, 0), a2, voffA);
            PG8_BAR; PG8_WAIT_L(0); PG8_MMA(1, 0, At, B0); PG8_BAR; PG8_SCHED;
            PG8_STAGE(PG8_SB(0, 1), b2 + hstep, voffB);
            PG8_WAIT_V(6); PG8_BAR; PG8_MMA(1, 1, At, B1); PG8_BAR;
            PG8_LDB(B0, 1, 0); PG8_SCHED; PG8_LDA(At, 1, 0); PG8_STAGE(PG8_SA(0, 1), a2 + hstep, voffA);
            PG8_WAIT_L(8); PG8_BAR; PG8_WAIT_L(0); PG8_MMA(0, 0, At, B0); PG8_BAR; PG8_SCHED;
            PG8_LDB(B1, 1, 1); PG8_STAGE(PG8_SB(1, 0), b3, voffB);
            PG8_BAR; PG8_WAIT_L(0); PG8_MMA(0, 1, At, B1); PG8_BAR;
            PG8_LDA(At, 1, 1); PG8_STAGE(PG8_SA(1, 0), a3, voffA);
            PG8_BAR; PG8_WAIT_L(0); PG8_MMA(1, 0, At, B0); PG8_BAR; PG8_SCHED;
            PG8_STAGE(PG8_SB(1, 1), b3 + hstep, voffB);
            PG8_WAIT_V(6); PG8_BAR; PG8_MMA(1, 1, At, B1); PG8_BAR;
            }
        }
        if constexpr (ALIGN_EPI) { if (wr == 0) PG8_BAR; }
        if constexpr (!Epi::AFTER_DRAIN) { E(acc, cur, wr, wc, fr, fq); S.done(cur); }
        if (!has_next) break;
#pragma unroll
        for (int a = 0; a < 2; ++a)
#pragma unroll
            for (int b = 0; b < 2; ++b)
#pragma unroll
                for (int m = 0; m < 4; ++m)
#pragma unroll
                    for (int n = 0; n < 2; ++n) acc[a][b][m][n] = (f32x4){0.f, 0.f, 0.f, 0.f};
        cur = nxt; cA = nA; cB = nB; ++ui;
        if constexpr (ALIGN_EPI) { if (wr == 1) PG8_BAR; }
    }
    PG8_WAIT_V(0);
    if constexpr (!ALIGN_EPI) { if (wr == 0) PG8_BAR; }
    PG8_BAR;
    if constexpr (Epi::AFTER_DRAIN) { E.fused(acc, cur, wr, wc, fr, fq, lds, wid, lane); S.done(cur); }
#undef PG8_SA
#undef PG8_SB
#undef PG8_STAGE
#undef PG8_LDA
#undef PG8_LDB
#undef PG8_MMA
#undef PG8_WAIT_V
#undef PG8_WAIT_L
#undef PG8_BAR
#undef PG8_SCHED
}
}
namespace pg8 {
constexpr float RMS_EPS = 1e-6f;
typedef unsigned u32x2 __attribute__((ext_vector_type(2)));
template <int CTRL> __device__ __forceinline__ float dpp_mov(float old, float src) {
    return __builtin_bit_cast(float, __builtin_amdgcn_update_dpp(__builtin_bit_cast(int, old), __builtin_bit_cast(int, src), CTRL, 0xf, 0xf, false)); }
__device__ __forceinline__ float bf_lo(unsigned w) { return __builtin_bit_cast(float, w << 16); }
__device__ __forceinline__ float bf_hi(unsigned w) { return __builtin_bit_cast(float, w & 0xffff0000u); }

struct EpiScaleBf16 {
    static constexpr bool PERM = true, AFTER_DRAIN = false;
    bf16_t* O; int ldc; const float* rs;
    __device__ __forceinline__ void operator()(const f32x4 (&acc)[2][2][4][2], const Unit& u, int wr, int wc, int fr, int fq) const {
        const int row0 = u.pm * BM + wr * 64 + fr, col0 = u.pn * BM + wc * 32 + 8 * fq;
#pragma unroll
        for (int ai = 0; ai < 2; ++ai)
#pragma unroll
            for (int m = 0; m < 4; ++m) { const int r = row0 + ai * HALF + m * 16; const float s = rs[r]; bf16_t* rowp = O + (size_t)r * ldc + col0;
#pragma unroll
                for (int bj = 0; bj < 2; ++bj) { const f32x4 v0 = acc[ai][bj][m][0] * s, v1 = acc[ai][bj][m][1] * s;
                    u32x4 w; w.x = cvt_pk_bf16(v0[0], v0[1]); w.y = cvt_pk_bf16(v0[2], v0[3]); w.z = cvt_pk_bf16(v1[0], v1[1]); w.w = cvt_pk_bf16(v1[2], v1[3]);
                    *(u32x4*)(rowp + bj * HALF) = w; } }
    }
};
struct EpiRes {
    static constexpr bool PERM = true, AFTER_DRAIN = false;
    const float* base; float* outf; bf16_t* outb; float* ss; int ldc;
    __device__ __forceinline__ void operator()(const f32x4 (&acc)[2][2][4][2], const Unit& u, int wr, int wc, int fr, int fq) const {
        const int row0 = u.pm * BM + wr * 64 + fr, col0 = u.pn * BM + wc * 32 + 8 * fq;
#pragma unroll
        for (int ai = 0; ai < 2; ++ai)
#pragma unroll
            for (int m = 0; m < 4; ++m) { const int r = row0 + ai * HALF + m * 16; float q = 0.f;
#pragma unroll
                for (int bj = 0; bj < 2; ++bj) { const size_t off = (size_t)r * ldc + col0 + bj * HALF;
                    f32x4 v0 = acc[ai][bj][m][0], v1 = acc[ai][bj][m][1];
                    if (base) { v0 += *(const f32x4*)(base + off); v1 += *(const f32x4*)(base + off + 4); }
                    if (outf) { *(f32x4*)(outf + off) = v0; *(f32x4*)(outf + off + 4) = v1; }
                    u32x4 w; w.x = cvt_pk_bf16(v0[0], v0[1]); w.y = cvt_pk_bf16(v0[2], v0[3]); w.z = cvt_pk_bf16(v1[0], v1[1]); w.w = cvt_pk_bf16(v1[2], v1[3]);
                    *(u32x4*)(outb + off) = w;
                    q += (v0[0] * v0[0] + v0[1] * v0[1]) + (v0[2] * v0[2] + v0[3] * v0[3]) + (v1[0] * v1[0] + v1[1] * v1[1]) + (v1[2] * v1[2] + v1[3] * v1[3]); }
                q += __shfl_xor(q, 16); q += __shfl_xor(q, 32);
                if (fq == 0) atomicAdd(ss + r, q); }
    }
};
struct EpiGate {
    static constexpr bool PERM = true, AFTER_DRAIN = false;
    const float* x2; float* out; const bf16_t* E; const float* ss3; const float* ssE; const float* bpg; const float* peg; int ldc;
    __device__ __forceinline__ void operator()(const f32x4 (&acc)[2][2][4][2], const Unit& u, int wr, int wc, int fr, int fq) const {
        const int row0 = u.pm * BM + wr * 64 + fr, col0 = u.pn * BM + wc * 32 + 8 * fq;
        f32x4 bp[2][2], pg[2][2];
#pragma unroll
        for (int bj = 0; bj < 2; ++bj)
#pragma unroll
            for (int n = 0; n < 2; ++n) { bp[bj][n] = *(const f32x4*)(bpg + col0 + bj * HALF + 4 * n); pg[bj][n] = *(const f32x4*)(peg + col0 + bj * HALF + 4 * n); }
#pragma unroll
        for (int ai = 0; ai < 2; ++ai)
#pragma unroll
            for (int m = 0; m < 4; ++m) { const int r = row0 + ai * HALF + m * 16;
                const float r3 = rsqrtf(ss3[r] * (1.f / 1024.f) + RMS_EPS), rE = rsqrtf(ssE[r] * (1.f / 1024.f) + RMS_EPS);
#pragma unroll
                for (int bj = 0; bj < 2; ++bj) { const size_t off = (size_t)r * ldc + col0 + bj * HALF;
                    const u32x4 ew = *(const u32x4*)(E + off);
                    const float ev[8] = {bf_lo(ew.x), bf_hi(ew.x), bf_lo(ew.y), bf_hi(ew.y), bf_lo(ew.z), bf_hi(ew.z), bf_lo(ew.w), bf_hi(ew.w)};
#pragma unroll
                    for (int n = 0; n < 2; ++n) { const f32x4 xv = *(const f32x4*)(x2 + off + 4 * n); f32x4 o;
#pragma unroll
                        for (int i = 0; i < 4; ++i) { const float z = acc[ai][bj][m][n][i] * r3 + bp[bj][n][i]; const float g = 1.f / (1.f + __expf(-z));
                            o[i] = xv[i] + g * (ev[4 * n + i] * rE * pg[bj][n][i]); }
                        *(f32x4*)(out + off + 4 * n) = o; } } }
    }
};
struct EpiUp {
    static constexpr bool PERM = true, AFTER_DRAIN = false;
    bf16_t* act; const float* ss2; const float* cw; const float* cb; PG8_LAS float* xch;
    __device__ __forceinline__ void operator()(f32x4 (&acc)[2][2][4][2], const Unit& u, int wr, int wc, int fr, int fq) const {
        constexpr int FF = 2816, MROWS = 16384;
#pragma unroll
        for (int ai = 0; ai < 2; ++ai)
#pragma unroll
            for (int m = 0; m < 4; ++m) { const int gr = u.arow + ai * HALF + wr * 64 + m * 16 + fr;
                const float s = (gr >= 0 && gr < MROWS) ? rsqrtf(ss2[gr] * (1.f / 1024.f) + RMS_EPS) : 0.f;
#pragma unroll
                for (int bj = 0; bj < 2; ++bj)
#pragma unroll
                    for (int n = 0; n < 2; ++n) acc[ai][bj][m][n] *= s; }
        const int cl0 = wc * 32 + 8 * fq;
        if (fr >= 14) {
#pragma unroll
            for (int ai = 0; ai < 2; ++ai)
#pragma unroll
                for (int bj = 0; bj < 2; ++bj)
#pragma unroll
                    for (int n = 0; n < 2; ++n) *(PG8_LAS f32x4*)(xch + ((ai * 2 + wr) * 2 + (fr - 14)) * 256 + bj * HALF + cl0 + 4 * n) = acc[ai][bj][3][n];
        }
        asm volatile("s_waitcnt lgkmcnt(0)\n\ts_barrier" ::: "memory");
        const int ch0 = u.pn * HALF + cl0;
#pragma unroll
        for (int n = 0; n < 2; ++n) {
            f32x4 w0[2], w1[2], w2[2], bb[2];
#pragma unroll
            for (int bj = 0; bj < 2; ++bj) { const int c = bj * FF + ch0 + 4 * n;
                w0[bj] = *(const f32x4*)(cw + c); w1[bj] = *(const f32x4*)(cw + 2 * FF + c); w2[bj] = *(const f32x4*)(cw + 4 * FF + c); bb[bj] = *(const f32x4*)(cb + c); }
#pragma unroll
            for (int ai = 0; ai < 2; ++ai) {
                const int g = ai * 2 + wr;
#pragma unroll
                for (int m = 0; m < 4; ++m) {
                    const int rt = ai * HALF + wr * 64 + m * 16 + fr, gr = u.arow + rt, t = gr & 2047;
                    f32x4 cv[2];
#pragma unroll
                    for (int bj = 0; bj < 2; ++bj) {
                        const f32x4 cur = acc[ai][bj][m][n]; f32x4 prev;
                        if (m > 0) prev = acc[ai][bj][m - 1][n];
                        else { prev = (f32x4){0.f, 0.f, 0.f, 0.f}; if (g > 0 && fr >= 14) prev = *(const PG8_LAS f32x4*)(xch + ((g - 1) * 2 + (fr - 14)) * 256 + bj * HALF + cl0 + 4 * n); }
                        f32x4 p1, p2;
#pragma unroll
                        for (int i = 0; i < 4; ++i) {
                            const float r1 = dpp_mov<0x121>(0.f, prev[i]), r2 = dpp_mov<0x122>(0.f, prev[i]);
                            p1[i] = dpp_mov<0x111>(r1, cur[i]); p2[i] = dpp_mov<0x112>(r2, cur[i]);
                        }
                        if (t == 0) { p1 = (f32x4){0.f, 0.f, 0.f, 0.f}; }
                        if (t <= 1) { p2 = (f32x4){0.f, 0.f, 0.f, 0.f}; }
                        cv[bj] = bb[bj] + w2[bj] * cur + w1[bj] * p1 + w0[bj] * p2;
                    }
                    float a4[4];
#pragma unroll
                    for (int i = 0; i < 4; ++i) { const float gv = cv[0][i]; a4[i] = gv / (1.f + __expf(-gv)) * cv[1][i]; }
                    u32x2 w; w.x = cvt_pk_bf16(a4[0], a4[1]); w.y = cvt_pk_bf16(a4[2], a4[3]);
                    if (rt >= 2 && gr < MROWS) *(u32x2*)(act + (size_t)gr * FF + ch0 + 4 * n) = w;
                }
            }
        }
    }
};
}
#include <hip/hip_bf16.h>
#include <cmath>
namespace attn_body {
using bf16=__hip_bfloat16;
using bf16x8=__attribute__((ext_vector_type(8)))short;
using s16x4=__attribute__((ext_vector_type(4)))short;
using f32x16=__attribute__((ext_vector_type(16)))float;
using u32x4=__attribute__((ext_vector_type(4)))unsigned;
constexpr int BATCH=8,NHEAD=8,SEQ=2048,D=64,DM=3072,OM=1024;
constexpr int NW=8,QBLK=32,QB=QBLK*NW,KVBLK=64,NQB=SEQ/QB;
constexpr int ATTN_PITCH=DM, ATTN_UNIT_ROWS=QB;
__device__ __forceinline__ int crow(int r,int hi){return (r&3)+8*(r>>2)+4*hi;}
#define SBAR() __builtin_amdgcn_sched_barrier(0)
__device__ __forceinline__ void cmask(f32x16&p0,f32x16&p1,int jb,int qrel,int hi){
  const float NEG=-INFINITY; int kb=64*jb+4*hi;
  #pragma unroll
  for(int r=0;r<16;++r){int kv=kb+(r&3)+8*(r>>2); if(kv>qrel)p0[r]=NEG; if(kv+32>qrel)p1[r]=NEG;}
}

constexpr int NSLOT=3, SLOTB=8192;
constexpr int LDS_K=0, LDS_V=NSLOT*SLOTB, LDS_WS=2*NSLOT*SLOTB, LDS_OST=LDS_WS+NW*64*4, LDS_CB=LDS_OST+NW*4096, LDS_BYTES=LDS_CB+8192;
constexpr float C2=0.125f*1.4426950408889634f;
__device__ __forceinline__ void glds16(const void*gsrc,unsigned lds_dst){unsigned keep;
  asm volatile("s_mov_b32 %0, m0\n\ts_mov_b32 m0, %2\n\ts_nop 0\n\tglobal_load_lds_dwordx4 %1, off\n\ts_mov_b32 m0, %0":"=&s"(keep):"v"(gsrc),"s"(lds_dst):"memory");}
__device__ __forceinline__ float max3f(float a,float b,float c){float r;asm("v_max3_f32 %0, %1, %2, %3":"=v"(r):"v"(a),"v"(b),"v"(c));return r;}
__device__ __forceinline__ float max2f(float a,float b){float r;asm("v_max_f32_e32 %0, %1, %2":"=v"(r):"v"(a),"v"(b));return r;}
__device__ __forceinline__ float fadd_s(float a,float b){float r;asm("v_add_f32_e32 %0, %1, %2":"=v"(r):"v"(a),"v"(b));return r;}
__device__ __forceinline__ float fsub_s(float a,float b){float r;asm("v_sub_f32_e32 %0, %1, %2":"=v"(r):"v"(a),"v"(b));return r;}
typedef float f32x2_t __attribute__((ext_vector_type(2))); typedef __bf16 bf16x2_t __attribute__((ext_vector_type(2)));
__device__ __forceinline__ unsigned cvtpk_s(float lo,float hi){f32x2_t v={lo,hi};bf16x2_t b=__builtin_convertvector(v,bf16x2_t);return __builtin_bit_cast(unsigned,b);}
#define WAIT_BAR(N) asm volatile("s_waitcnt vmcnt(" #N ") lgkmcnt(0)\n\ts_barrier":::"memory")

__device__ __forceinline__ void qkt(f32x16&p0,f32x16&p1,const char*Kslot,const bf16x8*qr,const f32x16&negm,int r32,int hi){
  const char*kb=Kslot+hi*1024+r32*16;
  #pragma unroll
  for(int d0=0;d0<4;++d0){
    const bf16x8 b0=*reinterpret_cast<const bf16x8*>(kb+d0*2048);
    const bf16x8 b1=*reinterpret_cast<const bf16x8*>(kb+d0*2048+512);
    if(d0==0){p0=__builtin_amdgcn_mfma_f32_32x32x16_bf16(b0,qr[0],negm,0,0,0);p1=__builtin_amdgcn_mfma_f32_32x32x16_bf16(b1,qr[0],negm,0,0,0);}
    else{p0=__builtin_amdgcn_mfma_f32_32x32x16_bf16(b0,qr[d0],p0,0,0,0);p1=__builtin_amdgcn_mfma_f32_32x32x16_bf16(b1,qr[d0],p1,0,0,0);}}
}
typedef __attribute__((address_space(3))) const char* lds_cptr;
typedef short v4i16_t __attribute__((ext_vector_type(4)));
__device__ __forceinline__ void kload8(bf16x8*kf,lds_cptr kp){
  kf[0]=*(const __attribute__((address_space(3))) bf16x8*)(kp);      kf[1]=*(const __attribute__((address_space(3))) bf16x8*)(kp+512);
  kf[2]=*(const __attribute__((address_space(3))) bf16x8*)(kp+2048); kf[3]=*(const __attribute__((address_space(3))) bf16x8*)(kp+2560);
  kf[4]=*(const __attribute__((address_space(3))) bf16x8*)(kp+4096); kf[5]=*(const __attribute__((address_space(3))) bf16x8*)(kp+4608);
  kf[6]=*(const __attribute__((address_space(3))) bf16x8*)(kp+6144); kf[7]=*(const __attribute__((address_space(3))) bf16x8*)(kp+6656);
}
__device__ __forceinline__ void kload2(bf16x8*kf,lds_cptr kp,int j){ kf[2*j]=*(const __attribute__((address_space(3))) bf16x8*)(kp+j*2048); kf[2*j+1]=*(const __attribute__((address_space(3))) bf16x8*)(kp+j*2048+512); }
__device__ __forceinline__ s16x4 vtr(lds_cptr p){ return __builtin_bit_cast(s16x4,__builtin_amdgcn_ds_read_tr16_b64_v4i16((__attribute__((address_space(3))) v4i16_t*)p)); }
__device__ __forceinline__ float rowmax(const f32x16&p0,const f32x16&p1){
  float a=max3f(p0[0],p0[1],p1[0]),b=max3f(p0[2],p0[3],p1[1]);a=max3f(a,p1[2],p1[3]);
  #pragma unroll
  for(int r=4;r<16;r+=4){a=max3f(a,p0[r],p0[r+1]);b=max3f(b,p0[r+2],p0[r+3]);a=max3f(a,p1[r],p1[r+1]);b=max3f(b,p1[r+2],p1[r+3]);}
  const float m=max2f(a,b);
  auto rr=__builtin_amdgcn_permlane32_swap(__float_as_uint(m),__float_as_uint(m),false,false);
  return max2f(__uint_as_float(rr[0]),__uint_as_float(rr[1]));
}
__device__ __forceinline__ void pv(f32x16*o,int vb,bf16x8 pa0,bf16x8 pa1,bf16x8 pa2,bf16x8 pa3){
  #pragma unroll
  for(int d0=0;d0<2;++d0){s16x4 lo[4],hi[4];
    #pragma unroll
    for(int ks=0;ks<4;++ks){
      asm volatile("ds_read_b64_tr_b16 %0,%1 offset:%c2":"=&v"(lo[ks]):"v"(vb),"i"(d0*4096+ks*1024):"memory");
      asm volatile("ds_read_b64_tr_b16 %0,%1 offset:%c2":"=&v"(hi[ks]):"v"(vb),"i"(d0*4096+ks*1024+512):"memory");}
    asm volatile("s_waitcnt lgkmcnt(0)":::"memory");SBAR();
    #define PK(k) (bf16x8){lo[k][0],lo[k][1],lo[k][2],lo[k][3],hi[k][0],hi[k][1],hi[k][2],hi[k][3]}
    o[d0]=__builtin_amdgcn_mfma_f32_32x32x16_bf16(pa0,PK(0),o[d0],0,0,0);
    o[d0]=__builtin_amdgcn_mfma_f32_32x32x16_bf16(pa1,PK(1),o[d0],0,0,0);
    o[d0]=__builtin_amdgcn_mfma_f32_32x32x16_bf16(pa2,PK(2),o[d0],0,0,0);
    o[d0]=__builtin_amdgcn_mfma_f32_32x32x16_bf16(pa3,PK(3),o[d0],0,0,0);
    #undef PK
  }
}

#ifndef ATTN_STORE16
#define ATTN_STORE16(p,v) (*(u32x4*)(p)=(v))
#endif
template<int THRL> __device__ __forceinline__ void attn_unit(int b,int h,int qb,const bf16*Q,const bf16*__restrict__ K,const bf16*__restrict__ V,bf16*O,const float*__restrict__ CB,char*shm){
  const int tid=threadIdx.x,lane=tid&63,r32=lane&31,hi=lane>>5; const int wid=__builtin_amdgcn_readfirstlane(tid>>6);
  const long rowbase=(long)b*SEQ; const int q0=qb*QB;
  const bf16*Qw=Q+(rowbase+q0+wid*QBLK)*DM+h*D;
  const bf16*Kh=K+rowbase*DM+h*D,*Vh=V+rowbase*DM+h*D;
  const lds_cptr shm3=(lds_cptr)shm; const unsigned lds0=(unsigned)(uintptr_t)shm;
  float*wsf=(float*)(shm+LDS_WS)+wid*64;
  const bf16*ksrc=Kh+(long)lane*DM+wid*8;
  const bf16*vsrc=Vh+(long)(16*(wid&3)+(lane>>2))*DM+(wid>>2)*32+(lane&3)*8;
  const unsigned kdst=lds0+LDS_K+wid*1024, vdst=lds0+LDS_V+wid*1024;
  #define DMA_K(t,slot) glds16(ksrc+(long)(t)*KVBLK*DM,(unsigned)__builtin_amdgcn_readfirstlane(kdst+(slot)))
  #define DMA_V(t,slot) glds16(vsrc+(long)(t)*KVBLK*DM,(unsigned)__builtin_amdgcn_readfirstlane(vdst+(slot)))
  const int vb0=(int)(lds0+LDS_V)+((lane>>4)&1)*32+(lane&3)*8+(4*hi+((lane&15)>>2))*64;
  const char*Kbase=shm+LDS_K; bf16x8 kf[8];
  const lds_cptr kp0=shm3+LDS_K+hi*1024+r32*16; const lds_cptr vp0=shm3+LDS_V+((lane>>4)&1)*32+(lane&3)*8+(4*hi+((lane&15)>>2))*64;
  const int NT=(q0+QB)/KVBLK;
  typedef __attribute__((address_space(3))) float* lds_fptr; typedef float f32x4_t __attribute__((ext_vector_type(4)));
  const lds_fptr cbl=(lds_fptr)(shm3+LDS_CB);
  { const float*cg_=CB+(long)(b*NHEAD+h)*SEQ; const float cref=cg_[q0];
    for(int i_=tid;i_<(q0+QB)/4;i_+=NW*64){ f32x4_t v_=*(const f32x4_t*)(cg_+4*i_); v_-=cref; *(__attribute__((address_space(3))) f32x4_t*)(cbl+4*i_)=v_; } }
  #define BIAS(P0,P1,t) do{ const lds_fptr cp_=cbl+64*(t)+4*hi; \
    _Pragma("unroll") for(int g_=0;g_<4;++g_){ { const f32x4_t c0_=*(const __attribute__((address_space(3))) f32x4_t*)(cp_+8*g_)+mhat; \
      _Pragma("unroll") for(int i_=0;i_<4;++i_){ P0[4*g_+i_]-=c0_[i_]; } } asm volatile("":::"memory"); \
      { const f32x4_t c1_=*(const __attribute__((address_space(3))) f32x4_t*)(cp_+32+8*g_)+mhat; \
      _Pragma("unroll") for(int i_=0;i_<4;++i_){ P1[4*g_+i_]-=c1_[i_]; } } asm volatile("":::"memory"); } }while(0)
  DMA_K(0,0);DMA_V(0,0);DMA_K(1,SLOTB);
  bf16x8 qr[4];
  #pragma unroll
  for(int d0=0;d0<4;++d0)qr[d0]=*reinterpret_cast<const bf16x8*>(&Qw[(long)r32*DM+d0*16+hi*8]);
  float mhat=0.f,l_reg=0.f;f32x16 o[2];o[0]=f32x16{};o[1]=f32x16{};f32x16 negm=f32x16{}; const f32x16 zero16=f32x16{};
  const int qrel=wid*QBLK+r32;
  #define CMASK(P0,P1,t) do{int jb_=(t)-(NT-4); if(jb_>=0)cmask(P0,P1,jb_,qrel,hi);}while(0)
  bool resc=false;
  #define START(P0,P1) do{ const float rm=rowmax(P0,P1); resc=false; \
    { const float dl=rm; mhat=fadd_s(mhat,dl); \
      _Pragma("unroll") for(int r=0;r<16;++r){P0[r]=fsub_s(P0[r],dl);P1[r]=fsub_s(P1[r],dl);} \
      _Pragma("unroll") for(int r=0;r<16;++r)negm[r]=-mhat;  } \
    _Pragma("unroll") for(int r=0;r<16;++r)P0[r]=__builtin_amdgcn_exp2f(P0[r]); }while(0)
  #define RESC() do{ if(resc){ asm volatile("s_waitcnt lgkmcnt(0)":::"memory"); \
      _Pragma("unroll") for(int d_=0;d_<2;++d_) _Pragma("unroll") for(int r=0;r<16;++r)o[d_][r]*=wsf[crow(r,hi)]; } }while(0)
  f32x16 pA0,pA1,pB0,pB1;
  int sl_prev=0,sl_cur=0,sl_next=SLOTB;
  #define ROT() do{sl_prev=sl_cur;sl_cur=sl_next;sl_next=(sl_next==(NSLOT-1)*SLOTB)?0:sl_next+SLOTB;}while(0)
  DMA_K(2,2*SLOTB);
  WAIT_BAR(3);
  qkt(pA0,pA1,Kbase,qr,zero16,r32,hi);asm volatile("s_nop 15\n\ts_nop 7":"+v"(pA0),"+v"(pA1));BIAS(pA0,pA1,0);CMASK(pA0,pA1,0);
  START(pA0,pA1);
  _Pragma("unroll") for(int r=0;r<16;++r)pA1[r]=__builtin_amdgcn_exp2f(pA1[r]);
  WAIT_BAR(0);
  DMA_K(3,0);DMA_V(1,SLOTB);
  ROT();
  kload8(kf,kp0+sl_cur);
  WAIT_BAR(2);
  s16x4 vlo[8],vhi[8]; u32x4 pw0,pw1,pw2,pw3;
  #define PKW(P,B) cvtpk_s(P[B],P[B+1])
  #define PAF(k) __builtin_bit_cast(bf16x8,pw##k)
  #define VFR(i) (bf16x8){vlo[i][0],vlo[i][1],vlo[i][2],vlo[i][3],vhi[i][0],vhi[i][1],vhi[i][2],vhi[i][3]}
  #define PIN(x) asm volatile("":"+v"(x))
  #define MX3(a,b,c) __builtin_fmaxf(__builtin_fmaxf((a),(b)),(c))
  #define GAPA(MF,A0,A1,A2,A3,W0,W1,PW) do{ MF; sacc+=A0; sacc+=A1; sacc+=A2; sacc+=A3; PIN(sacc); W0; W1; PIN(PW); SBAR(); }while(0)
  #define EX(v) __builtin_amdgcn_exp2f(v)
  #define GAPB(MF,X,B) do{ MF; X[B]=EX(X[B]); X[B+1]=EX(X[B+1]); X[B+2]=EX(X[B+2]); X[B+3]=EX(X[B+3]); PIN(X); SBAR(); }while(0)
  #define VRD(i) do{ vlo[i]=vtr(vp_+(((i)>>2)*4096+((i)&3)*1024)); vhi[i]=vtr(vp_+(((i)>>2)*4096+((i)&3)*1024+512)); }while(0)
  #define KRD(G,j) do{ if(G){ kload2(kf,kp0+sl_next,j); SBAR(); } }while(0)
  #define STEP(C0,C1,P0,P1,t,GK,GV,GL) do{ SBAR(); \
    const lds_cptr vp_=vp0+sl_prev; \
    VRD(0); SBAR(); float sacc=(P0[0]+P0[1]); \
    GAPA(C0=__builtin_amdgcn_mfma_f32_32x32x16_bf16(kf[0],qr[0],zero16,0,0,0), P0[2],P0[3],P0[4],P0[5],     pw0[0]=PKW(P0,0), pw0[1]=PKW(P0,2), pw0); \
    VRD(4); SBAR(); GAPA(C1=__builtin_amdgcn_mfma_f32_32x32x16_bf16(kf[1],qr[0],zero16,0,0,0), P0[6],P0[7],P0[8],P0[9],     pw0[2]=PKW(P0,4), pw0[3]=PKW(P0,6), pw0); \
    VRD(1); SBAR(); GAPA(C0=__builtin_amdgcn_mfma_f32_32x32x16_bf16(kf[2],qr[1],C0,0,0,0),   P0[10],P0[11],P0[12],P0[13], pw1[0]=PKW(P0,8), pw1[1]=PKW(P0,10), pw1); \
    VRD(5); SBAR(); GAPA(C1=__builtin_amdgcn_mfma_f32_32x32x16_bf16(kf[3],qr[1],C1,0,0,0),   P0[14],P0[15],P1[0],P1[1],   pw1[2]=PKW(P0,12),pw1[3]=PKW(P0,14), pw1); \
    VRD(2); SBAR(); GAPA(C0=__builtin_amdgcn_mfma_f32_32x32x16_bf16(kf[4],qr[2],C0,0,0,0),   P1[2],P1[3],P1[4],P1[5],     pw2[0]=PKW(P1,0), pw2[1]=PKW(P1,2), pw2); \
    VRD(6); SBAR(); GAPA(C1=__builtin_amdgcn_mfma_f32_32x32x16_bf16(kf[5],qr[2],C1,0,0,0),   P1[6],P1[7],P1[8],P1[9],     pw2[2]=PKW(P1,4), pw2[3]=PKW(P1,6), pw2); \
    VRD(3); SBAR(); GAPA(C0=__builtin_amdgcn_mfma_f32_32x32x16_bf16(kf[6],qr[3],C0,0,0,0),   P1[10],P1[11],P1[12],P1[13], pw3[0]=PKW(P1,8), pw3[1]=PKW(P1,10), pw3); \
    VRD(7); SBAR(); GAPA(C1=__builtin_amdgcn_mfma_f32_32x32x16_bf16(kf[7],qr[3],C1,0,0,0),   P1[14],P1[15],0.f,0.f,       pw3[2]=PKW(P1,12),pw3[3]=PKW(P1,14), pw3); \
    l_reg+=sacc; \
    if(GK){DMA_K((t)+3,sl_cur);} if(GV){DMA_V((t)+1,sl_next);} \
    BIAS(C0,C1,t); CMASK(C0,C1,t); \
    { float a=MX3(C0[0],C0[1],C1[0]),b=MX3(C0[2],C0[3],C1[1]); a=MX3(a,C1[2],C1[3]); \
      _Pragma("unroll") for(int r=4;r<16;r+=4){a=MX3(a,C0[r],C0[r+1]);b=MX3(b,C0[r+2],C0[r+3]);a=MX3(a,C1[r],C1[r+1]);b=MX3(b,C1[r+2],C1[r+3]);} \
      float rm=__builtin_fmaxf(a,b); { auto rr=__builtin_amdgcn_permlane32_swap(__float_as_uint(rm),__float_as_uint(rm),false,false); rm=__builtin_fmaxf(__uint_as_float(rr[0]),__uint_as_float(rr[1])); } \
      resc=false; \
      if(__builtin_expect(__any(rm>(float)THRL),0)){ const float dl=__builtin_fmaxf(rm,0.f); mhat+=dl; \
        _Pragma("unroll") for(int r=0;r<16;++r){C0[r]-=dl;C1[r]-=dl;} \
        _Pragma("unroll") for(int r=0;r<16;++r)negm[r]=-mhat;  \
        const float f=__builtin_amdgcn_exp2f(-dl); l_reg*=f; if(hi==0)wsf[r32]=f; resc=true; } } \
    SBAR(); \
    GAPB(o[0]=__builtin_amdgcn_mfma_f32_32x32x16_bf16(PAF(0),VFR(0),o[0],0,0,0), C0,0); \
    GAPB(o[1]=__builtin_amdgcn_mfma_f32_32x32x16_bf16(PAF(0),VFR(4),o[1],0,0,0), C0,4); \
    KRD(GL,0); GAPB(o[0]=__builtin_amdgcn_mfma_f32_32x32x16_bf16(PAF(1),VFR(1),o[0],0,0,0), C0,8); \
    KRD(GL,1); GAPB(o[1]=__builtin_amdgcn_mfma_f32_32x32x16_bf16(PAF(1),VFR(5),o[1],0,0,0), C0,12); \
    KRD(GL,2); GAPB(o[0]=__builtin_amdgcn_mfma_f32_32x32x16_bf16(PAF(2),VFR(2),o[0],0,0,0), C1,0); \
    KRD(GL,3); GAPB(o[1]=__builtin_amdgcn_mfma_f32_32x32x16_bf16(PAF(2),VFR(6),o[1],0,0,0), C1,4); \
    GAPB(o[0]=__builtin_amdgcn_mfma_f32_32x32x16_bf16(PAF(3),VFR(3),o[0],0,0,0), C1,8); \
    GAPB(o[1]=__builtin_amdgcn_mfma_f32_32x32x16_bf16(PAF(3),VFR(7),o[1],0,0,0), C1,12); \
    }while(0)
  int t=1;
  #undef CMASK
  #define CMASK(P0,P1,t) do{}while(0)
  for(;t+5<NT;t+=2){
    STEP(pB0,pB1,pA0,pA1,t,true,true,true);     WAIT_BAR(2); RESC(); ROT();
    STEP(pA0,pA1,pB0,pB1,t+1,true,true,true);   WAIT_BAR(2); RESC(); ROT();
  }
  #undef CMASK
  #define CMASK(P0,P1,t) do{int jb_=(t)-(NT-4); if(jb_>=0)cmask(P0,P1,jb_,qrel,hi);}while(0)
  #define ENDW(tt) do{ if((tt)+3<NT){WAIT_BAR(2);} else if((tt)+2<NT){WAIT_BAR(1);} else {WAIT_BAR(0);} }while(0)
  for(;t+1<NT;t+=2){
    STEP(pB0,pB1,pA0,pA1,t,(t+3<NT),(t+1<NT),(t+1<NT));       ENDW(t);   RESC(); ROT();
    STEP(pA0,pA1,pB0,pB1,t+1,(t+4<NT),(t+2<NT),(t+2<NT));     ENDW(t+1); RESC(); ROT();
  }
  STEP(pB0,pB1,pA0,pA1,NT-1,false,false,false); RESC();
  { float sacc=pB0[0]+pB0[1]; _Pragma("unroll") for(int r=2;r<16;++r)sacc+=pB0[r]; _Pragma("unroll") for(int r=0;r<16;++r)sacc+=pB1[r]; l_reg+=sacc;
    pw0=(u32x4){PKW(pB0,0),PKW(pB0,2),PKW(pB0,4),PKW(pB0,6)};pw1=(u32x4){PKW(pB0,8),PKW(pB0,10),PKW(pB0,12),PKW(pB0,14)};pw2=(u32x4){PKW(pB1,0),PKW(pB1,2),PKW(pB1,4),PKW(pB1,6)};pw3=(u32x4){PKW(pB1,8),PKW(pB1,10),PKW(pB1,12),PKW(pB1,14)};
    SBAR(); pv(o,vb0+sl_cur,PAF(0),PAF(1),PAF(2),PAF(3)); }
  #undef PKW
  #undef PAF
  #undef VFR
  #undef PIN
  #undef MX3
  #undef GAPA
  #undef GAPB
  #undef EX
  #undef VRD
  #undef KRD
  #undef STEP
  #undef ENDW
  {auto rr=__builtin_amdgcn_permlane32_swap(__float_as_uint(l_reg),__float_as_uint(l_reg),false,false);l_reg=__uint_as_float(rr[0])+__uint_as_float(rr[1]);}
  if(hi==0)wsf[32+r32]=l_reg;asm volatile("s_waitcnt lgkmcnt(0)":::"memory");
  float rli[16];
  #pragma unroll
  for(int r=0;r<16;++r)rli[r]=__builtin_amdgcn_rcpf(wsf[32+crow(r,hi)]);
  bf16*Ow=O+(rowbase+q0+wid*QBLK)*OM+h*D;
  { bf16*stg=(bf16*)(shm+LDS_OST)+wid*2048;
    #pragma unroll
    for(int r=0;r<16;++r){const int orow=crow(r,hi);
      #pragma unroll
      for(int d0=0;d0<2;++d0)stg[orow*64+d0*32+r32]=__float2bfloat16(o[d0][r]*rli[r]);}
    asm volatile("s_waitcnt lgkmcnt(0)":::"memory");
    #pragma unroll
    for(int i=0;i<4;++i){const int row=i*8+(lane>>3),ch=lane&7; const u32x4 v=*(const u32x4*)(stg+row*64+ch*8); ATTN_STORE16(Ow+(long)row*OM+ch*8,v);} }
  asm volatile("s_waitcnt lgkmcnt(0)\n\ts_barrier":::"memory");
  #undef DMA_K
  #undef DMA_V
  #undef CMASK
  #undef START
  #undef RESC
  #undef ROT
  #undef BIAS
}
constexpr int ATTN_LDS_BYTES=LDS_BYTES;
struct AttnTensors { const bf16* Q; const bf16* K; const bf16* V; bf16* O; const float* CB; };
struct AttnUnit { int bh; int qb; };
struct StaticOrder {
  int vcu,G;
  __device__ __forceinline__ explicit StaticOrder(int grid,int v):vcu(v),G(grid){}
  __device__ __forceinline__ bool next(int i,AttnUnit&u)const{ const int p=vcu+(i>>1)*G; if(p>=256)return false; const int s=p&3; u.bh=p>>2; u.qb=(i&1)?7-s:s; return true; }
  __device__ __forceinline__ void a_ready(const AttnUnit&)const{}
  __device__ __forceinline__ void done(const AttnUnit&)const{}
};
template<class Sched,int THRL=8> __device__ __forceinline__ void attn_phase(char*lds,const AttnTensors&T,const Sched&S){
  AttnUnit u;
  for(int i=0;S.next(i,u);++i){ S.a_ready(u); attn_unit<THRL>(u.bh/NHEAD,u.bh%NHEAD,u.qb,T.Q,T.K,T.V,T.O,T.CB,lds); S.done(u); }
}
#undef SBAR
#undef WAIT_BAR
}
#define LAS __attribute__((address_space(3)))
namespace mk {
typedef unsigned short bf16;
typedef unsigned u32x4 __attribute__((ext_vector_type(4)));
typedef unsigned u32x2 __attribute__((ext_vector_type(2)));
typedef float f32x4 __attribute__((ext_vector_type(4)));
typedef float f32x2 __attribute__((ext_vector_type(2)));
typedef float f32x16 __attribute__((ext_vector_type(16)));
typedef short bf16x8 __attribute__((ext_vector_type(8)));
typedef unsigned v4u __attribute__((ext_vector_type(4)));
constexpr int NWAVES = 8, NT = 512;
constexpr int M = 16384, SEQ = 2048, DM = 1024, INW = 3096, PROJW = 3072, FF = 2816, PLE = 256;
constexpr float EPS = 1e-6f, LOG2E = 1.4426950408889634f, C2 = 0.125f * LOG2E;
constexpr size_t MiB = 1u << 20;
constexpr size_t WS_WIN = 1 * MiB, WS_WSK = 7 * MiB, WS_WO = 8 * MiB, WS_WUP = 10 * MiB, WS_WD = 21 * MiB, WS_WPG = 27 * MiB, WS_WPE = 29 * MiB;
constexpr size_t WS_SMALL = 30 * MiB;
constexpr size_t WS_LRF = 31 * MiB, WS_PB = 33 * MiB, WS_QE = 41 * MiB, WS_XB = 50 * MiB  , WS_MIX = 83 * MiB, WS_PROJ = 115 * MiB, WS_END = 211 * MiB;
constexpr size_t WS_SPREV = WS_XB, WS_E = WS_MIX, WS_ACT = WS_PROJ;
constexpr int LDS_BYTES = 147456, XCH_OFF = 131072;

__device__ __forceinline__ unsigned f2bf(float f) { unsigned u = __builtin_bit_cast(unsigned, f); return (u + 0x7fffu + ((u >> 16) & 1u)) >> 16; }
__device__ __forceinline__ unsigned pk2(float lo, float hi) { return f2bf(lo) | (f2bf(hi) << 16); }
__device__ __forceinline__ float bf2f(unsigned short h) { return __builtin_bit_cast(float, (unsigned)h << 16); }
__device__ __forceinline__ float bflo(unsigned w) { return __builtin_bit_cast(float, w << 16); }
__device__ __forceinline__ float bfhi(unsigned w) { return __builtin_bit_cast(float, w & 0xffff0000u); }
__device__ __forceinline__ float logsig(float z) { return fminf(z, 0.f) - log1pf(__expf(-fabsf(z))); }
__device__ __forceinline__ int crow(int r, int hi) { return (r & 3) + 8 * (r >> 2) + 4 * hi; }
__device__ __forceinline__ float wave_sum(float v) {
#pragma unroll
    for (int o = 1; o < 64; o <<= 1) v += __shfl_xor(v, o);
    return v;
}
#define LDS_WAIT() asm volatile("s_waitcnt lgkmcnt(0)" ::: "memory")

struct Args { const float* in[21]; float* out; unsigned char* ws; };

__device__ __forceinline__ void tr_item(const float* W, int ldw, int k0, int srccol, const float* gain, bf16* WT, int ldk, int dstrow0, LAS float* scr, int lane) {
#pragma unroll 8
    for (int i = 0; i < 32; ++i) { const int kk = 2 * i + (lane >> 5); float v = srccol >= 0 ? W[(size_t)(k0 + kk) * ldw + srccol] : 0.f; if (gain) v *= gain[k0 + kk]; scr[kk * 33 + (lane & 31)] = v; }
    LDS_WAIT();
    const int c = lane & 7;
#pragma unroll
    for (int j = 0; j < 4; ++j) { const int n = (lane >> 3) + 8 * j; const LAS float* s = scr + (8 * c) * 33 + n;
        u32x4 o; o.x = pk2(s[0 * 33], s[1 * 33]); o.y = pk2(s[2 * 33], s[3 * 33]); o.z = pk2(s[4 * 33], s[5 * 33]); o.w = pk2(s[6 * 33], s[7 * 33]);
        *(u32x4*)(WT + (size_t)(dstrow0 + n) * ldk + k0 + 8 * c) = o; }
    LDS_WAIT();
}

__device__ __forceinline__ void p0_prologue(const Args& a, LAS unsigned char* lds, int vcu, int G, int wave, int lane, int tid) {
    unsigned char* ws = a.ws;
    LAS float* scr = (LAS float*)(lds + wave * 16384);
    const int gw = vcu * NWAVES + wave, NGW = G * NWAVES;
    constexpr int I_IN = 16 * 96, I_SK = 16, I_O = 16 * 32, I_UP = 16 * 176, I_D = 44 * 32, I_PG = 16 * 32, I_PE = 4 * 32;
    constexpr int NITEMS = I_IN + I_SK + I_O + I_UP + I_D + I_PG + I_PE;
    for (int it = gw; it < NITEMS; it += NGW) {
        int r = it; const int nl = lane & 31;
        if (r < I_IN) { const int kb = r / 96, nb = r % 96, n0 = 32 * nb; tr_item(a.in[3], INW, 64 * kb, n0 + (n0 >= 1536 ? 16 : 0) + nl, a.in[2], (bf16*)(ws + WS_WIN), DM, n0, scr, lane); continue; } r -= I_IN;
        if (r < I_SK) { const int sc = nl < 16 ? 1536 + nl : (nl < 24 ? 3088 + nl - 16 : -1); tr_item(a.in[3], INW, 64 * r, sc, a.in[2], (bf16*)(ws + WS_WSK), DM, 0, scr, lane); continue; } r -= I_SK;
        if (r < I_O) { const int kb = r / 32, nb = r % 32; tr_item(a.in[10], DM, 64 * kb, 32 * nb + nl, nullptr, (bf16*)(ws + WS_WO), DM, 32 * nb, scr, lane); continue; } r -= I_O;
        if (r < I_UP) { const int kb = r / 176, nb = r % 176, pn = nb >> 3, wi = nb & 7; const int sc0 = wi < 4 ? 128 * pn + 32 * wi : FF + 128 * pn + 32 * (wi - 4);
            tr_item(a.in[12], 2 * FF, 64 * kb, sc0 + nl, a.in[11], (bf16*)(ws + WS_WUP), DM, 32 * nb, scr, lane); continue; } r -= I_UP;
        if (r < I_D) { const int kb = r / 32, nb = r % 32; tr_item(a.in[15], DM, 64 * kb, 32 * nb + nl, nullptr, (bf16*)(ws + WS_WD), FF, 32 * nb, scr, lane); continue; } r -= I_D;
        if (r < I_PG) { const int kb = r / 32, nb = r % 32; tr_item(a.in[19], DM, 64 * kb, 32 * nb + nl, a.in[16], (bf16*)(ws + WS_WPG), DM, 32 * nb, scr, lane); continue; } r -= I_PG;
        { const int kb = r / 32, nb = r % 32; tr_item(a.in[17], DM, 64 * kb, 32 * nb + nl, nullptr, (bf16*)(ws + WS_WPE), PLE, 32 * nb, scr, lane); }
    }
    float* rstd1 = (float*)(ws + WS_SMALL); bf16* xb = (bf16*)(ws + WS_XB); bf16* pb = (bf16*)(ws + WS_PB);
    for (int m = gw; m < M; m += NGW) {
        const f32x4* xr = (const f32x4*)(a.in[0] + (size_t)m * DM) + lane; f32x4 v[4]; float s = 0.f;
#pragma unroll
        for (int j = 0; j < 4; ++j) { v[j] = xr[64 * j]; s += (v[j].x * v[j].x + v[j].y * v[j].y) + (v[j].z * v[j].z + v[j].w * v[j].w); }
        s = wave_sum(s); if (lane == 0) rstd1[m] = rsqrtf(s * (1.f / DM) + EPS);
        u32x2* o8 = (u32x2*)(xb + (size_t)m * DM) + lane;
#pragma unroll
        for (int j = 0; j < 4; ++j) o8[64 * j] = (u32x2){pk2(v[j].x, v[j].y), pk2(v[j].z, v[j].w)};
        const f32x4 pv = *((const f32x4*)(a.in[1] + (size_t)m * PLE) + lane);
        *((u32x2*)(pb + (size_t)m * PLE) + lane) = (u32x2){pk2(pv.x, pv.y), pk2(pv.z, pv.w)};
    }
    float* ssz = (float*)(ws + WS_SMALL) + M;
    for (int i = vcu * NT + tid; i < 3 * M; i += G * NT) ssz[i] = 0.f;
}

__device__ __forceinline__ void p1_skinny(const Args& a, LAS unsigned char* lds, int vcu, int G, int wave, int lane, int tid) {
    const bf16* xb = (const bf16*)(a.ws + WS_XB); const bf16* wsk = (const bf16*)(a.ws + WS_WSK); const float* rstd1 = (const float*)(a.ws + WS_SMALL); float* lrf = (float*)(a.ws + WS_LRF);
    LAS float* red = (LAS float*)lds;
    const int r32 = lane & 31, hi = lane >> 5;
    for (int rg = vcu; rg < M / 64; rg += G) {
        const int row0 = rg * 64; f32x16 acc0 = {}, acc1 = {};
#pragma unroll
        for (int ks = 0; ks < 8; ++ks) { const int k = wave * 128 + ks * 16 + 8 * hi;
            const bf16x8 a0 = *(const bf16x8*)(xb + (size_t)(row0 + r32) * DM + k), a1 = *(const bf16x8*)(xb + (size_t)(row0 + 32 + r32) * DM + k), b = *(const bf16x8*)(wsk + (size_t)r32 * DM + k);
            acc0 = __builtin_amdgcn_mfma_f32_32x32x16_bf16(a0, b, acc0, 0, 0, 0); acc1 = __builtin_amdgcn_mfma_f32_32x32x16_bf16(a1, b, acc1, 0, 0, 0); }
#pragma unroll
        for (int r = 0; r < 16; ++r) { red[(wave * 64 + crow(r, hi)) * 32 + r32] = acc0[r]; red[(wave * 64 + 32 + crow(r, hi)) * 32 + r32] = acc1[r]; }
        __syncthreads();
        { const int row = tid >> 3, c4 = tid & 7; f32x4 s = {0.f, 0.f, 0.f, 0.f};
#pragma unroll
            for (int w = 0; w < 8; ++w) s += *(const LAS f32x4*)(red + (w * 64 + row) * 32 + c4 * 4);
            s *= rstd1[row0 + row]; *(f32x4*)(lrf + (size_t)(row0 + row) * 32 + c4 * 4) = s; }
        __syncthreads();
    }
}

__device__ __forceinline__ bf16x8 ldfrag(const LAS bf16* base, int row, int ks, int hi) { return *(const LAS bf16x8*)(base + row * 72 + ks * 16 + 8 * hi); }
__device__ __forceinline__ void gla_local(const Args& a, LAS unsigned char* lds, int task, int wave, int lane, int tid) {
    unsigned char* ws = a.ws;
    const bf16* proj = (const bf16*)(ws + WS_PROJ); const float* lrf = (const float*)(ws + WS_LRF); bf16* qeg = (bf16*)(ws + WS_QE);
    float* decay = (float*)(ws + WS_SMALL) + 4 * M; float* ointra = a.out; float* dS = a.out + (size_t)M * 512;
    const int bh = task >> 5, n = task & 31, b = bh >> 2, h = bh & 3, tok0 = b * SEQ + n * 64;
    LAS bf16* QE = (LAS bf16*)lds; LAS bf16* KE = QE + 64 * 72; LAS bf16* KDT = KE + 64 * 72; LAS bf16* VT = KDT + 64 * 72; LAS bf16* AT = VT + 128 * 72; LAS float* SEG = (LAS float*)(AT + 64 * 72);
    const int r32 = lane & 31, hi = lane >> 5;
    {
        const int k = tid & 63, seg = tid >> 6;
        float w[16];
#pragma unroll
        for (int j = 0; j < 16; ++j) w[j] = a.in[4][j * 256 + h * 64 + k];
        const float bias = a.in[5][h * 64 + k];
        float bl[8]; float run = 0.f;
#pragma unroll
        for (int i = 0; i < 8; ++i) { const float* lr = lrf + (size_t)(tok0 + seg * 8 + i) * 32; float z = bias;
#pragma unroll
            for (int j = 0; j < 16; ++j) z += lr[j] * w[j];
            run += logsig(z) * (1.f / 16.f); bl[i] = run; }
        SEG[seg * 64 + k] = run; __syncthreads();
        float prefix = 0.f, total = 0.f;
#pragma unroll
        for (int s = 0; s < 8; ++s) { const float v = SEG[s * 64 + k]; total += v; if (s < seg) prefix += v; }
        unsigned short kdh[8];
#pragma unroll
        for (int i = 0; i < 8; ++i) { const int t = seg * 8 + i; const float bb = bl[i] + prefix; const bf16* pr = proj + (size_t)(tok0 + t) * PROJW;
            const float qv = bf2f(pr[h * 64 + k]), kv = bf2f(pr[256 + h * 64 + k]);
            const unsigned short qeb = (unsigned short)f2bf(qv * 0.125f * __expf(bb));
            QE[t * 72 + k] = qeb; KE[t * 72 + k] = (unsigned short)f2bf(kv * __expf(-bb)); qeg[(size_t)(tok0 + t) * 256 + h * 64 + k] = qeb;
            kdh[i] = (unsigned short)f2bf(kv * __expf(total - bb)); }
        u32x4 kp; kp.x = kdh[0] | ((unsigned)kdh[1] << 16); kp.y = kdh[2] | ((unsigned)kdh[3] << 16); kp.z = kdh[4] | ((unsigned)kdh[5] << 16); kp.w = kdh[6] | ((unsigned)kdh[7] << 16);
        *(LAS u32x4*)(KDT + k * 72 + seg * 8) = kp;
        if (seg == 0) decay[task * 64 + k] = __expf(total);
    }
    {
        const int v = tid & 127, sg = tid >> 7; unsigned short vv[16];
#pragma unroll
        for (int i = 0; i < 16; ++i) vv[i] = proj[(size_t)(tok0 + sg * 16 + i) * PROJW + 512 + h * 128 + v];
        u32x4 p0, p1; p0.x = vv[0] | ((unsigned)vv[1] << 16); p0.y = vv[2] | ((unsigned)vv[3] << 16); p0.z = vv[4] | ((unsigned)vv[5] << 16); p0.w = vv[6] | ((unsigned)vv[7] << 16);
        p1.x = vv[8] | ((unsigned)vv[9] << 16); p1.y = vv[10] | ((unsigned)vv[11] << 16); p1.z = vv[12] | ((unsigned)vv[13] << 16); p1.w = vv[14] | ((unsigned)vv[15] << 16);
        *(LAS u32x4*)(VT + v * 72 + sg * 16) = p0; *(LAS u32x4*)(VT + v * 72 + sg * 16 + 8) = p1;
    }
    __syncthreads();
    if (wave < 4) {
        const int ti = wave >> 1, si = wave & 1; f32x16 acc = {};
        if (si <= ti) {
#pragma unroll
            for (int ks = 0; ks < 4; ++ks) acc = __builtin_amdgcn_mfma_f32_32x32x16_bf16(ldfrag(QE, ti * 32 + r32, ks, hi), ldfrag(KE, si * 32 + r32, ks, hi), acc, 0, 0, 0);
        }
#pragma unroll
        for (int r = 0; r < 16; ++r) { const int trow = ti * 32 + crow(r, hi), scol = si * 32 + r32; AT[trow * 72 + scol] = (unsigned short)f2bf(scol <= trow ? acc[r] : 0.f); }
    }
    __syncthreads();
    {
        const int ti = wave >> 2, vi = wave & 3; f32x16 o = {}, ds = {};
#pragma unroll
        for (int ks = 0; ks < 4; ++ks) { const bf16x8 vb = ldfrag(VT, vi * 32 + r32, ks, hi);
            o = __builtin_amdgcn_mfma_f32_32x32x16_bf16(ldfrag(AT, ti * 32 + r32, ks, hi), vb, o, 0, 0, 0);
            ds = __builtin_amdgcn_mfma_f32_32x32x16_bf16(ldfrag(KDT, ti * 32 + r32, ks, hi), vb, ds, 0, 0, 0); }
#pragma unroll
        for (int r = 0; r < 16; ++r) { const int row = ti * 32 + crow(r, hi);
            ointra[(size_t)(tok0 + row) * 512 + h * 128 + vi * 32 + r32] = o[r];
            dS[(size_t)task * 8192 + row * 128 + vi * 32 + r32] = ds[r]; }
    }
    __syncthreads();
}

__device__ __forceinline__ void fox_prep(const Args& a, int vcu, int G, int wave, int lane) {
    unsigned char* ws = a.ws; bf16* proj = (bf16*)(ws + WS_PROJ);
    const int gw = vcu * NWAVES + wave, NGW = G * NWAVES;
    const int c8 = (lane & 7) * 8;
    for (int it = gw; it < 2 * M; it += NGW) {
        const int tok = it >> 1, which = it & 1;
        bf16* p = proj + (size_t)tok * PROJW + (which ? 2048 : 1536) + lane * 8;
        const u32x4 w = *(const u32x4*)p;
        float v[8] = {bflo(w.x), bfhi(w.x), bflo(w.y), bfhi(w.y), bflo(w.z), bfhi(w.z), bflo(w.w), bfhi(w.w)};
        float s = 0.f;
#pragma unroll
        for (int i = 0; i < 8; ++i) s += v[i] * v[i];
        s += __shfl_xor(s, 1); s += __shfl_xor(s, 2); s += __shfl_xor(s, 4);
        const float r = rsqrtf(s * (1.f / 64.f) + EPS) * (which ? 1.f : C2);
        const float* g = a.in[which ? 9 : 8] + c8; const f32x4 g0 = *(const f32x4*)g, g1 = *(const f32x4*)(g + 4);
        u32x4 o; o.x = pk2(v[0] * r * g0.x, v[1] * r * g0.y); o.y = pk2(v[2] * r * g0.z, v[3] * r * g0.w); o.z = pk2(v[4] * r * g1.x, v[5] * r * g1.y); o.w = pk2(v[6] * r * g1.z, v[7] * r * g1.w);
        *(u32x4*)p = o;
    }
    if (wave == 0) {
        const float* lrf = (const float*)(ws + WS_LRF); float* cb = (float*)(ws + WS_SMALL) + 4 * M + 65536;
        for (int bh = vcu; bh < 64; bh += G) {
            const int b = bh >> 3, h = bh & 7; const float bf = a.in[7][h];
            float loc[32]; float run = 0.f;
#pragma unroll
            for (int i = 0; i < 32; ++i) { run += logsig(lrf[(size_t)(b * SEQ + lane * 32 + i) * 32 + 16 + h] + bf); loc[i] = run; }
            float inc = run;
#pragma unroll
            for (int o = 1; o < 64; o <<= 1) { const float t = __shfl_up(inc, o); if (lane >= o) inc += t; }
            const float pre = inc - run;
#pragma unroll
            for (int i = 0; i < 32; ++i) cb[(size_t)bh * SEQ + lane * 32 + i] = (pre + loc[i]) * LOG2E;
        }
    }
}

__device__ __forceinline__ void gla_scan(const Args& a, int vcu, int G, int tid) {
    const float* decay = (const float*)(a.ws + WS_SMALL) + 4 * M; const float* dS = a.out + (size_t)M * 512; float* sprev = (float*)(a.ws + WS_SPREV);
    for (int e = (vcu * NT + tid) * 2; e < 32 * 8192; e += G * NT * 2) {
        const int bh = e >> 13, kv = e & 8191, k = kv >> 7; f32x2 st = {0.f, 0.f};
#pragma unroll 8
        for (int n = 0; n < 32; ++n) { const int task = bh * 32 + n; const size_t idx = (size_t)task * 8192 + kv;
            *(f32x2*)(sprev + idx) = st; const float d = decay[task * 64 + k]; const f32x2 ds = *(const f32x2*)(dS + idx); st = st * d + ds; }
    }
}

__device__ __forceinline__ void gla_final(const Args& a, LAS unsigned char* lds, int task, int wave, int lane, int tid) {
    unsigned char* ws = a.ws;
    const bf16* proj = (const bf16*)(ws + WS_PROJ); const bf16* qeg = (const bf16*)(ws + WS_QE); const float* sprev = (const float*)(ws + WS_SPREV);
    const float* ointra = a.out; bf16* mix = (bf16*)(ws + WS_MIX);
    const int bh = task >> 5, n = task & 31, b = bh >> 2, h = bh & 3, tok0 = b * SEQ + n * 64;
    LAS bf16* QE = (LAS bf16*)lds; LAS bf16* ST = QE + 64 * 72; LAS float* OL = (LAS float*)(lds + 27648);
    const int r32 = lane & 31, hi = lane >> 5;
    { const int t = tid >> 3, c = tid & 7; *(LAS u32x4*)(QE + t * 72 + c * 8) = *(const u32x4*)(qeg + (size_t)(tok0 + t) * 256 + h * 64 + c * 8); }
    { const int v = tid & 127, kg = tid >> 7; float f[16];
#pragma unroll
        for (int i = 0; i < 16; ++i) f[i] = sprev[(size_t)task * 8192 + (kg * 16 + i) * 128 + v];
        u32x4 p0, p1; p0.x = pk2(f[0], f[1]); p0.y = pk2(f[2], f[3]); p0.z = pk2(f[4], f[5]); p0.w = pk2(f[6], f[7]); p1.x = pk2(f[8], f[9]); p1.y = pk2(f[10], f[11]); p1.z = pk2(f[12], f[13]); p1.w = pk2(f[14], f[15]);
        *(LAS u32x4*)(ST + v * 72 + kg * 16) = p0; *(LAS u32x4*)(ST + v * 72 + kg * 16 + 8) = p1; }
    __syncthreads();
    { const int ti = wave >> 2, vi = wave & 3; f32x16 acc = {};
#pragma unroll
        for (int ks = 0; ks < 4; ++ks) acc = __builtin_amdgcn_mfma_f32_32x32x16_bf16(ldfrag(QE, ti * 32 + r32, ks, hi), ldfrag(ST, vi * 32 + r32, ks, hi), acc, 0, 0, 0);
#pragma unroll
        for (int r = 0; r < 16; ++r) { const int row = ti * 32 + crow(r, hi), col = vi * 32 + r32; OL[row * 132 + col] = acc[r] + ointra[(size_t)(tok0 + row) * 512 + h * 128 + col]; } }
    __syncthreads();
    { const int t = tid >> 3, j = tid & 7; f32x4 o[4]; float s = 0.f;
#pragma unroll
        for (int i = 0; i < 4; ++i) { o[i] = *(const LAS f32x4*)(OL + t * 132 + j * 16 + 4 * i); s += (o[i].x * o[i].x + o[i].y * o[i].y) + (o[i].z * o[i].z + o[i].w * o[i].w); }
        s += __shfl_xor(s, 1); s += __shfl_xor(s, 2); s += __shfl_xor(s, 4);
        const float r = rsqrtf(s * (1.f / 128.f) + EPS);
        const bf16* ogp = proj + (size_t)(tok0 + t) * PROJW + 1024 + h * 128 + j * 16; const u32x4 g0 = *(const u32x4*)ogp, g1 = *(const u32x4*)(ogp + 8);
        const float og[16] = {bflo(g0.x), bfhi(g0.x), bflo(g0.y), bfhi(g0.y), bflo(g0.z), bfhi(g0.z), bflo(g0.w), bfhi(g0.w), bflo(g1.x), bfhi(g1.x), bflo(g1.y), bfhi(g1.y), bflo(g1.z), bfhi(g1.z), bflo(g1.w), bfhi(g1.w)};
        float y[16];
#pragma unroll
        for (int i = 0; i < 4; ++i) { const f32x4 gn = *(const f32x4*)(a.in[6] + j * 16 + 4 * i);
#pragma unroll
            for (int c = 0; c < 4; ++c) { const float g = og[4 * i + c]; y[4 * i + c] = o[i][c] * r * gn[c] * (g / (1.f + __expf(-g))); } }
        u32x4 p0, p1; p0.x = pk2(y[0], y[1]); p0.y = pk2(y[2], y[3]); p0.z = pk2(y[4], y[5]); p0.w = pk2(y[6], y[7]); p1.x = pk2(y[8], y[9]); p1.y = pk2(y[10], y[11]); p1.z = pk2(y[12], y[13]); p1.w = pk2(y[14], y[15]);
        bf16* mp = mix + (size_t)(tok0 + t) * DM + h * 128 + j * 16; *(u32x4*)mp = p0; *(u32x4*)(mp + 8) = p1; }
    __syncthreads();
}

#define XB_TMO      128
#define XB_XCNT(j)  (256  + 64 * (j))
#define XB_XSUB(j)  (1280 + 64 * (j))
#define XB_XGEN(j)  (2304 + 64 * (j))
#define XB_TOP      3328
#define XB_TOPGEN   3392
#define XCD_BAR_WORDS 3456
#define XB_SPIN_CAP (1u << 18)

__device__ __forceinline__ unsigned xb_ld(unsigned* p)              { return __hip_atomic_load(p, __ATOMIC_RELAXED, __HIP_MEMORY_SCOPE_AGENT); }
__device__ __forceinline__ unsigned xb_add(unsigned* p, unsigned v) { return __hip_atomic_fetch_add(p, v, __ATOMIC_RELAXED, __HIP_MEMORY_SCOPE_AGENT); }
__device__ __forceinline__ unsigned xb_xcc_id() { return (unsigned)__builtin_amdgcn_s_getreg((3 << 11) | 20) & 0xFu; }
#define XB_SPIN(cond, bar) do { unsigned _sp = 0; while (cond) { __builtin_amdgcn_s_sleep(1); \
    if ((++_sp & 255u) == 0u) { if (xb_ld(&(bar)[XB_TMO])) break; if (_sp > XB_SPIN_CAP) { atomicAdd(&(bar)[XB_TMO], 1u); break; } } } } while (0)

struct XcdBarrier {
    unsigned* bar; unsigned x;
    volatile LAS unsigned* st;
};

__device__ __forceinline__ XcdBarrier xcd_barrier_post(unsigned* bar, volatile LAS unsigned* st, bool leader) {
    XcdBarrier b; b.bar = bar; b.x = xb_xcc_id(); b.st = st;
    if (leader) (void)xb_add(&bar[XB_XCNT(b.x)], 1u);
    return b;
}
__device__ __forceinline__ void xcd_barrier_complete(unsigned* bar, unsigned x, unsigned& nloc, unsigned& nx) {
    const unsigned G = gridDim.x * gridDim.y * gridDim.z;
    unsigned sum, cnt, mine, sp = 0u;
    for (;;) {
        sum = 0u; cnt = 0u; mine = 0u;
#pragma unroll
        for (unsigned j = 0; j < 16; ++j) { const unsigned c = xb_ld(&bar[XB_XCNT(j)]); sum += c; cnt += (c > 0u) ? 1u : 0u; mine = (j == x) ? c : mine; }
        if (sum == G) break;
        __builtin_amdgcn_s_sleep(1);
        if ((++sp & 255u) == 0u) { if (xb_ld(&bar[XB_TMO])) break; if (sp > XB_SPIN_CAP) { atomicAdd(&bar[XB_TMO], 1u); break; } }
    }
    nloc = mine > 0u ? mine : 1u; nx = cnt > 0u ? cnt : 1u;
}

__device__ __forceinline__ void xcd_barrier(const XcdBarrier& b, bool leader) {
    asm volatile("s_waitcnt vmcnt(0)" ::: "memory");
    __syncthreads();
    if (leader) {
        unsigned* bar = b.bar;
        __builtin_amdgcn_s_waitcnt(0);
        unsigned nloc = b.st[0], nx = b.st[1];
        if (nloc == 0u) { xcd_barrier_complete(bar, b.x, nloc, nx); b.st[0] = nloc; b.st[1] = nx; }
        const unsigned old = xb_add(&bar[XB_XSUB(b.x)], 1u);
        const unsigned gen = old / nloc;
        if (old + 1u == (gen + 1u) * nloc) {
            __builtin_amdgcn_fence(__ATOMIC_RELEASE, "agent");
            asm volatile("s_waitcnt vmcnt(0)" ::: "memory");
            const unsigned og = xb_add(&bar[XB_TOP], 1u);
            const unsigned tg = og / nx;
            if (og + 1u == (tg + 1u) * nx) xb_add(&bar[XB_TOPGEN], 1u);
            else XB_SPIN(xb_ld(&bar[XB_TOPGEN]) == tg, bar);
            __builtin_amdgcn_fence(__ATOMIC_ACQUIRE, "agent");
            xb_add(&bar[XB_XGEN(b.x)], 1u);
            asm volatile("s_waitcnt vmcnt(0)" ::: "memory");
        } else {
            XB_SPIN(xb_ld(&bar[XB_XGEN(b.x)]) == gen, bar);
            __builtin_amdgcn_fence(__ATOMIC_ACQUIRE, "agent");
            asm volatile("s_waitcnt vmcnt(0)" ::: "memory");
        }
    }
    __syncthreads();
}

#ifndef MK_SKIP
#define MK_SKIP 0
#endif
#define RUN(k) (!((MK_SKIP >> (k)) & 1))
#ifndef REP_SYNC
#define REP_SYNC 1
#endif
#ifndef REP_P0
#define REP_P0 1
#endif
#ifndef REP_P1
#define REP_P1 1
#endif
#ifndef REP_GL
#define REP_GL 1
#endif
#ifndef REP_SC
#define REP_SC 1
#endif
#ifndef REP_AT
#define REP_AT 1
#endif
#ifndef REP_GF
#define REP_GF 1
#endif
#ifndef REP_P6
#define REP_P6 1
#endif
#define GSYNC() do { for (int s_ = 0; s_ < REP_SYNC; ++s_) xcd_barrier(xbar, wave == 0 && lane_id() == 0); } while (0)
__global__ void __launch_bounds__(NT, 2) mk_fwd(Args a) {
    extern __shared__ __attribute__((aligned(16))) unsigned char lds_raw[];
    LAS unsigned char* lds = (LAS unsigned char*)lds_raw;
    const int wave = __builtin_amdgcn_readfirstlane(threadIdx.x >> 6);
#define lane (lane_id())
#define tid (wave * 64 + lane_id())
    const int G = gridDim.x, bx = blockIdx.x, vcu = (G % 8 == 0) ? (bx % 8) * (G / 8) + bx / 8 : bx;
    unsigned char* ws = a.ws;
    bf16* xb = (bf16*)(ws + WS_XB); float* small = (float*)(ws + WS_SMALL);
    float* ss2 = small + M; float* ss3 = small + 2 * M; float* ssE = small + 3 * M;
    volatile LAS unsigned* xst = (volatile LAS unsigned*)(lds + XCH_OFF + 8192);
    if (wave == 0 && lane_id() == 0) { xst[0] = 0u; xst[1] = 0u; }
    __syncthreads();
    const XcdBarrier xbar = xcd_barrier_post((unsigned*)ws, xst, wave == 0 && lane_id() == 0);

    for (int rep_ = 0; rep_ < REP_P0; ++rep_) if (RUN(0)) p0_prologue(a, lds, vcu, G, wave, lane, tid);
    GSYNC();
    for (int rep_ = 0; rep_ < REP_P1; ++rep_) if (RUN(1)) {   pg8::Gemm g{xb, (const bf16*)(ws + WS_WIN), M, PROJW, DM}; pg8::StaticOrder S; S.init(M / 256, PROJW / 256, G, bx);
        pg8::EpiScaleBf16 E{(bf16*)(ws + WS_PROJ), PROJW, small};
        pg8::gemm_phase<pg8::EpiScaleBf16, pg8::StaticOrder, true, true>(lds, g, S, E, wave);
        p1_skinny(a, lds, vcu, G, wave, lane, tid);
    }
    GSYNC();
    for (int rep_ = 0; rep_ < REP_GL; ++rep_) if (RUN(2)) for (int task = vcu; task < 1024; task += G) gla_local(a, lds, task, wave, lane, tid);
    if (RUN(9)) fox_prep(a, vcu, G, wave, lane);
    GSYNC();
    for (int rep_ = 0; rep_ < REP_SC; ++rep_) if (RUN(10)) gla_scan(a, vcu, G, tid);
    for (int rep_ = 0; rep_ < REP_AT; ++rep_) if (RUN(3)) {   const attn_body::bf16* pj = (const attn_body::bf16*)(ws + WS_PROJ);
        const attn_body::AttnTensors AT{pj + 1536, pj + 2048, pj + 2560, (attn_body::bf16*)(ws + WS_MIX) + 512, small + 4 * M + 65536};
        const attn_body::StaticOrder S(G, vcu);
        attn_body::attn_phase<attn_body::StaticOrder>((char*)lds_raw, AT, S);
    }
    GSYNC();
    for (int rep_ = 0; rep_ < REP_GF; ++rep_) if (RUN(4)) for (int task = vcu; task < 1024; task += G) gla_final(a, lds, task, wave, lane, tid);
    GSYNC();
    if (RUN(5)) {   pg8::Gemm g{(const bf16*)(ws + WS_MIX), (const bf16*)(ws + WS_WO), M, DM, DM}; pg8::StaticOrder S; S.init(M / 256, DM / 256, G, bx);
        pg8::EpiRes E{a.in[0], a.out, xb, ss2, DM};
        pg8::gemm_phase<pg8::EpiRes, pg8::StaticOrder, true, true>(lds, g, S, E, wave);
    }
    GSYNC();
    for (int rep_ = 0; rep_ < REP_P6; ++rep_) if (RUN(6)) {   pg8::Gemm g{xb, (const bf16*)(ws + WS_WUP), M, 2 * FF, DM}; pg8::StaticOrder S; S.init(65, 2 * FF / 256, G, bx, 254, -2);
        pg8::EpiUp E{(bf16*)(ws + WS_ACT), ss2, a.in[13], a.in[14], (LAS float*)(lds + XCH_OFF)};
        pg8::gemm_phase<pg8::EpiUp, pg8::StaticOrder, true, true>(lds, g, S, E, wave);
    }
    GSYNC();
    if (RUN(7)) {   pg8::Gemm g{(const bf16*)(ws + WS_ACT), (const bf16*)(ws + WS_WD), M, DM, FF}; pg8::StaticOrder S; S.init(M / 256, DM / 256, G, bx);
        pg8::EpiRes E{a.out, a.out, xb, ss3, DM};
        pg8::gemm_phase<pg8::EpiRes, pg8::StaticOrder, true, true>(lds, g, S, E, wave);
        pg8::Gemm g2{(const bf16*)(ws + WS_PB), (const bf16*)(ws + WS_WPE), M, DM, PLE};
        pg8::EpiRes E2{nullptr, nullptr, (bf16*)(ws + WS_E), ssE, DM};
        pg8::gemm_phase<pg8::EpiRes, pg8::StaticOrder, true, true>(lds, g2, S, E2, wave);
    }
    GSYNC();
    if (RUN(8)) {   pg8::Gemm g{xb, (const bf16*)(ws + WS_WPG), M, DM, DM}; pg8::StaticOrder S; S.init(M / 256, DM / 256, G, bx);
        pg8::EpiGate E{a.out, a.out, (const bf16*)(ws + WS_E), ss3, ssE, a.in[20], a.in[18], DM};
        pg8::gemm_phase<pg8::EpiGate, pg8::StaticOrder, true, true>(lds, g, S, E, wave);
    }
#undef lane
#undef tid
}
}

extern "C" void kernel_launch(void* const* d_in, const int* in_sizes, int n_in, void* d_out, int out_size, void* d_ws, size_t ws_size, hipStream_t stream) {
    static int grid = 0;
    if (grid == 0) {
        int dev = 0, cus = 0, per_cu = 0;
        hipGetDevice(&dev); hipDeviceGetAttribute(&cus, hipDeviceAttributeMultiprocessorCount, dev);
        hipFuncSetAttribute((const void*)mk::mk_fwd, hipFuncAttributeMaxDynamicSharedMemorySize, mk::LDS_BYTES);
        hipOccupancyMaxActiveBlocksPerMultiprocessor(&per_cu, (const void*)mk::mk_fwd, mk::NT, mk::LDS_BYTES);
        if (per_cu < 1) { fprintf(stderr, "kernel_launch: occupancy query says %d blocks per CU\n", per_cu); per_cu = 1; }
        grid = cus * per_cu;
        if (n_in != 21 || ws_size < mk::WS_END) { fprintf(stderr, "kernel_launch: unexpected n_in %d / ws %zu\n", n_in, ws_size); grid = -1; }
    }
    if (grid < 0) return;
    if (hipMemsetAsync(d_ws, 0, 65536, stream) != hipSuccess) { fprintf(stderr, "kernel_launch: memset of the barrier words failed\n"); return; }
    mk::Args a{};
    for (int i = 0; i < 21; ++i) a.in[i] = (const float*)d_in[i];
    a.out = (float*)d_out; a.ws = (unsigned char*)d_ws;
    void* args[] = {&a};
    hipError_t e = hipLaunchCooperativeKernel((const void*)mk::mk_fwd, dim3(grid), dim3(mk::NT), args, mk::LDS_BYTES, stream);
    if (e != hipSuccess) fprintf(stderr, "cooperative launch failed: %s (grid %d)\n", hipGetErrorString(e), grid);
}
```

```cpp
#include <hip/hip_runtime.h>
#include <hip/hip_cooperative_groups.h>
#include <cstdio>
#include <cstdint>
namespace cg = cooperative_groups;
__device__ __forceinline__ int lane_id() { int l; asm volatile("v_mbcnt_lo_u32_b32 %0, -1, 0\n\tv_mbcnt_hi_u32_b32 %0, -1, %0" : "=v"(l)); return l; }
namespace pg8 {
#define PG8_LAS __attribute__((address_space(3)))
typedef unsigned short bf16_t;
typedef short bf16x8 __attribute__((ext_vector_type(8)));
typedef float f32x4 __attribute__((ext_vector_type(4)));
typedef unsigned u32x4 __attribute__((ext_vector_type(4)));
constexpr int BM = 256, BK = 64, HALF = 128, HTB = HALF * BK * 2  , STAGE_BYTES = 8 * HTB, NXCD = 8, WGM = 8;

__host__ __device__ __forceinline__ int lds_byte(int r, int c) { const int st = (r >> 4) * 2 + (c >> 5), rr = r & 15, cc = c & 31, ob = rr * 64 + cc * 2; return st * 1024 + (ob ^ (((ob >> 9) & 1) << 5)); }
__host__ __device__ __forceinline__ void stage_rc(int b, int& R, int& C) { const int st = b / 1024, sb = b % 1024, swz = sb ^ (((sb >> 9) & 1) << 5); R = (st >> 1) * 16 + swz / 64; C = (st & 1) * 32 + (swz % 64) / 2; }
__host__ __device__ __forceinline__ int perm32(int rho) { const int n = rho >> 4, i = rho & 15; return 8 * (i >> 2) + 4 * n + (i & 3); }

struct Unit { int pm, pn, arow; };
struct Gemm { const bf16_t* A; const bf16_t* Bt; int M, N, K; };

struct StaticOrder {
    int nM, nN, nwg, G, c, mstride, moff;
    __host__ __device__ void init(int nM_, int nN_, int G_, int c_, int mstride_ = 256, int moff_ = 0) { nM = nM_; nN = nN_; nwg = nM * nN; G = G_; c = c_; mstride = mstride_; moff = moff_; }
    __host__ __device__ bool next(int i, Unit& u) const {
        const long L = (long)i * G + c; if (L >= nwg) return false;
        int wgid = (int)L; { const int q = nwg / NXCD, r = nwg % NXCD, xcd = wgid % NXCD, off = wgid / NXCD; wgid = (xcd < r ? xcd * (q + 1) : r * (q + 1) + (xcd - r) * q) + off; }
        const int nig = WGM * nN, gid = wgid / nig, fm = gid * WGM, gsz = (nM - fm) < WGM ? (nM - fm) : WGM;
        u.pm = fm + ((wgid % nig) % gsz); u.pn = (wgid % nig) / gsz; u.arow = u.pm * mstride + moff; return true;
    }
    __device__ __forceinline__ void a_ready(const Unit&) const {}
    __device__ __forceinline__ void done(const Unit&) const {}
};

__device__ __forceinline__ unsigned cvt_pk_bf16(float lo, float hi) { unsigned r; asm volatile("v_cvt_pk_bf16_f32 %0, %1, %2" : "=v"(r) : "v"(lo), "v"(hi)); return r; }
typedef float f32x2 __attribute__((ext_vector_type(2)));
typedef float f32x2 __attribute__((ext_vector_type(2)));
template <class Epi, class Sched, bool ALIGN_EPI = false, bool SP2 = false>
__device__ __forceinline__ void gemm_phase(PG8_LAS unsigned char* lds, const Gemm g, const Sched& S, const Epi& E, int wave_sgpr) {
    const int wid = wave_sgpr, lane = lane_id(), tid = wid * 64 + lane, wr = wid >> 2, wc = wid & 3, fr = lane & 15, fq = lane >> 4;
    const int K = g.K, nt = K / BK;
    unsigned voffA[2], voffB[2];
#pragma unroll
    for (int i = 0; i < 2; ++i) { int R, C; stage_rc(tid * 16 + i * 8192, R, C); const int Rb = Epi::PERM ? ((R & ~31) + perm32(R & 31)) : R;
        voffA[i] = (unsigned)(R * K + C) * 2u; voffB[i] = (unsigned)(Rb * K + C) * 2u; }
    const size_t kstep = (size_t)(BK * 2);
    const size_t hstep = (size_t)HALF * K * 2;
    const size_t tstep = 2 * hstep;
    const unsigned ldsw = (unsigned)wid * 1024u;
    const int aoff = lds_byte(wr * 64 + fr, fq * 8), boff = lds_byte(wc * 32 + fr, fq * 8);
#define PG8_SA(b, h) (((b) * 2 + (h)) * HTB)
#define PG8_SB(b, h) ((4 + (b) * 2 + (h)) * HTB)
#define PG8_STAGE(bufoff, gbase, voff) do { _Pragma("unroll") for (int _i = 0; _i < 2; ++_i) \
        __builtin_amdgcn_global_load_lds((const unsigned*)((const char*)(gbase) + (voff)[_i]), (PG8_LAS unsigned*)(lds + (bufoff) + ldsw + _i * 8192), 16, 0, 0); } while (0)
#define PG8_LDA(dst, b, h) do { _Pragma("unroll") for (int m = 0; m < 4; ++m) _Pragma("unroll") for (int k = 0; k < 2; ++k) dst[m][k] = *(const PG8_LAS bf16x8*)(lds + PG8_SA(b, h) + aoff + m * 2048 + k * 1024); } while (0)
#define PG8_LDB(dst, b, h) do { _Pragma("unroll") for (int n = 0; n < 2; ++n) _Pragma("unroll") for (int k = 0; k < 2; ++k) dst[n][k] = *(const PG8_LAS bf16x8*)(lds + PG8_SB(b, h) + boff + n * 2048 + k * 1024); } while (0)
#define PG8_MMA(ai, bj, At, Bt) do { __builtin_amdgcn_s_setprio(1); _Pragma("unroll") for (int m = 0; m < 4; ++m) _Pragma("unroll") for (int n = 0; n < 2; ++n) _Pragma("unroll") for (int k = 0; k < 2; ++k) \
        acc[ai][bj][m][n] = __builtin_amdgcn_mfma_f32_16x16x32_bf16(Bt[n][k], At[m][k], acc[ai][bj][m][n], 0, 0, 0); __builtin_amdgcn_s_setprio(0); } while (0)
#define PG8_WAIT_V(n) asm volatile("s_waitcnt vmcnt(" #n ")" ::: "memory")
#define PG8_WAIT_L(n) asm volatile("s_waitcnt lgkmcnt(" #n ")" ::: "memory")
#define PG8_BAR __builtin_amdgcn_s_barrier()
#define PG8_SCHED __builtin_amdgcn_sched_barrier(0)
    Unit cur, nxt; int ui = 0;
    if (!S.next(0, cur)) return;
    f32x4 acc[2][2][4][2];
#pragma unroll
    for (int a = 0; a < 2; ++a)
#pragma unroll
        for (int b = 0; b < 2; ++b)
#pragma unroll
            for (int m = 0; m < 4; ++m)
#pragma unroll
                for (int n = 0; n < 2; ++n) acc[a][b][m][n] = (f32x4){0.f, 0.f, 0.f, 0.f};
    bf16x8 At[4][2], B0[2][2], B1[2][2];
    const char* cA = (const char*)g.A + (long)cur.arow * (long)(K * 2); const char* cB = (const char*)g.Bt + (size_t)cur.pn * tstep;
    S.a_ready(cur);
    if constexpr (SP2) {
        PG8_STAGE(PG8_SB(0, 0), cB, voffB); PG8_STAGE(PG8_SB(0, 1), cB + hstep, voffB); PG8_STAGE(PG8_SA(0, 0), cA, voffA); PG8_STAGE(PG8_SA(0, 1), cA + hstep, voffA);
        if (wr == 1) PG8_BAR;
        PG8_WAIT_V(2); PG8_BAR;
        PG8_STAGE(PG8_SB(1, 0), cB + kstep, voffB); PG8_STAGE(PG8_SA(1, 0), cA + kstep, voffA); PG8_STAGE(PG8_SB(1, 1), cB + hstep + kstep, voffB);
        PG8_WAIT_V(6); PG8_BAR;
    } else {
        PG8_STAGE(PG8_SB(0, 0), cB, voffB); PG8_STAGE(PG8_SA(0, 0), cA, voffA); PG8_STAGE(PG8_SB(0, 1), cB + hstep, voffB); PG8_STAGE(PG8_SA(0, 1), cA + hstep, voffA);
        if (wr == 1) PG8_BAR;
        PG8_WAIT_V(4); PG8_BAR;
        PG8_STAGE(PG8_SB(1, 0), cB + kstep, voffB); PG8_STAGE(PG8_SA(1, 0), cA + kstep, voffA); PG8_STAGE(PG8_SB(1, 1), cB + hstep + kstep, voffB);
        PG8_WAIT_V(6); PG8_BAR;
    }
    for (;;) {
        const bool has_next = S.next(ui + 1, nxt);
        const char* nA = has_next ? (const char*)g.A + (long)nxt.arow * (long)(K * 2) : cA; const char* nB = has_next ? (const char*)g.Bt + (size_t)nxt.pn * tstep : cB;
        for (int t = 0; t < nt; t += 2) {
            const bool last = (t == nt - 2);
            const char* a1 = cA + (size_t)(t + 1) * kstep;
            const char* a2 = last ? nA : cA + (size_t)(t + 2) * kstep; const char* b2 = last ? nB : cB + (size_t)(t + 2) * kstep;
            const char* a3 = a2 + kstep; const char* b3 = b2 + kstep;
            if (last && has_next) S.a_ready(nxt);
            if constexpr (SP2) {
            PG8_LDB(B0, 0, 0); PG8_LDB(B1, 0, 1); PG8_SCHED; PG8_LDA(At, 0, 0); PG8_STAGE(PG8_SA(1, 1), a1 + hstep, voffA);
            PG8_WAIT_V(8); PG8_WAIT_L(0); PG8_BAR; PG8_MMA(0, 0, At, B0); PG8_MMA(0, 1, At, B1); PG8_BAR; PG8_SCHED;
            PG8_LDA(At, 0, 1); PG8_STAGE(PG8_SB(0, 0), b2, voffB); PG8_STAGE(PG8_SB(0, 1), b2 + hstep, voffB); PG8_STAGE(PG8_SA(0, 0), a2, voffA);
            PG8_WAIT_V(8); PG8_WAIT_L(0); PG8_BAR; PG8_MMA(1, 0, At, B0); PG8_MMA(1, 1, At, B1); PG8_BAR; PG8_SCHED;
            PG8_LDB(B0, 1, 0); PG8_LDB(B1, 1, 1); PG8_SCHED; PG8_LDA(At, 1, 0); PG8_STAGE(PG8_SA(0, 1), a2 + hstep, voffA);
            PG8_WAIT_V(8); PG8_WAIT_L(0); PG8_BAR; PG8_MMA(0, 0, At, B0); PG8_MMA(0, 1, At, B1); PG8_BAR; PG8_SCHED;
            PG8_LDA(At, 1, 1); PG8_STAGE(PG8_SB(1, 0), b3, voffB); PG8_STAGE(PG8_SB(1, 1), b3 + hstep, voffB); PG8_STAGE(PG8_SA(1, 0), a3, voffA);
            PG8_WAIT_V(8); PG8_WAIT_L(0); PG8_BAR; PG8_MMA(1, 0, At, B0); PG8_MMA(1, 1, At, B1); PG8_BAR; PG8_SCHED;
            } else {
            PG8_LDB(B0, 0, 0); PG8_SCHED; PG8_LDA(At, 0, 0); PG8_STAGE(PG8_SA(1, 1), a1 + hstep, voffA);
            PG8_WAIT_L(8); PG8_BAR; PG8_WAIT_L(0); PG8_MMA(0, 0, At, B0); PG8_BAR; PG8_SCHED;
            PG8_LDB(B1, 0, 1); PG8_STAGE(PG8_SB(0, 0), b2, voffB);
            PG8_BAR; PG8_WAIT_L(0); PG8_MMA(0, 1, At, B1); PG8_BAR;
            PG8_LDA(At, 0, 1); PG8_STAGE(PG8_SA(0, 0), a2, voffA);
            PG8_BAR; PG8_WAIT_L(0); PG8_MMA(1, 0, At, B0); PG8_BAR; PG8_SCHED;
            PG8_STAGE(PG8_SB(0, 1), b2 + hstep, voffB);
            PG8_WAIT_V(6); PG8_BAR; PG8_MMA(1, 1, At, B1); PG8_BAR;
            PG8_LDB(B0, 1, 0); PG8_SCHED; PG8_LDA(At, 1, 0); PG8_STAGE(PG8_SA(0, 1), a2 + hstep, voffA);
            PG8_WAIT_L(8); PG8_BAR; PG8_WAIT_L(0); PG8_MMA(0, 0, At, B0); PG8_BAR; PG8_SCHED;
            PG8_LDB(B1, 1, 1); PG8_STAGE(PG8_SB(1, 0), b3, voffB);
            PG8_BAR; PG8_WAIT_L(0); PG8_MMA(0, 1, At, B1); PG8_BAR;
            PG8_LDA(At, 1, 1); PG8_STAGE(PG8_SA(1, 0), a3, voffA);
            PG8_BAR; PG8_WAIT_L(0); PG8_MMA(1, 0, At, B0); PG8_BAR; PG8_SCHED;
            PG8_STAGE(PG8_SB(1, 1), b3 + hstep, voffB);
            PG8_WAIT_V(6); PG8_BAR; PG8_MMA(1, 1, At, B1); PG8_BAR;
            }
        }
        if constexpr (ALIGN_EPI) { if (wr == 0) PG8_BAR; }
        if constexpr (!Epi::AFTER_DRAIN) { E(acc, cur, wr, wc, fr, fq); S.done(cur); }
        if (!has_next) break;
#pragma unroll
        for (int a = 0; a < 2; ++a)
#pragma unroll
            for (int b = 0; b < 2; ++b)
#pragma unroll
                for (int m = 0; m < 4; ++m)
#pragma unroll
                    for (int n = 0; n < 2; ++n) acc[a][b][m][n] = (f32x4){0.f, 0.f, 0.f, 0.f};
        cur = nxt; cA = nA; cB = nB; ++ui;
        if constexpr (ALIGN_EPI) { if (wr == 1) PG8_BAR; }
    }
    PG8_WAIT_V(0);
    if constexpr (!ALIGN_EPI) { if (wr == 0) PG8_BAR; }
    PG8_BAR;
    if constexpr (Epi::AFTER_DRAIN) { E.fused(acc, cur, wr, wc, fr, fq, lds, wid, lane); S.done(cur); }
#undef PG8_SA
#undef PG8_SB
#undef PG8_STAGE
#undef PG8_LDA
#undef PG8_LDB
#undef PG8_MMA
#undef PG8_WAIT_V
#undef PG8_WAIT_L
#undef PG8_BAR
#undef PG8_SCHED
}
}
namespace pg8 {
constexpr float RMS_EPS = 1e-6f;
typedef unsigned u32x2 __attribute__((ext_vector_type(2)));
template <int CTRL> __device__ __forceinline__ float dpp_mov(float old, float src) {
    return __builtin_bit_cast(float, __builtin_amdgcn_update_dpp(__builtin_bit_cast(int, old), __builtin_bit_cast(int, src), CTRL, 0xf, 0xf, false)); }
__device__ __forceinline__ float bf_lo(unsigned w) { return __builtin_bit_cast(float, w << 16); }
__device__ __forceinline__ float bf_hi(unsigned w) { return __builtin_bit_cast(float, w & 0xffff0000u); }

struct EpiScaleBf16 {
    static constexpr bool PERM = true, AFTER_DRAIN = false;
    bf16_t* O; int ldc; const float* rs;
    __device__ __forceinline__ void operator()(const f32x4 (&acc)[2][2][4][2], const Unit& u, int wr, int wc, int fr, int fq) const {
        const int row0 = u.pm * BM + wr * 64 + fr, col0 = u.pn * BM + wc * 32 + 8 * fq;
#pragma unroll
        for (int ai = 0; ai < 2; ++ai)
#pragma unroll
            for (int m = 0; m < 4; ++m) { const int r = row0 + ai * HALF + m * 16; const float s = rs[r]; bf16_t* rowp = O + (size_t)r * ldc + col0;
#pragma unroll
                for (int bj = 0; bj < 2; ++bj) { const f32x4 v0 = acc[ai][bj][m][0] * s, v1 = acc[ai][bj][m][1] * s;
                    u32x4 w; w.x = cvt_pk_bf16(v0[0], v0[1]); w.y = cvt_pk_bf16(v0[2], v0[3]); w.z = cvt_pk_bf16(v1[0], v1[1]); w.w = cvt_pk_bf16(v1[2], v1[3]);
                    *(u32x4*)(rowp + bj * HALF) = w; } }
    }
};
struct EpiRes {
    static constexpr bool PERM = true, AFTER_DRAIN = false;
    const float* base; float* outf; bf16_t* outb; float* ss; int ldc;
    __device__ __forceinline__ void operator()(const f32x4 (&acc)[2][2][4][2], const Unit& u, int wr, int wc, int fr, int fq) const {
        const int row0 = u.pm * BM + wr * 64 + fr, col0 = u.pn * BM + wc * 32 + 8 * fq;
#pragma unroll
        for (int ai = 0; ai < 2; ++ai)
#pragma unroll
            for (int m = 0; m < 4; ++m) { const int r = row0 + ai * HALF + m * 16; float q = 0.f;
#pragma unroll
                for (int bj = 0; bj < 2; ++bj) { const size_t off = (size_t)r * ldc + col0 + bj * HALF;
                    f32x4 v0 = acc[ai][bj][m][0], v1 = acc[ai][bj][m][1];
                    if (base) { v0 += *(const f32x4*)(base + off); v1 += *(const f32x4*)(base + off + 4); }
                    if (outf) { *(f32x4*)(outf + off) = v0; *(f32x4*)(outf + off + 4) = v1; }
                    u32x4 w; w.x = cvt_pk_bf16(v0[0], v0[1]); w.y = cvt_pk_bf16(v0[2], v0[3]); w.z = cvt_pk_bf16(v1[0], v1[1]); w.w = cvt_pk_bf16(v1[2], v1[3]);
                    *(u32x4*)(outb + off) = w;
                    q += (v0[0] * v0[0] + v0[1] * v0[1]) + (v0[2] * v0[2] + v0[3] * v0[3]) + (v1[0] * v1[0] + v1[1] * v1[1]) + (v1[2] * v1[2] + v1[3] * v1[3]); }
                q += __shfl_xor(q, 16); q += __shfl_xor(q, 32);
                if (fq == 0) atomicAdd(ss + r, q); }
    }
};
struct EpiGate {
    static constexpr bool PERM = true, AFTER_DRAIN = false;
    const float* x2; float* out; const bf16_t* E; const float* ss3; const float* ssE; const float* bpg; const float* peg; int ldc;
    __device__ __forceinline__ void operator()(const f32x4 (&acc)[2][2][4][2], const Unit& u, int wr, int wc, int fr, int fq) const {
        const int row0 = u.pm * BM + wr * 64 + fr, col0 = u.pn * BM + wc * 32 + 8 * fq;
        f32x4 bp[2][2], pg[2][2];
#pragma unroll
        for (int bj = 0; bj < 2; ++bj)
#pragma unroll
            for (int n = 0; n < 2; ++n) { bp[bj][n] = *(const f32x4*)(bpg + col0 + bj * HALF + 4 * n); pg[bj][n] = *(const f32x4*)(peg + col0 + bj * HALF + 4 * n); }
#pragma unroll
        for (int ai = 0; ai < 2; ++ai)
#pragma unroll
            for (int m = 0; m < 4; ++m) { const int r = row0 + ai * HALF + m * 16;
                const float r3 = rsqrtf(ss3[r] * (1.f / 1024.f) + RMS_EPS), rE = rsqrtf(ssE[r] * (1.f / 1024.f) + RMS_EPS);
#pragma unroll
                for (int bj = 0; bj < 2; ++bj) { const size_t off = (size_t)r * ldc + col0 + bj * HALF;
                    const u32x4 ew = *(const u32x4*)(E + off);
                    const float ev[8] = {bf_lo(ew.x), bf_hi(ew.x), bf_lo(ew.y), bf_hi(ew.y), bf_lo(ew.z), bf_hi(ew.z), bf_lo(ew.w), bf_hi(ew.w)};
#pragma unroll
                    for (int n = 0; n < 2; ++n) { const f32x4 xv = *(const f32x4*)(x2 + off + 4 * n); f32x4 o;
#pragma unroll
                        for (int i = 0; i < 4; ++i) { const float z = acc[ai][bj][m][n][i] * r3 + bp[bj][n][i]; const float g = 1.f / (1.f + __expf(-z));
                            o[i] = xv[i] + g * (ev[4 * n + i] * rE * pg[bj][n][i]); }
                        *(f32x4*)(out + off + 4 * n) = o; } } }
    }
};
struct EpiUp {
    static constexpr bool PERM = true, AFTER_DRAIN = false;
    bf16_t* act; const float* ss2; const float* cw; const float* cb; PG8_LAS float* xch;
    __device__ __forceinline__ void operator()(f32x4 (&acc)[2][2][4][2], const Unit& u, int wr, int wc, int fr, int fq) const {
        constexpr int FF = 2816, MROWS = 16384;
#pragma unroll
        for (int ai = 0; ai < 2; ++ai)
#pragma unroll
            for (int m = 0; m < 4; ++m) { const int gr = u.arow + ai * HALF + wr * 64 + m * 16 + fr;
                const float s = (gr >= 0 && gr < MROWS) ? rsqrtf(ss2[gr] * (1.f / 1024.f) + RMS_EPS) : 0.f;
#pragma unroll
                for (int bj = 0; bj < 2; ++bj)
#pragma unroll
                    for (int n = 0; n < 2; ++n) acc[ai][bj][m][n] *= s; }
        const int cl0 = wc * 32 + 8 * fq;
        if (fr >= 14) {
#pragma unroll
            for (int ai = 0; ai < 2; ++ai)
#pragma unroll
                for (int bj = 0; bj < 2; ++bj)
#pragma unroll
                    for (int n = 0; n < 2; ++n) *(PG8_LAS f32x4*)(xch + ((ai * 2 + wr) * 2 + (fr - 14)) * 256 + bj * HALF + cl0 + 4 * n) = acc[ai][bj][3][n];
        }
        asm volatile("s_waitcnt lgkmcnt(0)\n\ts_barrier" ::: "memory");
        const int ch0 = u.pn * HALF + cl0;
#pragma unroll
        for (int n = 0; n < 2; ++n) {
            f32x4 w0[2], w1[2], w2[2], bb[2];
#pragma unroll
            for (int bj = 0; bj < 2; ++bj) { const int c = bj * FF + ch0 + 4 * n;
                w0[bj] = *(const f32x4*)(cw + c); w1[bj] = *(const f32x4*)(cw + 2 * FF + c); w2[bj] = *(const f32x4*)(cw + 4 * FF + c); bb[bj] = *(const f32x4*)(cb + c); }
#pragma unroll
            for (int ai = 0; ai < 2; ++ai) {
                const int g = ai * 2 + wr;
#pragma unroll
                for (int m = 0; m < 4; ++m) {
                    const int rt = ai * HALF + wr * 64 + m * 16 + fr, gr = u.arow + rt, t = gr & 2047;
                    f32x4 cv[2];
#pragma unroll
                    for (int bj = 0; bj < 2; ++bj) {
                        const f32x4 cur = acc[ai][bj][m][n]; f32x4 prev;
                        if (m > 0) prev = acc[ai][bj][m - 1][n];
                        else { prev = (f32x4){0.f, 0.f, 0.f, 0.f}; if (g > 0 && fr >= 14) prev = *(const PG8_LAS f32x4*)(xch + ((g - 1) * 2 + (fr - 14)) * 256 + bj * HALF + cl0 + 4 * n); }
                        f32x4 p1, p2;
#pragma unroll
                        for (int i = 0; i < 4; ++i) {
                            const float r1 = dpp_mov<0x121>(0.f, prev[i]), r2 = dpp_mov<0x122>(0.f, prev[i]);
                            p1[i] = dpp_mov<0x111>(r1, cur[i]); p2[i] = dpp_mov<0x112>(r2, cur[i]);
                        }
                        if (t == 0) { p1 = (f32x4){0.f, 0.f, 0.f, 0.f}; }
                        if (t <= 1) { p2 = (f32x4){0.f, 0.f, 0.f, 0.f}; }
                        cv[bj] = bb[bj] + w2[bj] * cur + w1[bj] * p1 + w0[bj] * p2;
                    }
                    float a4[4];
#pragma unroll
                    for (int i = 0; i < 4; ++i) { const float gv = cv[0][i]; a4[i] = gv / (1.f + __expf(-gv)) * cv[1][i]; }
                    u32x2 w; w.x = cvt_pk_bf16(a4[0], a4[1]); w.y = cvt_pk_bf16(a4[2], a4[3]);
                    if (rt >= 2 && gr < MROWS) *(u32x2*)(act + (size_t)gr * FF + ch0 + 4 * n) = w;
                }
            }
        }
    }
};
}
#include <hip/hip_bf16.h>
#include <cmath>
namespace attn_body {
using bf16=__hip_bfloat16;
using bf16x8=__attribute__((ext_vector_type(8)))short;
using s16x4=__attribute__((ext_vector_type(4)))short;
using f32x16=__attribute__((ext_vector_type(16)))float;
using u32x4=__attribute__((ext_vector_type(4)))unsigned;
constexpr int BATCH=8,NHEAD=8,SEQ=2048,D=64,DM=3072,OM=1024;
constexpr int NW=8,QBLK=32,QB=QBLK*NW,KVBLK=64,NQB=SEQ/QB;
constexpr int ATTN_PITCH=DM, ATTN_UNIT_ROWS=QB;
__device__ __forceinline__ int crow(int r,int hi){return (r&3)+8*(r>>2)+4*hi;}
#define SBAR() __builtin_amdgcn_sched_barrier(0)
__device__ __forceinline__ void cmask(f32x16&p0,f32x16&p1,int jb,int qrel,int hi){
  const float NEG=-INFINITY; int kb=64*jb+4*hi;
  #pragma unroll
  for(int r=0;r<16;++r){int kv=kb+(r&3)+8*(r>>2); if(kv>qrel)p0[r]=NEG; if(kv+32>qrel)p1[r]=NEG;}
}

constexpr int NSLOT=3, SLOTB=8192;
constexpr int LDS_K=0, LDS_V=NSLOT*SLOTB, LDS_WS=2*NSLOT*SLOTB, LDS_OST=LDS_WS+NW*64*4, LDS_CB=LDS_OST+NW*4096, LDS_BYTES=LDS_CB+8192;
constexpr float C2=0.125f*1.4426950408889634f;
__device__ __forceinline__ void glds16(const void*gsrc,unsigned lds_dst){unsigned keep;
  asm volatile("s_mov_b32 %0, m0\n\ts_mov_b32 m0, %2\n\ts_nop 0\n\tglobal_load_lds_dwordx4 %1, off\n\ts_mov_b32 m0, %0":"=&s"(keep):"v"(gsrc),"s"(lds_dst):"memory");}
__device__ __forceinline__ float max3f(float a,float b,float c){float r;asm("v_max3_f32 %0, %1, %2, %3":"=v"(r):"v"(a),"v"(b),"v"(c));return r;}
__device__ __forceinline__ float max2f(float a,float b){float r;asm("v_max_f32_e32 %0, %1, %2":"=v"(r):"v"(a),"v"(b));return r;}
__device__ __forceinline__ float fadd_s(float a,float b){float r;asm("v_add_f32_e32 %0, %1, %2":"=v"(r):"v"(a),"v"(b));return r;}
__device__ __forceinline__ float fsub_s(float a,float b){float r;asm("v_sub_f32_e32 %0, %1, %2":"=v"(r):"v"(a),"v"(b));return r;}
typedef float f32x2_t __attribute__((ext_vector_type(2))); typedef __bf16 bf16x2_t __attribute__((ext_vector_type(2)));
__device__ __forceinline__ unsigned cvtpk_s(float lo,float hi){f32x2_t v={lo,hi};bf16x2_t b=__builtin_convertvector(v,bf16x2_t);return __builtin_bit_cast(unsigned,b);}
#define WAIT_BAR(N) asm volatile("s_waitcnt vmcnt(" #N ") lgkmcnt(0)\n\ts_barrier":::"memory")

__device__ __forceinline__ void qkt(f32x16&p0,f32x16&p1,const char*Kslot,const bf16x8*qr,const f32x16&negm,int r32,int hi){
  const char*kb=Kslot+hi*1024+r32*16;
  #pragma unroll
  for(int d0=0;d0<4;++d0){
    const bf16x8 b0=*reinterpret_cast<const bf16x8*>(kb+d0*2048);
    const bf16x8 b1=*reinterpret_cast<const bf16x8*>(kb+d0*2048+512);
    if(d0==0){p0=__builtin_amdgcn_mfma_f32_32x32x16_bf16(b0,qr[0],negm,0,0,0);p1=__builtin_amdgcn_mfma_f32_32x32x16_bf16(b1,qr[0],negm,0,0,0);}
    else{p0=__builtin_amdgcn_mfma_f32_32x32x16_bf16(b0,qr[d0],p0,0,0,0);p1=__builtin_amdgcn_mfma_f32_32x32x16_bf16(b1,qr[d0],p1,0,0,0);}}
}
typedef __attribute__((address_space(3))) const char* lds_cptr;
typedef short v4i16_t __attribute__((ext_vector_type(4)));
__device__ __forceinline__ void kload8(bf16x8*kf,lds_cptr kp){
  kf[0]=*(const __attribute__((address_space(3))) bf16x8*)(kp);      kf[1]=*(const __attribute__((address_space(3))) bf16x8*)(kp+512);
  kf[2]=*(const __attribute__((address_space(3))) bf16x8*)(kp+2048); kf[3]=*(const __attribute__((address_space(3))) bf16x8*)(kp+2560);
  kf[4]=*(const __attribute__((address_space(3))) bf16x8*)(kp+4096); kf[5]=*(const __attribute__((address_space(3))) bf16x8*)(kp+4608);
  kf[6]=*(const __attribute__((address_space(3))) bf16x8*)(kp+6144); kf[7]=*(const __attribute__((address_space(3))) bf16x8*)(kp+6656);
}
__device__ __forceinline__ void kload2(bf16x8*kf,lds_cptr kp,int j){ kf[2*j]=*(const __attribute__((address_space(3))) bf16x8*)(kp+j*2048); kf[2*j+1]=*(const __attribute__((address_space(3))) bf16x8*)(kp+j*2048+512); }
__device__ __forceinline__ s16x4 vtr(lds_cptr p){ return __builtin_bit_cast(s16x4,__builtin_amdgcn_ds_read_tr16_b64_v4i16((__attribute__((address_space(3))) v4i16_t*)p)); }
__device__ __forceinline__ float rowmax(const f32x16&p0,const f32x16&p1){
  float a=max3f(p0[0],p0[1],p1[0]),b=max3f(p0[2],p0[3],p1[1]);a=max3f(a,p1[2],p1[3]);
  #pragma unroll
  for(int r=4;r<16;r+=4){a=max3f(a,p0[r],p0[r+1]);b=max3f(b,p0[r+2],p0[r+3]);a=max3f(a,p1[r],p1[r+1]);b=max3f(b,p1[r+2],p1[r+3]);}
  const float m=max2f(a,b);
  auto rr=__builtin_amdgcn_permlane32_swap(__float_as_uint(m),__float_as_uint(m),false,false);
  return max2f(__uint_as_float(rr[0]),__uint_as_float(rr[1]));
}
__device__ __forceinline__ void pv(f32x16*o,int vb,bf16x8 pa0,bf16x8 pa1,bf16x8 pa2,bf16x8 pa3){
  #pragma unroll
  for(int d0=0;d0<2;++d0){s16x4 lo[4],hi[4];
    #pragma unroll
    for(int ks=0;ks<4;++ks){
      asm volatile("ds_read_b64_tr_b16 %0,%1 offset:%c2":"=&v"(lo[ks]):"v"(vb),"i"(d0*4096+ks*1024):"memory");
      asm volatile("ds_read_b64_tr_b16 %0,%1 offset:%c2":"=&v"(hi[ks]):"v"(vb),"i"(d0*4096+ks*1024+512):"memory");}
    asm volatile("s_waitcnt lgkmcnt(0)":::"memory");SBAR();
    #define PK(k) (bf16x8){lo[k][0],lo[k][1],lo[k][2],lo[k][3],hi[k][0],hi[k][1],hi[k][2],hi[k][3]}
    o[d0]=__builtin_amdgcn_mfma_f32_32x32x16_bf16(pa0,PK(0),o[d0],0,0,0);
    o[d0]=__builtin_amdgcn_mfma_f32_32x32x16_bf16(pa1,PK(1),o[d0],0,0,0);
    o[d0]=__builtin_amdgcn_mfma_f32_32x32x16_bf16(pa2,PK(2),o[d0],0,0,0);
    o[d0]=__builtin_amdgcn_mfma_f32_32x32x16_bf16(pa3,PK(3),o[d0],0,0,0);
    #undef PK
  }
}

#ifndef ATTN_STORE16
#define ATTN_STORE16(p,v) (*(u32x4*)(p)=(v))
#endif
template<int THRL> __device__ __forceinline__ void attn_unit(int b,int h,int qb,const bf16*Q,const bf16*__restrict__ K,const bf16*__restrict__ V,bf16*O,const float*__restrict__ CB,char*shm){
  const int tid=threadIdx.x,lane=tid&63,r32=lane&31,hi=lane>>5; const int wid=__builtin_amdgcn_readfirstlane(tid>>6);
  const long rowbase=(long)b*SEQ; const int q0=qb*QB;
  const bf16*Qw=Q+(rowbase+q0+wid*QBLK)*DM+h*D;
  const bf16*Kh=K+rowbase*DM+h*D,*Vh=V+rowbase*DM+h*D;
  const lds_cptr shm3=(lds_cptr)shm; const unsigned lds0=(unsigned)(uintptr_t)shm;
  float*wsf=(float*)(shm+LDS_WS)+wid*64;
  const bf16*ksrc=Kh+(long)lane*DM+wid*8;
  const bf16*vsrc=Vh+(long)(16*(wid&3)+(lane>>2))*DM+(wid>>2)*32+(lane&3)*8;
  const unsigned kdst=lds0+LDS_K+wid*1024, vdst=lds0+LDS_V+wid*1024;
  #define DMA_K(t,slot) glds16(ksrc+(long)(t)*KVBLK*DM,(unsigned)__builtin_amdgcn_readfirstlane(kdst+(slot)))
  #define DMA_V(t,slot) glds16(vsrc+(long)(t)*KVBLK*DM,(unsigned)__builtin_amdgcn_readfirstlane(vdst+(slot)))
  const int vb0=(int)(lds0+LDS_V)+((lane>>4)&1)*32+(lane&3)*8+(4*hi+((lane&15)>>2))*64;
  const char*Kbase=shm+LDS_K; bf16x8 kf[8];
  const lds_cptr kp0=shm3+LDS_K+hi*1024+r32*16; const lds_cptr vp0=shm3+LDS_V+((lane>>4)&1)*32+(lane&3)*8+(4*hi+((lane&15)>>2))*64;
  const int NT=(q0+QB)/KVBLK;
  typedef __attribute__((address_space(3))) float* lds_fptr; typedef float f32x4_t __attribute__((ext_vector_type(4)));
  const lds_fptr cbl=(lds_fptr)(shm3+LDS_CB);
  { const float*cg_=CB+(long)(b*NHEAD+h)*SEQ; const float cref=cg_[q0];
    for(int i_=tid;i_<(q0+QB)/4;i_+=NW*64){ f32x4_t v_=*(const f32x4_t*)(cg_+4*i_); v_-=cref; *(__attribute__((address_space(3))) f32x4_t*)(cbl+4*i_)=v_; } }
  #define BIAS(P0,P1,t) do{ const lds_fptr cp_=cbl+64*(t)+4*hi; \
    _Pragma("unroll") for(int g_=0;g_<4;++g_){ { const f32x4_t c0_=*(const __attribute__((address_space(3))) f32x4_t*)(cp_+8*g_)+mhat; \
      _Pragma("unroll") for(int i_=0;i_<4;++i_){ P0[4*g_+i_]-=c0_[i_]; } } asm volatile("":::"memory"); \
      { const f32x4_t c1_=*(const __attribute__((address_space(3))) f32x4_t*)(cp_+32+8*g_)+mhat; \
      _Pragma("unroll") for(int i_=0;i_<4;++i_){ P1[4*g_+i_]-=c1_[i_]; } } asm volatile("":::"memory"); } }while(0)
  DMA_K(0,0);DMA_V(0,0);DMA_K(1,SLOTB);
  bf16x8 qr[4];
  #pragma unroll
  for(int d0=0;d0<4;++d0)qr[d0]=*reinterpret_cast<const bf16x8*>(&Qw[(long)r32*DM+d0*16+hi*8]);
  float mhat=0.f,l_reg=0.f;f32x16 o[2];o[0]=f32x16{};o[1]=f32x16{};f32x16 negm=f32x16{}; const f32x16 zero16=f32x16{};
  const int qrel=wid*QBLK+r32;
  #define CMASK(P0,P1,t) do{int jb_=(t)-(NT-4); if(jb_>=0)cmask(P0,P1,jb_,qrel,hi);}while(0)
  bool resc=false;
  #define START(P0,P1) do{ const float rm=rowmax(P0,P1); resc=false; \
    { const float dl=rm; mhat=fadd_s(mhat,dl); \
      _Pragma("unroll") for(int r=0;r<16;++r){P0[r]=fsub_s(P0[r],dl);P1[r]=fsub_s(P1[r],dl);} \
      _Pragma("unroll") for(int r=0;r<16;++r)negm[r]=-mhat;  } \
    _Pragma("unroll") for(int r=0;r<16;++r)P0[r]=__builtin_amdgcn_exp2f(P0[r]); }while(0)
  #define RESC() do{ if(resc){ asm volatile("s_waitcnt lgkmcnt(0)":::"memory"); \
      _Pragma("unroll") for(int d_=0;d_<2;++d_) _Pragma("unroll") for(int r=0;r<16;++r)o[d_][r]*=wsf[crow(r,hi)]; } }while(0)
  f32x16 pA0,pA1,pB0,pB1;
  int sl_prev=0,sl_cur=0,sl_next=SLOTB;
  #define ROT() do{sl_prev=sl_cur;sl_cur=sl_next;sl_next=(sl_next==(NSLOT-1)*SLOTB)?0:sl_next+SLOTB;}while(0)
  DMA_K(2,2*SLOTB);
  WAIT_BAR(3);
  qkt(pA0,pA1,Kbase,qr,zero16,r32,hi);asm volatile("s_nop 15\n\ts_nop 7":"+v"(pA0),"+v"(pA1));BIAS(pA0,pA1,0);CMASK(pA0,pA1,0);
  START(pA0,pA1);
  _Pragma("unroll") for(int r=0;r<16;++r)pA1[r]=__builtin_amdgcn_exp2f(pA1[r]);
  WAIT_BAR(0);
  DMA_K(3,0);DMA_V(1,SLOTB);
  ROT();
  kload8(kf,kp0+sl_cur);
  WAIT_BAR(2);
  s16x4 vlo[8],vhi[8]; u32x4 pw0,pw1,pw2,pw3;
  #define PKW(P,B) cvtpk_s(P[B],P[B+1])
  #define PAF(k) __builtin_bit_cast(bf16x8,pw##k)
  #define VFR(i) (bf16x8){vlo[i][0],vlo[i][1],vlo[i][2],vlo[i][3],vhi[i][0],vhi[i][1],vhi[i][2],vhi[i][3]}
  #define PIN(x) asm volatile("":"+v"(x))
  #define MX3(a,b,c) __builtin_fmaxf(__builtin_fmaxf((a),(b)),(c))
  #define GAPA(MF,A0,A1,A2,A3,W0,W1,PW) do{ MF; sacc+=A0; sacc+=A1; sacc+=A2; sacc+=A3; PIN(sacc); W0; W1; PIN(PW); SBAR(); }while(0)
  #define EX(v) __builtin_amdgcn_exp2f(v)
  #define GAPB(MF,X,B) do{ MF; X[B]=EX(X[B]); X[B+1]=EX(X[B+1]); X[B+2]=EX(X[B+2]); X[B+3]=EX(X[B+3]); PIN(X); SBAR(); }while(0)
  #define VRD(i) do{ vlo[i]=vtr(vp_+(((i)>>2)*4096+((i)&3)*1024)); vhi[i]=vtr(vp_+(((i)>>2)*4096+((i)&3)*1024+512)); }while(0)
  #define KRD(G,j) do{ if(G){ kload2(kf,kp0+sl_next,j); SBAR(); } }while(0)
  #define STEP(C0,C1,P0,P1,t,GK,GV,GL) do{ SBAR(); \
    const lds_cptr vp_=vp0+sl_prev; \
    VRD(0); SBAR(); float sacc=(P0[0]+P0[1]); \
    GAPA(C0=__builtin_amdgcn_mfma_f32_32x32x16_bf16(kf[0],qr[0],zero16,0,0,0), P0[2],P0[3],P0[4],P0[5],     pw0[0]=PKW(P0,0), pw0[1]=PKW(P0,2), pw0); \
    VRD(4); SBAR(); GAPA(C1=__builtin_amdgcn_mfma_f32_32x32x16_bf16(kf[1],qr[0],zero16,0,0,0), P0[6],P0[7],P0[8],P0[9],     pw0[2]=PKW(P0,4), pw0[3]=PKW(P0,6), pw0); \
    VRD(1); SBAR(); GAPA(C0=__builtin_amdgcn_mfma_f32_32x32x16_bf16(kf[2],qr[1],C0,0,0,0),   P0[10],P0[11],P0[12],P0[13], pw1[0]=PKW(P0,8), pw1[1]=PKW(P0,10), pw1); \
    VRD(5); SBAR(); GAPA(C1=__builtin_amdgcn_mfma_f32_32x32x16_bf16(kf[3],qr[1],C1,0,0,0),   P0[14],P0[15],P1[0],P1[1],   pw1[2]=PKW(P0,12),pw1[3]=PKW(P0,14), pw1); \
    VRD(2); SBAR(); GAPA(C0=__builtin_amdgcn_mfma_f32_32x32x16_bf16(kf[4],qr[2],C0,0,0,0),   P1[2],P1[3],P1[4],P1[5],     pw2[0]=PKW(P1,0), pw2[1]=PKW(P1,2), pw2); \
    VRD(6); SBAR(); GAPA(C1=__builtin_amdgcn_mfma_f32_32x32x16_bf16(kf[5],qr[2],C1,0,0,0),   P1[6],P1[7],P1[8],P1[9],     pw2[2]=PKW(P1,4), pw2[3]=PKW(P1,6), pw2); \
    VRD(3); SBAR(); GAPA(C0=__builtin_amdgcn_mfma_f32_32x32x16_bf16(kf[6],qr[3],C0,0,0,0),   P1[10],P1[11],P1[12],P1[13], pw3[0]=PKW(P1,8), pw3[1]=PKW(P1,10), pw3); \
    VRD(7); SBAR(); GAPA(C1=__builtin_amdgcn_mfma_f32_32x32x16_bf16(kf[7],qr[3],C1,0,0,0),   P1[14],P1[15],0.f,0.f,       pw3[2]=PKW(P1,12),pw3[3]=PKW(P1,14), pw3); \
    l_reg+=sacc; \
    if(GK){DMA_K((t)+3,sl_cur);} if(GV){DMA_V((t)+1,sl_next);} \
    BIAS(C0,C1,t); CMASK(C0,C1,t); \
    { float a=MX3(C0[0],C0[1],C1[0]),b=MX3(C0[2],C0[3],C1[1]); a=MX3(a,C1[2],C1[3]); \
      _Pragma("unroll") for(int r=4;r<16;r+=4){a=MX3(a,C0[r],C0[r+1]);b=MX3(b,C0[r+2],C0[r+3]);a=MX3(a,C1[r],C1[r+1]);b=MX3(b,C1[r+2],C1[r+3]);} \
      float rm=__builtin_fmaxf(a,b); { auto rr=__builtin_amdgcn_permlane32_swap(__float_as_uint(rm),__float_as_uint(rm),false,false); rm=__builtin_fmaxf(__uint_as_float(rr[0]),__uint_as_float(rr[1])); } \
      resc=false; \
      if(__builtin_expect(__any(rm>(float)THRL),0)){ const float dl=__builtin_fmaxf(rm,0.f); mhat+=dl; \
        _Pragma("unroll") for(int r=0;r<16;++r){C0[r]-=dl;C1[r]-=dl;} \
        _Pragma("unroll") for(int r=0;r<16;++r)negm[r]=-mhat;  \
        const float f=__builtin_amdgcn_exp2f(-dl); l_reg*=f; if(hi==0)wsf[r32]=f; resc=true; } } \
    SBAR(); \
    GAPB(o[0]=__builtin_amdgcn_mfma_f32_32x32x16_bf16(PAF(0),VFR(0),o[0],0,0,0), C0,0); \
    GAPB(o[1]=__builtin_amdgcn_mfma_f32_32x32x16_bf16(PAF(0),VFR(4),o[1],0,0,0), C0,4); \
    KRD(GL,0); GAPB(o[0]=__builtin_amdgcn_mfma_f32_32x32x16_bf16(PAF(1),VFR(1),o[0],0,0,0), C0,8); \
    KRD(GL,1); GAPB(o[1]=__builtin_amdgcn_mfma_f32_32x32x16_bf16(PAF(1),VFR(5),o[1],0,0,0), C0,12); \
    KRD(GL,2); GAPB(o[0]=__builtin_amdgcn_mfma_f32_32x32x16_bf16(PAF(2),VFR(2),o[0],0,0,0), C1,0); \
    KRD(GL,3); GAPB(o[1]=__builtin_amdgcn_mfma_f32_32x32x16_bf16(PAF(2),VFR(6),o[1],0,0,0), C1,4); \
    GAPB(o[0]=__builtin_amdgcn_mfma_f32_32x32x16_bf16(PAF(3),VFR(3),o[0],0,0,0), C1,8); \
    GAPB(o[1]=__builtin_amdgcn_mfma_f32_32x32x16_bf16(PAF(3),VFR(7),o[1],0,0,0), C1,12); \
    }while(0)
  int t=1;
  #undef CMASK
  #define CMASK(P0,P1,t) do{}while(0)
  for(;t+5<NT;t+=2){
    STEP(pB0,pB1,pA0,pA1,t,true,true,true);     WAIT_BAR(2); RESC(); ROT();
    STEP(pA0,pA1,pB0,pB1,t+1,true,true,true);   WAIT_BAR(2); RESC(); ROT();
  }
  #undef CMASK
  #define CMASK(P0,P1,t) do{int jb_=(t)-(NT-4); if(jb_>=0)cmask(P0,P1,jb_,qrel,hi);}while(0)
  #define ENDW(tt) do{ if((tt)+3<NT){WAIT_BAR(2);} else if((tt)+2<NT){WAIT_BAR(1);} else {WAIT_BAR(0);} }while(0)
  for(;t+1<NT;t+=2){
    STEP(pB0,pB1,pA0,pA1,t,(t+3<NT),(t+1<NT),(t+1<NT));       ENDW(t);   RESC(); ROT();
    STEP(pA0,pA1,pB0,pB1,t+1,(t+4<NT),(t+2<NT),(t+2<NT));     ENDW(t+1); RESC(); ROT();
  }
  STEP(pB0,pB1,pA0,pA1,NT-1,false,false,false); RESC();
  { float sacc=pB0[0]+pB0[1]; _Pragma("unroll") for(int r=2;r<16;++r)sacc+=pB0[r]; _Pragma("unroll") for(int r=0;r<16;++r)sacc+=pB1[r]; l_reg+=sacc;
    pw0=(u32x4){PKW(pB0,0),PKW(pB0,2),PKW(pB0,4),PKW(pB0,6)};pw1=(u32x4){PKW(pB0,8),PKW(pB0,10),PKW(pB0,12),PKW(pB0,14)};pw2=(u32x4){PKW(pB1,0),PKW(pB1,2),PKW(pB1,4),PKW(pB1,6)};pw3=(u32x4){PKW(pB1,8),PKW(pB1,10),PKW(pB1,12),PKW(pB1,14)};
    SBAR(); pv(o,vb0+sl_cur,PAF(0),PAF(1),PAF(2),PAF(3)); }
  #undef PKW
  #undef PAF
  #undef VFR
  #undef PIN
  #undef MX3
  #undef GAPA
  #undef GAPB
  #undef EX
  #undef VRD
  #undef KRD
  #undef STEP
  #undef ENDW
  {auto rr=__builtin_amdgcn_permlane32_swap(__float_as_uint(l_reg),__float_as_uint(l_reg),false,false);l_reg=__uint_as_float(rr[0])+__uint_as_float(rr[1]);}
  if(hi==0)wsf[32+r32]=l_reg;asm volatile("s_waitcnt lgkmcnt(0)":::"memory");
  float rli[16];
  #pragma unroll
  for(int r=0;r<16;++r)rli[r]=__builtin_amdgcn_rcpf(wsf[32+crow(r,hi)]);
  bf16*Ow=O+(rowbase+q0+wid*QBLK)*OM+h*D;
  { bf16*stg=(bf16*)(shm+LDS_OST)+wid*2048;
    #pragma unroll
    for(int r=0;r<16;++r){const int orow=crow(r,hi);
      #pragma unroll
      for(int d0=0;d0<2;++d0)stg[orow*64+d0*32+r32]=__float2bfloat16(o[d0][r]*rli[r]);}
    asm volatile("s_waitcnt lgkmcnt(0)":::"memory");
    #pragma unroll
    for(int i=0;i<4;++i){const int row=i*8+(lane>>3),ch=lane&7; const u32x4 v=*(const u32x4*)(stg+row*64+ch*8); ATTN_STORE16(Ow+(long)row*OM+ch*8,v);} }
  asm volatile("s_waitcnt lgkmcnt(0)\n\ts_barrier":::"memory");
  #undef DMA_K
  #undef DMA_V
  #undef CMASK
  #undef START
  #undef RESC
  #undef ROT
  #undef BIAS
}
constexpr int ATTN_LDS_BYTES=LDS_BYTES;
struct AttnTensors { const bf16* Q; const bf16* K; const bf16* V; bf16* O; const float* CB; };
struct AttnUnit { int bh; int qb; };
struct StaticOrder {
  int vcu,G;
  __device__ __forceinline__ explicit StaticOrder(int grid,int v):vcu(v),G(grid){}
  __device__ __forceinline__ bool next(int i,AttnUnit&u)const{ const int p=vcu+(i>>1)*G; if(p>=256)return false; const int s=p&3; u.bh=p>>2; u.qb=(i&1)?7-s:s; return true; }
  __device__ __forceinline__ void a_ready(const AttnUnit&)const{}
  __device__ __forceinline__ void done(const AttnUnit&)const{}
};
template<class Sched,int THRL=8> __device__ __forceinline__ void attn_phase(char*lds,const AttnTensors&T,const Sched&S){
  AttnUnit u;
  for(int i=0;S.next(i,u);++i){ S.a_ready(u); attn_unit<THRL>(u.bh/NHEAD,u.bh%NHEAD,u.qb,T.Q,T.K,T.V,T.O,T.CB,lds); S.done(u); }
}
#undef SBAR
#undef WAIT_BAR
}
#define LAS __attribute__((address_space(3)))
namespace mk {
typedef unsigned short bf16;
typedef unsigned u32x4 __attribute__((ext_vector_type(4)));
typedef unsigned u32x2 __attribute__((ext_vector_type(2)));
typedef float f32x4 __attribute__((ext_vector_type(4)));
typedef float f32x2 __attribute__((ext_vector_type(2)));
typedef float f32x16 __attribute__((ext_vector_type(16)));
typedef short bf16x8 __attribute__((ext_vector_type(8)));
typedef unsigned v4u __attribute__((ext_vector_type(4)));
constexpr int NWAVES = 8, NT = 512;
constexpr int M = 16384, SEQ = 2048, DM = 1024, INW = 3096, PROJW = 3072, FF = 2816, PLE = 256;
constexpr float EPS = 1e-6f, LOG2E = 1.4426950408889634f, C2 = 0.125f * LOG2E;
constexpr size_t MiB = 1u << 20;
constexpr size_t WS_WIN = 1 * MiB, WS_WSK = 7 * MiB, WS_WO = 8 * MiB, WS_WUP = 10 * MiB, WS_WD = 21 * MiB, WS_WPG = 27 * MiB, WS_WPE = 29 * MiB;
constexpr size_t WS_SMALL = 30 * MiB;
constexpr size_t WS_LRF = 31 * MiB, WS_PB = 33 * MiB, WS_QE = 41 * MiB, WS_XB = 50 * MiB  , WS_MIX = 83 * MiB, WS_PROJ = 115 * MiB, WS_END = 211 * MiB;
constexpr size_t WS_SPREV = WS_XB, WS_E = WS_MIX, WS_ACT = WS_PROJ;
constexpr int LDS_BYTES = 147456, XCH_OFF = 131072;

__device__ __forceinline__ unsigned f2bf(float f) { unsigned u = __builtin_bit_cast(unsigned, f); return (u + 0x7fffu + ((u >> 16) & 1u)) >> 16; }
__device__ __forceinline__ unsigned pk2(float lo, float hi) { return f2bf(lo) | (f2bf(hi) << 16); }
__device__ __forceinline__ float bf2f(unsigned short h) { return __builtin_bit_cast(float, (unsigned)h << 16); }
__device__ __forceinline__ float bflo(unsigned w) { return __builtin_bit_cast(float, w << 16); }
__device__ __forceinline__ float bfhi(unsigned w) { return __builtin_bit_cast(float, w & 0xffff0000u); }
__device__ __forceinline__ float logsig(float z) { return fminf(z, 0.f) - log1pf(__expf(-fabsf(z))); }
__device__ __forceinline__ int crow(int r, int hi) { return (r & 3) + 8 * (r >> 2) + 4 * hi; }
__device__ __forceinline__ float wave_sum(float v) {
#pragma unroll
    for (int o = 1; o < 64; o <<= 1) v += __shfl_xor(v, o);
    return v;
}
#define LDS_WAIT() asm volatile("s_waitcnt lgkmcnt(0)" ::: "memory")

struct Args { const float* in[21]; float* out; unsigned char* ws; };

__device__ __forceinline__ void tr_item(const float* W, int ldw, int k0, int srccol, const float* gain, bf16* WT, int ldk, int dstrow0, LAS float* scr, int lane) {
#pragma unroll
    for (int i = 0; i < 32; ++i) { const int kk = 2 * i + (lane >> 5); float v = srccol >= 0 ? W[(size_t)(k0 + kk) * ldw + srccol] : 0.f; if (gain) v *= gain[k0 + kk]; scr[kk * 33 + (lane & 31)] = v; }
    LDS_WAIT();
    const int c = lane & 7;
#pragma unroll
    for (int j = 0; j < 4; ++j) { const int n = (lane >> 3) + 8 * j; const LAS float* s = scr + (8 * c) * 33 + n;
        u32x4 o; o.x = pk2(s[0 * 33], s[1 * 33]); o.y = pk2(s[2 * 33], s[3 * 33]); o.z = pk2(s[4 * 33], s[5 * 33]); o.w = pk2(s[6 * 33], s[7 * 33]);
        *(u32x4*)(WT + (size_t)(dstrow0 + n) * ldk + k0 + 8 * c) = o; }
    LDS_WAIT();
}

__device__ __forceinline__ void p0_prologue(const Args& a, LAS unsigned char* lds, int vcu, int G, int wave, int lane, int tid) {
    unsigned char* ws = a.ws;
    LAS float* scr = (LAS float*)(lds + wave * 16384);
    const int gw = vcu * NWAVES + wave, NGW = G * NWAVES;
    constexpr int I_IN = 16 * 96, I_SK = 16, I_O = 16 * 32, I_UP = 16 * 176, I_D = 44 * 32, I_PG = 16 * 32, I_PE = 4 * 32;
    constexpr int NITEMS = I_IN + I_SK + I_O + I_UP + I_D + I_PG + I_PE;
    for (int it = gw; it < NITEMS; it += NGW) {
        int r = it; const int nl = lane & 31;
        if (r < I_IN) { const int kb = r / 96, nb = r % 96, n0 = 32 * nb; tr_item(a.in[3], INW, 64 * kb, n0 + (n0 >= 1536 ? 16 : 0) + nl, a.in[2], (bf16*)(ws + WS_WIN), DM, n0, scr, lane); continue; } r -= I_IN;
        if (r < I_SK) { const int sc = nl < 16 ? 1536 + nl : (nl < 24 ? 3088 + nl - 16 : -1); tr_item(a.in[3], INW, 64 * r, sc, a.in[2], (bf16*)(ws + WS_WSK), DM, 0, scr, lane); continue; } r -= I_SK;
        if (r < I_O) { const int kb = r / 32, nb = r % 32; tr_item(a.in[10], DM, 64 * kb, 32 * nb + nl, nullptr, (bf16*)(ws + WS_WO), DM, 32 * nb, scr, lane); continue; } r -= I_O;
        if (r < I_UP) { const int kb = r / 176, nb = r % 176, pn = nb >> 3, wi = nb & 7; const int sc0 = wi < 4 ? 128 * pn + 32 * wi : FF + 128 * pn + 32 * (wi - 4);
            tr_item(a.in[12], 2 * FF, 64 * kb, sc0 + nl, a.in[11], (bf16*)(ws + WS_WUP), DM, 32 * nb, scr, lane); continue; } r -= I_UP;
        if (r < I_D) { const int kb = r / 32, nb = r % 32; tr_item(a.in[15], DM, 64 * kb, 32 * nb + nl, nullptr, (bf16*)(ws + WS_WD), FF, 32 * nb, scr, lane); continue; } r -= I_D;
        if (r < I_PG) { const int kb = r / 32, nb = r % 32; tr_item(a.in[19], DM, 64 * kb, 32 * nb + nl, a.in[16], (bf16*)(ws + WS_WPG), DM, 32 * nb, scr, lane); continue; } r -= I_PG;
        { const int kb = r / 32, nb = r % 32; tr_item(a.in[17], DM, 64 * kb, 32 * nb + nl, nullptr, (bf16*)(ws + WS_WPE), PLE, 32 * nb, scr, lane); }
    }
    float* rstd1 = (float*)(ws + WS_SMALL); bf16* xb = (bf16*)(ws + WS_XB); bf16* pb = (bf16*)(ws + WS_PB);
    for (int m0 = gw; m0 < M; m0 += 2 * NGW) {
        f32x4 v[2][4], pv[2];
#pragma unroll
        for (int q = 0; q < 2; ++q) { const int m = m0 + q * NGW; const f32x4* xr = (const f32x4*)(a.in[0] + (size_t)m * DM) + lane;
#pragma unroll
            for (int j = 0; j < 4; ++j) v[q][j] = xr[64 * j];
            pv[q] = *((const f32x4*)(a.in[1] + (size_t)m * PLE) + lane); }
#pragma unroll
        for (int q = 0; q < 2; ++q) { const int m = m0 + q * NGW; float s = 0.f;
#pragma unroll
            for (int j = 0; j < 4; ++j) s += (v[q][j].x * v[q][j].x + v[q][j].y * v[q][j].y) + (v[q][j].z * v[q][j].z + v[q][j].w * v[q][j].w);
            s = wave_sum(s); if (lane == 0) rstd1[m] = rsqrtf(s * (1.f / DM) + EPS);
            u32x2* o8 = (u32x2*)(xb + (size_t)m * DM) + lane;
#pragma unroll
            for (int j = 0; j < 4; ++j) o8[64 * j] = (u32x2){pk2(v[q][j].x, v[q][j].y), pk2(v[q][j].z, v[q][j].w)};
            *((u32x2*)(pb + (size_t)m * PLE) + lane) = (u32x2){pk2(pv[q].x, pv[q].y), pk2(pv[q].z, pv[q].w)}; }
    }
    float* ssz = (float*)(ws + WS_SMALL) + M;
    for (int i = vcu * NT + tid; i < 3 * M; i += G * NT) ssz[i] = 0.f;
}

__device__ __forceinline__ void p1_skinny(const Args& a, LAS unsigned char* lds, int vcu, int G, int wave, int lane, int tid) {
    const bf16* xb = (const bf16*)(a.ws + WS_XB); const bf16* wsk = (const bf16*)(a.ws + WS_WSK); const float* rstd1 = (const float*)(a.ws + WS_SMALL); float* lrf = (float*)(a.ws + WS_LRF);
    LAS float* red = (LAS float*)lds;
    const int r32 = lane & 31, hi = lane >> 5;
    for (int rg = vcu; rg < M / 64; rg += G) {
        const int row0 = rg * 64; f32x16 acc0 = {}, acc1 = {};
#pragma unroll
        for (int ks = 0; ks < 8; ++ks) { const int k = wave * 128 + ks * 16 + 8 * hi;
            const bf16x8 a0 = *(const bf16x8*)(xb + (size_t)(row0 + r32) * DM + k), a1 = *(const bf16x8*)(xb + (size_t)(row0 + 32 + r32) * DM + k), b = *(const bf16x8*)(wsk + (size_t)r32 * DM + k);
            acc0 = __builtin_amdgcn_mfma_f32_32x32x16_bf16(a0, b, acc0, 0, 0, 0); acc1 = __builtin_amdgcn_mfma_f32_32x32x16_bf16(a1, b, acc1, 0, 0, 0); }
#pragma unroll
        for (int r = 0; r < 16; ++r) { red[(wave * 64 + crow(r, hi)) * 32 + r32] = acc0[r]; red[(wave * 64 + 32 + crow(r, hi)) * 32 + r32] = acc1[r]; }
        __syncthreads();
        { const int row = tid >> 3, c4 = tid & 7; f32x4 s = {0.f, 0.f, 0.f, 0.f};
#pragma unroll
            for (int w = 0; w < 8; ++w) s += *(const LAS f32x4*)(red + (w * 64 + row) * 32 + c4 * 4);
            s *= rstd1[row0 + row]; *(f32x4*)(lrf + (size_t)(row0 + row) * 32 + c4 * 4) = s; }
        __syncthreads();
    }
}

__device__ __forceinline__ bf16x8 ldfrag(const LAS bf16* base, int row, int ks, int hi) { return *(const LAS bf16x8*)(base + row * 72 + ks * 16 + 8 * hi); }
__device__ __forceinline__ void gla_local(const Args& a, LAS unsigned char* lds, int task, int wave, int lane, int tid) {
    unsigned char* ws = a.ws;
    const bf16* proj = (const bf16*)(ws + WS_PROJ); const float* lrf = (const float*)(ws + WS_LRF); bf16* qeg = (bf16*)(ws + WS_QE);
    float* decay = (float*)(ws + WS_SMALL) + 4 * M; float* ointra = a.out; float* dS = a.out + (size_t)M * 512;
    const int bh = task >> 5, n = task & 31, b = bh >> 2, h = bh & 3, tok0 = b * SEQ + n * 64;
    LAS bf16* QE = (LAS bf16*)lds; LAS bf16* KE = QE + 64 * 72; LAS bf16* KDT = KE + 64 * 72; LAS bf16* VT = KDT + 64 * 72; LAS bf16* AT = VT + 128 * 72; LAS float* SEG = (LAS float*)(AT + 64 * 72);
    const int r32 = lane & 31, hi = lane >> 5;
    {
        const int k = tid & 63, seg = tid >> 6;
        const int v = tid & 127, sg = tid >> 7;
        float w[16];
#pragma unroll
        for (int j = 0; j < 16; ++j) w[j] = a.in[4][j * 256 + h * 64 + k];
        const float bias = a.in[5][h * 64 + k];
        f32x4 lrv[8][4]; unsigned short qraw[8], kraw[8], vv[16];
#pragma unroll
        for (int i = 0; i < 8; ++i) { const f32x4* lr = (const f32x4*)(lrf + (size_t)(tok0 + seg * 8 + i) * 32);
#pragma unroll
            for (int j = 0; j < 4; ++j) lrv[i][j] = lr[j];
            const bf16* pr = proj + (size_t)(tok0 + seg * 8 + i) * PROJW; qraw[i] = pr[h * 64 + k]; kraw[i] = pr[256 + h * 64 + k]; }
#pragma unroll
        for (int i = 0; i < 16; ++i) vv[i] = proj[(size_t)(tok0 + sg * 16 + i) * PROJW + 512 + h * 128 + v];
        float bl[8]; float run = 0.f;
#pragma unroll
        for (int i = 0; i < 8; ++i) { float z = bias;
#pragma unroll
            for (int j = 0; j < 4; ++j) z += (lrv[i][j].x * w[4 * j] + lrv[i][j].y * w[4 * j + 1]) + (lrv[i][j].z * w[4 * j + 2] + lrv[i][j].w * w[4 * j + 3]);
            run += logsig(z) * (1.f / 16.f); bl[i] = run; }
        SEG[seg * 64 + k] = run;
        {
            u32x4 p0, p1; p0.x = vv[0] | ((unsigned)vv[1] << 16); p0.y = vv[2] | ((unsigned)vv[3] << 16); p0.z = vv[4] | ((unsigned)vv[5] << 16); p0.w = vv[6] | ((unsigned)vv[7] << 16);
            p1.x = vv[8] | ((unsigned)vv[9] << 16); p1.y = vv[10] | ((unsigned)vv[11] << 16); p1.z = vv[12] | ((unsigned)vv[13] << 16); p1.w = vv[14] | ((unsigned)vv[15] << 16);
            *(LAS u32x4*)(VT + v * 72 + sg * 16) = p0; *(LAS u32x4*)(VT + v * 72 + sg * 16 + 8) = p1; }
        __syncthreads();
        float prefix = 0.f, total = 0.f;
#pragma unroll
        for (int s = 0; s < 8; ++s) { const float sv = SEG[s * 64 + k]; total += sv; if (s < seg) prefix += sv; }
        unsigned short kdh[8];
#pragma unroll
        for (int i = 0; i < 8; ++i) { const int t = seg * 8 + i; const float bb = bl[i] + prefix;
            const float qv = bf2f(qraw[i]), kv = bf2f(kraw[i]);
            const unsigned short qeb = (unsigned short)f2bf(qv * 0.125f * __expf(bb));
            QE[t * 72 + k] = qeb; KE[t * 72 + k] = (unsigned short)f2bf(kv * __expf(-bb)); qeg[(size_t)(tok0 + t) * 256 + h * 64 + k] = qeb;
            kdh[i] = (unsigned short)f2bf(kv * __expf(total - bb)); }
        u32x4 kp; kp.x = kdh[0] | ((unsigned)kdh[1] << 16); kp.y = kdh[2] | ((unsigned)kdh[3] << 16); kp.z = kdh[4] | ((unsigned)kdh[5] << 16); kp.w = kdh[6] | ((unsigned)kdh[7] << 16);
        *(LAS u32x4*)(KDT + k * 72 + seg * 8) = kp;
        if (seg == 0) decay[task * 64 + k] = __expf(total);
    }
    __syncthreads();
    if (wave < 4) {
        const int ti = wave >> 1, si = wave & 1; f32x16 acc = {};
        if (si <= ti) {
#pragma unroll
            for (int ks = 0; ks < 4; ++ks) acc = __builtin_amdgcn_mfma_f32_32x32x16_bf16(ldfrag(QE, ti * 32 + r32, ks, hi), ldfrag(KE, si * 32 + r32, ks, hi), acc, 0, 0, 0);
        }
#pragma unroll
        for (int r = 0; r < 16; ++r) { const int trow = ti * 32 + crow(r, hi), scol = si * 32 + r32; AT[trow * 72 + scol] = (unsigned short)f2bf(scol <= trow ? acc[r] : 0.f); }
    }
    __syncthreads();
    {
        const int ti = wave >> 2, vi = wave & 3; f32x16 o = {}, ds = {};
#pragma unroll
        for (int ks = 0; ks < 4; ++ks) { const bf16x8 vb = ldfrag(VT, vi * 32 + r32, ks, hi);
            o = __builtin_amdgcn_mfma_f32_32x32x16_bf16(ldfrag(AT, ti * 32 + r32, ks, hi), vb, o, 0, 0, 0);
            ds = __builtin_amdgcn_mfma_f32_32x32x16_bf16(ldfrag(KDT, ti * 32 + r32, ks, hi), vb, ds, 0, 0, 0); }
#pragma unroll
        for (int r = 0; r < 16; ++r) { const int row = ti * 32 + crow(r, hi);
            ointra[(size_t)(tok0 + row) * 512 + h * 128 + vi * 32 + r32] = o[r];
            dS[(size_t)task * 8192 + row * 128 + vi * 32 + r32] = ds[r]; }
    }
    __syncthreads();
}

__device__ __forceinline__ void fox_prep(const Args& a, int vcu, int G, int wave, int lane) {
    unsigned char* ws = a.ws; bf16* proj = (bf16*)(ws + WS_PROJ);
    const int gw = vcu * NWAVES + wave, NGW = G * NWAVES;
    const int c8 = (lane & 7) * 8;
    for (int it0 = gw; it0 < 2 * M; it0 += 4 * NGW) {
        u32x4 wv[4];
#pragma unroll
        for (int q = 0; q < 4; ++q) { const int it = it0 + q * NGW; wv[q] = *(const u32x4*)(proj + (size_t)(it >> 1) * PROJW + ((it & 1) ? 2048 : 1536) + lane * 8); }
#pragma unroll
        for (int q = 0; q < 4; ++q) { const int it = it0 + q * NGW; const int tok = it >> 1, which = it & 1;
            bf16* p = proj + (size_t)tok * PROJW + (which ? 2048 : 1536) + lane * 8;
            const u32x4 w = wv[q];
            float v[8] = {bflo(w.x), bfhi(w.x), bflo(w.y), bfhi(w.y), bflo(w.z), bfhi(w.z), bflo(w.w), bfhi(w.w)};
            float s = 0.f;
#pragma unroll
            for (int i = 0; i < 8; ++i) s += v[i] * v[i];
            s += __shfl_xor(s, 1); s += __shfl_xor(s, 2); s += __shfl_xor(s, 4);
            const float r = rsqrtf(s * (1.f / 64.f) + EPS) * (which ? 1.f : C2);
            const float* g = a.in[which ? 9 : 8] + c8; const f32x4 g0 = *(const f32x4*)g, g1 = *(const f32x4*)(g + 4);
            u32x4 o; o.x = pk2(v[0] * r * g0.x, v[1] * r * g0.y); o.y = pk2(v[2] * r * g0.z, v[3] * r * g0.w); o.z = pk2(v[4] * r * g1.x, v[5] * r * g1.y); o.w = pk2(v[6] * r * g1.z, v[7] * r * g1.w);
            *(u32x4*)p = o; }
    }
    if (wave == 0) {
        const float* lrf = (const float*)(ws + WS_LRF); float* cb = (float*)(ws + WS_SMALL) + 4 * M + 65536;
        for (int bh = vcu; bh < 64; bh += G) {
            const int b = bh >> 3, h = bh & 7; const float bf = a.in[7][h];
            float loc[32]; float run = 0.f;
#pragma unroll
            for (int i = 0; i < 32; ++i) { run += logsig(lrf[(size_t)(b * SEQ + lane * 32 + i) * 32 + 16 + h] + bf); loc[i] = run; }
            float inc = run;
#pragma unroll
            for (int o = 1; o < 64; o <<= 1) { const float t = __shfl_up(inc, o); if (lane >= o) inc += t; }
            const float pre = inc - run;
#pragma unroll
            for (int i = 0; i < 32; ++i) cb[(size_t)bh * SEQ + lane * 32 + i] = (pre + loc[i]) * LOG2E;
        }
    }
}

__device__ __forceinline__ void gla_scan(const Args& a, int vcu, int G, int tid) {
    const float* decay = (const float*)(a.ws + WS_SMALL) + 4 * M; const float* dS = a.out + (size_t)M * 512; float* sprev = (float*)(a.ws + WS_SPREV);
    for (int e = (vcu * NT + tid) * 2; e < 32 * 8192; e += G * NT * 2) {
        const int bh = e >> 13, kv = e & 8191, k = kv >> 7; f32x2 st = {0.f, 0.f};
#pragma unroll
        for (int n = 0; n < 32; ++n) { const int task = bh * 32 + n; const size_t idx = (size_t)task * 8192 + kv;
            *(f32x2*)(sprev + idx) = st; const float d = decay[task * 64 + k]; const f32x2 ds = *(const f32x2*)(dS + idx); st = st * d + ds; }
    }
}

__device__ __forceinline__ void gla_final(const Args& a, LAS unsigned char* lds, int task, int wave, int lane, int tid) {
    unsigned char* ws = a.ws;
    const bf16* proj = (const bf16*)(ws + WS_PROJ); const bf16* qeg = (const bf16*)(ws + WS_QE); const float* sprev = (const float*)(ws + WS_SPREV);
    const float* ointra = a.out; bf16* mix = (bf16*)(ws + WS_MIX);
    const int bh = task >> 5, n = task & 31, b = bh >> 2, h = bh & 3, tok0 = b * SEQ + n * 64;
    LAS bf16* QE = (LAS bf16*)lds; LAS bf16* ST = QE + 64 * 72; LAS float* OL = (LAS float*)(lds + 27648);
    const int r32 = lane & 31, hi = lane >> 5;
    const int ti = wave >> 2, vi = wave & 3, t2 = tid >> 3, j2 = tid & 7;
    const u32x4 qv = *(const u32x4*)(qeg + (size_t)(tok0 + (tid >> 3)) * 256 + h * 64 + (tid & 7) * 8);
    float f[16];
    { const int v = tid & 127, kg = tid >> 7;
#pragma unroll
        for (int i = 0; i < 16; ++i) f[i] = sprev[(size_t)task * 8192 + (kg * 16 + i) * 128 + v]; }
    float oi[16];
#pragma unroll
    for (int r = 0; r < 16; ++r) oi[r] = ointra[(size_t)(tok0 + ti * 32 + crow(r, hi)) * 512 + h * 128 + vi * 32 + r32];
    const bf16* ogp = proj + (size_t)(tok0 + t2) * PROJW + 1024 + h * 128 + j2 * 16; const u32x4 g0 = *(const u32x4*)ogp, g1 = *(const u32x4*)(ogp + 8);
    f32x4 gn[4];
#pragma unroll
    for (int i = 0; i < 4; ++i) gn[i] = *(const f32x4*)(a.in[6] + j2 * 16 + 4 * i);
    { const int t = tid >> 3, c = tid & 7; *(LAS u32x4*)(QE + t * 72 + c * 8) = qv; }
    { const int v = tid & 127, kg = tid >> 7;
        u32x4 p0, p1; p0.x = pk2(f[0], f[1]); p0.y = pk2(f[2], f[3]); p0.z = pk2(f[4], f[5]); p0.w = pk2(f[6], f[7]); p1.x = pk2(f[8], f[9]); p1.y = pk2(f[10], f[11]); p1.z = pk2(f[12], f[13]); p1.w = pk2(f[14], f[15]);
        *(LAS u32x4*)(ST + v * 72 + kg * 16) = p0; *(LAS u32x4*)(ST + v * 72 + kg * 16 + 8) = p1; }
    __syncthreads();
    { f32x16 acc = {};
#pragma unroll
        for (int ks = 0; ks < 4; ++ks) acc = __builtin_amdgcn_mfma_f32_32x32x16_bf16(ldfrag(QE, ti * 32 + r32, ks, hi), ldfrag(ST, vi * 32 + r32, ks, hi), acc, 0, 0, 0);
#pragma unroll
        for (int r = 0; r < 16; ++r) { const int row = ti * 32 + crow(r, hi), col = vi * 32 + r32; OL[row * 132 + col] = acc[r] + oi[r]; } }
    __syncthreads();
    { const int t = t2, j = j2; f32x4 o[4]; float s = 0.f;
#pragma unroll
        for (int i = 0; i < 4; ++i) { o[i] = *(const LAS f32x4*)(OL + t * 132 + j * 16 + 4 * i); s += (o[i].x * o[i].x + o[i].y * o[i].y) + (o[i].z * o[i].z + o[i].w * o[i].w); }
        s += __shfl_xor(s, 1); s += __shfl_xor(s, 2); s += __shfl_xor(s, 4);
        const float r = rsqrtf(s * (1.f / 128.f) + EPS);
        const float og[16] = {bflo(g0.x), bfhi(g0.x), bflo(g0.y), bfhi(g0.y), bflo(g0.z), bfhi(g0.z), bflo(g0.w), bfhi(g0.w), bflo(g1.x), bfhi(g1.x), bflo(g1.y), bfhi(g1.y), bflo(g1.z), bfhi(g1.z), bflo(g1.w), bfhi(g1.w)};
        float y[16];
#pragma unroll
        for (int i = 0; i < 4; ++i) {
#pragma unroll
            for (int c = 0; c < 4; ++c) { const float g = og[4 * i + c]; y[4 * i + c] = o[i][c] * r * gn[i][c] * (g / (1.f + __expf(-g))); } }
        u32x4 p0, p1; p0.x = pk2(y[0], y[1]); p0.y = pk2(y[2], y[3]); p0.z = pk2(y[4], y[5]); p0.w = pk2(y[6], y[7]); p1.x = pk2(y[8], y[9]); p1.y = pk2(y[10], y[11]); p1.z = pk2(y[12], y[13]); p1.w = pk2(y[14], y[15]);
        bf16* mp = mix + (size_t)(tok0 + t) * DM + h * 128 + j * 16; *(u32x4*)mp = p0; *(u32x4*)(mp + 8) = p1; }
    __syncthreads();
}

#define XB_TMO      128
#define XB_XCNT(j)  (256  + 64 * (j))
#define XB_XSUB(j)  (1280 + 64 * (j))
#define XB_XGEN(j)  (2304 + 64 * (j))
#define XB_TOP      3328
#define XB_TOPGEN   3392
#define XCD_BAR_WORDS 3456
#define XB_SPIN_CAP (1u << 18)

__device__ __forceinline__ unsigned xb_ld(unsigned* p)              { return __hip_atomic_load(p, __ATOMIC_RELAXED, __HIP_MEMORY_SCOPE_AGENT); }
__device__ __forceinline__ unsigned xb_add(unsigned* p, unsigned v) { return __hip_atomic_fetch_add(p, v, __ATOMIC_RELAXED, __HIP_MEMORY_SCOPE_AGENT); }
__device__ __forceinline__ unsigned xb_xcc_id() { return (unsigned)__builtin_amdgcn_s_getreg((3 << 11) | 20) & 0xFu; }
#define XB_SPIN(cond, bar) do { unsigned _sp = 0; while (cond) { __builtin_amdgcn_s_sleep(1); \
    if ((++_sp & 255u) == 0u) { if (xb_ld(&(bar)[XB_TMO])) break; if (_sp > XB_SPIN_CAP) { atomicAdd(&(bar)[XB_TMO], 1u); break; } } } } while (0)

struct XcdBarrier {
    unsigned* bar; unsigned x;
    volatile LAS unsigned* st;
};

__device__ __forceinline__ XcdBarrier xcd_barrier_post(unsigned* bar, volatile LAS unsigned* st, bool leader) {
    XcdBarrier b; b.bar = bar; b.x = xb_xcc_id(); b.st = st;
    if (leader) (void)xb_add(&bar[XB_XCNT(b.x)], 1u);
    return b;
}
__device__ __forceinline__ void xcd_barrier_complete(unsigned* bar, unsigned x, unsigned& nloc, unsigned& nx) {
    const unsigned G = gridDim.x * gridDim.y * gridDim.z;
    unsigned sum, cnt, mine, sp = 0u;
    for (;;) {
        sum = 0u; cnt = 0u; mine = 0u;
#pragma unroll
        for (unsigned j = 0; j < 16; ++j) { const unsigned c = xb_ld(&bar[XB_XCNT(j)]); sum += c; cnt += (c > 0u) ? 1u : 0u; mine = (j == x) ? c : mine; }
        if (sum == G) break;
        __builtin_amdgcn_s_sleep(1);
        if ((++sp & 255u) == 0u) { if (xb_ld(&bar[XB_TMO])) break; if (sp > XB_SPIN_CAP) { atomicAdd(&bar[XB_TMO], 1u); break; } }
    }
    nloc = mine > 0u ? mine : 1u; nx = cnt > 0u ? cnt : 1u;
}

__device__ __forceinline__ void xcd_barrier(const XcdBarrier& b, bool leader) {
    asm volatile("s_waitcnt vmcnt(0)" ::: "memory");
    __syncthreads();
    if (leader) {
        unsigned* bar = b.bar;
        __builtin_amdgcn_s_waitcnt(0);
        unsigned nloc = b.st[0], nx = b.st[1];
        if (nloc == 0u) { xcd_barrier_complete(bar, b.x, nloc, nx); b.st[0] = nloc; b.st[1] = nx; }
        const unsigned old = xb_add(&bar[XB_XSUB(b.x)], 1u);
        const unsigned gen = old / nloc;
        if (old + 1u == (gen + 1u) * nloc) {
            __builtin_amdgcn_fence(__ATOMIC_RELEASE, "agent");
            asm volatile("s_waitcnt vmcnt(0)" ::: "memory");
            const unsigned og = xb_add(&bar[XB_TOP], 1u);
            const unsigned tg = og / nx;
            if (og + 1u == (tg + 1u) * nx) xb_add(&bar[XB_TOPGEN], 1u);
            else XB_SPIN(xb_ld(&bar[XB_TOPGEN]) == tg, bar);
            __builtin_amdgcn_fence(__ATOMIC_ACQUIRE, "agent");
            xb_add(&bar[XB_XGEN(b.x)], 1u);
            asm volatile("s_waitcnt vmcnt(0)" ::: "memory");
        } else {
            XB_SPIN(xb_ld(&bar[XB_XGEN(b.x)]) == gen, bar);
            __builtin_amdgcn_fence(__ATOMIC_ACQUIRE, "agent");
            asm volatile("s_waitcnt vmcnt(0)" ::: "memory");
        }
    }
    __syncthreads();
}

#ifndef MK_SKIP
#define MK_SKIP 0
#endif
#define RUN(k) (!((MK_SKIP >> (k)) & 1))
#ifndef REP_SYNC
#define REP_SYNC 1
#endif
#ifndef REP_P0
#define REP_P0 1
#endif
#ifndef REP_P1
#define REP_P1 1
#endif
#ifndef REP_GL
#define REP_GL 1
#endif
#ifndef REP_SC
#define REP_SC 1
#endif
#ifndef REP_AT
#define REP_AT 1
#endif
#ifndef REP_GF
#define REP_GF 1
#endif
#ifndef REP_P6
#define REP_P6 1
#endif
#define GSYNC() do { for (int s_ = 0; s_ < REP_SYNC; ++s_) xcd_barrier(xbar, wave == 0 && lane_id() == 0); } while (0)
__global__ void __launch_bounds__(NT, 2) mk_fwd(Args a) {
    extern __shared__ __attribute__((aligned(16))) unsigned char lds_raw[];
    LAS unsigned char* lds = (LAS unsigned char*)lds_raw;
    const int wave = __builtin_amdgcn_readfirstlane(threadIdx.x >> 6);
#define lane (lane_id())
#define tid (wave * 64 + lane_id())
    const int G = gridDim.x, bx = blockIdx.x, vcu = (G % 8 == 0) ? (bx % 8) * (G / 8) + bx / 8 : bx;
    unsigned char* ws = a.ws;
    bf16* xb = (bf16*)(ws + WS_XB); float* small = (float*)(ws + WS_SMALL);
    float* ss2 = small + M; float* ss3 = small + 2 * M; float* ssE = small + 3 * M;
    volatile LAS unsigned* xst = (volatile LAS unsigned*)(lds + XCH_OFF + 8192);
    if (wave == 0 && lane_id() == 0) { xst[0] = 0u; xst[1] = 0u; }
    __syncthreads();
    const XcdBarrier xbar = xcd_barrier_post((unsigned*)ws, xst, wave == 0 && lane_id() == 0);

    for (int rep_ = 0; rep_ < REP_P0; ++rep_) if (RUN(0)) p0_prologue(a, lds, vcu, G, wave, lane, tid);
    GSYNC();
    for (int rep_ = 0; rep_ < REP_P1; ++rep_) if (RUN(1)) {   pg8::Gemm g{xb, (const bf16*)(ws + WS_WIN), M, PROJW, DM}; pg8::StaticOrder S; S.init(M / 256, PROJW / 256, G, bx);
        pg8::EpiScaleBf16 E{(bf16*)(ws + WS_PROJ), PROJW, small};
        pg8::gemm_phase<pg8::EpiScaleBf16, pg8::StaticOrder, true, true>(lds, g, S, E, wave);
        p1_skinny(a, lds, vcu, G, wave, lane, tid);
    }
    GSYNC();
    for (int rep_ = 0; rep_ < REP_GL; ++rep_) if (RUN(2)) for (int task = vcu; task < 1024; task += G) gla_local(a, lds, task, wave, lane, tid);
    if (RUN(9)) fox_prep(a, vcu, G, wave, lane);
    GSYNC();
    for (int rep_ = 0; rep_ < REP_SC; ++rep_) if (RUN(10)) gla_scan(a, vcu, G, tid);
    for (int rep_ = 0; rep_ < REP_AT; ++rep_) if (RUN(3)) {   const attn_body::bf16* pj = (const attn_body::bf16*)(ws + WS_PROJ);
        const attn_body::AttnTensors AT{pj + 1536, pj + 2048, pj + 2560, (attn_body::bf16*)(ws + WS_MIX) + 512, small + 4 * M + 65536};
        const attn_body::StaticOrder S(G, vcu);
        attn_body::attn_phase<attn_body::StaticOrder>((char*)lds_raw, AT, S);
    }
    GSYNC();
    for (int rep_ = 0; rep_ < REP_GF; ++rep_) if (RUN(4)) for (int task = vcu; task < 1024; task += G) gla_final(a, lds, task, wave, lane, tid);
    GSYNC();
    if (RUN(5)) {   pg8::Gemm g{(const bf16*)(ws + WS_MIX), (const bf16*)(ws + WS_WO), M, DM, DM}; pg8::StaticOrder S; S.init(M / 256, DM / 256, G, bx);
        pg8::EpiRes E{a.in[0], a.out, xb, ss2, DM};
        pg8::gemm_phase<pg8::EpiRes, pg8::StaticOrder, true, true>(lds, g, S, E, wave);
    }
    GSYNC();
    for (int rep_ = 0; rep_ < REP_P6; ++rep_) if (RUN(6)) {   pg8::Gemm g{xb, (const bf16*)(ws + WS_WUP), M, 2 * FF, DM}; pg8::StaticOrder S; S.init(65, 2 * FF / 256, G, bx, 254, -2);
        pg8::EpiUp E{(bf16*)(ws + WS_ACT), ss2, a.in[13], a.in[14], (LAS float*)(lds + XCH_OFF)};
        pg8::gemm_phase<pg8::EpiUp, pg8::StaticOrder, true, true>(lds, g, S, E, wave);
    }
    GSYNC();
    if (RUN(7)) {   pg8::Gemm g{(const bf16*)(ws + WS_ACT), (const bf16*)(ws + WS_WD), M, DM, FF}; pg8::StaticOrder S; S.init(M / 256, DM / 256, G, bx);
        pg8::EpiRes E{a.out, a.out, xb, ss3, DM};
        pg8::gemm_phase<pg8::EpiRes, pg8::StaticOrder, true, true>(lds, g, S, E, wave);
        pg8::Gemm g2{(const bf16*)(ws + WS_PB), (const bf16*)(ws + WS_WPE), M, DM, PLE};
        pg8::EpiRes E2{nullptr, nullptr, (bf16*)(ws + WS_E), ssE, DM};
        pg8::gemm_phase<pg8::EpiRes, pg8::StaticOrder, true, true>(lds, g2, S, E2, wave);
    }
    GSYNC();
    if (RUN(8)) {   pg8::Gemm g{xb, (const bf16*)(ws + WS_WPG), M, DM, DM}; pg8::StaticOrder S; S.init(M / 256, DM / 256, G, bx);
        pg8::EpiGate E{a.out, a.out, (const bf16*)(ws + WS_E), ss3, ssE, a.in[20], a.in[18], DM};
        pg8::gemm_phase<pg8::EpiGate, pg8::StaticOrder, true, true>(lds, g, S, E, wave);
    }
#undef lane
#undef tid
}
}

extern "C" void kernel_launch(void* const* d_in, const int* in_sizes, int n_in, void* d_out, int out_size, void* d_ws, size_t ws_size, hipStream_t stream) {
    static int grid = 0;
    if (grid == 0) {
        int dev = 0, cus = 0, per_cu = 0;
        hipGetDevice(&dev); hipDeviceGetAttribute(&cus, hipDeviceAttributeMultiprocessorCount, dev);
        hipFuncSetAttribute((const void*)mk::mk_fwd, hipFuncAttributeMaxDynamicSharedMemorySize, mk::LDS_BYTES);
        hipOccupancyMaxActiveBlocksPerMultiprocessor(&per_cu, (const void*)mk::mk_fwd, mk::NT, mk::LDS_BYTES);
        if (per_cu < 1) { fprintf(stderr, "kernel_launch: occupancy query says %d blocks per CU\n", per_cu); per_cu = 1; }
        grid = cus * per_cu;
        if (n_in != 21 || ws_size < mk::WS_END) { fprintf(stderr, "kernel_launch: unexpected n_in %d / ws %zu\n", n_in, ws_size); grid = -1; }
    }
    if (grid < 0) return;
    if (hipMemsetAsync(d_ws, 0, 65536, stream) != hipSuccess) { fprintf(stderr, "kernel_launch: memset of the barrier words failed\n"); return; }
    mk::Args a{};
    for (int i = 0; i < 21; ++i) a.in[i] = (const float*)d_in[i];
    a.out = (float*)d_out; a.ws = (unsigned char*)d_ws;
    void* args[] = {&a};
    hipError_t e = hipLaunchCooperativeKernel((const void*)mk::mk_fwd, dim3(grid), dim3(mk::NT), args, mk::LDS_BYTES, stream);
    if (e != hipSuccess) fprintf(stderr, "cooperative launch failed: %s (grid %d)\n", hipGetErrorString(e), grid);
}
```

```cpp
#include <hip/hip_runtime.h>
#include <hip/hip_cooperative_groups.h>
#include <cstdio>
#include <cstdint>
namespace cg = cooperative_groups;
__device__ __forceinline__ int lane_id() { int l; asm volatile("v_mbcnt_lo_u32_b32 %0, -1, 0\n\tv_mbcnt_hi_u32_b32 %0, -1, %0" : "=v"(l)); return l; }
namespace pg8 {
#define PG8_LAS __attribute__((address_space(3)))
typedef unsigned short bf16_t;
typedef short bf16x8 __attribute__((ext_vector_type(8)));
typedef float f32x4 __attribute__((ext_vector_type(4)));
typedef unsigned u32x4 __attribute__((ext_vector_type(4)));
constexpr int BM = 256, BK = 64, HALF = 128, HTB = HALF * BK * 2  , STAGE_BYTES = 8 * HTB, NXCD = 8, WGM = 8;

__host__ __device__ __forceinline__ int lds_byte(int r, int c) { const int st = (r >> 4) * 2 + (c >> 5), rr = r & 15, cc = c & 31, ob = rr * 64 + cc * 2; return st * 1024 + (ob ^ (((ob >> 9) & 1) << 5)); }
__host__ __device__ __forceinline__ void stage_rc(int b, int& R, int& C) { const int st = b / 1024, sb = b % 1024, swz = sb ^ (((sb >> 9) & 1) << 5); R = (st >> 1) * 16 + swz / 64; C = (st & 1) * 32 + (swz % 64) / 2; }
__host__ __device__ __forceinline__ int perm32(int rho) { const int n = rho >> 4, i = rho & 15; return 8 * (i >> 2) + 4 * n + (i & 3); }

struct Unit { int pm, pn, arow; };
struct Gemm { const bf16_t* A; const bf16_t* Bt; int M, N, K; };

struct StaticOrder {
    int nM, nN, nwg, G, c, mstride, moff;
    __host__ __device__ void init(int nM_, int nN_, int G_, int c_, int mstride_ = 256, int moff_ = 0) { nM = nM_; nN = nN_; nwg = nM * nN; G = G_; c = c_; mstride = mstride_; moff = moff_; }
    __host__ __device__ bool next(int i, Unit& u) const {
        const long L = (long)i * G + c; if (L >= nwg) return false;
        int wgid = (int)L; { const int q = nwg / NXCD, r = nwg % NXCD, xcd = wgid % NXCD, off = wgid / NXCD; wgid = (xcd < r ? xcd * (q + 1) : r * (q + 1) + (xcd - r) * q) + off; }
        const int nig = WGM * nN, gid = wgid / nig, fm = gid * WGM, gsz = (nM - fm) < WGM ? (nM - fm) : WGM;
        u.pm = fm + ((wgid % nig) % gsz); u.pn = (wgid % nig) / gsz; u.arow = u.pm * mstride + moff; return true;
    }
    __device__ __forceinline__ void a_ready(const Unit&) const {}
    __device__ __forceinline__ void done(const Unit&) const {}
};

__device__ __forceinline__ unsigned cvt_pk_bf16(float lo, float hi) { unsigned r; asm volatile("v_cvt_pk_bf16_f32 %0, %1, %2" : "=v"(r) : "v"(lo), "v"(hi)); return r; }
typedef float f32x2 __attribute__((ext_vector_type(2)));
typedef float f32x2 __attribute__((ext_vector_type(2)));
template <class Epi, class Sched, bool ALIGN_EPI = false, bool SP2 = false>
__device__ __forceinline__ void gemm_phase(PG8_LAS unsigned char* lds, const Gemm g, const Sched& S, const Epi& E, int wave_sgpr) {
    const int wid = wave_sgpr, lane = lane_id(), tid = wid * 64 + lane, wr = wid >> 2, wc = wid & 3, fr = lane & 15, fq = lane >> 4;
    const int K = g.K, nt = K / BK;
    unsigned voffA[2], voffB[2];
#pragma unroll
    for (int i = 0; i < 2; ++i) { int R, C; stage_rc(tid * 16 + i * 8192, R, C); const int Rb = Epi::PERM ? ((R & ~31) + perm32(R & 31)) : R;
        voffA[i] = (unsigned)(R * K + C) * 2u; voffB[i] = (unsigned)(Rb * K + C) * 2u; }
    const size_t kstep = (size_t)(BK * 2);
    const size_t hstep = (size_t)HALF * K * 2;
    const size_t tstep = 2 * hstep;
    const unsigned ldsw = (unsigned)wid * 1024u;
    const int aoff = lds_byte(wr * 64 + fr, fq * 8), boff = lds_byte(wc * 32 + fr, fq * 8);
#define PG8_SA(b, h) (((b) * 2 + (h)) * HTB)
#define PG8_SB(b, h) ((4 + (b) * 2 + (h)) * HTB)
#define PG8_STAGE(bufoff, gbase, voff) do { _Pragma("unroll") for (int _i = 0; _i < 2; ++_i) \
        __builtin_amdgcn_global_load_lds((const unsigned*)((const char*)(gbase) + (voff)[_i]), (PG8_LAS unsigned*)(lds + (bufoff) + ldsw + _i * 8192), 16, 0, 0); } while (0)
#define PG8_LDA(dst, b, h) do { _Pragma("unroll") for (int m = 0; m < 4; ++m) _Pragma("unroll") for (int k = 0; k < 2; ++k) dst[m][k] = *(const PG8_LAS bf16x8*)(lds + PG8_SA(b, h) + aoff + m * 2048 + k * 1024); } while (0)
#define PG8_LDB(dst, b, h) do { _Pragma("unroll") for (int n = 0; n < 2; ++n) _Pragma("unroll") for (int k = 0; k < 2; ++k) dst[n][k] = *(const PG8_LAS bf16x8*)(lds + PG8_SB(b, h) + boff + n * 2048 + k * 1024); } while (0)
#define PG8_MMA(ai, bj, At, Bt) do { __builtin_amdgcn_s_setprio(1); _Pragma("unroll") for (int m = 0; m < 4; ++m) _Pragma("unroll") for (int n = 0; n < 2; ++n) _Pragma("unroll") for (int k = 0; k < 2; ++k) \
        acc[ai][bj][m][n] = __builtin_amdgcn_mfma_f32_16x16x32_bf16(Bt[n][k], At[m][k], acc[ai][bj][m][n], 0, 0, 0); __builtin_amdgcn_s_setprio(0); } while (0)
#define PG8_WAIT_V(n) asm volatile("s_waitcnt vmcnt(" #n ")" ::: "memory")
#define PG8_WAIT_L(n) asm volatile("s_waitcnt lgkmcnt(" #n ")" ::: "memory")
#define PG8_BAR __builtin_amdgcn_s_barrier()
#define PG8_SCHED __builtin_amdgcn_sched_barrier(0)
    Unit cur, nxt; int ui = 0;
    if (!S.next(0, cur)) return;
    f32x4 acc[2][2][4][2];
#pragma unroll
    for (int a = 0; a < 2; ++a)
#pragma unroll
        for (int b = 0; b < 2; ++b)
#pragma unroll
            for (int m = 0; m < 4; ++m)
#pragma unroll
                for (int n = 0; n < 2; ++n) acc[a][b][m][n] = (f32x4){0.f, 0.f, 0.f, 0.f};
    bf16x8 At[4][2], B0[2][2], B1[2][2];
    const char* cA = (const char*)g.A + (long)cur.arow * (long)(K * 2); const char* cB = (const char*)g.Bt + (size_t)cur.pn * tstep;
    S.a_ready(cur);
    if constexpr (SP2) {
        PG8_STAGE(PG8_SB(0, 0), cB, voffB); PG8_STAGE(PG8_SB(0, 1), cB + hstep, voffB); PG8_STAGE(PG8_SA(0, 0), cA, voffA); PG8_STAGE(PG8_SA(0, 1), cA + hstep, voffA);
        if (wr == 1) PG8_BAR;
        PG8_WAIT_V(2); PG8_BAR;
        PG8_STAGE(PG8_SB(1, 0), cB + kstep, voffB); PG8_STAGE(PG8_SA(1, 0), cA + kstep, voffA); PG8_STAGE(PG8_SB(1, 1), cB + hstep + kstep, voffB);
        PG8_WAIT_V(6); PG8_BAR;
    } else {
        PG8_STAGE(PG8_SB(0, 0), cB, voffB); PG8_STAGE(PG8_SA(0, 0), cA, voffA); PG8_STAGE(PG8_SB(0, 1), cB + hstep, voffB); PG8_STAGE(PG8_SA(0, 1), cA + hstep, voffA);
        if (wr == 1) PG8_BAR;
        PG8_WAIT_V(4); PG8_BAR;
        PG8_STAGE(PG8_SB(1, 0), cB + kstep, voffB); PG8_STAGE(PG8_SA(1, 0), cA + kstep, voffA); PG8_STAGE(PG8_SB(1, 1), cB + hstep + kstep, voffB);
        PG8_WAIT_V(6); PG8_BAR;
    }
    for (;;) {
        const bool has_next = S.next(ui + 1, nxt);
        const char* nA = has_next ? (const char*)g.A + (long)nxt.arow * (long)(K * 2) : cA; const char* nB = has_next ? (const char*)g.Bt + (size_t)nxt.pn * tstep : cB;
        for (int t = 0; t < nt; t += 2) {
            const bool last = (t == nt - 2);
            const char* a1 = cA + (size_t)(t + 1) * kstep;
            const char* a2 = last ? nA : cA + (size_t)(t + 2) * kstep; const char* b2 = last ? nB : cB + (size_t)(t + 2) * kstep;
            const char* a3 = a2 + kstep; const char* b3 = b2 + kstep;
            if (last && has_next) S.a_ready(nxt);
            if constexpr (SP2) {
            PG8_LDB(B0, 0, 0); PG8_LDB(B1, 0, 1); PG8_SCHED; PG8_LDA(At, 0, 0); PG8_STAGE(PG8_SA(1, 1), a1 + hstep, voffA);
            PG8_WAIT_V(8); PG8_WAIT_L(0); PG8_BAR; PG8_MMA(0, 0, At, B0); PG8_MMA(0, 1, At, B1); PG8_BAR; PG8_SCHED;
            PG8_LDA(At, 0, 1); PG8_STAGE(PG8_SB(0, 0), b2, voffB); PG8_STAGE(PG8_SB(0, 1), b2 + hstep, voffB); PG8_STAGE(PG8_SA(0, 0), a2, voffA);
            PG8_WAIT_V(8); PG8_WAIT_L(0); PG8_BAR; PG8_MMA(1, 0, At, B0); PG8_MMA(1, 1, At, B1); PG8_BAR; PG8_SCHED;
            PG8_LDB(B0, 1, 0); PG8_LDB(B1, 1, 1); PG8_SCHED; PG8_LDA(At, 1, 0); PG8_STAGE(PG8_SA(0, 1), a2 + hstep, voffA);
            PG8_WAIT_V(8); PG8_WAIT_L(0); PG8_BAR; PG8_MMA(0, 0, At, B0); PG8_MMA(0, 1, At, B1); PG8_BAR; PG8_SCHED;
            PG8_LDA(At, 1, 1); PG8_STAGE(PG8_SB(1, 0), b3, voffB); PG8_STAGE(PG8_SB(1, 1), b3 + hstep, voffB); PG8_STAGE(PG8_SA(1, 0), a3, voffA);
            PG8_WAIT_V(8); PG8_WAIT_L(0); PG8_BAR; PG8_MMA(1, 0, At, B0); PG8_MMA(1, 1, At, B1); PG8_BAR; PG8_SCHED;
            } else {
            PG8_LDB(B0, 0, 0); PG8_SCHED; PG8_LDA(At, 0, 0); PG8_STAGE(PG8_SA(1, 1), a1 + hstep, voffA);
            PG8_WAIT_L(8); PG8_BAR; PG8_WAIT_L(0); PG8_MMA(0, 0, At, B0); PG8_BAR; PG8_SCHED;
            PG8_LDB(B1, 0, 1); PG8_STAGE(PG8_SB(0, 0), b2, voffB);
            PG8_BAR; PG8_WAIT_L(0); PG8_MMA(0, 1, At, B1); PG8_BAR;
            PG8_LDA(At, 0, 1); PG8_STAGE(PG8_SA(0, 0), a2, voffA);
            PG8_BAR; PG8_WAIT_L(0); PG8_MMA(1, 0, At, B0); PG8_BAR; PG8_SCHED;
            PG8_STAGE(PG8_SB(0, 1), b2 + hstep, voffB);
            PG8_WAIT_V(6); PG8_BAR; PG8_MMA(1, 1, At, B1); PG8_BAR;
            PG8_LDB(B0, 1, 0); PG8_SCHED; PG8_LDA(At, 1, 0); PG8_STAGE(PG8_SA(0, 1), a2 + hstep, voffA);
            PG8_WAIT_L(8); PG8_BAR; PG8_WAIT_L(0); PG8_MMA(0, 0, At, B0); PG8_BAR; PG8_SCHED;
            PG8_LDB(B1, 1, 1); PG8_STAGE(PG8_SB(1, 0), b3, voffB);
            PG8_BAR; PG8_WAIT_L(0); PG8_MMA(0, 1, At, B1); PG8_BAR;
            PG8_LDA(At, 1, 1); PG8_STAGE(PG8_SA(1, 0), a3, voffA);
            PG8_BAR; PG8_WAIT_L(0); PG8_MMA(1, 0, At, B0); PG8_BAR; PG8_SCHED;
            PG8_STAGE(PG8_SB(1, 1), b3 + hstep, voffB);
            PG8_WAIT_V(6); PG8_BAR; PG8_MMA(1, 1, At, B1); PG8_BAR;
            }
        }
        if constexpr (ALIGN_EPI) { if (wr == 0) PG8_BAR; }
        if constexpr (!Epi::AFTER_DRAIN) { E(acc, cur, wr, wc, fr, fq); S.done(cur); }
        if (!has_next) break;
#pragma unroll
        for (int a = 0; a < 2; ++a)
#pragma unroll
            for (int b = 0; b < 2; ++b)
#pragma unroll
                for (int m = 0; m < 4; ++m)
#pragma unroll
                    for (int n = 0; n < 2; ++n) acc[a][b][m][n] = (f32x4){0.f, 0.f, 0.f, 0.f};
        cur = nxt; cA = nA; cB = nB; ++ui;
        if constexpr (ALIGN_EPI) { if (wr == 1) PG8_BAR; }
    }
    PG8_WAIT_V(0);
    if constexpr (!ALIGN_EPI) { if (wr == 0) PG8_BAR; }
    PG8_BAR;
    if constexpr (Epi::AFTER_DRAIN) { E.fused(acc, cur, wr, wc, fr, fq, lds, wid, lane); S.done(cur); }
#undef PG8_SA
#undef PG8_SB
#undef PG8_STAGE
#undef PG8_LDA
#undef PG8_LDB
#undef PG8_MMA
#undef PG8_WAIT_V
#undef PG8_WAIT_L
#undef PG8_BAR
#undef PG8_SCHED
}
}
namespace pg8 {
constexpr float RMS_EPS = 1e-6f;
typedef unsigned u32x2 __attribute__((ext_vector_type(2)));
template <int CTRL> __device__ __forceinline__ float dpp_mov(float old, float src) {
    return __builtin_bit_cast(float, __builtin_amdgcn_update_dpp(__builtin_bit_cast(int, old), __builtin_bit_cast(int, src), CTRL, 0xf, 0xf, false)); }
__device__ __forceinline__ float bf_lo(unsigned w) { return __builtin_bit_cast(float, w << 16); }
__device__ __forceinline__ float bf_hi(unsigned w) { return __builtin_bit_cast(float, w & 0xffff0000u); }

struct EpiScaleBf16 {
    static constexpr bool PERM = true, AFTER_DRAIN = false;
    bf16_t* O; int ldc; const float* rs;
    __device__ __forceinline__ void operator()(const f32x4 (&acc)[2][2][4][2], const Unit& u, int wr, int wc, int fr, int fq) const {
        const int row0 = u.pm * BM + wr * 64 + fr, col0 = u.pn * BM + wc * 32 + 8 * fq;
#pragma unroll
        for (int ai = 0; ai < 2; ++ai)
#pragma unroll
            for (int m = 0; m < 4; ++m) { const int r = row0 + ai * HALF + m * 16; const float s = rs[r]; bf16_t* rowp = O + (size_t)r * ldc + col0;
#pragma unroll
                for (int bj = 0; bj < 2; ++bj) { const f32x4 v0 = acc[ai][bj][m][0] * s, v1 = acc[ai][bj][m][1] * s;
                    u32x4 w; w.x = cvt_pk_bf16(v0[0], v0[1]); w.y = cvt_pk_bf16(v0[2], v0[3]); w.z = cvt_pk_bf16(v1[0], v1[1]); w.w = cvt_pk_bf16(v1[2], v1[3]);
                    *(u32x4*)(rowp + bj * HALF) = w; } }
    }
};
struct EpiRes {
    static constexpr bool PERM = true, AFTER_DRAIN = false;
    const float* base; float* outf; bf16_t* outb; float* ss; int ldc;
    __device__ __forceinline__ void operator()(const f32x4 (&acc)[2][2][4][2], const Unit& u, int wr, int wc, int fr, int fq) const {
        const int row0 = u.pm * BM + wr * 64 + fr, col0 = u.pn * BM + wc * 32 + 8 * fq;
#pragma unroll
        for (int ai = 0; ai < 2; ++ai)
#pragma unroll
            for (int m = 0; m < 4; ++m) { const int r = row0 + ai * HALF + m * 16; float q = 0.f;
#pragma unroll
                for (int bj = 0; bj < 2; ++bj) { const size_t off = (size_t)r * ldc + col0 + bj * HALF;
                    f32x4 v0 = acc[ai][bj][m][0], v1 = acc[ai][bj][m][1];
                    if (base) { v0 += *(const f32x4*)(base + off); v1 += *(const f32x4*)(base + off + 4); }
                    if (outf) { *(f32x4*)(outf + off) = v0; *(f32x4*)(outf + off + 4) = v1; }
                    u32x4 w; w.x = cvt_pk_bf16(v0[0], v0[1]); w.y = cvt_pk_bf16(v0[2], v0[3]); w.z = cvt_pk_bf16(v1[0], v1[1]); w.w = cvt_pk_bf16(v1[2], v1[3]);
                    *(u32x4*)(outb + off) = w;
                    q += (v0[0] * v0[0] + v0[1] * v0[1]) + (v0[2] * v0[2] + v0[3] * v0[3]) + (v1[0] * v1[0] + v1[1] * v1[1]) + (v1[2] * v1[2] + v1[3] * v1[3]); }
                q += __shfl_xor(q, 16); q += __shfl_xor(q, 32);
                if (fq == 0) atomicAdd(ss + r, q); }
    }
};
struct EpiGate {
    static constexpr bool PERM = true, AFTER_DRAIN = false;
    const float* x2; float* out; const bf16_t* E; const float* ss3; const float* ssE; const float* bpg; const float* peg; int ldc;
    __device__ __forceinline__ void operator()(const f32x4 (&acc)[2][2][4][2], const Unit& u, int wr, int wc, int fr, int fq) const {
        const int row0 = u.pm * BM + wr * 64 + fr, col0 = u.pn * BM + wc * 32 + 8 * fq;
        f32x4 bp[2][2], pg[2][2];
#pragma unroll
        for (int bj = 0; bj < 2; ++bj)
#pragma unroll
            for (int n = 0; n < 2; ++n) { bp[bj][n] = *(const f32x4*)(bpg + col0 + bj * HALF + 4 * n); pg[bj][n] = *(const f32x4*)(peg + col0 + bj * HALF + 4 * n); }
#pragma unroll
        for (int ai = 0; ai < 2; ++ai)
#pragma unroll
            for (int m = 0; m < 4; ++m) { const int r = row0 + ai * HALF + m * 16;
                const float r3 = rsqrtf(ss3[r] * (1.f / 1024.f) + RMS_EPS), rE = rsqrtf(ssE[r] * (1.f / 1024.f) + RMS_EPS);
#pragma unroll
                for (int bj = 0; bj < 2; ++bj) { const size_t off = (size_t)r * ldc + col0 + bj * HALF;
                    const u32x4 ew = *(const u32x4*)(E + off);
                    const float ev[8] = {bf_lo(ew.x), bf_hi(ew.x), bf_lo(ew.y), bf_hi(ew.y), bf_lo(ew.z), bf_hi(ew.z), bf_lo(ew.w), bf_hi(ew.w)};
#pragma unroll
                    for (int n = 0; n < 2; ++n) { const f32x4 xv = *(const f32x4*)(x2 + off + 4 * n); f32x4 o;
#pragma unroll
                        for (int i = 0; i < 4; ++i) { const float z = acc[ai][bj][m][n][i] * r3 + bp[bj][n][i]; const float g = 1.f / (1.f + __expf(-z));
                            o[i] = xv[i] + g * (ev[4 * n + i] * rE * pg[bj][n][i]); }
                        *(f32x4*)(out + off + 4 * n) = o; } } }
    }
};
struct EpiUp {
    static constexpr bool PERM = true, AFTER_DRAIN = false;
    bf16_t* act; const float* ss2; const float* cw; const float* cb; PG8_LAS float* xch;
    __device__ __forceinline__ void operator()(f32x4 (&acc)[2][2][4][2], const Unit& u, int wr, int wc, int fr, int fq) const {
        constexpr int FF = 2816, MROWS = 16384;
#pragma unroll
        for (int ai = 0; ai < 2; ++ai)
#pragma unroll
            for (int m = 0; m < 4; ++m) { const int gr = u.arow + ai * HALF + wr * 64 + m * 16 + fr;
                const float s = (gr >= 0 && gr < MROWS) ? rsqrtf(ss2[gr] * (1.f / 1024.f) + RMS_EPS) : 0.f;
#pragma unroll
                for (int bj = 0; bj < 2; ++bj)
#pragma unroll
                    for (int n = 0; n < 2; ++n) acc[ai][bj][m][n] *= s; }
        const int cl0 = wc * 32 + 8 * fq;
        if (fr >= 14) {
#pragma unroll
            for (int ai = 0; ai < 2; ++ai)
#pragma unroll
                for (int bj = 0; bj < 2; ++bj)
#pragma unroll
                    for (int n = 0; n < 2; ++n) *(PG8_LAS f32x4*)(xch + ((ai * 2 + wr) * 2 + (fr - 14)) * 256 + bj * HALF + cl0 + 4 * n) = acc[ai][bj][3][n];
        }
        asm volatile("s_waitcnt lgkmcnt(0)\n\ts_barrier" ::: "memory");
        const int ch0 = u.pn * HALF + cl0;
#pragma unroll
        for (int n = 0; n < 2; ++n) {
            f32x4 w0[2], w1[2], w2[2], bb[2];
#pragma unroll
            for (int bj = 0; bj < 2; ++bj) { const int c = bj * FF + ch0 + 4 * n;
                w0[bj] = *(const f32x4*)(cw + c); w1[bj] = *(const f32x4*)(cw + 2 * FF + c); w2[bj] = *(const f32x4*)(cw + 4 * FF + c); bb[bj] = *(const f32x4*)(cb + c); }
#pragma unroll
            for (int ai = 0; ai < 2; ++ai) {
                const int g = ai * 2 + wr;
#pragma unroll
                for (int m = 0; m < 4; ++m) {
                    const int rt = ai * HALF + wr * 64 + m * 16 + fr, gr = u.arow + rt, t = gr & 2047;
                    f32x4 cv[2];
#pragma unroll
                    for (int bj = 0; bj < 2; ++bj) {
                        const f32x4 cur = acc[ai][bj][m][n]; f32x4 prev;
                        if (m > 0) prev = acc[ai][bj][m - 1][n];
                        else { prev = (f32x4){0.f, 0.f, 0.f, 0.f}; if (g > 0 && fr >= 14) prev = *(const PG8_LAS f32x4*)(xch + ((g - 1) * 2 + (fr - 14)) * 256 + bj * HALF + cl0 + 4 * n); }
                        f32x4 p1, p2;
#pragma unroll
                        for (int i = 0; i < 4; ++i) {
                            const float r1 = dpp_mov<0x121>(0.f, prev[i]), r2 = dpp_mov<0x122>(0.f, prev[i]);
                            p1[i] = dpp_mov<0x111>(r1, cur[i]); p2[i] = dpp_mov<0x112>(r2, cur[i]);
                        }
                        if (t == 0) { p1 = (f32x4){0.f, 0.f, 0.f, 0.f}; }
                        if (t <= 1) { p2 = (f32x4){0.f, 0.f, 0.f, 0.f}; }
                        cv[bj] = bb[bj] + w2[bj] * cur + w1[bj] * p1 + w0[bj] * p2;
                    }
                    float a4[4];
#pragma unroll
                    for (int i = 0; i < 4; ++i) { const float gv = cv[0][i]; a4[i] = gv / (1.f + __expf(-gv)) * cv[1][i]; }
                    u32x2 w; w.x = cvt_pk_bf16(a4[0], a4[1]); w.y = cvt_pk_bf16(a4[2], a4[3]);
                    if (rt >= 2 && gr < MROWS) *(u32x2*)(act + (size_t)gr * FF + ch0 + 4 * n) = w;
                }
            }
        }
    }
};
}
#include <hip/hip_bf16.h>
#include <cmath>
namespace attn_body {
using bf16=__hip_bfloat16;
using bf16x8=__attribute__((ext_vector_type(8)))short;
using s16x4=__attribute__((ext_vector_type(4)))short;
using f32x16=__attribute__((ext_vector_type(16)))float;
using u32x4=__attribute__((ext_vector_type(4)))unsigned;
constexpr int BATCH=8,NHEAD=8,SEQ=2048,D=64,DM=3072,OM=1024;
constexpr int NW=8,QBLK=32,QB=QBLK*NW,KVBLK=64,NQB=SEQ/QB;
constexpr int ATTN_PITCH=DM, ATTN_UNIT_ROWS=QB;
__device__ __forceinline__ int crow(int r,int hi){return (r&3)+8*(r>>2)+4*hi;}
#define SBAR() __builtin_amdgcn_sched_barrier(0)
__device__ __forceinline__ void cmask(f32x16&p0,f32x16&p1,int jb,int qrel,int hi){
  const float NEG=-INFINITY; int kb=64*jb+4*hi;
  #pragma unroll
  for(int r=0;r<16;++r){int kv=kb+(r&3)+8*(r>>2); if(kv>qrel)p0[r]=NEG; if(kv+32>qrel)p1[r]=NEG;}
}

constexpr int NSLOT=3, SLOTB=8192;
constexpr int LDS_K=0, LDS_V=NSLOT*SLOTB, LDS_WS=2*NSLOT*SLOTB, LDS_OST=LDS_WS+NW*64*4, LDS_CB=LDS_OST+NW*4096, LDS_BYTES=LDS_CB+8192;
constexpr float C2=0.125f*1.4426950408889634f;
__device__ __forceinline__ void glds16(const void*gsrc,unsigned lds_dst){unsigned keep;
  asm volatile("s_mov_b32 %0, m0\n\ts_mov_b32 m0, %2\n\ts_nop 0\n\tglobal_load_lds_dwordx4 %1, off\n\ts_mov_b32 m0, %0":"=&s"(keep):"v"(gsrc),"s"(lds_dst):"memory");}
__device__ __forceinline__ float max3f(float a,float b,float c){float r;asm("v_max3_f32 %0, %1, %2, %3":"=v"(r):"v"(a),"v"(b),"v"(c));return r;}
__device__ __forceinline__ float max2f(float a,float b){float r;asm("v_max_f32_e32 %0, %1, %2":"=v"(r):"v"(a),"v"(b));return r;}
__device__ __forceinline__ float fadd_s(float a,float b){float r;asm("v_add_f32_e32 %0, %1, %2":"=v"(r):"v"(a),"v"(b));return r;}
__device__ __forceinline__ float fsub_s(float a,float b){float r;asm("v_sub_f32_e32 %0, %1, %2":"=v"(r):"v"(a),"v"(b));return r;}
typedef float f32x2_t __attribute__((ext_vector_type(2))); typedef __bf16 bf16x2_t __attribute__((ext_vector_type(2)));
__device__ __forceinline__ unsigned cvtpk_s(float lo,float hi){f32x2_t v={lo,hi};bf16x2_t b=__builtin_convertvector(v,bf16x2_t);return __builtin_bit_cast(unsigned,b);}
#define WAIT_BAR(N) asm volatile("s_waitcnt vmcnt(" #N ") lgkmcnt(0)\n\ts_barrier":::"memory")

__device__ __forceinline__ void qkt(f32x16&p0,f32x16&p1,const char*Kslot,const bf16x8*qr,const f32x16&negm,int r32,int hi){
  const char*kb=Kslot+hi*1024+r32*16;
  #pragma unroll
  for(int d0=0;d0<4;++d0){
    const bf16x8 b0=*reinterpret_cast<const bf16x8*>(kb+d0*2048);
    const bf16x8 b1=*reinterpret_cast<const bf16x8*>(kb+d0*2048+512);
    if(d0==0){p0=__builtin_amdgcn_mfma_f32_32x32x16_bf16(b0,qr[0],negm,0,0,0);p1=__builtin_amdgcn_mfma_f32_32x32x16_bf16(b1,qr[0],negm,0,0,0);}
    else{p0=__builtin_amdgcn_mfma_f32_32x32x16_bf16(b0,qr[d0],p0,0,0,0);p1=__builtin_amdgcn_mfma_f32_32x32x16_bf16(b1,qr[d0],p1,0,0,0);}}
}
typedef __attribute__((address_space(3))) const char* lds_cptr;
typedef short v4i16_t __attribute__((ext_vector_type(4)));
__device__ __forceinline__ void kload8(bf16x8*kf,lds_cptr kp){
  kf[0]=*(const __attribute__((address_space(3))) bf16x8*)(kp);      kf[1]=*(const __attribute__((address_space(3))) bf16x8*)(kp+512);
  kf[2]=*(const __attribute__((address_space(3))) bf16x8*)(kp+2048); kf[3]=*(const __attribute__((address_space(3))) bf16x8*)(kp+2560);
  kf[4]=*(const __attribute__((address_space(3))) bf16x8*)(kp+4096); kf[5]=*(const __attribute__((address_space(3))) bf16x8*)(kp+4608);
  kf[6]=*(const __attribute__((address_space(3))) bf16x8*)(kp+6144); kf[7]=*(const __attribute__((address_space(3))) bf16x8*)(kp+6656);
}
__device__ __forceinline__ void kload2(bf16x8*kf,lds_cptr kp,int j){ kf[2*j]=*(const __attribute__((address_space(3))) bf16x8*)(kp+j*2048); kf[2*j+1]=*(const __attribute__((address_space(3))) bf16x8*)(kp+j*2048+512); }
__device__ __forceinline__ s16x4 vtr(lds_cptr p){ return __builtin_bit_cast(s16x4,__builtin_amdgcn_ds_read_tr16_b64_v4i16((__attribute__((address_space(3))) v4i16_t*)p)); }
__device__ __forceinline__ float rowmax(const f32x16&p0,const f32x16&p1){
  float a=max3f(p0[0],p0[1],p1[0]),b=max3f(p0[2],p0[3],p1[1]);a=max3f(a,p1[2],p1[3]);
  #pragma unroll
  for(int r=4;r<16;r+=4){a=max3f(a,p0[r],p0[r+1]);b=max3f(b,p0[r+2],p0[r+3]);a=max3f(a,p1[r],p1[r+1]);b=max3f(b,p1[r+2],p1[r+3]);}
  const float m=max2f(a,b);
  auto rr=__builtin_amdgcn_permlane32_swap(__float_as_uint(m),__float_as_uint(m),false,false);
  return max2f(__uint_as_float(rr[0]),__uint_as_float(rr[1]));
}
__device__ __forceinline__ void pv(f32x16*o,int vb,bf16x8 pa0,bf16x8 pa1,bf16x8 pa2,bf16x8 pa3){
  #pragma unroll
  for(int d0=0;d0<2;++d0){s16x4 lo[4],hi[4];
    #pragma unroll
    for(int ks=0;ks<4;++ks){
      asm volatile("ds_read_b64_tr_b16 %0,%1 offset:%c2":"=&v"(lo[ks]):"v"(vb),"i"(d0*4096+ks*1024):"memory");
      asm volatile("ds_read_b64_tr_b16 %0,%1 offset:%c2":"=&v"(hi[ks]):"v"(vb),"i"(d0*4096+ks*1024+512):"memory");}
    asm volatile("s_waitcnt lgkmcnt(0)":::"memory");SBAR();
    #define PK(k) (bf16x8){lo[k][0],lo[k][1],lo[k][2],lo[k][3],hi[k][0],hi[k][1],hi[k][2],hi[k][3]}
    o[d0]=__builtin_amdgcn_mfma_f32_32x32x16_bf16(pa0,PK(0),o[d0],0,0,0);
    o[d0]=__builtin_amdgcn_mfma_f32_32x32x16_bf16(pa1,PK(1),o[d0],0,0,0);
    o[d0]=__builtin_amdgcn_mfma_f32_32x32x16_bf16(pa2,PK(2),o[d0],0,0,0);
    o[d0]=__builtin_amdgcn_mfma_f32_32x32x16_bf16(pa3,PK(3),o[d0],0,0,0);
    #undef PK
  }
}

#ifndef ATTN_STORE16
#define ATTN_STORE16(p,v) (*(u32x4*)(p)=(v))
#endif
template<int THRL> __device__ __forceinline__ void attn_unit(int b,int h,int qb,const bf16*Q,const bf16*__restrict__ K,const bf16*__restrict__ V,bf16*O,const float*__restrict__ CB,char*shm){
  const int tid=threadIdx.x,lane=tid&63,r32=lane&31,hi=lane>>5; const int wid=__builtin_amdgcn_readfirstlane(tid>>6);
  const long rowbase=(long)b*SEQ; const int q0=qb*QB;
  const bf16*Qw=Q+(rowbase+q0+wid*QBLK)*DM+h*D;
  const bf16*Kh=K+rowbase*DM+h*D,*Vh=V+rowbase*DM+h*D;
  const lds_cptr shm3=(lds_cptr)shm; const unsigned lds0=(unsigned)(uintptr_t)shm;
  float*wsf=(float*)(shm+LDS_WS)+wid*64;
  const bf16*ksrc=Kh+(long)lane*DM+wid*8;
  const bf16*vsrc=Vh+(long)(16*(wid&3)+(lane>>2))*DM+(wid>>2)*32+(lane&3)*8;
  const unsigned kdst=lds0+LDS_K+wid*1024, vdst=lds0+LDS_V+wid*1024;
  #define DMA_K(t,slot) glds16(ksrc+(long)(t)*KVBLK*DM,(unsigned)__builtin_amdgcn_readfirstlane(kdst+(slot)))
  #define DMA_V(t,slot) glds16(vsrc+(long)(t)*KVBLK*DM,(unsigned)__builtin_amdgcn_readfirstlane(vdst+(slot)))
  const int vb0=(int)(lds0+LDS_V)+((lane>>4)&1)*32+(lane&3)*8+(4*hi+((lane&15)>>2))*64;
  const char*Kbase=shm+LDS_K; bf16x8 kf[8];
  const lds_cptr kp0=shm3+LDS_K+hi*1024+r32*16; const lds_cptr vp0=shm3+LDS_V+((lane>>4)&1)*32+(lane&3)*8+(4*hi+((lane&15)>>2))*64;
  const int NT=(q0+QB)/KVBLK;
  typedef __attribute__((address_space(3))) float* lds_fptr; typedef float f32x4_t __attribute__((ext_vector_type(4)));
  const lds_fptr cbl=(lds_fptr)(shm3+LDS_CB);
  { const float*cg_=CB+(long)(b*NHEAD+h)*SEQ; const float cref=cg_[q0];
    for(int i_=tid;i_<(q0+QB)/4;i_+=NW*64){ f32x4_t v_=*(const f32x4_t*)(cg_+4*i_); v_-=cref; *(__attribute__((address_space(3))) f32x4_t*)(cbl+4*i_)=v_; } }
  #define BIAS(P0,P1,t) do{ const lds_fptr cp_=cbl+64*(t)+4*hi; \
    _Pragma("unroll") for(int g_=0;g_<4;++g_){ { const f32x4_t c0_=*(const __attribute__((address_space(3))) f32x4_t*)(cp_+8*g_)+mhat; \
      _Pragma("unroll") for(int i_=0;i_<4;++i_){ P0[4*g_+i_]-=c0_[i_]; } } asm volatile("":::"memory"); \
      { const f32x4_t c1_=*(const __attribute__((address_space(3))) f32x4_t*)(cp_+32+8*g_)+mhat; \
      _Pragma("unroll") for(int i_=0;i_<4;++i_){ P1[4*g_+i_]-=c1_[i_]; } } asm volatile("":::"memory"); } }while(0)
  DMA_K(0,0);DMA_V(0,0);DMA_K(1,SLOTB);
  bf16x8 qr[4];
  #pragma unroll
  for(int d0=0;d0<4;++d0)qr[d0]=*reinterpret_cast<const bf16x8*>(&Qw[(long)r32*DM+d0*16+hi*8]);
  float mhat=0.f,l_reg=0.f;f32x16 o[2];o[0]=f32x16{};o[1]=f32x16{};f32x16 negm=f32x16{}; const f32x16 zero16=f32x16{};
  const int qrel=wid*QBLK+r32;
  #define CMASK(P0,P1,t) do{int jb_=(t)-(NT-4); if(jb_>=0)cmask(P0,P1,jb_,qrel,hi);}while(0)
  bool resc=false;
  #define START(P0,P1) do{ const float rm=rowmax(P0,P1); resc=false; \
    { const float dl=rm; mhat=fadd_s(mhat,dl); \
      _Pragma("unroll") for(int r=0;r<16;++r){P0[r]=fsub_s(P0[r],dl);P1[r]=fsub_s(P1[r],dl);} \
      _Pragma("unroll") for(int r=0;r<16;++r)negm[r]=-mhat;  } \
    _Pragma("unroll") for(int r=0;r<16;++r)P0[r]=__builtin_amdgcn_exp2f(P0[r]); }while(0)
  #define RESC() do{ if(resc){ asm volatile("s_waitcnt lgkmcnt(0)":::"memory"); \
      _Pragma("unroll") for(int d_=0;d_<2;++d_) _Pragma("unroll") for(int r=0;r<16;++r)o[d_][r]*=wsf[crow(r,hi)]; } }while(0)
  f32x16 pA0,pA1,pB0,pB1;
  int sl_prev=0,sl_cur=0,sl_next=SLOTB;
  #define ROT() do{sl_prev=sl_cur;sl_cur=sl_next;sl_next=(sl_next==(NSLOT-1)*SLOTB)?0:sl_next+SLOTB;}while(0)
  DMA_K(2,2*SLOTB);
  WAIT_BAR(3);
  qkt(pA0,pA1,Kbase,qr,zero16,r32,hi);asm volatile("s_nop 15\n\ts_nop 7":"+v"(pA0),"+v"(pA1));BIAS(pA0,pA1,0);CMASK(pA0,pA1,0);
  START(pA0,pA1);
  _Pragma("unroll") for(int r=0;r<16;++r)pA1[r]=__builtin_amdgcn_exp2f(pA1[r]);
  WAIT_BAR(0);
  DMA_K(3,0);DMA_V(1,SLOTB);
  ROT();
  kload8(kf,kp0+sl_cur);
  WAIT_BAR(2);
  s16x4 vlo[8],vhi[8]; u32x4 pw0,pw1,pw2,pw3;
  #define PKW(P,B) cvtpk_s(P[B],P[B+1])
  #define PAF(k) __builtin_bit_cast(bf16x8,pw##k)
  #define VFR(i) (bf16x8){vlo[i][0],vlo[i][1],vlo[i][2],vlo[i][3],vhi[i][0],vhi[i][1],vhi[i][2],vhi[i][3]}
  #define PIN(x) asm volatile("":"+v"(x))
  #define MX3(a,b,c) __builtin_fmaxf(__builtin_fmaxf((a),(b)),(c))
  #define GAPA(MF,A0,A1,A2,A3,W0,W1,PW) do{ MF; sacc+=A0; sacc+=A1; sacc+=A2; sacc+=A3; PIN(sacc); W0; W1; PIN(PW); SBAR(); }while(0)
  #define EX(v) __builtin_amdgcn_exp2f(v)
  #define GAPB(MF,X,B) do{ MF; X[B]=EX(X[B]); X[B+1]=EX(X[B+1]); X[B+2]=EX(X[B+2]); X[B+3]=EX(X[B+3]); PIN(X); SBAR(); }while(0)
  #define VRD(i) do{ vlo[i]=vtr(vp_+(((i)>>2)*4096+((i)&3)*1024)); vhi[i]=vtr(vp_+(((i)>>2)*4096+((i)&3)*1024+512)); }while(0)
  #define KRD(G,j) do{ if(G){ kload2(kf,kp0+sl_next,j); SBAR(); } }while(0)
  #define STEP(C0,C1,P0,P1,t,GK,GV,GL) do{ SBAR(); \
    const lds_cptr vp_=vp0+sl_prev; \
    VRD(0); SBAR(); float sacc=(P0[0]+P0[1]); \
    GAPA(C0=__builtin_amdgcn_mfma_f32_32x32x16_bf16(kf[0],qr[0],zero16,0,0,0), P0[2],P0[3],P0[4],P0[5],     pw0[0]=PKW(P0,0), pw0[1]=PKW(P0,2), pw0); \
    VRD(4); SBAR(); GAPA(C1=__builtin_amdgcn_mfma_f32_32x32x16_bf16(kf[1],qr[0],zero16,0,0,0), P0[6],P0[7],P0[8],P0[9],     pw0[2]=PKW(P0,4), pw0[3]=PKW(P0,6), pw0); \
    VRD(1); SBAR(); GAPA(C0=__builtin_amdgcn_mfma_f32_32x32x16_bf16(kf[2],qr[1],C0,0,0,0),   P0[10],P0[11],P0[12],P0[13], pw1[0]=PKW(P0,8), pw1[1]=PKW(P0,10), pw1); \
    VRD(5); SBAR(); GAPA(C1=__builtin_amdgcn_mfma_f32_32x32x16_bf16(kf[3],qr[1],C1,0,0,0),   P0[14],P0[15],P1[0],P1[1],   pw1[2]=PKW(P0,12),pw1[3]=PKW(P0,14), pw1); \
    VRD(2); SBAR(); GAPA(C0=__builtin_amdgcn_mfma_f32_32x32x16_bf16(kf[4],qr[2],C0,0,0,0),   P1[2],P1[3],P1[4],P1[5],     pw2[0]=PKW(P1,0), pw2[1]=PKW(P1,2), pw2); \
    VRD(6); SBAR(); GAPA(C1=__builtin_amdgcn_mfma_f32_32x32x16_bf16(kf[5],qr[2],C1,0,0,0),   P1[6],P1[7],P1[8],P1[9],     pw2[2]=PKW(P1,4), pw2[3]=PKW(P1,6), pw2); \
    VRD(3); SBAR(); GAPA(C0=__builtin_amdgcn_mfma_f32_32x32x16_bf16(kf[6],qr[3],C0,0,0,0),   P1[10],P1[11],P1[12],P1[13], pw3[0]=PKW(P1,8), pw3[1]=PKW(P1,10), pw3); \
    VRD(7); SBAR(); GAPA(C1=__builtin_amdgcn_mfma_f32_32x32x16_bf16(kf[7],qr[3],C1,0,0,0),   P1[14],P1[15],0.f,0.f,       pw3[2]=PKW(P1,12),pw3[3]=PKW(P1,14), pw3); \
    l_reg+=sacc; \
    if(GK){DMA_K((t)+3,sl_cur);} if(GV){DMA_V((t)+1,sl_next);} \
    BIAS(C0,C1,t); CMASK(C0,C1,t); \
    { float a=MX3(C0[0],C0[1],C1[0]),b=MX3(C0[2],C0[3],C1[1]); a=MX3(a,C1[2],C1[3]); \
      _Pragma("unroll") for(int r=4;r<16;r+=4){a=MX3(a,C0[r],C0[r+1]);b=MX3(b,C0[r+2],C0[r+3]);a=MX3(a,C1[r],C1[r+1]);b=MX3(b,C1[r+2],C1[r+3]);} \
      float rm=__builtin_fmaxf(a,b); { auto rr=__builtin_amdgcn_permlane32_swap(__float_as_uint(rm),__float_as_uint(rm),false,false); rm=__builtin_fmaxf(__uint_as_float(rr[0]),__uint_as_float(rr[1])); } \
      resc=false; \
      if(__builtin_expect(__any(rm>(float)THRL),0)){ const float dl=__builtin_fmaxf(rm,0.f); mhat+=dl; \
        _Pragma("unroll") for(int r=0;r<16;++r){C0[r]-=dl;C1[r]-=dl;} \
        _Pragma("unroll") for(int r=0;r<16;++r)negm[r]=-mhat;  \
        const float f=__builtin_amdgcn_exp2f(-dl); l_reg*=f; if(hi==0)wsf[r32]=f; resc=true; } } \
    SBAR(); \
    GAPB(o[0]=__builtin_amdgcn_mfma_f32_32x32x16_bf16(PAF(0),VFR(0),o[0],0,0,0), C0,0); \
    GAPB(o[1]=__builtin_amdgcn_mfma_f32_32x32x16_bf16(PAF(0),VFR(4),o[1],0,0,0), C0,4); \
    KRD(GL,0); GAPB(o[0]=__builtin_amdgcn_mfma_f32_32x32x16_bf16(PAF(1),VFR(1),o[0],0,0,0), C0,8); \
    KRD(GL,1); GAPB(o[1]=__builtin_amdgcn_mfma_f32_32x32x16_bf16(PAF(1),VFR(5),o[1],0,0,0), C0,12); \
    KRD(GL,2); GAPB(o[0]=__builtin_amdgcn_mfma_f32_32x32x16_bf16(PAF(2),VFR(2),o[0],0,0,0), C1,0); \
    KRD(GL,3); GAPB(o[1]=__builtin_amdgcn_mfma_f32_32x32x16_bf16(PAF(2),VFR(6),o[1],0,0,0), C1,4); \
    GAPB(o[0]=__builtin_amdgcn_mfma_f32_32x32x16_bf16(PAF(3),VFR(3),o[0],0,0,0), C1,8); \
    GAPB(o[1]=__builtin_amdgcn_mfma_f32_32x32x16_bf16(PAF(3),VFR(7),o[1],0,0,0), C1,12); \
    }while(0)
  int t=1;
  #undef CMASK
  #define CMASK(P0,P1,t) do{}while(0)
  for(;t+5<NT;t+=2){
    STEP(pB0,pB1,pA0,pA1,t,true,true,true);     WAIT_BAR(2); RESC(); ROT();
    STEP(pA0,pA1,pB0,pB1,t+1,true,true,true);   WAIT_BAR(2); RESC(); ROT();
  }
  #undef CMASK
  #define CMASK(P0,P1,t) do{int jb_=(t)-(NT-4); if(jb_>=0)cmask(P0,P1,jb_,qrel,hi);}while(0)
  #define ENDW(tt) do{ if((tt)+3<NT){WAIT_BAR(2);} else if((tt)+2<NT){WAIT_BAR(1);} else {WAIT_BAR(0);} }while(0)
  for(;t+1<NT;t+=2){
    STEP(pB0,pB1,pA0,pA1,t,(t+3<NT),(t+1<NT),(t+1<NT));       ENDW(t);   RESC(); ROT();
    STEP(pA0,pA1,pB0,pB1,t+1,(t+4<NT),(t+2<NT),(t+2<NT));     ENDW(t+1); RESC(); ROT();
  }
  STEP(pB0,pB1,pA0,pA1,NT-1,false,false,false); RESC();
  { float sacc=pB0[0]+pB0[1]; _Pragma("unroll") for(int r=2;r<16;++r)sacc+=pB0[r]; _Pragma("unroll") for(int r=0;r<16;++r)sacc+=pB1[r]; l_reg+=sacc;
    pw0=(u32x4){PKW(pB0,0),PKW(pB0,2),PKW(pB0,4),PKW(pB0,6)};pw1=(u32x4){PKW(pB0,8),PKW(pB0,10),PKW(pB0,12),PKW(pB0,14)};pw2=(u32x4){PKW(pB1,0),PKW(pB1,2),PKW(pB1,4),PKW(pB1,6)};pw3=(u32x4){PKW(pB1,8),PKW(pB1,10),PKW(pB1,12),PKW(pB1,14)};
    SBAR(); pv(o,vb0+sl_cur,PAF(0),PAF(1),PAF(2),PAF(3)); }
  #undef PKW
  #undef PAF
  #undef VFR
  #undef PIN
  #undef MX3
  #undef GAPA
  #undef GAPB
  #undef EX
  #undef VRD
  #undef KRD
  #undef STEP
  #undef ENDW
  {auto rr=__builtin_amdgcn_permlane32_swap(__float_as_uint(l_reg),__float_as_uint(l_reg),false,false);l_reg=__uint_as_float(rr[0])+__uint_as_float(rr[1]);}
  if(hi==0)wsf[32+r32]=l_reg;asm volatile("s_waitcnt lgkmcnt(0)":::"memory");
  float rli[16];
  #pragma unroll
  for(int r=0;r<16;++r)rli[r]=__builtin_amdgcn_rcpf(wsf[32+crow(r,hi)]);
  bf16*Ow=O+(rowbase+q0+wid*QBLK)*OM+h*D;
  { bf16*stg=(bf16*)(shm+LDS_OST)+wid*2048;
    #pragma unroll
    for(int r=0;r<16;++r){const int orow=crow(r,hi);
      #pragma unroll
      for(int d0=0;d0<2;++d0)stg[orow*64+d0*32+r32]=__float2bfloat16(o[d0][r]*rli[r]);}
    asm volatile("s_waitcnt lgkmcnt(0)":::"memory");
    #pragma unroll
    for(int i=0;i<4;++i){const int row=i*8+(lane>>3),ch=lane&7; const u32x4 v=*(const u32x4*)(stg+row*64+ch*8); ATTN_STORE16(Ow+(long)row*OM+ch*8,v);} }
  asm volatile("s_waitcnt lgkmcnt(0)\n\ts_barrier":::"memory");
  #undef DMA_K
  #undef DMA_V
  #undef CMASK
  #undef START
  #undef RESC
  #undef ROT
  #undef BIAS
}
constexpr int ATTN_LDS_BYTES=LDS_BYTES;
struct AttnTensors { const bf16* Q; const bf16* K; const bf16* V; bf16* O; const float* CB; };
struct AttnUnit { int bh; int qb; };
struct StaticOrder {
  int vcu,G;
  __device__ __forceinline__ explicit StaticOrder(int grid,int v):vcu(v),G(grid){}
  __device__ __forceinline__ bool next(int i,AttnUnit&u)const{ const int p=vcu+(i>>1)*G; if(p>=256)return false; const int s=p&3; u.bh=p>>2; u.qb=(i&1)?7-s:s; return true; }
  __device__ __forceinline__ void a_ready(const AttnUnit&)const{}
  __device__ __forceinline__ void done(const AttnUnit&)const{}
};
template<class Sched,int THRL=8> __device__ __forceinline__ void attn_phase(char*lds,const AttnTensors&T,const Sched&S){
  AttnUnit u;
  for(int i=0;S.next(i,u);++i){ S.a_ready(u); attn_unit<THRL>(u.bh/NHEAD,u.bh%NHEAD,u.qb,T.Q,T.K,T.V,T.O,T.CB,lds); S.done(u); }
}
#undef SBAR
#undef WAIT_BAR
}
#define LAS __attribute__((address_space(3)))
namespace mk {
typedef unsigned short bf16;
typedef unsigned u32x4 __attribute__((ext_vector_type(4)));
typedef unsigned u32x2 __attribute__((ext_vector_type(2)));
typedef float f32x4 __attribute__((ext_vector_type(4)));
typedef float f32x2 __attribute__((ext_vector_type(2)));
typedef float f32x16 __attribute__((ext_vector_type(16)));
typedef short bf16x8 __attribute__((ext_vector_type(8)));
typedef unsigned v4u __attribute__((ext_vector_type(4)));
constexpr int NWAVES = 8, NT = 512;
constexpr int M = 16384, SEQ = 2048, DM = 1024, INW = 3096, PROJW = 3072, FF = 2816, PLE = 256;
constexpr float EPS = 1e-6f, LOG2E = 1.4426950408889634f, C2 = 0.125f * LOG2E;
constexpr size_t MiB = 1u << 20;
constexpr size_t WS_WIN = 1 * MiB, WS_WSK = 7 * MiB, WS_WO = 8 * MiB, WS_WUP = 10 * MiB, WS_WD = 21 * MiB, WS_WPG = 27 * MiB, WS_WPE = 29 * MiB;
constexpr size_t WS_SMALL = 30 * MiB;
constexpr size_t WS_LRF = 31 * MiB, WS_PB = 33 * MiB, WS_QE = 41 * MiB, WS_XB = 50 * MiB  , WS_MIX = 83 * MiB, WS_PROJ = 115 * MiB, WS_END = 211 * MiB;
constexpr size_t WS_SPREV = WS_XB, WS_E = WS_MIX, WS_ACT = WS_PROJ;
constexpr int LDS_BYTES = 147456, XCH_OFF = 131072;

__device__ __forceinline__ unsigned f2bf(float f) { unsigned u = __builtin_bit_cast(unsigned, f); return (u + 0x7fffu + ((u >> 16) & 1u)) >> 16; }
__device__ __forceinline__ unsigned pk2(float lo, float hi) { return f2bf(lo) | (f2bf(hi) << 16); }
__device__ __forceinline__ float bf2f(unsigned short h) { return __builtin_bit_cast(float, (unsigned)h << 16); }
__device__ __forceinline__ float bflo(unsigned w) { return __builtin_bit_cast(float, w << 16); }
__device__ __forceinline__ float bfhi(unsigned w) { return __builtin_bit_cast(float, w & 0xffff0000u); }
__device__ __forceinline__ float logsig(float z) { return fminf(z, 0.f) - log1pf(__expf(-fabsf(z))); }
__device__ __forceinline__ int crow(int r, int hi) { return (r & 3) + 8 * (r >> 2) + 4 * hi; }
__device__ __forceinline__ float wave_sum(float v) {
#pragma unroll
    for (int o = 1; o < 64; o <<= 1) v += __shfl_xor(v, o);
    return v;
}
#define LDS_WAIT() asm volatile("s_waitcnt lgkmcnt(0)" ::: "memory")

struct Args { const float* in[21]; float* out; unsigned char* ws; };

template <bool HAS_GAIN>
__device__ __forceinline__ void tr_item(const float* W, int ldw, int k0, int srccol, const float* gain, bf16* WT, int ldk, int dstrow0, LAS float* scr, int lane) {
    const int sc = srccol < 0 ? 0 : srccol; const float msk = srccol < 0 ? 0.f : 1.f;
    const float* wp = W + (size_t)(k0 + (lane >> 5)) * ldw + sc;
    float v[32], gv[32];
#pragma unroll
    for (int i = 0; i < 32; ++i) v[i] = wp[(size_t)(2 * i) * ldw];
    if (HAS_GAIN) {
#pragma unroll
        for (int i = 0; i < 32; ++i) gv[i] = gain[k0 + 2 * i + (lane >> 5)];
    }
#pragma unroll
    for (int i = 0; i < 32; ++i) scr[(2 * i + (lane >> 5)) * 33 + (lane & 31)] = HAS_GAIN ? v[i] * gv[i] * msk : v[i] * msk;
    LDS_WAIT();
    const int c = lane & 7;
#pragma unroll
    for (int j = 0; j < 4; ++j) { const int n = (lane >> 3) + 8 * j; const LAS float* s = scr + (8 * c) * 33 + n;
        u32x4 o; o.x = pk2(s[0 * 33], s[1 * 33]); o.y = pk2(s[2 * 33], s[3 * 33]); o.z = pk2(s[4 * 33], s[5 * 33]); o.w = pk2(s[6 * 33], s[7 * 33]);
        *(u32x4*)(WT + (size_t)(dstrow0 + n) * ldk + k0 + 8 * c) = o; }
    LDS_WAIT();
}

__device__ __forceinline__ void p0_prologue(const Args& a, LAS unsigned char* lds, int vcu, int G, int wave, int lane, int tid) {
    unsigned char* ws = a.ws;
    LAS float* scr = (LAS float*)(lds + wave * 16384);
    const int gw = vcu * NWAVES + wave, NGW = G * NWAVES;
    constexpr int I_IN = 16 * 96, I_SK = 16, I_O = 16 * 32, I_UP = 16 * 176, I_D = 44 * 32, I_PG = 16 * 32, I_PE = 4 * 32;
    constexpr int NITEMS = I_IN + I_SK + I_O + I_UP + I_D + I_PG + I_PE;
    for (int it = gw; it < NITEMS; it += NGW) {
        int r = it; const int nl = lane & 31;
        if (r < I_IN) { const int kb = r / 96, nb = r % 96, n0 = 32 * nb; tr_item<true>(a.in[3], INW, 64 * kb, n0 + (n0 >= 1536 ? 16 : 0) + nl, a.in[2], (bf16*)(ws + WS_WIN), DM, n0, scr, lane); continue; } r -= I_IN;
        if (r < I_SK) { const int sc = nl < 16 ? 1536 + nl : (nl < 24 ? 3088 + nl - 16 : -1); tr_item<true>(a.in[3], INW, 64 * r, sc, a.in[2], (bf16*)(ws + WS_WSK), DM, 0, scr, lane); continue; } r -= I_SK;
        if (r < I_O) { const int kb = r / 32, nb = r % 32; tr_item<false>(a.in[10], DM, 64 * kb, 32 * nb + nl, nullptr, (bf16*)(ws + WS_WO), DM, 32 * nb, scr, lane); continue; } r -= I_O;
        if (r < I_UP) { const int kb = r / 176, nb = r % 176, pn = nb >> 3, wi = nb & 7; const int sc0 = wi < 4 ? 128 * pn + 32 * wi : FF + 128 * pn + 32 * (wi - 4);
            tr_item<true>(a.in[12], 2 * FF, 64 * kb, sc0 + nl, a.in[11], (bf16*)(ws + WS_WUP), DM, 32 * nb, scr, lane); continue; } r -= I_UP;
        if (r < I_D) { const int kb = r / 32, nb = r % 32; tr_item<false>(a.in[15], DM, 64 * kb, 32 * nb + nl, nullptr, (bf16*)(ws + WS_WD), FF, 32 * nb, scr, lane); continue; } r -= I_D;
        if (r < I_PG) { const int kb = r / 32, nb = r % 32; tr_item<true>(a.in[19], DM, 64 * kb, 32 * nb + nl, a.in[16], (bf16*)(ws + WS_WPG), DM, 32 * nb, scr, lane); continue; } r -= I_PG;
        { const int kb = r / 32, nb = r % 32; tr_item<false>(a.in[17], DM, 64 * kb, 32 * nb + nl, nullptr, (bf16*)(ws + WS_WPE), PLE, 32 * nb, scr, lane); }
    }
    float* rstd1 = (float*)(ws + WS_SMALL); bf16* xb = (bf16*)(ws + WS_XB); bf16* pb = (bf16*)(ws + WS_PB);
    for (int m0 = gw; m0 < M; m0 += 2 * NGW) {
        f32x4 v[2][4], pv[2];
#pragma unroll
        for (int q = 0; q < 2; ++q) { const int m = m0 + q * NGW; const f32x4* xr = (const f32x4*)(a.in[0] + (size_t)m * DM) + lane;
#pragma unroll
            for (int j = 0; j < 4; ++j) v[q][j] = xr[64 * j];
            pv[q] = *((const f32x4*)(a.in[1] + (size_t)m * PLE) + lane); }
#pragma unroll
        for (int q = 0; q < 2; ++q) { const int m = m0 + q * NGW; float s = 0.f;
#pragma unroll
            for (int j = 0; j < 4; ++j) s += (v[q][j].x * v[q][j].x + v[q][j].y * v[q][j].y) + (v[q][j].z * v[q][j].z + v[q][j].w * v[q][j].w);
            s = wave_sum(s); if (lane == 0) rstd1[m] = rsqrtf(s * (1.f / DM) + EPS);
            u32x2* o8 = (u32x2*)(xb + (size_t)m * DM) + lane;
#pragma unroll
            for (int j = 0; j < 4; ++j) o8[64 * j] = (u32x2){pk2(v[q][j].x, v[q][j].y), pk2(v[q][j].z, v[q][j].w)};
            *((u32x2*)(pb + (size_t)m * PLE) + lane) = (u32x2){pk2(pv[q].x, pv[q].y), pk2(pv[q].z, pv[q].w)}; }
    }
    float* ssz = (float*)(ws + WS_SMALL) + M;
    for (int i = vcu * NT + tid; i < 3 * M; i += G * NT) ssz[i] = 0.f;
}

__device__ __forceinline__ void p1_skinny(const Args& a, LAS unsigned char* lds, int vcu, int G, int wave, int lane, int tid) {
    const bf16* xb = (const bf16*)(a.ws + WS_XB); const bf16* wsk = (const bf16*)(a.ws + WS_WSK); const float* rstd1 = (const float*)(a.ws + WS_SMALL); float* lrf = (float*)(a.ws + WS_LRF);
    LAS float* red = (LAS float*)lds;
    const int r32 = lane & 31, hi = lane >> 5;
    for (int rg = vcu; rg < M / 64; rg += G) {
        const int row0 = rg * 64; f32x16 acc0 = {}, acc1 = {};
#pragma unroll
        for (int ks = 0; ks < 8; ++ks) { const int k = wave * 128 + ks * 16 + 8 * hi;
            const bf16x8 a0 = *(const bf16x8*)(xb + (size_t)(row0 + r32) * DM + k), a1 = *(const bf16x8*)(xb + (size_t)(row0 + 32 + r32) * DM + k), b = *(const bf16x8*)(wsk + (size_t)r32 * DM + k);
            acc0 = __builtin_amdgcn_mfma_f32_32x32x16_bf16(a0, b, acc0, 0, 0, 0); acc1 = __builtin_amdgcn_mfma_f32_32x32x16_bf16(a1, b, acc1, 0, 0, 0); }
#pragma unroll
        for (int r = 0; r < 16; ++r) { red[(wave * 64 + crow(r, hi)) * 32 + r32] = acc0[r]; red[(wave * 64 + 32 + crow(r, hi)) * 32 + r32] = acc1[r]; }
        __syncthreads();
        { const int row = tid >> 3, c4 = tid & 7; f32x4 s = {0.f, 0.f, 0.f, 0.f};
#pragma unroll
            for (int w = 0; w < 8; ++w) s += *(const LAS f32x4*)(red + (w * 64 + row) * 32 + c4 * 4);
            s *= rstd1[row0 + row]; *(f32x4*)(lrf + (size_t)(row0 + row) * 32 + c4 * 4) = s; }
        __syncthreads();
    }
}

__device__ __forceinline__ bf16x8 ldfrag(const LAS bf16* base, int row, int ks, int hi) { return *(const LAS bf16x8*)(base + row * 72 + ks * 16 + 8 * hi); }
__device__ __forceinline__ void gla_local(const Args& a, LAS unsigned char* lds, int task, int wave, int lane, int tid) {
    unsigned char* ws = a.ws;
    const bf16* proj = (const bf16*)(ws + WS_PROJ); const float* lrf = (const float*)(ws + WS_LRF); bf16* qeg = (bf16*)(ws + WS_QE);
    float* decay = (float*)(ws + WS_SMALL) + 4 * M; float* ointra = a.out; float* dS = a.out + (size_t)M * 512;
    const int bh = task >> 5, n = task & 31, b = bh >> 2, h = bh & 3, tok0 = b * SEQ + n * 64;
    LAS bf16* QE = (LAS bf16*)lds; LAS bf16* KE = QE + 64 * 72; LAS bf16* KDT = KE + 64 * 72; LAS bf16* VT = KDT + 64 * 72; LAS bf16* AT = VT + 128 * 72; LAS float* SEG = (LAS float*)(AT + 64 * 72);
    const int r32 = lane & 31, hi = lane >> 5;
    {
        const int k = tid & 63, seg = tid >> 6;
        const int v = tid & 127, sg = tid >> 7;
        float w[16];
#pragma unroll
        for (int j = 0; j < 16; ++j) w[j] = a.in[4][j * 256 + h * 64 + k];
        const float bias = a.in[5][h * 64 + k];
        f32x4 lrv[8][4]; unsigned short qraw[8], kraw[8], vv[16];
#pragma unroll
        for (int i = 0; i < 8; ++i) { const f32x4* lr = (const f32x4*)(lrf + (size_t)(tok0 + seg * 8 + i) * 32);
#pragma unroll
            for (int j = 0; j < 4; ++j) lrv[i][j] = lr[j];
            const bf16* pr = proj + (size_t)(tok0 + seg * 8 + i) * PROJW; qraw[i] = pr[h * 64 + k]; kraw[i] = pr[256 + h * 64 + k]; }
#pragma unroll
        for (int i = 0; i < 16; ++i) vv[i] = proj[(size_t)(tok0 + sg * 16 + i) * PROJW + 512 + h * 128 + v];
        float bl[8]; float run = 0.f;
#pragma unroll
        for (int i = 0; i < 8; ++i) { float z = bias;
#pragma unroll
            for (int j = 0; j < 4; ++j) z += (lrv[i][j].x * w[4 * j] + lrv[i][j].y * w[4 * j + 1]) + (lrv[i][j].z * w[4 * j + 2] + lrv[i][j].w * w[4 * j + 3]);
            run += logsig(z) * (1.f / 16.f); bl[i] = run; }
        SEG[seg * 64 + k] = run;
        {
            u32x4 p0, p1; p0.x = vv[0] | ((unsigned)vv[1] << 16); p0.y = vv[2] | ((unsigned)vv[3] << 16); p0.z = vv[4] | ((unsigned)vv[5] << 16); p0.w = vv[6] | ((unsigned)vv[7] << 16);
            p1.x = vv[8] | ((unsigned)vv[9] << 16); p1.y = vv[10] | ((unsigned)vv[11] << 16); p1.z = vv[12] | ((unsigned)vv[13] << 16); p1.w = vv[14] | ((unsigned)vv[15] << 16);
            *(LAS u32x4*)(VT + v * 72 + sg * 16) = p0; *(LAS u32x4*)(VT + v * 72 + sg * 16 + 8) = p1; }
        __syncthreads();
        float prefix = 0.f, total = 0.f;
#pragma unroll
        for (int s = 0; s < 8; ++s) { const float sv = SEG[s * 64 + k]; total += sv; if (s < seg) prefix += sv; }
        unsigned short kdh[8];
#pragma unroll
        for (int i = 0; i < 8; ++i) { const int t = seg * 8 + i; const float bb = bl[i] + prefix;
            const float qv = bf2f(qraw[i]), kv = bf2f(kraw[i]);
            const unsigned short qeb = (unsigned short)f2bf(qv * 0.125f * __expf(bb));
            QE[t * 72 + k] = qeb; KE[t * 72 + k] = (unsigned short)f2bf(kv * __expf(-bb)); qeg[(size_t)(tok0 + t) * 256 + h * 64 + k] = qeb;
            kdh[i] = (unsigned short)f2bf(kv * __expf(total - bb)); }
        u32x4 kp; kp.x = kdh[0] | ((unsigned)kdh[1] << 16); kp.y = kdh[2] | ((unsigned)kdh[3] << 16); kp.z = kdh[4] | ((unsigned)kdh[5] << 16); kp.w = kdh[6] | ((unsigned)kdh[7] << 16);
        *(LAS u32x4*)(KDT + k * 72 + seg * 8) = kp;
        if (seg == 0) decay[task * 64 + k] = __expf(total);
    }
    __syncthreads();
    if (wave < 4) {
        const int ti = wave >> 1, si = wave & 1; f32x16 acc = {};
        if (si <= ti) {
#pragma unroll
            for (int ks = 0; ks < 4; ++ks) acc = __builtin_amdgcn_mfma_f32_32x32x16_bf16(ldfrag(QE, ti * 32 + r32, ks, hi), ldfrag(KE, si * 32 + r32, ks, hi), acc, 0, 0, 0);
        }
#pragma unroll
        for (int r = 0; r < 16; ++r) { const int trow = ti * 32 + crow(r, hi), scol = si * 32 + r32; AT[trow * 72 + scol] = (unsigned short)f2bf(scol <= trow ? acc[r] : 0.f); }
    }
    __syncthreads();
    {
        const int ti = wave >> 2, vi = wave & 3; f32x16 o = {}, ds = {};
#pragma unroll
        for (int ks = 0; ks < 4; ++ks) { const bf16x8 vb = ldfrag(VT, vi * 32 + r32, ks, hi);
            o = __builtin_amdgcn_mfma_f32_32x32x16_bf16(ldfrag(AT, ti * 32 + r32, ks, hi), vb, o, 0, 0, 0);
            ds = __builtin_amdgcn_mfma_f32_32x32x16_bf16(ldfrag(KDT, ti * 32 + r32, ks, hi), vb, ds, 0, 0, 0); }
#pragma unroll
        for (int r = 0; r < 16; ++r) { const int row = ti * 32 + crow(r, hi);
            ointra[(size_t)(tok0 + row) * 512 + h * 128 + vi * 32 + r32] = o[r];
            dS[(size_t)task * 8192 + row * 128 + vi * 32 + r32] = ds[r]; }
    }
    __syncthreads();
}

__device__ __forceinline__ void fox_prep(const Args& a, int vcu, int G, int wave, int lane) {
    unsigned char* ws = a.ws; bf16* proj = (bf16*)(ws + WS_PROJ);
    const int gw = vcu * NWAVES + wave, NGW = G * NWAVES;
    const int c8 = (lane & 7) * 8;
    for (int it0 = gw; it0 < 2 * M; it0 += 4 * NGW) {
        u32x4 wv[4];
#pragma unroll
        for (int q = 0; q < 4; ++q) { const int it = it0 + q * NGW; wv[q] = *(const u32x4*)(proj + (size_t)(it >> 1) * PROJW + ((it & 1) ? 2048 : 1536) + lane * 8); }
#pragma unroll
        for (int q = 0; q < 4; ++q) { const int it = it0 + q * NGW; const int tok = it >> 1, which = it & 1;
            bf16* p = proj + (size_t)tok * PROJW + (which ? 2048 : 1536) + lane * 8;
            const u32x4 w = wv[q];
            float v[8] = {bflo(w.x), bfhi(w.x), bflo(w.y), bfhi(w.y), bflo(w.z), bfhi(w.z), bflo(w.w), bfhi(w.w)};
            float s = 0.f;
#pragma unroll
            for (int i = 0; i < 8; ++i) s += v[i] * v[i];
            s += __shfl_xor(s, 1); s += __shfl_xor(s, 2); s += __shfl_xor(s, 4);
            const float r = rsqrtf(s * (1.f / 64.f) + EPS) * (which ? 1.f : C2);
            const float* g = a.in[which ? 9 : 8] + c8; const f32x4 g0 = *(const f32x4*)g, g1 = *(const f32x4*)(g + 4);
            u32x4 o; o.x = pk2(v[0] * r * g0.x, v[1] * r * g0.y); o.y = pk2(v[2] * r * g0.z, v[3] * r * g0.w); o.z = pk2(v[4] * r * g1.x, v[5] * r * g1.y); o.w = pk2(v[6] * r * g1.z, v[7] * r * g1.w);
            *(u32x4*)p = o; }
    }
    if (wave == 0) {
        const float* lrf = (const float*)(ws + WS_LRF); float* cb = (float*)(ws + WS_SMALL) + 4 * M + 65536;
        for (int bh = vcu; bh < 64; bh += G) {
            const int b = bh >> 3, h = bh & 7; const float bf = a.in[7][h];
            float loc[32]; float run = 0.f;
#pragma unroll
            for (int i = 0; i < 32; ++i) { run += logsig(lrf[(size_t)(b * SEQ + lane * 32 + i) * 32 + 16 + h] + bf); loc[i] = run; }
            float inc = run;
#pragma unroll
            for (int o = 1; o < 64; o <<= 1) { const float t = __shfl_up(inc, o); if (lane >= o) inc += t; }
            const float pre = inc - run;
#pragma unroll
            for (int i = 0; i < 32; ++i) cb[(size_t)bh * SEQ + lane * 32 + i] = (pre + loc[i]) * LOG2E;
        }
    }
}

__device__ __forceinline__ void gla_scan(const Args& a, int vcu, int G, int tid) {
    const float* decay = (const float*)(a.ws + WS_SMALL) + 4 * M; const float* dS = a.out + (size_t)M * 512; float* sprev = (float*)(a.ws + WS_SPREV);
    for (int e = (vcu * NT + tid) * 2; e < 32 * 8192; e += G * NT * 2) {
        const int bh = e >> 13, kv = e & 8191, k = kv >> 7; f32x2 st = {0.f, 0.f};
#pragma unroll
        for (int n = 0; n < 32; ++n) { const int task = bh * 32 + n; const size_t idx = (size_t)task * 8192 + kv;
            *(f32x2*)(sprev + idx) = st; const float d = decay[task * 64 + k]; const f32x2 ds = *(const f32x2*)(dS + idx); st = st * d + ds; }
    }
}

__device__ __forceinline__ void gla_final(const Args& a, LAS unsigned char* lds, int task, int wave, int lane, int tid) {
    unsigned char* ws = a.ws;
    const bf16* proj = (const bf16*)(ws + WS_PROJ); const bf16* qeg = (const bf16*)(ws + WS_QE); const float* sprev = (const float*)(ws + WS_SPREV);
    const float* ointra = a.out; bf16* mix = (bf16*)(ws + WS_MIX);
    const int bh = task >> 5, n = task & 31, b = bh >> 2, h = bh & 3, tok0 = b * SEQ + n * 64;
    LAS bf16* QE = (LAS bf16*)lds; LAS bf16* ST = QE + 64 * 72; LAS float* OL = (LAS float*)(lds + 27648);
    const int r32 = lane & 31, hi = lane >> 5;
    const int ti = wave >> 2, vi = wave & 3, t2 = tid >> 3, j2 = tid & 7;
    const u32x4 qv = *(const u32x4*)(qeg + (size_t)(tok0 + (tid >> 3)) * 256 + h * 64 + (tid & 7) * 8);
    float f[16];
    { const int v = tid & 127, kg = tid >> 7;
#pragma unroll
        for (int i = 0; i < 16; ++i) f[i] = sprev[(size_t)task * 8192 + (kg * 16 + i) * 128 + v]; }
    float oi[16];
#pragma unroll
    for (int r = 0; r < 16; ++r) oi[r] = ointra[(size_t)(tok0 + ti * 32 + crow(r, hi)) * 512 + h * 128 + vi * 32 + r32];
    const bf16* ogp = proj + (size_t)(tok0 + t2) * PROJW + 1024 + h * 128 + j2 * 16; const u32x4 g0 = *(const u32x4*)ogp, g1 = *(const u32x4*)(ogp + 8);
    f32x4 gn[4];
#pragma unroll
    for (int i = 0; i < 4; ++i) gn[i] = *(const f32x4*)(a.in[6] + j2 * 16 + 4 * i);
    { const int t = tid >> 3, c = tid & 7; *(LAS u32x4*)(QE + t * 72 + c * 8) = qv; }
    { const int v = tid & 127, kg = tid >> 7;
        u32x4 p0, p1; p0.x = pk2(f[0], f[1]); p0.y = pk2(f[2], f[3]); p0.z = pk2(f[4], f[5]); p0.w = pk2(f[6], f[7]); p1.x = pk2(f[8], f[9]); p1.y = pk2(f[10], f[11]); p1.z = pk2(f[12], f[13]); p1.w = pk2(f[14], f[15]);
        *(LAS u32x4*)(ST + v * 72 + kg * 16) = p0; *(LAS u32x4*)(ST + v * 72 + kg * 16 + 8) = p1; }
    __syncthreads();
    { f32x16 acc = {};
#pragma unroll
        for (int ks = 0; ks < 4; ++ks) acc = __builtin_amdgcn_mfma_f32_32x32x16_bf16(ldfrag(QE, ti * 32 + r32, ks, hi), ldfrag(ST, vi * 32 + r32, ks, hi), acc, 0, 0, 0);
#pragma unroll
        for (int r = 0; r < 16; ++r) { const int row = ti * 32 + crow(r, hi), col = vi * 32 + r32; OL[row * 132 + col] = acc[r] + oi[r]; } }
    __syncthreads();
    { const int t = t2, j = j2; f32x4 o[4]; float s = 0.f;
#pragma unroll
        for (int i = 0; i < 4; ++i) { o[i] = *(const LAS f32x4*)(OL + t * 132 + j * 16 + 4 * i); s += (o[i].x * o[i].x + o[i].y * o[i].y) + (o[i].z * o[i].z + o[i].w * o[i].w); }
        s += __shfl_xor(s, 1); s += __shfl_xor(s, 2); s += __shfl_xor(s, 4);
        const float r = rsqrtf(s * (1.f / 128.f) + EPS);
        const float og[16] = {bflo(g0.x), bfhi(g0.x), bflo(g0.y), bfhi(g0.y), bflo(g0.z), bfhi(g0.z), bflo(g0.w), bfhi(g0.w), bflo(g1.x), bfhi(g1.x), bflo(g1.y), bfhi(g1.y), bflo(g1.z), bfhi(g1.z), bflo(g1.w), bfhi(g1.w)};
        float y[16];
#pragma unroll
        for (int i = 0; i < 4; ++i) {
#pragma unroll
            for (int c = 0; c < 4; ++c) { const float g = og[4 * i + c]; y[4 * i + c] = o[i][c] * r * gn[i][c] * (g / (1.f + __expf(-g))); } }
        u32x4 p0, p1; p0.x = pk2(y[0], y[1]); p0.y = pk2(y[2], y[3]); p0.z = pk2(y[4], y[5]); p0.w = pk2(y[6], y[7]); p1.x = pk2(y[8], y[9]); p1.y = pk2(y[10], y[11]); p1.z = pk2(y[12], y[13]); p1.w = pk2(y[14], y[15]);
        bf16* mp = mix + (size_t)(tok0 + t) * DM + h * 128 + j * 16; *(u32x4*)mp = p0; *(u32x4*)(mp + 8) = p1; }
    __syncthreads();
}

#define XB_TMO      128
#define XB_XCNT(j)  (256  + 64 * (j))
#define XB_XSUB(j)  (1280 + 64 * (j))
#define XB_XGEN(j)  (2304 + 64 * (j))
#define XB_TOP      3328
#define XB_TOPGEN   3392
#define XCD_BAR_WORDS 3456
#define XB_SPIN_CAP (1u << 18)

__device__ __forceinline__ unsigned xb_ld(unsigned* p)              { return __hip_atomic_load(p, __ATOMIC_RELAXED, __HIP_MEMORY_SCOPE_AGENT); }
__device__ __forceinline__ unsigned xb_add(unsigned* p, unsigned v) { return __hip_atomic_fetch_add(p, v, __ATOMIC_RELAXED, __HIP_MEMORY_SCOPE_AGENT); }
__device__ __forceinline__ unsigned xb_xcc_id() { return (unsigned)__builtin_amdgcn_s_getreg((3 << 11) | 20) & 0xFu; }
#define XB_SPIN(cond, bar) do { unsigned _sp = 0; while (cond) { __builtin_amdgcn_s_sleep(1); \
    if ((++_sp & 255u) == 0u) { if (xb_ld(&(bar)[XB_TMO])) break; if (_sp > XB_SPIN_CAP) { atomicAdd(&(bar)[XB_TMO], 1u); break; } } } } while (0)

struct XcdBarrier {
    unsigned* bar; unsigned x;
    volatile LAS unsigned* st;
};

__device__ __forceinline__ XcdBarrier xcd_barrier_post(unsigned* bar, volatile LAS unsigned* st, bool leader) {
    XcdBarrier b; b.bar = bar; b.x = xb_xcc_id(); b.st = st;
    if (leader) (void)xb_add(&bar[XB_XCNT(b.x)], 1u);
    return b;
}
__device__ __forceinline__ void xcd_barrier_complete(unsigned* bar, unsigned x, unsigned& nloc, unsigned& nx) {
    const unsigned G = gridDim.x * gridDim.y * gridDim.z;
    unsigned sum, cnt, mine, sp = 0u;
    for (;;) {
        sum = 0u; cnt = 0u; mine = 0u;
#pragma unroll
        for (unsigned j = 0; j < 16; ++j) { const unsigned c = xb_ld(&bar[XB_XCNT(j)]); sum += c; cnt += (c > 0u) ? 1u : 0u; mine = (j == x) ? c : mine; }
        if (sum == G) break;
        __builtin_amdgcn_s_sleep(1);
        if ((++sp & 255u) == 0u) { if (xb_ld(&bar[XB_TMO])) break; if (sp > XB_SPIN_CAP) { atomicAdd(&bar[XB_TMO], 1u); break; } }
    }
    nloc = mine > 0u ? mine : 1u; nx = cnt > 0u ? cnt : 1u;
}

__device__ __forceinline__ void xcd_barrier(const XcdBarrier& b, bool leader) {
    asm volatile("s_waitcnt vmcnt(0)" ::: "memory");
    __syncthreads();
    if (leader) {
        unsigned* bar = b.bar;
        __builtin_amdgcn_s_waitcnt(0);
        unsigned nloc = b.st[0], nx = b.st[1];
        if (nloc == 0u) { xcd_barrier_complete(bar, b.x, nloc, nx); b.st[0] = nloc; b.st[1] = nx; }
        const unsigned old = xb_add(&bar[XB_XSUB(b.x)], 1u);
        const unsigned gen = old / nloc;
        if (old + 1u == (gen + 1u) * nloc) {
            __builtin_amdgcn_fence(__ATOMIC_RELEASE, "agent");
            asm volatile("s_waitcnt vmcnt(0)" ::: "memory");
            const unsigned og = xb_add(&bar[XB_TOP], 1u);
            const unsigned tg = og / nx;
            if (og + 1u == (tg + 1u) * nx) xb_add(&bar[XB_TOPGEN], 1u);
            else XB_SPIN(xb_ld(&bar[XB_TOPGEN]) == tg, bar);
            __builtin_amdgcn_fence(__ATOMIC_ACQUIRE, "agent");
            xb_add(&bar[XB_XGEN(b.x)], 1u);
            asm volatile("s_waitcnt vmcnt(0)" ::: "memory");
        } else {
            XB_SPIN(xb_ld(&bar[XB_XGEN(b.x)]) == gen, bar);
            __builtin_amdgcn_fence(__ATOMIC_ACQUIRE, "agent");
            asm volatile("s_waitcnt vmcnt(0)" ::: "memory");
        }
    }
    __syncthreads();
}

#ifndef MK_SKIP
#define MK_SKIP 0
#endif
#define RUN(k) (!((MK_SKIP >> (k)) & 1))
#ifndef REP_SYNC
#define REP_SYNC 1
#endif
#ifndef REP_P0
#define REP_P0 1
#endif
#ifndef REP_P1
#define REP_P1 1
#endif
#ifndef REP_GL
#define REP_GL 1
#endif
#ifndef REP_SC
#define REP_SC 1
#endif
#ifndef REP_AT
#define REP_AT 1
#endif
#ifndef REP_GF
#define REP_GF 1
#endif
#ifndef REP_P6
#define REP_P6 1
#endif
#define GSYNC() do { for (int s_ = 0; s_ < REP_SYNC; ++s_) xcd_barrier(xbar, wave == 0 && lane_id() == 0); } while (0)
__global__ void __launch_bounds__(NT, 2) mk_fwd(Args a) {
    extern __shared__ __attribute__((aligned(16))) unsigned char lds_raw[];
    LAS unsigned char* lds = (LAS unsigned char*)lds_raw;
    const int wave = __builtin_amdgcn_readfirstlane(threadIdx.x >> 6);
#define lane (lane_id())
#define tid (wave * 64 + lane_id())
    const int G = gridDim.x, bx = blockIdx.x, vcu = (G % 8 == 0) ? (bx % 8) * (G / 8) + bx / 8 : bx;
    unsigned char* ws = a.ws;
    bf16* xb = (bf16*)(ws + WS_XB); float* small = (float*)(ws + WS_SMALL);
    float* ss2 = small + M; float* ss3 = small + 2 * M; float* ssE = small + 3 * M;
    volatile LAS unsigned* xst = (volatile LAS unsigned*)(lds + XCH_OFF + 8192);
    if (wave == 0 && lane_id() == 0) { xst[0] = 0u; xst[1] = 0u; }
    __syncthreads();
    const XcdBarrier xbar = xcd_barrier_post((unsigned*)ws, xst, wave == 0 && lane_id() == 0);

    for (int rep_ = 0; rep_ < REP_P0; ++rep_) if (RUN(0)) p0_prologue(a, lds, vcu, G, wave, lane, tid);
    GSYNC();
    for (int rep_ = 0; rep_ < REP_P1; ++rep_) if (RUN(1)) {   pg8::Gemm g{xb, (const bf16*)(ws + WS_WIN), M, PROJW, DM}; pg8::StaticOrder S; S.init(M / 256, PROJW / 256, G, bx);
        pg8::EpiScaleBf16 E{(bf16*)(ws + WS_PROJ), PROJW, small};
        pg8::gemm_phase<pg8::EpiScaleBf16, pg8::StaticOrder, true, true>(lds, g, S, E, wave);
        p1_skinny(a, lds, vcu, G, wave, lane, tid);
    }
    GSYNC();
    for (int rep_ = 0; rep_ < REP_GL; ++rep_) if (RUN(2)) for (int task = vcu; task < 1024; task += G) gla_local(a, lds, task, wave, lane, tid);
    if (RUN(9)) fox_prep(a, vcu, G, wave, lane);
    GSYNC();
    for (int rep_ = 0; rep_ < REP_SC; ++rep_) if (RUN(10)) gla_scan(a, vcu, G, tid);
    for (int rep_ = 0; rep_ < REP_AT; ++rep_) if (RUN(3)) {   const attn_body::bf16* pj = (const attn_body::bf16*)(ws + WS_PROJ);
        const attn_body::AttnTensors AT{pj + 1536, pj + 2048, pj + 2560, (attn_body::bf16*)(ws + WS_MIX) + 512, small + 4 * M + 65536};
        const attn_body::StaticOrder S(G, vcu);
        attn_body::attn_phase<attn_body::StaticOrder>((char*)lds_raw, AT, S);
    }
    GSYNC();
    for (int rep_ = 0; rep_ < REP_GF; ++rep_) if (RUN(4)) for (int task = vcu; task < 1024; task += G) gla_final(a, lds, task, wave, lane, tid);
    GSYNC();
    if (RUN(5)) {   pg8::Gemm g{(const bf16*)(ws + WS_MIX), (const bf16*)(ws + WS_WO), M, DM, DM}; pg8::StaticOrder S; S.init(M / 256, DM / 256, G, bx);
        pg8::EpiRes E{a.in[0], a.out, xb, ss2, DM};
        pg8::gemm_phase<pg8::EpiRes, pg8::StaticOrder, true, true>(lds, g, S, E, wave);
    }
    GSYNC();
    for (int rep_ = 0; rep_ < REP_P6; ++rep_) if (RUN(6)) {   pg8::Gemm g{xb, (const bf16*)(ws + WS_WUP), M, 2 * FF, DM}; pg8::StaticOrder S; S.init(65, 2 * FF / 256, G, bx, 254, -2);
        pg8::EpiUp E{(bf16*)(ws + WS_ACT), ss2, a.in[13], a.in[14], (LAS float*)(lds + XCH_OFF)};
        pg8::gemm_phase<pg8::EpiUp, pg8::StaticOrder, true, true>(lds, g, S, E, wave);
    }
    GSYNC();
    if (RUN(7)) {   pg8::Gemm g{(const bf16*)(ws + WS_ACT), (const bf16*)(ws + WS_WD), M, DM, FF}; pg8::StaticOrder S; S.init(M / 256, DM / 256, G, bx);
        pg8::EpiRes E{a.out, a.out, xb, ss3, DM};
        pg8::gemm_phase<pg8::EpiRes, pg8::StaticOrder, true, true>(lds, g, S, E, wave);
        pg8::Gemm g2{(const bf16*)(ws + WS_PB), (const bf16*)(ws + WS_WPE), M, DM, PLE};
        pg8::EpiRes E2{nullptr, nullptr, (bf16*)(ws + WS_E), ssE, DM};
        pg8::gemm_phase<pg8::EpiRes, pg8::StaticOrder, true, true>(lds, g2, S, E2, wave);
    }
    GSYNC();
    if (RUN(8)) {   pg8::Gemm g{xb, (const bf16*)(ws + WS_WPG), M, DM, DM}; pg8::StaticOrder S; S.init(M / 256, DM / 256, G, bx);
        pg8::EpiGate E{a.out, a.out, (const bf16*)(ws + WS_E), ss3, ssE, a.in[20], a.in[18], DM};
        pg8::gemm_phase<pg8::EpiGate, pg8::StaticOrder, true, true>(lds, g, S, E, wave);
    }
#undef lane
#undef tid
}
}

extern "C" void kernel_launch(void* const* d_in, const int* in_sizes, int n_in, void* d_out, int out_size, void* d_ws, size_t ws_size, hipStream_t stream) {
    static int grid = 0;
    if (grid == 0) {
        int dev = 0, cus = 0, per_cu = 0;
        hipGetDevice(&dev); hipDeviceGetAttribute(&cus, hipDeviceAttributeMultiprocessorCount, dev);
        hipFuncSetAttribute((const void*)mk::mk_fwd, hipFuncAttributeMaxDynamicSharedMemorySize, mk::LDS_BYTES);
        hipOccupancyMaxActiveBlocksPerMultiprocessor(&per_cu, (const void*)mk::mk_fwd, mk::NT, mk::LDS_BYTES);
        if (per_cu < 1) { fprintf(stderr, "kernel_launch: occupancy query says %d blocks per CU\n", per_cu); per_cu = 1; }
        grid = cus * per_cu;
        if (n_in != 21 || ws_size < mk::WS_END) { fprintf(stderr, "kernel_launch: unexpected n_in %d / ws %zu\n", n_in, ws_size); grid = -1; }
    }
    if (grid < 0) return;
    if (hipMemsetAsync(d_ws, 0, 65536, stream) != hipSuccess) { fprintf(stderr, "kernel_launch: memset of the barrier words failed\n"); return; }
    mk::Args a{};
    for (int i = 0; i < 21; ++i) a.in[i] = (const float*)d_in[i];
    a.out = (float*)d_out; a.ws = (unsigned char*)d_ws;
    void* args[] = {&a};
    hipError_t e = hipLaunchCooperativeKernel((const void*)mk::mk_fwd, dim3(grid), dim3(mk::NT), args, mk::LDS_BYTES, stream);
    if (e != hipSuccess) fprintf(stderr, "cooperative launch failed: %s (grid %d)\n", hipGetErrorString(e), grid);
}
```

```cpp
#include <hip/hip_runtime.h>
#include <cstdio>
#include <cstdint>
__device__ __forceinline__ int lane_id() { int l; asm volatile("v_mbcnt_lo_u32_b32 %0, -1, 0\n\tv_mbcnt_hi_u32_b32 %0, -1, %0" : "=v"(l)); return l; }
namespace pg8 {
#define PG8_LAS __attribute__((address_space(3)))
typedef unsigned short bf16_t;
typedef short bf16x8 __attribute__((ext_vector_type(8)));
typedef float f32x4 __attribute__((ext_vector_type(4)));
typedef unsigned u32x4 __attribute__((ext_vector_type(4)));
constexpr int BM = 256, BK = 64, HALF = 128, HTB = HALF * BK * 2  , STAGE_BYTES = 8 * HTB, NXCD = 8, WGM = 8;

__host__ __device__ __forceinline__ int lds_byte(int r, int c) { const int st = (r >> 4) * 2 + (c >> 5), rr = r & 15, cc = c & 31, ob = rr * 64 + cc * 2; return st * 1024 + (ob ^ (((ob >> 9) & 1) << 5)); }
__host__ __device__ __forceinline__ void stage_rc(int b, int& R, int& C) { const int st = b / 1024, sb = b % 1024, swz = sb ^ (((sb >> 9) & 1) << 5); R = (st >> 1) * 16 + swz / 64; C = (st & 1) * 32 + (swz % 64) / 2; }
__host__ __device__ __forceinline__ int perm32(int rho) { const int n = rho >> 4, i = rho & 15; return 8 * (i >> 2) + 4 * n + (i & 3); }

struct Unit { int pm, pn, arow, idx; };
struct Gemm { const bf16_t* A; const bf16_t* Bt; int M, N, K; };

struct StaticOrder {
    int nM, nN, nwg, G, c, mstride, moff;
    __host__ __device__ void init(int nM_, int nN_, int G_, int c_, int mstride_ = 256, int moff_ = 0) { nM = nM_; nN = nN_; nwg = nM * nN; G = G_; c = c_; mstride = mstride_; moff = moff_; }
    __host__ __device__ bool next(int i, Unit& u) const {
        const long L = (long)i * G + c; if (L >= nwg) return false;
        int wgid = (int)L; { const int q = nwg / NXCD, r = nwg % NXCD, xcd = wgid % NXCD, off = wgid / NXCD; wgid = (xcd < r ? xcd * (q + 1) : r * (q + 1) + (xcd - r) * q) + off; }
        const int nig = WGM * nN, gid = wgid / nig, fm = gid * WGM, gsz = (nM - fm) < WGM ? (nM - fm) : WGM;
        u.pm = fm + ((wgid % nig) % gsz); u.pn = (wgid % nig) / gsz; u.arow = u.pm * mstride + moff; u.idx = i; return true;
    }
    __device__ __forceinline__ void a_ready(const Unit&) const {}
    __device__ __forceinline__ void done(const Unit&) const {}
};

__device__ __forceinline__ unsigned cvt_pk_bf16(float lo, float hi) { unsigned r; asm volatile("v_cvt_pk_bf16_f32 %0, %1, %2" : "=v"(r) : "v"(lo), "v"(hi)); return r; }
typedef float f32x2 __attribute__((ext_vector_type(2)));
typedef float f32x2 __attribute__((ext_vector_type(2)));
template <class Epi, class Sched, bool ALIGN_EPI = false, bool SP2 = false>
__device__ __forceinline__ void gemm_phase(PG8_LAS unsigned char* lds, const Gemm g, const Sched& S, const Epi& E, int wave_sgpr) {
    const int wid = wave_sgpr, lane = lane_id(), tid = wid * 64 + lane, wr = wid >> 2, wc = wid & 3, fr = lane & 15, fq = lane >> 4;
    const int K = g.K, nt = K / BK;
    unsigned voffA[2], voffB[2];
#pragma unroll
    for (int i = 0; i < 2; ++i) { int R, C; stage_rc(tid * 16 + i * 8192, R, C); const int Rb = Epi::PERM ? ((R & ~31) + perm32(R & 31)) : R;
        voffA[i] = (unsigned)(R * K + C) * 2u; voffB[i] = (unsigned)(Rb * K + C) * 2u; }
    const size_t kstep = (size_t)(BK * 2);
    const size_t hstep = (size_t)HALF * K * 2;
    const size_t tstep = 2 * hstep;
    const unsigned ldsw = (unsigned)wid * 1024u;
    const int aoff = lds_byte(wr * 64 + fr, fq * 8), boff = lds_byte(wc * 32 + fr, fq * 8);
#define PG8_SA(b, h) (((b) * 2 + (h)) * HTB)
#define PG8_SB(b, h) ((4 + (b) * 2 + (h)) * HTB)
#define PG8_STAGE(bufoff, gbase, voff) do { _Pragma("unroll") for (int _i = 0; _i < 2; ++_i) \
        __builtin_amdgcn_global_load_lds((const unsigned*)((const char*)(gbase) + (voff)[_i]), (PG8_LAS unsigned*)(lds + (bufoff) + ldsw + _i * 8192), 16, 0, 0); } while (0)
#define PG8_LDA(dst, b, h) do { _Pragma("unroll") for (int m = 0; m < 4; ++m) _Pragma("unroll") for (int k = 0; k < 2; ++k) dst[m][k] = *(const PG8_LAS bf16x8*)(lds + PG8_SA(b, h) + aoff + m * 2048 + k * 1024); } while (0)
#define PG8_LDB(dst, b, h) do { _Pragma("unroll") for (int n = 0; n < 2; ++n) _Pragma("unroll") for (int k = 0; k < 2; ++k) dst[n][k] = *(const PG8_LAS bf16x8*)(lds + PG8_SB(b, h) + boff + n * 2048 + k * 1024); } while (0)
#define PG8_MMA(ai, bj, At, Bt) do { __builtin_amdgcn_s_setprio(1); _Pragma("unroll") for (int m = 0; m < 4; ++m) _Pragma("unroll") for (int n = 0; n < 2; ++n) _Pragma("unroll") for (int k = 0; k < 2; ++k) \
        acc[ai][bj][m][n] = __builtin_amdgcn_mfma_f32_16x16x32_bf16(Bt[n][k], At[m][k], acc[ai][bj][m][n], 0, 0, 0); __builtin_amdgcn_s_setprio(0); } while (0)
#define PG8_WAIT_V(n) asm volatile("s_waitcnt vmcnt(" #n ")" ::: "memory")
#define PG8_WAIT_L(n) asm volatile("s_waitcnt lgkmcnt(" #n ")" ::: "memory")
#define PG8_BAR __builtin_amdgcn_s_barrier()
#define PG8_SCHED __builtin_amdgcn_sched_barrier(0)
    Unit cur, nxt; int ui = 0;
    if (!S.next(0, cur)) return;
    f32x4 acc[2][2][4][2];
#pragma unroll
    for (int a = 0; a < 2; ++a)
#pragma unroll
        for (int b = 0; b < 2; ++b)
#pragma unroll
            for (int m = 0; m < 4; ++m)
#pragma unroll
                for (int n = 0; n < 2; ++n) acc[a][b][m][n] = (f32x4){0.f, 0.f, 0.f, 0.f};
    bf16x8 At[4][2], B0[2][2], B1[2][2];
    const char* cA = (const char*)g.A + (long)cur.arow * (long)(K * 2); const char* cB = (const char*)g.Bt + (size_t)cur.pn * tstep;
    S.a_ready(cur);
    if constexpr (SP2) {
        PG8_STAGE(PG8_SB(0, 0), cB, voffB); PG8_STAGE(PG8_SB(0, 1), cB + hstep, voffB); PG8_STAGE(PG8_SA(0, 0), cA, voffA); PG8_STAGE(PG8_SA(0, 1), cA + hstep, voffA);
        if (wr == 1) PG8_BAR;
        PG8_WAIT_V(2); PG8_BAR;
        PG8_STAGE(PG8_SB(1, 0), cB + kstep, voffB); PG8_STAGE(PG8_SA(1, 0), cA + kstep, voffA); PG8_STAGE(PG8_SB(1, 1), cB + hstep + kstep, voffB);
        PG8_WAIT_V(6); PG8_BAR;
    } else {
        PG8_STAGE(PG8_SB(0, 0), cB, voffB); PG8_STAGE(PG8_SA(0, 0), cA, voffA); PG8_STAGE(PG8_SB(0, 1), cB + hstep, voffB); PG8_STAGE(PG8_SA(0, 1), cA + hstep, voffA);
        if (wr == 1) PG8_BAR;
        PG8_WAIT_V(4); PG8_BAR;
        PG8_STAGE(PG8_SB(1, 0), cB + kstep, voffB); PG8_STAGE(PG8_SA(1, 0), cA + kstep, voffA); PG8_STAGE(PG8_SB(1, 1), cB + hstep + kstep, voffB);
        PG8_WAIT_V(6); PG8_BAR;
    }
    for (;;) {
        const bool has_next = S.next(ui + 1, nxt);
        const char* nA = has_next ? (const char*)g.A + (long)nxt.arow * (long)(K * 2) : cA; const char* nB = has_next ? (const char*)g.Bt + (size_t)nxt.pn * tstep : cB;
        for (int t = 0; t < nt; t += 2) {
            const bool last = (t == nt - 2);
            const char* a1 = cA + (size_t)(t + 1) * kstep;
            const char* a2 = last ? nA : cA + (size_t)(t + 2) * kstep; const char* b2 = last ? nB : cB + (size_t)(t + 2) * kstep;
            const char* a3 = a2 + kstep; const char* b3 = b2 + kstep;
            if (last && has_next) S.a_ready(nxt);
            if constexpr (SP2) {
            PG8_LDB(B0, 0, 0); PG8_LDB(B1, 0, 1); PG8_SCHED; PG8_LDA(At, 0, 0); PG8_STAGE(PG8_SA(1, 1), a1 + hstep, voffA);
            PG8_WAIT_V(8); PG8_WAIT_L(0); PG8_BAR; PG8_MMA(0, 0, At, B0); PG8_MMA(0, 1, At, B1); PG8_BAR; PG8_SCHED;
            PG8_LDA(At, 0, 1); PG8_STAGE(PG8_SB(0, 0), b2, voffB); PG8_STAGE(PG8_SB(0, 1), b2 + hstep, voffB); PG8_STAGE(PG8_SA(0, 0), a2, voffA);
            PG8_WAIT_V(8); PG8_WAIT_L(0); PG8_BAR; PG8_MMA(1, 0, At, B0); PG8_MMA(1, 1, At, B1); PG8_BAR; PG8_SCHED;
            PG8_LDB(B0, 1, 0); PG8_LDB(B1, 1, 1); PG8_SCHED; PG8_LDA(At, 1, 0); PG8_STAGE(PG8_SA(0, 1), a2 + hstep, voffA);
            PG8_WAIT_V(8); PG8_WAIT_L(0); PG8_BAR; PG8_MMA(0, 0, At, B0); PG8_MMA(0, 1, At, B1); PG8_BAR; PG8_SCHED;
            PG8_LDA(At, 1, 1); PG8_STAGE(PG8_SB(1, 0), b3, voffB); PG8_STAGE(PG8_SB(1, 1), b3 + hstep, voffB); PG8_STAGE(PG8_SA(1, 0), a3, voffA);
            PG8_WAIT_V(8); PG8_WAIT_L(0); PG8_BAR; PG8_MMA(1, 0, At, B0); PG8_MMA(1, 1, At, B1); PG8_BAR; PG8_SCHED;
            } else {
            PG8_LDB(B0, 0, 0); PG8_SCHED; PG8_LDA(At, 0, 0); PG8_STAGE(PG8_SA(1, 1), a1 + hstep, voffA);
            PG8_WAIT_L(8); PG8_BAR; PG8_WAIT_L(0); PG8_MMA(0, 0, At, B0); PG8_BAR; PG8_SCHED;
            PG8_LDB(B1, 0, 1); PG8_STAGE(PG8_SB(0, 0), b2, voffB);
            PG8_BAR; PG8_WAIT_L(0); PG8_MMA(0, 1, At, B1); PG8_BAR;
            PG8_LDA(At, 0, 1); PG8_STAGE(PG8_SA(0, 0), a2, voffA);
            PG8_BAR; PG8_WAIT_L(0); PG8_MMA(1, 0, At, B0); PG8_BAR; PG8_SCHED;
            PG8_STAGE(PG8_SB(0, 1), b2 + hstep, voffB);
            PG8_WAIT_V(6); PG8_BAR; PG8_MMA(1, 1, At, B1); PG8_BAR;
            PG8_LDB(B0, 1, 0); PG8_SCHED; PG8_LDA(At, 1, 0); PG8_STAGE(PG8_SA(0, 1), a2 + hstep, voffA);
            PG8_WAIT_L(8); PG8_BAR; PG8_WAIT_L(0); PG8_MMA(0, 0, At, B0); PG8_BAR; PG8_SCHED;
            PG8_LDB(B1, 1, 1); PG8_STAGE(PG8_SB(1, 0), b3, voffB);
            PG8_BAR; PG8_WAIT_L(0); PG8_MMA(0, 1, At, B1); PG8_BAR;
            PG8_LDA(At, 1, 1); PG8_STAGE(PG8_SA(1, 0), a3, voffA);
            PG8_BAR; PG8_WAIT_L(0); PG8_MMA(1, 0, At, B0); PG8_BAR; PG8_SCHED;
            PG8_STAGE(PG8_SB(1, 1), b3 + hstep, voffB);
            PG8_WAIT_V(6); PG8_BAR; PG8_MMA(1, 1, At, B1); PG8_BAR;
            }
        }
        if constexpr (ALIGN_EPI) { if (wr == 0) PG8_BAR; }
        if constexpr (!Epi::AFTER_DRAIN) { E(acc, cur, wr, wc, fr, fq); S.done(cur); }
        if (!has_next) break;
#pragma unroll
        for (int a = 0; a < 2; ++a)
#pragma unroll
            for (int b = 0; b < 2; ++b)
#pragma unroll
                for (int m = 0; m < 4; ++m)
#pragma unroll
                    for (int n = 0; n < 2; ++n) acc[a][b][m][n] = (f32x4){0.f, 0.f, 0.f, 0.f};
        cur = nxt; cA = nA; cB = nB; ++ui;
        if constexpr (ALIGN_EPI) { if (wr == 1) PG8_BAR; }
    }
    PG8_WAIT_V(0);
    if constexpr (!ALIGN_EPI) { if (wr == 0) PG8_BAR; }
    PG8_BAR;
    if constexpr (Epi::AFTER_DRAIN) { E.fused(acc, cur, wr, wc, fr, fq, lds, wid, lane); S.done(cur); }
#undef PG8_SA
#undef PG8_SB
#undef PG8_STAGE
#undef PG8_LDA
#undef PG8_LDB
#undef PG8_MMA
#undef PG8_WAIT_V
#undef PG8_WAIT_L
#undef PG8_BAR
#undef PG8_SCHED
}
}
namespace pg8 {
constexpr float RMS_EPS = 1e-6f;
typedef unsigned u32x2 __attribute__((ext_vector_type(2)));
template <int CTRL> __device__ __forceinline__ float dpp_mov(float old, float src) {
    return __builtin_bit_cast(float, __builtin_amdgcn_update_dpp(__builtin_bit_cast(int, old), __builtin_bit_cast(int, src), CTRL, 0xf, 0xf, false)); }
__device__ __forceinline__ float bf_lo(unsigned w) { return __builtin_bit_cast(float, w << 16); }
__device__ __forceinline__ float bf_hi(unsigned w) { return __builtin_bit_cast(float, w & 0xffff0000u); }

struct EpiScaleBf16 {
    static constexpr bool PERM = true, AFTER_DRAIN = false;
    bf16_t* O; int ldc; const float* rs;
    __device__ __forceinline__ void operator()(const f32x4 (&acc)[2][2][4][2], const Unit& u, int wr, int wc, int fr, int fq) const {
        const int row0 = u.pm * BM + wr * 64 + fr, col0 = u.pn * BM + wc * 32 + 8 * fq;
        float sc[2][4];
#pragma unroll
        for (int ai = 0; ai < 2; ++ai)
#pragma unroll
            for (int m = 0; m < 4; ++m) sc[ai][m] = rs[row0 + ai * HALF + m * 16];
#pragma unroll
        for (int ai = 0; ai < 2; ++ai)
#pragma unroll
            for (int m = 0; m < 4; ++m) { const int r = row0 + ai * HALF + m * 16; const float s = sc[ai][m]; bf16_t* rowp = O + (size_t)r * ldc + col0;
#pragma unroll
                for (int bj = 0; bj < 2; ++bj) { const f32x4 v0 = acc[ai][bj][m][0] * s, v1 = acc[ai][bj][m][1] * s;
                    u32x4 w; w.x = cvt_pk_bf16(v0[0], v0[1]); w.y = cvt_pk_bf16(v0[2], v0[3]); w.z = cvt_pk_bf16(v1[0], v1[1]); w.w = cvt_pk_bf16(v1[2], v1[3]);
                    *(u32x4*)(rowp + bj * HALF) = w; } }
    }
};
struct EpiProj {
    static constexpr bool PERM = true, AFTER_DRAIN = false;
    bf16_t* O; int ldc; const float* rs; const float* gq; const float* gk; PG8_LAS float* part;
    __device__ __forceinline__ void operator()(f32x4 (&acc)[2][2][4][2], const Unit& u, int wr, int wc, int fr, int fq) const {
        const int row0 = u.pm * BM + wr * 64 + fr, col0 = u.pn * BM + wc * 32 + 8 * fq;
        float sc[2][4];
#pragma unroll
        for (int ai = 0; ai < 2; ++ai)
#pragma unroll
            for (int m = 0; m < 4; ++m) sc[ai][m] = rs[row0 + ai * HALF + m * 16];
        const bool fox = (u.pn >= 6 && u.pn < 10);
        if (!fox) {
#pragma unroll
            for (int ai = 0; ai < 2; ++ai)
#pragma unroll
                for (int m = 0; m < 4; ++m) { const int r = row0 + ai * HALF + m * 16; const float s = sc[ai][m]; bf16_t* rowp = O + (size_t)r * ldc + col0;
#pragma unroll
                    for (int bj = 0; bj < 2; ++bj) { const f32x4 v0 = acc[ai][bj][m][0] * s, v1 = acc[ai][bj][m][1] * s;
                        u32x4 w; w.x = cvt_pk_bf16(v0[0], v0[1]); w.y = cvt_pk_bf16(v0[2], v0[3]); w.z = cvt_pk_bf16(v1[0], v1[1]); w.w = cvt_pk_bf16(v1[2], v1[3]);
                        *(u32x4*)(rowp + bj * HALF) = w; } }
        } else {
#pragma unroll
            for (int ai = 0; ai < 2; ++ai)
#pragma unroll
                for (int m = 0; m < 4; ++m) { const float s = sc[ai][m]; const int rl = ai * HALF + wr * 64 + m * 16 + fr;
#pragma unroll
                    for (int bj = 0; bj < 2; ++bj) { acc[ai][bj][m][0] *= s; acc[ai][bj][m][1] *= s; const f32x4 v0 = acc[ai][bj][m][0], v1 = acc[ai][bj][m][1];
                        float q = (v0[0] * v0[0] + v0[1] * v0[1]) + (v0[2] * v0[2] + v0[3] * v0[3]) + (v1[0] * v1[0] + v1[1] * v1[1]) + (v1[2] * v1[2] + v1[3] * v1[3]);
                        q += __shfl_xor(q, 16); q += __shfl_xor(q, 32);
                        if (fq == 0) part[(wc * 2 + bj) * 256 + rl] = q; } }
            const float* gp = (u.pn < 8 ? gq : gk) + 32 * (wc & 1) + 8 * fq; const f32x4 g0 = *(const f32x4*)gp, g1 = *(const f32x4*)(gp + 4);
            asm volatile("s_waitcnt lgkmcnt(0)\n\ts_barrier" ::: "memory");
            const float mul = u.pn < 8 ? 0.125f * 1.4426950408889634f : 1.f;
#pragma unroll
            for (int ai = 0; ai < 2; ++ai)
#pragma unroll
                for (int m = 0; m < 4; ++m) { const int rl = ai * HALF + wr * 64 + m * 16 + fr; bf16_t* rowp = O + (size_t)(u.pm * BM + rl) * ldc + col0;
#pragma unroll
                    for (int bj = 0; bj < 2; ++bj) { const float tot = part[(wc * 2 + bj) * 256 + rl] + part[((wc ^ 1) * 2 + bj) * 256 + rl];
                        const float r = rsqrtf(tot * (1.f / 64.f) + RMS_EPS) * mul; const f32x4 v0 = acc[ai][bj][m][0] * r * g0, v1 = acc[ai][bj][m][1] * r * g1;
                        u32x4 w; w.x = cvt_pk_bf16(v0[0], v0[1]); w.y = cvt_pk_bf16(v0[2], v0[3]); w.z = cvt_pk_bf16(v1[0], v1[1]); w.w = cvt_pk_bf16(v1[2], v1[3]);
                        *(u32x4*)(rowp + bj * HALF) = w; } }
        }
    }
};
template <int BASE> struct EpiRes {
    static constexpr bool PERM = true, AFTER_DRAIN = false;
    const float* basef; const bf16_t* baseb; bf16_t* outb; float* ss; int ldc;
    __device__ __forceinline__ void operator()(const f32x4 (&acc)[2][2][4][2], const Unit& u, int wr, int wc, int fr, int fq) const {
        const int row0 = u.pm * BM + wr * 64 + fr, col0 = u.pn * BM + wc * 32 + 8 * fq;
        u32x4 preb[2][4][2];
        if (BASE == 2) {
#pragma unroll
            for (int ai = 0; ai < 2; ++ai)
#pragma unroll
                for (int m = 0; m < 4; ++m)
#pragma unroll
                    for (int bj = 0; bj < 2; ++bj) preb[ai][m][bj] = *(const u32x4*)(baseb + (size_t)(row0 + ai * HALF + m * 16) * ldc + col0 + bj * HALF);
            asm volatile("" ::: "memory");
        }
#pragma unroll
        for (int ai = 0; ai < 2; ++ai)
#pragma unroll
          for (int mp = 0; mp < 2; ++mp) {
            f32x4 pre[2][2][2];
            if (BASE == 1) {
#pragma unroll
                for (int mm = 0; mm < 2; ++mm)
#pragma unroll
                    for (int bj = 0; bj < 2; ++bj) { const size_t off = (size_t)(row0 + ai * HALF + (2 * mp + mm) * 16) * ldc + col0 + bj * HALF;
                        pre[mm][bj][0] = *(const f32x4*)(basef + off); pre[mm][bj][1] = *(const f32x4*)(basef + off + 4); }
                asm volatile("" ::: "memory");
            }
#pragma unroll
            for (int mm = 0; mm < 2; ++mm) { const int m = 2 * mp + mm; const int r = row0 + ai * HALF + m * 16; float q = 0.f;
#pragma unroll
                for (int bj = 0; bj < 2; ++bj) { const size_t off = (size_t)r * ldc + col0 + bj * HALF;
                    f32x4 v0 = acc[ai][bj][m][0], v1 = acc[ai][bj][m][1];
                    if (BASE == 1) { v0 += pre[mm][bj][0]; v1 += pre[mm][bj][1]; }
                    if (BASE == 2) { const u32x4 b = preb[ai][m][bj]; v0 += (f32x4){bf_lo(b.x), bf_hi(b.x), bf_lo(b.y), bf_hi(b.y)}; v1 += (f32x4){bf_lo(b.z), bf_hi(b.z), bf_lo(b.w), bf_hi(b.w)}; }
                    u32x4 w; w.x = cvt_pk_bf16(v0[0], v0[1]); w.y = cvt_pk_bf16(v0[2], v0[3]); w.z = cvt_pk_bf16(v1[0], v1[1]); w.w = cvt_pk_bf16(v1[2], v1[3]);
                    *(u32x4*)(outb + off) = w;
                    q += (v0[0] * v0[0] + v0[1] * v0[1]) + (v0[2] * v0[2] + v0[3] * v0[3]) + (v1[0] * v1[0] + v1[1] * v1[1]) + (v1[2] * v1[2] + v1[3] * v1[3]); }
                q += __shfl_xor(q, 16); q += __shfl_xor(q, 32);
                if (fq == 0) atomicAdd(ss + r, q); }
          }
    }
};
struct EpiGate {
    static constexpr bool PERM = true, AFTER_DRAIN = false;
    const bf16_t* x2; float* out; const bf16_t* E; const float* ss3; const float* ssE; const float* bpg; const float* peg; int ldc;
    __device__ __forceinline__ void operator()(const f32x4 (&acc)[2][2][4][2], const Unit& u, int wr, int wc, int fr, int fq) const {
        const int row0 = u.pm * BM + wr * 64 + fr, col0 = u.pn * BM + wc * 32 + 8 * fq;
        f32x4 bp[2][2], pg[2][2];
#pragma unroll
        for (int bj = 0; bj < 2; ++bj)
#pragma unroll
            for (int n = 0; n < 2; ++n) { bp[bj][n] = *(const f32x4*)(bpg + col0 + bj * HALF + 4 * n); pg[bj][n] = *(const f32x4*)(peg + col0 + bj * HALF + 4 * n); }
#pragma unroll
        for (int ai = 0; ai < 2; ++ai)
#pragma unroll
            for (int mp = 0; mp < 2; ++mp) {
                u32x4 xw[2][2]; u32x4 ew[2][2];
                float s3[2], sE[2];
#pragma unroll
                for (int mm = 0; mm < 2; ++mm) { const int r = row0 + ai * HALF + (2 * mp + mm) * 16; s3[mm] = ss3[r]; sE[mm] = ssE[r]; }
#pragma unroll
                for (int mm = 0; mm < 2; ++mm)
#pragma unroll
                    for (int bj = 0; bj < 2; ++bj) { const size_t off = (size_t)(row0 + ai * HALF + (2 * mp + mm) * 16) * ldc + col0 + bj * HALF;
                        xw[mm][bj] = *(const u32x4*)(x2 + off); ew[mm][bj] = *(const u32x4*)(E + off); }
                asm volatile("" ::: "memory");
#pragma unroll
                for (int mm = 0; mm < 2; ++mm) { const int m = 2 * mp + mm; const int r = row0 + ai * HALF + m * 16;
                    const float r3 = rsqrtf(s3[mm] * (1.f / 1024.f) + RMS_EPS), rE = rsqrtf(sE[mm] * (1.f / 1024.f) + RMS_EPS);
#pragma unroll
                    for (int bj = 0; bj < 2; ++bj) { const size_t off = (size_t)r * ldc + col0 + bj * HALF; const u32x4 w = ew[mm][bj];
                        const float ev[8] = {bf_lo(w.x), bf_hi(w.x), bf_lo(w.y), bf_hi(w.y), bf_lo(w.z), bf_hi(w.z), bf_lo(w.w), bf_hi(w.w)};
                        const u32x4 xq = xw[mm][bj]; const float xv8[8] = {bf_lo(xq.x), bf_hi(xq.x), bf_lo(xq.y), bf_hi(xq.y), bf_lo(xq.z), bf_hi(xq.z), bf_lo(xq.w), bf_hi(xq.w)};
#pragma unroll
                        for (int n = 0; n < 2; ++n) { f32x4 o;
#pragma unroll
                            for (int i = 0; i < 4; ++i) { const float z = acc[ai][bj][m][n][i] * r3 + bp[bj][n][i]; const float g = __builtin_amdgcn_rcpf(1.f + __expf(-z));
                                o[i] = xv8[4 * n + i] + g * (ev[4 * n + i] * rE * pg[bj][n][i]); }
                            *(f32x4*)(out + off + 4 * n) = o; } } }
                asm volatile("" ::: "memory");
            }
    }
};
struct EpiUp {
    static constexpr bool PERM = true, AFTER_DRAIN = false;
    bf16_t* act; const float* ss2; const float* cw; const float* cb; PG8_LAS float* xch; PG8_LAS float* taps; PG8_LAS float* rsl;
    __device__ __forceinline__ void operator()(f32x4 (&acc)[2][2][4][2], const Unit& u, int wr, int wc, int fr, int fq) const {
        constexpr int FF = 2816, MROWS = 16384;
        const int tid_ = (wr * 4 + wc) * 64 + fq * 16 + fr; f32x4 tapv;
        if (tid_ < 256) { const int r = tid_ >> 5, c4 = tid_ & 31, kind = r & 3, half = r >> 2;
            tapv = *(const f32x4*)((kind < 3 ? cw + kind * 2 * FF : cb) + half * FF + u.pn * HALF + 4 * c4); }
#pragma unroll
        for (int ai = 0; ai < 2; ++ai)
#pragma unroll
            for (int m = 0; m < 4; ++m) { const int rt_ = ai * HALF + wr * 64 + m * 16 + fr, gr = u.arow + rt_;
                float s;
                if (u.idx < 6) s = rsl[u.idx * 256 + rt_];
                else s = (gr >= 0 && gr < MROWS) ? rsqrtf(ss2[gr] * (1.f / 1024.f) + RMS_EPS) : 0.f;
#pragma unroll
                for (int bj = 0; bj < 2; ++bj)
#pragma unroll
                    for (int n = 0; n < 2; ++n) acc[ai][bj][m][n] *= s; }
        const int cl0 = wc * 32 + 8 * fq;
        if (fr >= 14) {
#pragma unroll
            for (int ai = 0; ai < 2; ++ai)
#pragma unroll
                for (int bj = 0; bj < 2; ++bj)
#pragma unroll
                    for (int n = 0; n < 2; ++n) *(PG8_LAS f32x4*)(xch + ((ai * 2 + wr) * 2 + (fr - 14)) * 256 + bj * HALF + cl0 + 4 * n) = acc[ai][bj][3][n];
        }
        if (tid_ < 256) *(PG8_LAS f32x4*)(taps + (tid_ >> 5) * 128 + 4 * (tid_ & 31)) = tapv;
        asm volatile("s_waitcnt lgkmcnt(0)\n\ts_barrier" ::: "memory");
        const int ch0 = u.pn * HALF + cl0;
        const bool seqstart = ((u.arow - 1 + 2047 + 2048) / 2048) <= ((u.arow + 255 + 2048) / 2048);
#pragma unroll
        for (int n = 0; n < 2; ++n) {
            f32x4 w0[2], w1[2], w2[2], bb[2];
#pragma unroll
            for (int bj = 0; bj < 2; ++bj) { const PG8_LAS float* tp = taps + bj * 512 + cl0 + 4 * n;
                w0[bj] = *(const PG8_LAS f32x4*)tp; w1[bj] = *(const PG8_LAS f32x4*)(tp + 128); w2[bj] = *(const PG8_LAS f32x4*)(tp + 256); bb[bj] = *(const PG8_LAS f32x4*)(tp + 384); }
#pragma unroll
            for (int ai = 0; ai < 2; ++ai) {
                const int g = ai * 2 + wr;
#pragma unroll
                for (int m = 0; m < 4; ++m) {
                    const int rt = ai * HALF + wr * 64 + m * 16 + fr, gr = u.arow + rt, t = gr & 2047;
                    f32x4 cv[2];
#pragma unroll
                    for (int bj = 0; bj < 2; ++bj) {
                        const f32x4 cur = acc[ai][bj][m][n]; f32x4 prev;
                        if (m > 0) prev = acc[ai][bj][m - 1][n];
                        else { prev = (f32x4){0.f, 0.f, 0.f, 0.f}; if (g > 0 && fr >= 14) prev = *(const PG8_LAS f32x4*)(xch + ((g - 1) * 2 + (fr - 14)) * 256 + bj * HALF + cl0 + 4 * n); }
                        f32x4 p1, p2;
#pragma unroll
                        for (int i = 0; i < 4; ++i) {
                            const float r1 = dpp_mov<0x121>(0.f, prev[i]), r2 = dpp_mov<0x122>(0.f, prev[i]);
                            p1[i] = dpp_mov<0x111>(r1, cur[i]); p2[i] = dpp_mov<0x112>(r2, cur[i]);
                        }
                        if (seqstart) { if (t == 0) { p1 = (f32x4){0.f, 0.f, 0.f, 0.f}; } if (t <= 1) { p2 = (f32x4){0.f, 0.f, 0.f, 0.f}; } }
                        cv[bj] = bb[bj] + w2[bj] * cur + w1[bj] * p1 + w0[bj] * p2;
                    }
                    float a4[4];
#pragma unroll
                    for (int i = 0; i < 4; ++i) { const float gv = cv[0][i]; a4[i] = gv * __builtin_amdgcn_rcpf(1.f + __expf(-gv)) * cv[1][i]; }
                    u32x2 w; w.x = cvt_pk_bf16(a4[0], a4[1]); w.y = cvt_pk_bf16(a4[2], a4[3]);
                    if (rt >= 2 && gr < MROWS) *(u32x2*)(act + (size_t)gr * FF + ch0 + 4 * n) = w;
                }
            }
        }
    }
};
}
#include <hip/hip_bf16.h>
#include <cmath>
namespace attn_body {
using bf16=__hip_bfloat16;
using bf16x8=__attribute__((ext_vector_type(8)))short;
using s16x4=__attribute__((ext_vector_type(4)))short;
using f32x16=__attribute__((ext_vector_type(16)))float;
using u32x4=__attribute__((ext_vector_type(4)))unsigned;
constexpr int BATCH=8,NHEAD=8,SEQ=2048,D=64,DM=3072,OM=1024;
constexpr int NW=8,QBLK=32,QB=QBLK*NW,KVBLK=64,NQB=SEQ/QB;
constexpr int ATTN_PITCH=DM, ATTN_UNIT_ROWS=QB;
__device__ __forceinline__ int crow(int r,int hi){return (r&3)+8*(r>>2)+4*hi;}
#define SBAR() __builtin_amdgcn_sched_barrier(0)
__device__ __forceinline__ void cmask(f32x16&p0,f32x16&p1,int jb,int qrel,int hi){
  const float NEG=-INFINITY; int kb=64*jb+4*hi;
  #pragma unroll
  for(int r=0;r<16;++r){int kv=kb+(r&3)+8*(r>>2); if(kv>qrel)p0[r]=NEG; if(kv+32>qrel)p1[r]=NEG;}
}

constexpr int NSLOT=3, SLOTB=8192;
constexpr int LDS_K=0, LDS_V=NSLOT*SLOTB, LDS_WS=2*NSLOT*SLOTB, LDS_OST=LDS_WS+NW*64*4, LDS_CB=LDS_OST+NW*4096, LDS_BYTES=LDS_CB+8192;
constexpr float C2=0.125f*1.4426950408889634f;
__device__ __forceinline__ void glds16(const void*gsrc,unsigned lds_dst){unsigned keep;
  asm volatile("s_mov_b32 %0, m0\n\ts_mov_b32 m0, %2\n\ts_nop 0\n\tglobal_load_lds_dwordx4 %1, off\n\ts_mov_b32 m0, %0":"=&s"(keep):"v"(gsrc),"s"(lds_dst):"memory");}
__device__ __forceinline__ float max3f(float a,float b,float c){float r;asm("v_max3_f32 %0, %1, %2, %3":"=v"(r):"v"(a),"v"(b),"v"(c));return r;}
__device__ __forceinline__ float max2f(float a,float b){float r;asm("v_max_f32_e32 %0, %1, %2":"=v"(r):"v"(a),"v"(b));return r;}
__device__ __forceinline__ float fadd_s(float a,float b){float r;asm("v_add_f32_e32 %0, %1, %2":"=v"(r):"v"(a),"v"(b));return r;}
__device__ __forceinline__ float fsub_s(float a,float b){float r;asm("v_sub_f32_e32 %0, %1, %2":"=v"(r):"v"(a),"v"(b));return r;}
typedef float f32x2_t __attribute__((ext_vector_type(2))); typedef __bf16 bf16x2_t __attribute__((ext_vector_type(2)));
__device__ __forceinline__ unsigned cvtpk_s(float lo,float hi){f32x2_t v={lo,hi};bf16x2_t b=__builtin_convertvector(v,bf16x2_t);return __builtin_bit_cast(unsigned,b);}
#define WAIT_BAR(N) asm volatile("s_waitcnt vmcnt(" #N ") lgkmcnt(0)\n\ts_barrier":::"memory")

__device__ __forceinline__ void qkt(f32x16&p0,f32x16&p1,const char*Kslot,const bf16x8*qr,const f32x16&negm,int r32,int hi){
  const char*kb=Kslot+hi*1024+r32*16;
  #pragma unroll
  for(int d0=0;d0<4;++d0){
    const bf16x8 b0=*reinterpret_cast<const bf16x8*>(kb+d0*2048);
    const bf16x8 b1=*reinterpret_cast<const bf16x8*>(kb+d0*2048+512);
    if(d0==0){p0=__builtin_amdgcn_mfma_f32_32x32x16_bf16(b0,qr[0],negm,0,0,0);p1=__builtin_amdgcn_mfma_f32_32x32x16_bf16(b1,qr[0],negm,0,0,0);}
    else{p0=__builtin_amdgcn_mfma_f32_32x32x16_bf16(b0,qr[d0],p0,0,0,0);p1=__builtin_amdgcn_mfma_f32_32x32x16_bf16(b1,qr[d0],p1,0,0,0);}}
}
typedef __attribute__((address_space(3))) const char* lds_cptr;
typedef short v4i16_t __attribute__((ext_vector_type(4)));
__device__ __forceinline__ void kload8(bf16x8*kf,lds_cptr kp){
  kf[0]=*(const __attribute__((address_space(3))) bf16x8*)(kp);      kf[1]=*(const __attribute__((address_space(3))) bf16x8*)(kp+512);
  kf[2]=*(const __attribute__((address_space(3))) bf16x8*)(kp+2048); kf[3]=*(const __attribute__((address_space(3))) bf16x8*)(kp+2560);
  kf[4]=*(const __attribute__((address_space(3))) bf16x8*)(kp+4096); kf[5]=*(const __attribute__((address_space(3))) bf16x8*)(kp+4608);
  kf[6]=*(const __attribute__((address_space(3))) bf16x8*)(kp+6144); kf[7]=*(const __attribute__((address_space(3))) bf16x8*)(kp+6656);
}
__device__ __forceinline__ void kload2(bf16x8*kf,lds_cptr kp,int j){ kf[2*j]=*(const __attribute__((address_space(3))) bf16x8*)(kp+j*2048); kf[2*j+1]=*(const __attribute__((address_space(3))) bf16x8*)(kp+j*2048+512); }
__device__ __forceinline__ s16x4 vtr(lds_cptr p){ return __builtin_bit_cast(s16x4,__builtin_amdgcn_ds_read_tr16_b64_v4i16((__attribute__((address_space(3))) v4i16_t*)p)); }
__device__ __forceinline__ float rowmax(const f32x16&p0,const f32x16&p1){
  float a=max3f(p0[0],p0[1],p1[0]),b=max3f(p0[2],p0[3],p1[1]);a=max3f(a,p1[2],p1[3]);
  #pragma unroll
  for(int r=4;r<16;r+=4){a=max3f(a,p0[r],p0[r+1]);b=max3f(b,p0[r+2],p0[r+3]);a=max3f(a,p1[r],p1[r+1]);b=max3f(b,p1[r+2],p1[r+3]);}
  const float m=max2f(a,b);
  auto rr=__builtin_amdgcn_permlane32_swap(__float_as_uint(m),__float_as_uint(m),false,false);
  return max2f(__uint_as_float(rr[0]),__uint_as_float(rr[1]));
}
__device__ __forceinline__ void pv(f32x16*o,int vb,bf16x8 pa0,bf16x8 pa1,bf16x8 pa2,bf16x8 pa3){
  #pragma unroll
  for(int d0=0;d0<2;++d0){s16x4 lo[4],hi[4];
    #pragma unroll
    for(int ks=0;ks<4;++ks){
      asm volatile("ds_read_b64_tr_b16 %0,%1 offset:%c2":"=&v"(lo[ks]):"v"(vb),"i"(d0*4096+ks*1024):"memory");
      asm volatile("ds_read_b64_tr_b16 %0,%1 offset:%c2":"=&v"(hi[ks]):"v"(vb),"i"(d0*4096+ks*1024+512):"memory");}
    asm volatile("s_waitcnt lgkmcnt(0)":::"memory");SBAR();
    #define PK(k) (bf16x8){lo[k][0],lo[k][1],lo[k][2],lo[k][3],hi[k][0],hi[k][1],hi[k][2],hi[k][3]}
    o[d0]=__builtin_amdgcn_mfma_f32_32x32x16_bf16(pa0,PK(0),o[d0],0,0,0);
    o[d0]=__builtin_amdgcn_mfma_f32_32x32x16_bf16(pa1,PK(1),o[d0],0,0,0);
    o[d0]=__builtin_amdgcn_mfma_f32_32x32x16_bf16(pa2,PK(2),o[d0],0,0,0);
    o[d0]=__builtin_amdgcn_mfma_f32_32x32x16_bf16(pa3,PK(3),o[d0],0,0,0);
    #undef PK
  }
}

#ifndef ATTN_STORE16
#define ATTN_STORE16(p,v) (*(u32x4*)(p)=(v))
#endif
template<int THRL> __device__ __forceinline__ void attn_unit(int b,int h,int qb,const bf16*Q,const bf16*__restrict__ K,const bf16*__restrict__ V,bf16*O,const float*__restrict__ CB,float thr,char*shm){
  const int tid=threadIdx.x,lane=tid&63,r32=lane&31,hi=lane>>5; const int wid=__builtin_amdgcn_readfirstlane(tid>>6);
  const long rowbase=(long)b*SEQ; const int q0=qb*QB;
  const float*cgp_=CB+(long)(b*NHEAD+h)*SEQ; const float cref_=cgp_[q0];
  const int nt4_=(q0+QB)/KVBLK-4;
  const bool need_=((threadIdx.x&63)<nt4_) && ((cgp_[64*(threadIdx.x&63)+63]-cref_)<=thr);
  const int tn_=nt4_-__popcll(__ballot(need_));
  const int t0_=__builtin_amdgcn_readfirstlane(tn_&~1);
  const bf16*Qw=Q+(rowbase+q0+wid*QBLK)*DM+h*D;
  const bf16*Kh=K+(rowbase+64*t0_)*DM+h*D,*Vh=V+(rowbase+64*t0_)*DM+h*D;
  const lds_cptr shm3=(lds_cptr)shm; const unsigned lds0=(unsigned)(uintptr_t)shm;
  float*wsf=(float*)(shm+LDS_WS)+wid*64;
  const bf16*ksrc=Kh+(long)lane*DM+wid*8;
  const bf16*vsrc=Vh+(long)(16*(wid&3)+(lane>>2))*DM+(wid>>2)*32+(lane&3)*8;
  const unsigned kdst=lds0+LDS_K+wid*1024, vdst=lds0+LDS_V+wid*1024;
  #define DMA_K(t,slot) glds16(ksrc+(long)(t)*KVBLK*DM,(unsigned)__builtin_amdgcn_readfirstlane(kdst+(slot)))
  #define DMA_V(t,slot) glds16(vsrc+(long)(t)*KVBLK*DM,(unsigned)__builtin_amdgcn_readfirstlane(vdst+(slot)))
  const int vb0=(int)(lds0+LDS_V)+((lane>>4)&1)*32+(lane&3)*8+(4*hi+((lane&15)>>2))*64;
  const char*Kbase=shm+LDS_K; bf16x8 kf[8];
  const lds_cptr kp0=shm3+LDS_K+hi*1024+r32*16; const lds_cptr vp0=shm3+LDS_V+((lane>>4)&1)*32+(lane&3)*8+(4*hi+((lane&15)>>2))*64;
  const int NT=(q0+QB)/KVBLK-t0_;
  typedef __attribute__((address_space(3))) float* lds_fptr; typedef float f32x4_t __attribute__((ext_vector_type(4)));
  const lds_fptr cbl=(lds_fptr)(shm3+LDS_CB);
  { const float*cg_=cgp_+64*t0_; const float cref=cref_;
    for(int i_=tid;i_<(q0+QB-64*t0_)/4;i_+=NW*64){ f32x4_t v_=*(const f32x4_t*)(cg_+4*i_); v_-=cref; *(__attribute__((address_space(3))) f32x4_t*)(cbl+4*i_)=v_; } }
  #define INITC(C,ptr) do{ const lds_fptr ip_=(ptr); \
    _Pragma("unroll") for(int g_=0;g_<4;++g_){ const f32x4_t c_=*(const __attribute__((address_space(3))) f32x4_t*)(ip_+8*g_); \
      _Pragma("unroll") for(int i_=0;i_<4;++i_){ C[4*g_+i_]=nmh_-c_[i_]; } } }while(0)
  #define BIAS(P0,P1,t) do{ const lds_fptr cp_=cbl+64*(t)+4*hi; \
    _Pragma("unroll") for(int g_=0;g_<4;++g_){ { const f32x4_t c0_=*(const __attribute__((address_space(3))) f32x4_t*)(cp_+8*g_)+mhat; \
      _Pragma("unroll") for(int i_=0;i_<4;++i_){ P0[4*g_+i_]-=c0_[i_]; } } asm volatile("":::"memory"); \
      { const f32x4_t c1_=*(const __attribute__((address_space(3))) f32x4_t*)(cp_+32+8*g_)+mhat; \
      _Pragma("unroll") for(int i_=0;i_<4;++i_){ P1[4*g_+i_]-=c1_[i_]; } } asm volatile("":::"memory"); } }while(0)
  DMA_K(0,0);DMA_V(0,0);DMA_K(1,SLOTB);
  bf16x8 qr[4];
  #pragma unroll
  for(int d0=0;d0<4;++d0)qr[d0]=*reinterpret_cast<const bf16x8*>(&Qw[(long)r32*DM+d0*16+hi*8]);
  float mhat=0.f,l_reg=0.f;f32x16 o[2];o[0]=f32x16{};o[1]=f32x16{};f32x16 negm=f32x16{}; const f32x16 zero16=f32x16{};
  const int qrel=wid*QBLK+r32;
  #define CMASK(P0,P1,t) do{int jb_=(t)-(NT-4); if(jb_>=0)cmask(P0,P1,jb_,qrel,hi);}while(0)
  bool resc=false;
  #define START(P0,P1) do{ const float rm=rowmax(P0,P1); resc=false; \
    { const float dl=rm; mhat=fadd_s(mhat,dl); \
      _Pragma("unroll") for(int r=0;r<16;++r){P0[r]=fsub_s(P0[r],dl);P1[r]=fsub_s(P1[r],dl);} \
      _Pragma("unroll") for(int r=0;r<16;++r)negm[r]=-mhat;  } \
    _Pragma("unroll") for(int r=0;r<16;++r)P0[r]=__builtin_amdgcn_exp2f(P0[r]); }while(0)
  #define RESC() do{ if(resc){ asm volatile("s_waitcnt lgkmcnt(0)":::"memory"); \
      _Pragma("unroll") for(int d_=0;d_<2;++d_) _Pragma("unroll") for(int r=0;r<16;++r)o[d_][r]*=wsf[crow(r,hi)]; } }while(0)
  f32x16 pA0,pA1,pB0,pB1;
  int sl_prev=0,sl_cur=0,sl_next=SLOTB;
  #define ROT() do{sl_prev=sl_cur;sl_cur=sl_next;sl_next=(sl_next==(NSLOT-1)*SLOTB)?0:sl_next+SLOTB;}while(0)
  DMA_K(2,2*SLOTB);
  WAIT_BAR(3);
  qkt(pA0,pA1,Kbase,qr,zero16,r32,hi);asm volatile("s_nop 15\n\ts_nop 7":"+v"(pA0),"+v"(pA1));BIAS(pA0,pA1,0);CMASK(pA0,pA1,0);
  START(pA0,pA1);
  _Pragma("unroll") for(int r=0;r<16;++r)pA1[r]=__builtin_amdgcn_exp2f(pA1[r]);
  WAIT_BAR(0);
  DMA_K(3,0);DMA_V(1,SLOTB);
  ROT();
  kload8(kf,kp0+sl_cur);
  WAIT_BAR(2);
  s16x4 vlo[8],vhi[8]; u32x4 pw0,pw1,pw2,pw3;
  #define PKW(P,B) cvtpk_s(P[B],P[B+1])
  #define PAF(k) __builtin_bit_cast(bf16x8,pw##k)
  #define VFR(i) (bf16x8){vlo[i][0],vlo[i][1],vlo[i][2],vlo[i][3],vhi[i][0],vhi[i][1],vhi[i][2],vhi[i][3]}
  #define PIN(x) asm volatile("":"+v"(x))
  #define MX3(a,b,c) __builtin_fmaxf(__builtin_fmaxf((a),(b)),(c))
  #define GAPA(MF,A0,A1,A2,A3,W0,W1,PW) do{ MF; sacc+=A0; sacc+=A1; sacc+=A2; sacc+=A3; PIN(sacc); W0; W1; PIN(PW); SBAR(); }while(0)
  #define EX(v) __builtin_amdgcn_exp2f(v)
  #define GAPB(MF,X,B) do{ MF; X[B]=EX(X[B]); X[B+1]=EX(X[B+1]); X[B+2]=EX(X[B+2]); X[B+3]=EX(X[B+3]); PIN(X); SBAR(); }while(0)
  #define VRD(i) do{ vlo[i]=vtr(vp_+(((i)>>2)*4096+((i)&3)*1024)); vhi[i]=vtr(vp_+(((i)>>2)*4096+((i)&3)*1024+512)); }while(0)
  #define KRD(G,j) do{ if(G){ kload2(kf,kp0+sl_next,j); SBAR(); } }while(0)
  #define STEP(C0,C1,P0,P1,t,GK,GV,GL) do{ SBAR(); \
    const lds_cptr vp_=vp0+sl_prev; \
    const float nmh_=-mhat; INITC(C0,cbl+64*(t)+4*hi); SBAR(); \
    VRD(0); SBAR(); float sacc=(P0[0]+P0[1]); \
    GAPA(C0=__builtin_amdgcn_mfma_f32_32x32x16_bf16(kf[0],qr[0],C0,0,0,0), P0[2],P0[3],P0[4],P0[5],     pw0[0]=PKW(P0,0), pw0[1]=PKW(P0,2), pw0); \
    INITC(C1,cbl+64*(t)+32+4*hi); SBAR(); \
    VRD(4); SBAR(); GAPA(C1=__builtin_amdgcn_mfma_f32_32x32x16_bf16(kf[1],qr[0],C1,0,0,0), P0[6],P0[7],P0[8],P0[9],     pw0[2]=PKW(P0,4), pw0[3]=PKW(P0,6), pw0); \
    VRD(1); SBAR(); GAPA(C0=__builtin_amdgcn_mfma_f32_32x32x16_bf16(kf[2],qr[1],C0,0,0,0),   P0[10],P0[11],P0[12],P0[13], pw1[0]=PKW(P0,8), pw1[1]=PKW(P0,10), pw1); \
    VRD(5); SBAR(); GAPA(C1=__builtin_amdgcn_mfma_f32_32x32x16_bf16(kf[3],qr[1],C1,0,0,0),   P0[14],P0[15],P1[0],P1[1],   pw1[2]=PKW(P0,12),pw1[3]=PKW(P0,14), pw1); \
    VRD(2); SBAR(); GAPA(C0=__builtin_amdgcn_mfma_f32_32x32x16_bf16(kf[4],qr[2],C0,0,0,0),   P1[2],P1[3],P1[4],P1[5],     pw2[0]=PKW(P1,0), pw2[1]=PKW(P1,2), pw2); \
    VRD(6); SBAR(); GAPA(C1=__builtin_amdgcn_mfma_f32_32x32x16_bf16(kf[5],qr[2],C1,0,0,0),   P1[6],P1[7],P1[8],P1[9],     pw2[2]=PKW(P1,4), pw2[3]=PKW(P1,6), pw2); \
    VRD(3); SBAR(); GAPA(C0=__builtin_amdgcn_mfma_f32_32x32x16_bf16(kf[6],qr[3],C0,0,0,0),   P1[10],P1[11],P1[12],P1[13], pw3[0]=PKW(P1,8), pw3[1]=PKW(P1,10), pw3); \
    VRD(7); SBAR(); GAPA(C1=__builtin_amdgcn_mfma_f32_32x32x16_bf16(kf[7],qr[3],C1,0,0,0),   P1[14],P1[15],0.f,0.f,       pw3[2]=PKW(P1,12),pw3[3]=PKW(P1,14), pw3); \
    l_reg+=sacc; \
    if(GK){DMA_K((t)+3,sl_cur);} if(GV){DMA_V((t)+1,sl_next);} \
    CMASK(C0,C1,t); \
    { float a=MX3(C0[0],C0[1],C1[0]),b=MX3(C0[2],C0[3],C1[1]); a=MX3(a,C1[2],C1[3]); \
      _Pragma("unroll") for(int r=4;r<16;r+=4){a=MX3(a,C0[r],C0[r+1]);b=MX3(b,C0[r+2],C0[r+3]);a=MX3(a,C1[r],C1[r+1]);b=MX3(b,C1[r+2],C1[r+3]);} \
      float rm=__builtin_fmaxf(a,b); { auto rr=__builtin_amdgcn_permlane32_swap(__float_as_uint(rm),__float_as_uint(rm),false,false); rm=__builtin_fmaxf(__uint_as_float(rr[0]),__uint_as_float(rr[1])); } \
      resc=false; \
      if(__builtin_expect(__any(rm>(float)THRL),0)){ const float dl=__builtin_fmaxf(rm,0.f); mhat+=dl; \
        _Pragma("unroll") for(int r=0;r<16;++r){C0[r]-=dl;C1[r]-=dl;} \
        _Pragma("unroll") for(int r=0;r<16;++r)negm[r]=-mhat;  \
        const float f=__builtin_amdgcn_exp2f(-dl); l_reg*=f; if(hi==0)wsf[r32]=f; resc=true; } } \
    SBAR(); \
    GAPB(o[0]=__builtin_amdgcn_mfma_f32_32x32x16_bf16(PAF(0),VFR(0),o[0],0,0,0), C0,0); \
    GAPB(o[1]=__builtin_amdgcn_mfma_f32_32x32x16_bf16(PAF(0),VFR(4),o[1],0,0,0), C0,4); \
    KRD(GL,0); GAPB(o[0]=__builtin_amdgcn_mfma_f32_32x32x16_bf16(PAF(1),VFR(1),o[0],0,0,0), C0,8); \
    KRD(GL,1); GAPB(o[1]=__builtin_amdgcn_mfma_f32_32x32x16_bf16(PAF(1),VFR(5),o[1],0,0,0), C0,12); \
    KRD(GL,2); GAPB(o[0]=__builtin_amdgcn_mfma_f32_32x32x16_bf16(PAF(2),VFR(2),o[0],0,0,0), C1,0); \
    KRD(GL,3); GAPB(o[1]=__builtin_amdgcn_mfma_f32_32x32x16_bf16(PAF(2),VFR(6),o[1],0,0,0), C1,4); \
    GAPB(o[0]=__builtin_amdgcn_mfma_f32_32x32x16_bf16(PAF(3),VFR(3),o[0],0,0,0), C1,8); \
    GAPB(o[1]=__builtin_amdgcn_mfma_f32_32x32x16_bf16(PAF(3),VFR(7),o[1],0,0,0), C1,12); \
    }while(0)
  int t=1;
  #undef CMASK
  #define CMASK(P0,P1,t) do{}while(0)
  for(;t+5<NT;t+=2){
    STEP(pB0,pB1,pA0,pA1,t,true,true,true);     WAIT_BAR(2); RESC(); ROT();
    STEP(pA0,pA1,pB0,pB1,t+1,true,true,true);   WAIT_BAR(2); RESC(); ROT();
  }
  #undef CMASK
  #define CMASK(P0,P1,t) do{int jb_=(t)-(NT-4); if(jb_>=0)cmask(P0,P1,jb_,qrel,hi);}while(0)
  #define ENDW(tt) do{ if((tt)+3<NT){WAIT_BAR(2);} else if((tt)+2<NT){WAIT_BAR(1);} else {WAIT_BAR(0);} }while(0)
  for(;t+1<NT;t+=2){
    STEP(pB0,pB1,pA0,pA1,t,(t+3<NT),(t+1<NT),(t+1<NT));       ENDW(t);   RESC(); ROT();
    STEP(pA0,pA1,pB0,pB1,t+1,(t+4<NT),(t+2<NT),(t+2<NT));     ENDW(t+1); RESC(); ROT();
  }
  STEP(pB0,pB1,pA0,pA1,NT-1,false,false,false); RESC();
  { float sacc=pB0[0]+pB0[1]; _Pragma("unroll") for(int r=2;r<16;++r)sacc+=pB0[r]; _Pragma("unroll") for(int r=0;r<16;++r)sacc+=pB1[r]; l_reg+=sacc;
    pw0=(u32x4){PKW(pB0,0),PKW(pB0,2),PKW(pB0,4),PKW(pB0,6)};pw1=(u32x4){PKW(pB0,8),PKW(pB0,10),PKW(pB0,12),PKW(pB0,14)};pw2=(u32x4){PKW(pB1,0),PKW(pB1,2),PKW(pB1,4),PKW(pB1,6)};pw3=(u32x4){PKW(pB1,8),PKW(pB1,10),PKW(pB1,12),PKW(pB1,14)};
    SBAR(); pv(o,vb0+sl_cur,PAF(0),PAF(1),PAF(2),PAF(3)); }
  #undef PKW
  #undef PAF
  #undef VFR
  #undef PIN
  #undef MX3
  #undef GAPA
  #undef GAPB
  #undef EX
  #undef VRD
  #undef KRD
  #undef STEP
  #undef ENDW
  {auto rr=__builtin_amdgcn_permlane32_swap(__float_as_uint(l_reg),__float_as_uint(l_reg),false,false);l_reg=__uint_as_float(rr[0])+__uint_as_float(rr[1]);}
  if(hi==0)wsf[32+r32]=l_reg;asm volatile("s_waitcnt lgkmcnt(0)":::"memory");
  float rli[16];
  #pragma unroll
  for(int r=0;r<16;++r)rli[r]=__builtin_amdgcn_rcpf(wsf[32+crow(r,hi)]);
  bf16*Ow=O+(rowbase+q0+wid*QBLK)*OM+h*D;
  { bf16*stg=(bf16*)(shm+LDS_OST)+wid*2048;
    #pragma unroll
    for(int r=0;r<16;++r){const int orow=crow(r,hi);
      #pragma unroll
      for(int d0=0;d0<2;++d0)stg[orow*64+d0*32+r32]=__float2bfloat16(o[d0][r]*rli[r]);}
    asm volatile("s_waitcnt lgkmcnt(0)":::"memory");
    #pragma unroll
    for(int i=0;i<4;++i){const int row=i*8+(lane>>3),ch=lane&7; const u32x4 v=*(const u32x4*)(stg+row*64+ch*8); ATTN_STORE16(Ow+(long)row*OM+ch*8,v);} }
  asm volatile("s_waitcnt lgkmcnt(0)\n\ts_barrier":::"memory");
  #undef DMA_K
  #undef DMA_V
  #undef CMASK
  #undef START
  #undef RESC
  #undef ROT
  #undef BIAS
  #undef INITC
}
constexpr int ATTN_LDS_BYTES=LDS_BYTES;
struct AttnTensors { const bf16* Q; const bf16* K; const bf16* V; bf16* O; const float* CB; float thr; };
struct AttnUnit { int bh; int qb; };
struct StaticOrder {
  int vcu,G;
  __device__ __forceinline__ explicit StaticOrder(int grid,int v):vcu(v),G(grid){}
  __device__ __forceinline__ bool next(int i,AttnUnit&u)const{ const int p=vcu+(i>>1)*G; if(p>=256)return false; const int s=p&3; u.bh=p>>2; u.qb=(i&1)?7-s:s; return true; }
  __device__ __forceinline__ void a_ready(const AttnUnit&)const{}
  __device__ __forceinline__ void done(const AttnUnit&)const{}
};
template<class Sched,int THRL=8> __device__ __forceinline__ void attn_phase(char*lds,const AttnTensors&T,const Sched&S){
  AttnUnit u;
  for(int i=0;S.next(i,u);++i){ S.a_ready(u); attn_unit<THRL>(u.bh/NHEAD,u.bh%NHEAD,u.qb,T.Q,T.K,T.V,T.O,T.CB,T.thr,lds); S.done(u); }
}
#undef SBAR
#undef WAIT_BAR
}
#define LAS __attribute__((address_space(3)))
namespace mk {
typedef unsigned short bf16;
typedef unsigned u32x4 __attribute__((ext_vector_type(4)));
typedef unsigned u32x2 __attribute__((ext_vector_type(2)));
typedef float f32x4 __attribute__((ext_vector_type(4)));
typedef float f32x2 __attribute__((ext_vector_type(2)));
typedef float f32x16 __attribute__((ext_vector_type(16)));
typedef short bf16x8 __attribute__((ext_vector_type(8)));
typedef unsigned v4u __attribute__((ext_vector_type(4)));
constexpr int NWAVES = 8, NT = 512;
constexpr int M = 16384, SEQ = 2048, DM = 1024, INW = 3096, PROJW = 3072, FF = 2816, PLE = 256;
constexpr float EPS = 1e-6f, LOG2E = 1.4426950408889634f, C2 = 0.125f * LOG2E;
constexpr size_t MiB = 1u << 20;
constexpr size_t WS_WIN = 1 * MiB, WS_WSK = 7 * MiB, WS_WO = 8 * MiB, WS_WUP = 10 * MiB, WS_WD = 21 * MiB, WS_WPG = 27 * MiB, WS_WPE = 29 * MiB;
constexpr size_t WS_SMALL = 30 * MiB;
constexpr size_t WS_LRF = 31 * MiB, WS_PB = 33 * MiB, WS_QE = 41 * MiB, WS_XB = 50 * MiB  , WS_MIX = 83 * MiB, WS_PROJ = 115 * MiB, WS_END = 228 * MiB;
constexpr size_t WS_SPREV = 212 * MiB  , WS_E = WS_MIX, WS_ACT = WS_PROJ;
constexpr int LDS_BYTES = 151552, XCH_OFF = 131072, RSL_OFF = XCH_OFF + 12544;

typedef __bf16 hwbf16x2 __attribute__((ext_vector_type(2)));
__device__ __forceinline__ unsigned pk2(float lo, float hi) { f32x2 v = {lo, hi}; return __builtin_bit_cast(unsigned, __builtin_convertvector(v, hwbf16x2)); }
__device__ __forceinline__ unsigned f2bf(float f) { return pk2(f, 0.f) & 0xffffu; }
__device__ __forceinline__ float bf2f(unsigned short h) { return __builtin_bit_cast(float, (unsigned)h << 16); }
__device__ __forceinline__ float bflo(unsigned w) { return __builtin_bit_cast(float, w << 16); }
__device__ __forceinline__ float bfhi(unsigned w) { return __builtin_bit_cast(float, w & 0xffff0000u); }
__device__ __forceinline__ float logsig(float z) { return fminf(z, 0.f) - __logf(1.f + __expf(-fabsf(z))); }
__device__ __forceinline__ int crow(int r, int hi) { return (r & 3) + 8 * (r >> 2) + 4 * hi; }
__device__ __forceinline__ float wave_sum(float v) {
#pragma unroll
    for (int o = 1; o < 64; o <<= 1) v += __shfl_xor(v, o);
    return v;
}
#define LDS_WAIT() asm volatile("s_waitcnt lgkmcnt(0)" ::: "memory")
#define LDS_SYNC() asm volatile("s_waitcnt lgkmcnt(0)\n\ts_barrier" ::: "memory")

struct Args { const float* in[21]; float* out; unsigned char* ws; };

template <bool HAS_GAIN>
__device__ __forceinline__ void tr_item(const float* W, int ldw, int k0, int srccol, const float* gain, bf16* WT, int ldk, int dstrow0, LAS float* scr, int lane) {
    const int sc = srccol < 0 ? 0 : srccol; const float msk = srccol < 0 ? 0.f : 1.f;
    const float* wp = W + (size_t)(k0 + (lane >> 5)) * ldw + sc;
    float v[32], gv[32];
#pragma unroll
    for (int i = 0; i < 32; ++i) v[i] = wp[(size_t)(2 * i) * ldw];
    if (HAS_GAIN) {
#pragma unroll
        for (int i = 0; i < 32; ++i) gv[i] = gain[k0 + 2 * i + (lane >> 5)];
    }
#pragma unroll
    for (int i = 0; i < 32; ++i) scr[(2 * i + (lane >> 5)) * 33 + (lane & 31)] = HAS_GAIN ? v[i] * gv[i] * msk : v[i] * msk;
    LDS_WAIT();
    const int c = lane & 7;
#pragma unroll
    for (int j = 0; j < 4; ++j) { const int n = (lane >> 3) + 8 * j; const LAS float* s = scr + (8 * c) * 33 + n;
        u32x4 o; o.x = pk2(s[0 * 33], s[1 * 33]); o.y = pk2(s[2 * 33], s[3 * 33]); o.z = pk2(s[4 * 33], s[5 * 33]); o.w = pk2(s[6 * 33], s[7 * 33]);
        *(u32x4*)(WT + (size_t)(dstrow0 + n) * ldk + k0 + 8 * c) = o; }
    LDS_WAIT();
}

__device__ __forceinline__ void p0_prologue(const Args& a, LAS unsigned char* lds, int vcu, int G, int wave, int lane, int tid) {
    unsigned char* ws = a.ws;
    LAS float* scr = (LAS float*)(lds + wave * 16384);
    const int gw = vcu * NWAVES + wave, NGW = G * NWAVES;
    constexpr int I_IN = 16 * 96, I_SK = 16, I_O = 16 * 32, I_UP = 16 * 176, I_D = 44 * 32, I_PG = 16 * 32, I_PE = 4 * 32;
    constexpr int NITEMS = I_IN + I_SK + I_O + I_UP + I_PE;
    for (int it = gw; it < NITEMS; it += NGW) {
        int r = it; const int nl = lane & 31;
        if (r < I_IN) { const int kb = r / 96, nb = r % 96, n0 = 32 * nb; tr_item<true>(a.in[3], INW, 64 * kb, n0 + (n0 >= 1536 ? 16 : 0) + nl, a.in[2], (bf16*)(ws + WS_WIN), DM, n0, scr, lane); continue; } r -= I_IN;
        if (r < I_SK) { const int sc = nl < 16 ? 1536 + nl : (nl < 24 ? 3088 + nl - 16 : -1); tr_item<true>(a.in[3], INW, 64 * r, sc, a.in[2], (bf16*)(ws + WS_WSK), DM, 0, scr, lane); continue; } r -= I_SK;
        if (r < I_O) { const int kb = r / 32, nb = r % 32; tr_item<false>(a.in[10], DM, 64 * kb, 32 * nb + nl, nullptr, (bf16*)(ws + WS_WO), DM, 32 * nb, scr, lane); continue; } r -= I_O;
        if (r < I_UP) { const int kb = r / 176, nb = r % 176, pn = nb >> 3, wi = nb & 7; const int sc0 = wi < 4 ? 128 * pn + 32 * wi : FF + 128 * pn + 32 * (wi - 4);
            tr_item<true>(a.in[12], 2 * FF, 64 * kb, sc0 + nl, a.in[11], (bf16*)(ws + WS_WUP), DM, 32 * nb, scr, lane); continue; } r -= I_UP;
        { const int kb = r / 32, nb = r % 32; tr_item<false>(a.in[17], DM, 64 * kb, 32 * nb + nl, nullptr, (bf16*)(ws + WS_WPE), PLE, 32 * nb, scr, lane); }
    }
    float* rstd1 = (float*)(ws + WS_SMALL); bf16* xb = (bf16*)(ws + WS_XB); bf16* pb = (bf16*)(ws + WS_PB);
    for (int m0 = gw; m0 < M; m0 += 2 * NGW) {
        f32x4 v[2][4], pv[2];
#pragma unroll
        for (int q = 0; q < 2; ++q) { const int m = m0 + q * NGW; const f32x4* xr = (const f32x4*)(a.in[0] + (size_t)m * DM) + lane;
#pragma unroll
            for (int j = 0; j < 4; ++j) v[q][j] = xr[64 * j];
            pv[q] = *((const f32x4*)(a.in[1] + (size_t)m * PLE) + lane); }
#pragma unroll
        for (int q = 0; q < 2; ++q) { const int m = m0 + q * NGW; float s = 0.f;
#pragma unroll
            for (int j = 0; j < 4; ++j) s += (v[q][j].x * v[q][j].x + v[q][j].y * v[q][j].y) + (v[q][j].z * v[q][j].z + v[q][j].w * v[q][j].w);
            s = wave_sum(s); if (lane == 0) rstd1[m] = rsqrtf(s * (1.f / DM) + EPS);
            u32x2* o8 = (u32x2*)(xb + (size_t)m * DM) + lane;
#pragma unroll
            for (int j = 0; j < 4; ++j) o8[64 * j] = (u32x2){pk2(v[q][j].x, v[q][j].y), pk2(v[q][j].z, v[q][j].w)};
            *((u32x2*)(pb + (size_t)m * PLE) + lane) = (u32x2){pk2(pv[q].x, pv[q].y), pk2(pv[q].z, pv[q].w)}; }
    }
    float* ssz = (float*)(ws + WS_SMALL) + M;
    for (int i = vcu * NT + tid; i < 3 * M; i += G * NT) ssz[i] = 0.f;
}

__device__ __forceinline__ void p6_late_weights(const Args& a, LAS unsigned char* lds, int cl, int nl, int wave, int lane) {
    unsigned char* ws = a.ws; LAS float* scr = (LAS float*)(lds + wave * 16384); const int nl32 = lane & 31;
    constexpr int I_D = 44 * 32, I_PG = 16 * 32;
    for (int it = cl * NWAVES + wave; it < I_D + I_PG; it += nl * NWAVES) {
        if (it < I_D) { const int kb = it / 32, nb = it % 32; tr_item<false>(a.in[15], DM, 64 * kb, 32 * nb + nl32, nullptr, (bf16*)(ws + WS_WD), FF, 32 * nb, scr, lane); }
        else { const int r = it - I_D, kb = r / 32, nb = r % 32; tr_item<true>(a.in[19], DM, 64 * kb, 32 * nb + nl32, a.in[16], (bf16*)(ws + WS_WPG), DM, 32 * nb, scr, lane); }
    }
}

__device__ __forceinline__ void p1_skinny(const Args& a, LAS unsigned char* lds, int vcu, int G, int wave, int lane, int tid) {
    const bf16* xb = (const bf16*)(a.ws + WS_XB); const bf16* wsk = (const bf16*)(a.ws + WS_WSK); const float* rstd1 = (const float*)(a.ws + WS_SMALL); float* lrf = (float*)(a.ws + WS_LRF);
    LAS float* red = (LAS float*)lds;
    const int r32 = lane & 31, hi = lane >> 5;
    for (int rg = vcu; rg < M / 64; rg += G) {
        const int row0 = rg * 64; f32x16 acc0 = {}, acc1 = {};
#pragma unroll
        for (int ks = 0; ks < 8; ++ks) { const int k = wave * 128 + ks * 16 + 8 * hi;
            const bf16x8 a0 = *(const bf16x8*)(xb + (size_t)(row0 + r32) * DM + k), a1 = *(const bf16x8*)(xb + (size_t)(row0 + 32 + r32) * DM + k), b = *(const bf16x8*)(wsk + (size_t)r32 * DM + k);
            acc0 = __builtin_amdgcn_mfma_f32_32x32x16_bf16(a0, b, acc0, 0, 0, 0); acc1 = __builtin_amdgcn_mfma_f32_32x32x16_bf16(a1, b, acc1, 0, 0, 0); }
#pragma unroll
        for (int r = 0; r < 16; ++r) { red[(wave * 64 + crow(r, hi)) * 32 + r32] = acc0[r]; red[(wave * 64 + 32 + crow(r, hi)) * 32 + r32] = acc1[r]; }
        LDS_SYNC();
        { const int row = tid >> 3, c4 = tid & 7; f32x4 s = {0.f, 0.f, 0.f, 0.f};
#pragma unroll
            for (int w = 0; w < 8; ++w) s += *(const LAS f32x4*)(red + (w * 64 + row) * 32 + c4 * 4);
            s *= rstd1[row0 + row];
            if (c4 == 4 || c4 == 5) { const f32x4 bf = *(const f32x4*)(a.in[7] + (c4 - 4) * 4); s = (f32x4){logsig(s.x + bf.x), logsig(s.y + bf.y), logsig(s.z + bf.z), logsig(s.w + bf.w)}; }
            *(f32x4*)(lrf + (size_t)(row0 + row) * 32 + c4 * 4) = s; }
        LDS_SYNC();
    }
}

__device__ __forceinline__ bf16x8 ldfrag(const LAS bf16* base, int row, int ks, int hi) { return *(const LAS bf16x8*)(base + row * 72 + ks * 16 + 8 * hi); }
#define PK16(a_, b_) ((unsigned)(a_) | ((unsigned)(b_) << 16))
struct GlaIn { f32x4 lrq; unsigned qp[8], kp[8], vv2[16]; };
__device__ __forceinline__ void gla_local_load(GlaIn& I, const Args& a, int task0, int wave, int tid) {
    const bf16* proj = (const bf16*)(a.ws + WS_PROJ); const float* lrf = (const float*)(a.ws + WS_LRF);
    const int hb = wave >> 2, t256 = tid & 255, task = task0 + hb;
    const int bh = task >> 5, n = task & 31, b = bh >> 2, h = bh & 3, tok0 = b * SEQ + n * 64;
    const int kp = t256 & 31, seg = t256 >> 5, vp = t256 & 63, sg = t256 >> 6;
    I.lrq = *(const f32x4*)(lrf + (size_t)(tok0 + (t256 >> 2)) * 32 + (t256 & 3) * 4);
#pragma unroll
    for (int i = 0; i < 8; ++i) { const bf16* pr = proj + (size_t)(tok0 + seg * 8 + i) * PROJW + h * 64 + 2 * kp; I.qp[i] = *(const unsigned*)pr; I.kp[i] = *(const unsigned*)(pr + 256); }
#pragma unroll
    for (int i = 0; i < 16; ++i) I.vv2[i] = *(const unsigned*)(proj + (size_t)(tok0 + sg * 16 + i) * PROJW + 512 + h * 128 + 2 * vp);
}
__device__ __forceinline__ void gla_local2(const GlaIn& I, const f32x2 (&w)[16], f32x2 bias, const Args& a, LAS unsigned char* lds_all, int task0, int wave, int lane, int tid) {
    unsigned char* ws = a.ws;
    bf16* qeg = (bf16*)(ws + WS_QE);
    float* decay = (float*)(ws + WS_SMALL) + 4 * M; float* ointra = a.out; float* dS = a.out + (size_t)M * 512;
    const int hb = wave >> 2, w4 = wave & 3, t256 = tid & 255, task = task0 + hb;
    const int bh = task >> 5, n = task & 31, b = bh >> 2, h = bh & 3, tok0 = b * SEQ + n * 64;
    LAS unsigned char* lds = lds_all + hb * 61440;
    LAS bf16* QE = (LAS bf16*)lds; LAS bf16* KE = QE + 64 * 72; LAS bf16* KDT = KE + 64 * 72; LAS bf16* VT = KDT + 64 * 72; LAS bf16* AT = VT + 128 * 72;
    LAS float* SEG = (LAS float*)(AT + 64 * 72); LAS float* LR = SEG + 512;
    const int r32 = lane & 31, hi = lane >> 5;
    const int kp = t256 & 31, seg = t256 >> 5;
    const int vp = t256 & 63, sg = t256 >> 6;
    *(LAS f32x4*)(LR + (t256 >> 2) * 16 + (t256 & 3) * 4) = I.lrq;
    LDS_SYNC();
    f32x2 bl[8]; f32x2 run = {0.f, 0.f};
#pragma unroll
    for (int i = 0; i < 8; ++i) { const LAS f32x4* lr = (const LAS f32x4*)(LR + (seg * 8 + i) * 16); f32x2 z = bias;
#pragma unroll
        for (int j = 0; j < 4; ++j) { const f32x4 l4 = lr[j]; z += (w[4 * j] * l4.x + w[4 * j + 1] * l4.y) + (w[4 * j + 2] * l4.z + w[4 * j + 3] * l4.w); }
        run += (f32x2){logsig(z.x), logsig(z.y)} * (1.f / 16.f); bl[i] = run; }
    *(LAS f32x2*)(SEG + seg * 64 + 2 * kp) = run;
    {
        unsigned lo[8], hh[8];
#pragma unroll
        for (int q = 0; q < 8; ++q) { const unsigned x0 = I.vv2[2 * q], x1 = I.vv2[2 * q + 1]; lo[q] = (x0 & 0xffffu) | (x1 << 16); hh[q] = (x0 >> 16) | (x1 & 0xffff0000u); }
        *(LAS u32x4*)(VT + (2 * vp) * 72 + sg * 16) = (u32x4){lo[0], lo[1], lo[2], lo[3]}; *(LAS u32x4*)(VT + (2 * vp) * 72 + sg * 16 + 8) = (u32x4){lo[4], lo[5], lo[6], lo[7]};
        *(LAS u32x4*)(VT + (2 * vp + 1) * 72 + sg * 16) = (u32x4){hh[0], hh[1], hh[2], hh[3]}; *(LAS u32x4*)(VT + (2 * vp + 1) * 72 + sg * 16 + 8) = (u32x4){hh[4], hh[5], hh[6], hh[7]}; }
    LDS_SYNC();
    {   f32x2 prefix = {0.f, 0.f}, total = {0.f, 0.f};
#pragma unroll
        for (int s2 = 0; s2 < 8; ++s2) { const f32x2 sv = *(const LAS f32x2*)(SEG + s2 * 64 + 2 * kp); total += sv; if (s2 < seg) prefix += sv; }
        float kd0[8], kd1[8];
#pragma unroll
        for (int i = 0; i < 8; ++i) { const int t = seg * 8 + i; const f32x2 bb = bl[i] + prefix;
            const float q0 = bflo(I.qp[i]), q1 = bfhi(I.qp[i]), k0 = bflo(I.kp[i]), k1 = bfhi(I.kp[i]);
            const unsigned qe = pk2(q0 * 0.125f * __expf(bb.x), q1 * 0.125f * __expf(bb.y));
            *(LAS unsigned*)(QE + t * 72 + 2 * kp) = qe; *(LAS unsigned*)(KE + t * 72 + 2 * kp) = pk2(k0 * __expf(-bb.x), k1 * __expf(-bb.y));
            *(unsigned*)(qeg + (size_t)(tok0 + t) * 256 + h * 64 + 2 * kp) = qe;
            kd0[i] = k0 * __expf(total.x - bb.x); kd1[i] = k1 * __expf(total.y - bb.y); }
        *(LAS u32x4*)(KDT + (2 * kp) * 72 + seg * 8) = (u32x4){pk2(kd0[0], kd0[1]), pk2(kd0[2], kd0[3]), pk2(kd0[4], kd0[5]), pk2(kd0[6], kd0[7])};
        *(LAS u32x4*)(KDT + (2 * kp + 1) * 72 + seg * 8) = (u32x4){pk2(kd1[0], kd1[1]), pk2(kd1[2], kd1[3]), pk2(kd1[4], kd1[5]), pk2(kd1[6], kd1[7])};
        if (seg == 0) *(f32x2*)(decay + task * 64 + 2 * kp) = (f32x2){__expf(total.x), __expf(total.y)};
    }
    LDS_SYNC();
    {
        const int ti = w4 >> 1, si = w4 & 1; f32x16 acc = {};
        if (si <= ti) {
#pragma unroll
            for (int ks = 0; ks < 4; ++ks) acc = __builtin_amdgcn_mfma_f32_32x32x16_bf16(ldfrag(QE, ti * 32 + r32, ks, hi), ldfrag(KE, si * 32 + r32, ks, hi), acc, 0, 0, 0);
        }
#pragma unroll
        for (int r = 0; r < 16; ++r) { const int trow = ti * 32 + crow(r, hi), scol = si * 32 + r32; AT[trow * 72 + scol] = (unsigned short)f2bf(scol <= trow ? acc[r] : 0.f); }
    }
    LDS_SYNC();
    {
        const int ti = w4 >> 1;
#pragma unroll
        for (int q = 0; q < 2; ++q) { const int vi = (w4 & 1) * 2 + q; f32x16 o = {}, ds = {};
#pragma unroll
            for (int ks = 0; ks < 4; ++ks) { const bf16x8 vb = ldfrag(VT, vi * 32 + r32, ks, hi);
                o = __builtin_amdgcn_mfma_f32_32x32x16_bf16(ldfrag(AT, ti * 32 + r32, ks, hi), vb, o, 0, 0, 0);
                ds = __builtin_amdgcn_mfma_f32_32x32x16_bf16(ldfrag(KDT, ti * 32 + r32, ks, hi), vb, ds, 0, 0, 0); }
#pragma unroll
            for (int r = 0; r < 16; ++r) { const int row = ti * 32 + crow(r, hi);
                ointra[(size_t)(tok0 + row) * 512 + h * 128 + vi * 32 + r32] = o[r];
                dS[(size_t)task * 8192 + row * 128 + vi * 32 + r32] = ds[r]; } }
    }
    LDS_SYNC();
}
__device__ __forceinline__ void gla_w_load(f32x2 (&w)[16], f32x2& bias, const Args& a, int h, int kp) {
#pragma unroll
    for (int j = 0; j < 16; ++j) w[j] = *(const f32x2*)(a.in[4] + j * 256 + h * 64 + 2 * kp);
    bias = *(const f32x2*)(a.in[5] + h * 64 + 2 * kp);
}
__device__ __forceinline__ void gla_local_all(const Args& a, LAS unsigned char* lds, int vcu, int G, int wave, int lane, int tid) {
    const bool aff = (G == 256);
    const int t0 = aff ? 128 * (vcu >> 5) + 2 * (vcu & 31) : 2 * vcu; if (t0 >= 1024) return;
    const int kp = tid & 31;
    f32x2 w[16]; f32x2 bias; gla_w_load(w, bias, a, ((t0 + (wave >> 2)) >> 5) & 3, kp);
    const int t1 = aff ? t0 + 64 : t0 + 2 * G; const bool has1 = t1 < 1024;
    {   GlaIn A, B; gla_local_load(A, a, t0, wave, tid);
        if (has1) gla_local_load(B, a, t1, wave, tid);
        gla_local2(A, w, bias, a, lds, t0, wave, lane, tid);
        if (has1) {
            if (aff || (2 * G) % 128 != 0) gla_w_load(w, bias, a, ((t1 + (wave >> 2)) >> 5) & 3, kp);
            gla_local2(B, w, bias, a, lds, t1, wave, lane, tid); } }
    if (aff) return;
    for (int task = t0 + 4 * G; task < 1024; task += 2 * G) {
        gla_w_load(w, bias, a, ((task + (wave >> 2)) >> 5) & 3, kp);
        GlaIn C; gla_local_load(C, a, task, wave, tid); gla_local2(C, w, bias, a, lds, task, wave, lane, tid); }
}

__device__ __forceinline__ void fox_prep(const Args& a, LAS unsigned char* lds, int vcu, int G, int wave, int lane, int tid) {
    const float* lrf = (const float*)(a.ws + WS_LRF); float* cb = (float*)(a.ws + WS_SMALL) + 4 * M + 65536; LAS float* wt = (LAS float*)lds;
    for (int bh = vcu; bh < 64; bh += G) {
        const int b = bh >> 3, h = bh & 7; float v[4];
#pragma unroll
        for (int i = 0; i < 4; ++i) v[i] = lrf[(size_t)(b * SEQ + tid * 4 + i) * 32 + 16 + h];
        v[1] += v[0]; v[2] += v[1]; v[3] += v[2];
        float inc = v[3];
#pragma unroll
        for (int o = 1; o < 64; o <<= 1) { const float t = __shfl_up(inc, o); if (lane >= o) inc += t; }
        if (lane == 63) wt[wave] = inc;
        LDS_SYNC();
        float pre = inc - v[3];
#pragma unroll
        for (int w = 0; w < 8; ++w) { const float x = wt[w]; if (w < wave) pre += x; }
        *(f32x4*)(cb + (size_t)bh * SEQ + tid * 4) = (f32x4){(pre + v[0]) * LOG2E, (pre + v[1]) * LOG2E, (pre + v[2]) * LOG2E, (pre + v[3]) * LOG2E};
        LDS_SYNC();
    }
}

__device__ __forceinline__ void gla_scan(const Args& a, int vcu, int G, int tid) {
    const float* decay = (const float*)(a.ws + WS_SMALL) + 4 * M; const float* dS = a.out + (size_t)M * 512; bf16* sprev = (bf16*)(a.ws + WS_SPREV);
    for (int e = (vcu * NT + tid) * 2; e < 32 * 8192; e += G * NT * 2) {
        const int j = e >> 13, bh = (G == 256) ? j : (j & 1) + 2 * (j >> 2) + 16 * ((j >> 1) & 1), kv = e & 8191, k = kv >> 7; f32x2 st = {0.f, 0.f};
#pragma unroll
        for (int n = 0; n < 32; ++n) { const int task = bh * 32 + n; const size_t idx = (size_t)task * 8192 + kv;
            *(unsigned*)(sprev + idx) = pk2(st.x, st.y); const float d = decay[task * 64 + k]; const f32x2 ds = *(const f32x2*)(dS + idx); st = st * d + ds; }
    }
}

__device__ __forceinline__ void gla_final2(const Args& a, LAS unsigned char* lds_all, int task0, int wave, int lane, int tid) {
    unsigned char* ws = a.ws;
    const bf16* proj = (const bf16*)(ws + WS_PROJ); const bf16* qeg = (const bf16*)(ws + WS_QE); const bf16* sprev = (const bf16*)(ws + WS_SPREV);
    const float* ointra = a.out; bf16* mix = (bf16*)(ws + WS_MIX);
    const int hb = wave >> 2, w4 = wave & 3, t256 = tid & 255, task = task0 + hb;
    const int bh = task >> 5, n = task & 31, b = bh >> 2, h = bh & 3, tok0 = b * SEQ + n * 64;
    LAS unsigned char* lds = lds_all + hb * 61440;
    LAS bf16* QE = (LAS bf16*)lds; LAS bf16* ST = QE + 64 * 72; LAS float* OL = (LAS float*)(lds + 27648);
    const int r32 = lane & 31, hi = lane >> 5, ti = w4 >> 1;
    const int rr = t256 >> 4, c16 = t256 & 15;
    u32x4 qv[2];
#pragma unroll
    for (int q = 0; q < 2; ++q) { const int e = t256 + 256 * q; qv[q] = *(const u32x4*)(qeg + (size_t)(tok0 + (e >> 3)) * 256 + h * 64 + (e & 7) * 8); }
    unsigned f2[16];
    { const int vp = t256 & 63, kg = t256 >> 6;
#pragma unroll
        for (int i = 0; i < 16; ++i) f2[i] = *(const unsigned*)(sprev + (size_t)task * 8192 + (kg * 16 + i) * 128 + 2 * vp); }
    f32x4 oiv[4][2]; u32x4 gw[4];
#pragma unroll
    for (int p = 0; p < 4; ++p) { const size_t tok = (size_t)(tok0 + p * 16 + rr);
        oiv[p][0] = *(const f32x4*)(ointra + tok * 512 + h * 128 + c16 * 8); oiv[p][1] = *(const f32x4*)(ointra + tok * 512 + h * 128 + c16 * 8 + 4);
        gw[p] = *(const u32x4*)(proj + tok * PROJW + 1024 + h * 128 + c16 * 8); }
    const f32x4 gn0 = *(const f32x4*)(a.in[6] + c16 * 8), gn1 = *(const f32x4*)(a.in[6] + c16 * 8 + 4);
#pragma unroll
    for (int q = 0; q < 2; ++q) { const int e = t256 + 256 * q; *(LAS u32x4*)(QE + (e >> 3) * 72 + (e & 7) * 8) = qv[q]; }
    { const int vp = t256 & 63, kg = t256 >> 6; unsigned lo[8], hh[8];
#pragma unroll
        for (int q = 0; q < 8; ++q) { const unsigned x0 = f2[2 * q], x1 = f2[2 * q + 1]; lo[q] = (x0 & 0xffffu) | (x1 << 16); hh[q] = (x0 >> 16) | (x1 & 0xffff0000u); }
        *(LAS u32x4*)(ST + (2 * vp) * 72 + kg * 16) = (u32x4){lo[0], lo[1], lo[2], lo[3]}; *(LAS u32x4*)(ST + (2 * vp) * 72 + kg * 16 + 8) = (u32x4){lo[4], lo[5], lo[6], lo[7]};
        *(LAS u32x4*)(ST + (2 * vp + 1) * 72 + kg * 16) = (u32x4){hh[0], hh[1], hh[2], hh[3]}; *(LAS u32x4*)(ST + (2 * vp + 1) * 72 + kg * 16 + 8) = (u32x4){hh[4], hh[5], hh[6], hh[7]}; }
    LDS_SYNC();
#pragma unroll
    for (int q = 0; q < 2; ++q) { const int vi = (w4 & 1) * 2 + q; f32x16 acc = {};
#pragma unroll
        for (int ks = 0; ks < 4; ++ks) acc = __builtin_amdgcn_mfma_f32_32x32x16_bf16(ldfrag(QE, ti * 32 + r32, ks, hi), ldfrag(ST, vi * 32 + r32, ks, hi), acc, 0, 0, 0);
#pragma unroll
        for (int r = 0; r < 16; ++r) { const int row = ti * 32 + crow(r, hi), col = vi * 32 + r32; OL[row * 132 + col] = acc[r]; } }
    LDS_SYNC();
#pragma unroll
    for (int p = 0; p < 4; ++p) { const int t = p * 16 + rr;
        const f32x4 o0 = *(const LAS f32x4*)(OL + t * 132 + c16 * 8) + oiv[p][0], o1 = *(const LAS f32x4*)(OL + t * 132 + c16 * 8 + 4) + oiv[p][1];
        float ssq = (o0.x * o0.x + o0.y * o0.y) + (o0.z * o0.z + o0.w * o0.w) + (o1.x * o1.x + o1.y * o1.y) + (o1.z * o1.z + o1.w * o1.w);
        ssq += __shfl_xor(ssq, 1); ssq += __shfl_xor(ssq, 2); ssq += __shfl_xor(ssq, 4); ssq += __shfl_xor(ssq, 8);
        const float r = rsqrtf(ssq * (1.f / 128.f) + EPS);
        const u32x4 g = gw[p]; const float og[8] = {bflo(g.x), bfhi(g.x), bflo(g.y), bfhi(g.y), bflo(g.z), bfhi(g.z), bflo(g.w), bfhi(g.w)};
        float y[8];
#pragma unroll
        for (int c = 0; c < 4; ++c) { const float g0 = og[c], g1 = og[4 + c];
            y[c] = o0[c] * r * gn0[c] * (g0 * __builtin_amdgcn_rcpf(1.f + __expf(-g0))); y[4 + c] = o1[c] * r * gn1[c] * (g1 * __builtin_amdgcn_rcpf(1.f + __expf(-g1))); }
        u32x4 pk; pk.x = pk2(y[0], y[1]); pk.y = pk2(y[2], y[3]); pk.z = pk2(y[4], y[5]); pk.w = pk2(y[6], y[7]);
        *(u32x4*)(mix + (size_t)(tok0 + t) * DM + h * 128 + c16 * 8) = pk; }
    LDS_SYNC();
}

#define XB_TMO      128
#define XB_XCNT(j)  (256  + 64 * (j))
#define XB_XSUB(j)  (1280 + 64 * (j))
#define XB_XGEN(j)  (2304 + 64 * (j))
#define XB_TOP      3328
#define XB_TOPGEN   3392
#define XCD_BAR_WORDS 3456
#define XB_SPIN_CAP (1u << 18)

__device__ __forceinline__ unsigned xb_ld(unsigned* p)              { return __hip_atomic_load(p, __ATOMIC_RELAXED, __HIP_MEMORY_SCOPE_AGENT); }
__device__ __forceinline__ unsigned xb_add(unsigned* p, unsigned v) { return __hip_atomic_fetch_add(p, v, __ATOMIC_RELAXED, __HIP_MEMORY_SCOPE_AGENT); }
__device__ __forceinline__ unsigned xb_xcc_id() { return (unsigned)__builtin_amdgcn_s_getreg((3 << 11) | 20) & 0xFu; }
#define XB_SPIN(cond, bar) do { unsigned _sp = 0; while (cond) { __builtin_amdgcn_s_sleep(1); \
    if ((++_sp & 255u) == 0u) { if (xb_ld(&(bar)[XB_TMO])) break; if (_sp > XB_SPIN_CAP) { atomicAdd(&(bar)[XB_TMO], 1u); break; } } } } while (0)

struct XcdBarrier {
    unsigned* bar; unsigned x;
    volatile LAS unsigned* st;
};

__device__ __forceinline__ XcdBarrier xcd_barrier_post(unsigned* bar, volatile LAS unsigned* st, bool leader) {
    XcdBarrier b; b.bar = bar; b.x = xb_xcc_id(); b.st = st;
    if (leader) (void)xb_add(&bar[XB_XCNT(b.x)], 1u);
    return b;
}
__device__ __forceinline__ void xcd_barrier_complete(unsigned* bar, unsigned x, unsigned& nloc, unsigned& nx) {
    const unsigned G = gridDim.x * gridDim.y * gridDim.z;
    unsigned sum, cnt, mine, sp = 0u;
    for (;;) {
        sum = 0u; cnt = 0u; mine = 0u;
#pragma unroll
        for (unsigned j = 0; j < 16; ++j) { const unsigned c = xb_ld(&bar[XB_XCNT(j)]); sum += c; cnt += (c > 0u) ? 1u : 0u; mine = (j == x) ? c : mine; }
        if (sum == G) break;
        __builtin_amdgcn_s_sleep(1);
        if ((++sp & 255u) == 0u) { if (xb_ld(&bar[XB_TMO])) break; if (sp > XB_SPIN_CAP) { atomicAdd(&bar[XB_TMO], 1u); break; } }
    }
    nloc = mine > 0u ? mine : 1u; nx = cnt > 0u ? cnt : 1u;
}

__device__ __forceinline__ void xcd_barrier(const XcdBarrier& b, bool leader) {
    asm volatile("s_waitcnt vmcnt(0)" ::: "memory");
    __syncthreads();
    if (leader) {
        unsigned* bar = b.bar;
        __builtin_amdgcn_s_waitcnt(0);
        unsigned nloc = b.st[0], nx = b.st[1];
        if (nloc == 0u) { xcd_barrier_complete(bar, b.x, nloc, nx); b.st[0] = nloc; b.st[1] = nx; }
        const unsigned old = xb_add(&bar[XB_XSUB(b.x)], 1u);
        const unsigned gen = old / nloc;
        if (old + 1u == (gen + 1u) * nloc) {
            __builtin_amdgcn_fence(__ATOMIC_RELEASE, "agent");
            asm volatile("s_waitcnt vmcnt(0)" ::: "memory");
            const unsigned og = xb_add(&bar[XB_TOP], 1u);
            const unsigned tg = og / nx;
            if (og + 1u == (tg + 1u) * nx) xb_add(&bar[XB_TOPGEN], 1u);
            else XB_SPIN(xb_ld(&bar[XB_TOPGEN]) == tg, bar);
            __builtin_amdgcn_fence(__ATOMIC_ACQUIRE, "agent");
            xb_add(&bar[XB_XGEN(b.x)], 1u);
            asm volatile("s_waitcnt vmcnt(0)" ::: "memory");
        } else {
            XB_SPIN(xb_ld(&bar[XB_XGEN(b.x)]) == gen, bar);
            __builtin_amdgcn_fence(__ATOMIC_ACQUIRE, "agent");
            asm volatile("s_waitcnt vmcnt(0)" ::: "memory");
        }
    }
    __syncthreads();
}

__device__ __forceinline__ void sb_arrive(const XcdBarrier& b, int set, bool leader) {
    asm volatile("s_waitcnt vmcnt(0)" ::: "memory"); __syncthreads();
    if (leader) { unsigned* w = b.bar + 4096 + 2048 * set; const unsigned nloc = b.st[0], nx = b.st[1];
        const unsigned old = xb_add(&w[64 * b.x], 1u);
        if (old + 1u == nloc) { __builtin_amdgcn_fence(__ATOMIC_RELEASE, "agent"); asm volatile("s_waitcnt vmcnt(0)" ::: "memory");
            const unsigned og = xb_add(&w[1024], 1u); if (og + 1u == nx) xb_add(&w[1088], 1u); } }
}
__device__ __forceinline__ void sb_wait(const XcdBarrier& b, int set, bool leader) {
    if (leader) { unsigned* w = b.bar + 4096 + 2048 * set; XB_SPIN(xb_ld(&w[1088]) == 0u, b.bar);
        __builtin_amdgcn_fence(__ATOMIC_ACQUIRE, "agent"); asm volatile("s_waitcnt vmcnt(0)" ::: "memory"); }
    __syncthreads();
}
#ifndef MK_SKIP
#define MK_SKIP 0
#endif
#define RUN(k) (!((MK_SKIP >> (k)) & 1))
#ifndef REP_SYNC
#define REP_SYNC 1
#endif
#ifndef REP_P0
#define REP_P0 1
#endif
#ifndef REP_P1
#define REP_P1 1
#endif
#ifndef REP_GL
#define REP_GL 1
#endif
#ifndef REP_SC
#define REP_SC 1
#endif
#ifndef REP_AT
#define REP_AT 1
#endif
#ifndef REP_GF
#define REP_GF 1
#endif
#ifndef REP_P5
#define REP_P5 1
#endif
#ifndef REP_P7
#define REP_P7 1
#endif
#ifndef REP_P8
#define REP_P8 1
#endif
#ifndef REP_FP
#define REP_FP 1
#endif
#ifndef REP_P6
#define REP_P6 1
#endif
#ifndef STAMP_K
#define STAMP_K -1
#endif
#define GSYNC() do { for (int s_ = 0; s_ < REP_SYNC; ++s_) xcd_barrier(xbar, wave == 0 && lane_id() == 0); \
    if (STAMP_K >= 0) { if (bx == 0 && wave == 0 && lane_id() == 0) { ((unsigned long long*)(ws + 65536))[n_stamp] = __builtin_amdgcn_s_memrealtime(); } ++n_stamp; } } while (0)
__global__ void __launch_bounds__(NT, 2) mk_fwd(Args a) {
    extern __shared__ __attribute__((aligned(16))) unsigned char lds_raw[];
    LAS unsigned char* lds = (LAS unsigned char*)lds_raw;
    const int wave = __builtin_amdgcn_readfirstlane(threadIdx.x >> 6);
#define lane (lane_id())
#define tid (wave * 64 + lane_id())
    const int G = gridDim.x, bx = blockIdx.x, vcu = (G % 8 == 0) ? (bx % 8) * (G / 8) + bx / 8 : bx;
    unsigned char* ws = a.ws;
    bf16* xb = (bf16*)(ws + WS_XB); float* small = (float*)(ws + WS_SMALL);
    float* ss2 = small + M; float* ss3 = small + 2 * M; float* ssE = small + 3 * M;
    volatile LAS unsigned* xst = (volatile LAS unsigned*)(lds + XCH_OFF + 8192);
    if (wave == 0 && lane_id() == 0) { xst[0] = 0u; xst[1] = 0u; }
    __syncthreads();
    int n_stamp = 1; if (STAMP_K >= 0 && bx == 0 && wave == 0 && lane_id() == 0) ((unsigned long long*)(ws + 65536))[0] = __builtin_amdgcn_s_memrealtime();
    const XcdBarrier xbar = xcd_barrier_post((unsigned*)ws, xst, wave == 0 && lane_id() == 0);

    for (int rep_ = 0; rep_ < REP_P0; ++rep_) if (RUN(0)) p0_prologue(a, lds, vcu, G, wave, lane, tid);
    GSYNC();
    for (int rep_ = 0; rep_ < REP_P1; ++rep_) if (RUN(1)) {   pg8::Gemm g{xb, (const bf16*)(ws + WS_WIN), M, PROJW, DM}; pg8::StaticOrder S; S.init(M / 256, PROJW / 256, G, bx);
        pg8::EpiProj E{(bf16*)(ws + WS_PROJ), PROJW, small, a.in[8], a.in[9], (LAS float*)(lds + XCH_OFF)};
        pg8::gemm_phase<pg8::EpiProj, pg8::StaticOrder, true, true>(lds, g, S, E, wave);
        p1_skinny(a, lds, vcu, G, wave, lane, tid);
    }
    GSYNC();
    {
#ifndef STAMP2_K
#define STAMP2_K -1
#endif
#define SUBSTAMP(i) do { if (STAMP2_K >= 0 && bx == 0 && wave == 0 && lane_id() == 0) ((unsigned long long*)(ws + 65536 + 1024))[i] = __builtin_amdgcn_s_memrealtime(); } while (0)
        SUBSTAMP(0);
        if (RUN(9)) fox_prep(a, lds, vcu, G, wave, lane, tid);
        sb_arrive(xbar, 0, wave == 0 && lane_id() == 0);
        for (int rep_ = 0; rep_ < REP_GL; ++rep_) if (RUN(2)) gla_local_all(a, lds, vcu, G, wave, lane, tid);
        sb_arrive(xbar, 1, wave == 0 && lane_id() == 0); SUBSTAMP(1);
        sb_wait(xbar, 0, wave == 0 && lane_id() == 0); SUBSTAMP(2);
        const attn_body::bf16* pj = (const attn_body::bf16*)(ws + WS_PROJ);
        float gqm = 0.f, gkm = 0.f;
        for (int i = 0; i < 64; ++i) { gqm = fmaxf(gqm, fabsf(a.in[8][i])); gkm = fmaxf(gkm, fabsf(a.in[9][i])); }
#ifndef ATTN_PRUNE
#define ATTN_PRUNE 1
#endif
        const float thr = ATTN_PRUNE ? 2.f * (64.f * gqm * gkm * C2 * 1.02f) + 48.f : 1e30f;
        const attn_body::AttnTensors AT{pj + 1536, pj + 2048, pj + 2560, (attn_body::bf16*)(ws + WS_MIX) + 512, small + 4 * M + 65536, thr};
        const attn_body::StaticOrder S(G, vcu);
        attn_body::AttnUnit u; bool scanned = false;
        for (int i = 0; S.next(i, u); ++i) {
            if (i == 1) { SUBSTAMP(3); sb_wait(xbar, 1, wave == 0 && lane_id() == 0); SUBSTAMP(4); gla_scan(a, vcu, G, tid); sb_arrive(xbar, 2, wave == 0 && lane_id() == 0); scanned = true; SUBSTAMP(5); }
            if (RUN(3)) attn_body::attn_unit<8>(u.bh / attn_body::NHEAD, u.bh % attn_body::NHEAD, u.qb, AT.Q, AT.K, AT.V, AT.O, AT.CB, AT.thr, (char*)lds_raw);
        }
        if (!scanned) { sb_wait(xbar, 1, wave == 0 && lane_id() == 0); gla_scan(a, vcu, G, tid); sb_arrive(xbar, 2, wave == 0 && lane_id() == 0); }
        SUBSTAMP(6); sb_wait(xbar, 2, wave == 0 && lane_id() == 0); SUBSTAMP(7);
        for (int rep_ = 0; rep_ < REP_GF; ++rep_) if (RUN(4)) { if (G == 256) { const int tf = 128 * (vcu >> 5) + 2 * (vcu & 31); gla_final2(a, lds, tf, wave, lane, tid); gla_final2(a, lds, tf + 64, wave, lane, tid); }
          else for (int task = 2 * vcu; task < 1024; task += 2 * G) gla_final2(a, lds, task, wave, lane, tid); }
        SUBSTAMP(8);
    }
    GSYNC();
    SUBSTAMP(9);
    if (RUN(5)) {   pg8::Gemm g{(const bf16*)(ws + WS_MIX), (const bf16*)(ws + WS_WO), M, DM, DM}; pg8::StaticOrder S; S.init(M / 256, DM / 256, G, bx);
        pg8::EpiRes<2> E{nullptr, xb, xb, ss2, DM};
        pg8::gemm_phase<pg8::EpiRes<2>, pg8::StaticOrder, true, true>(lds, g, S, E, wave);
    }
    GSYNC();
    for (int rep_ = 0; rep_ < REP_P6; ++rep_) if (RUN(6)) {   pg8::Gemm g{xb, (const bf16*)(ws + WS_WUP), M, 2 * FF, DM}; pg8::StaticOrder S; S.init(65, 2 * FF / 256, G, bx, 254, -2);
        {   LAS float* rsl = (LAS float*)(lds + RSL_OFF); pg8::Unit uu;
            for (int i = 0; i < 6 && S.next(i, uu); ++i) { const int r = tid; if (r < 256) { const int gr = uu.arow + r; rsl[i * 256 + r] = (gr >= 0 && gr < M) ? rsqrtf(ss2[gr] * (1.f / 1024.f) + EPS) : 0.f; } }
            LDS_SYNC(); }
        pg8::EpiUp E{(bf16*)(ws + WS_ACT), ss2, a.in[13], a.in[14], (LAS float*)(lds + XCH_OFF), (LAS float*)(lds + XCH_OFF + 8192 + 256), (LAS float*)(lds + RSL_OFF)};
        pg8::gemm_phase<pg8::EpiUp, pg8::StaticOrder, true, true>(lds, g, S, E, wave);
        {   const int nwg6 = 65 * (2 * FF / 256), rem = nwg6 % G, nl = rem ? G - rem : G, cl = rem ? bx - rem : bx;
            if (cl >= 0) { pg8::Gemm g2{(const bf16*)(ws + WS_PB), (const bf16*)(ws + WS_WPE), M, DM, PLE}; pg8::StaticOrder S2; S2.init(M / 256, DM / 256, nl, cl);
                pg8::EpiRes<0> E2{nullptr, nullptr, (bf16*)(ws + WS_E), ssE, DM};
                pg8::gemm_phase<pg8::EpiRes<0>, pg8::StaticOrder, true, true>(lds, g2, S2, E2, wave);
                p6_late_weights(a, lds, cl, nl, wave, lane); } }
    }
    GSYNC();
    if (RUN(7)) {   pg8::Gemm g{(const bf16*)(ws + WS_ACT), (const bf16*)(ws + WS_WD), M, DM, FF}; pg8::StaticOrder S; S.init(M / 256, DM / 256, G, bx);
        pg8::EpiRes<2> E{nullptr, xb, xb, ss3, DM};
        pg8::gemm_phase<pg8::EpiRes<2>, pg8::StaticOrder, true, true>(lds, g, S, E, wave);
    }
    GSYNC();
    if (RUN(8)) {   pg8::Gemm g{xb, (const bf16*)(ws + WS_WPG), M, DM, DM}; pg8::StaticOrder S; S.init(M / 256, DM / 256, G, bx);
        for (int rep_ = REP_P8 - 1; rep_ > 0; --rep_) { pg8::EpiGate Ed{xb, (float*)(ws + WS_PROJ), (const bf16*)(ws + WS_E), ss3, ssE, a.in[20], a.in[18], DM}; pg8::gemm_phase<pg8::EpiGate, pg8::StaticOrder, true, true>(lds, g, S, Ed, wave); }
        pg8::EpiGate E{xb, a.out, (const bf16*)(ws + WS_E), ss3, ssE, a.in[20], a.in[18], DM};
        pg8::gemm_phase<pg8::EpiGate, pg8::StaticOrder, true, true>(lds, g, S, E, wave);
    }
    if (STAMP2_K >= 0) { xcd_barrier(xbar, wave == 0 && lane_id() == 0);
        if (bx == 0 && wave == 0 && lane_id() == 0) { const unsigned long long* ts = (const unsigned long long*)(ws + 65536 + 1024);
            a.out[0] += 0.25f + (float)(ts[STAMP2_K + 1] - ts[STAMP2_K]) * 1e-4f; } }
    if (STAMP_K >= 0) { GSYNC();
        if (bx == 0 && wave == 0 && lane_id() == 0) { const unsigned long long* ts = (const unsigned long long*)(ws + 65536);
            a.out[0] += (float)(ts[STAMP_K + 1] - ts[STAMP_K]) * 1e-4f; } }
#undef lane
#undef tid
}
}

extern "C" void kernel_launch(void* const* d_in, const int* in_sizes, int n_in, void* d_out, int out_size, void* d_ws, size_t ws_size, hipStream_t stream) {
    static int grid = 0;
    if (grid == 0) {
        int dev = 0, cus = 0, per_cu = 0;
        hipGetDevice(&dev); hipDeviceGetAttribute(&cus, hipDeviceAttributeMultiprocessorCount, dev);
        hipFuncSetAttribute((const void*)mk::mk_fwd, hipFuncAttributeMaxDynamicSharedMemorySize, mk::LDS_BYTES);
        hipOccupancyMaxActiveBlocksPerMultiprocessor(&per_cu, (const void*)mk::mk_fwd, mk::NT, mk::LDS_BYTES);
        if (per_cu < 1) { fprintf(stderr, "kernel_launch: occupancy query says %d blocks per CU\n", per_cu); per_cu = 1; }
        grid = cus * per_cu;
        if (n_in != 21 || ws_size < mk::WS_END) { fprintf(stderr, "kernel_launch: unexpected n_in %d / ws %zu\n", n_in, ws_size); grid = -1; }
    }
    if (grid < 0) return;
#ifdef PROBE_MEMSET2
    (void)hipMemsetAsync((char*)d_ws + 131072, 0, 65536, stream);
#endif
    if (hipMemsetAsync(d_ws, 0, 65536, stream) != hipSuccess) { fprintf(stderr, "kernel_launch: memset of the barrier words failed\n"); return; }
    mk::Args a{};
    for (int i = 0; i < 21; ++i) a.in[i] = (const float*)d_in[i];
    a.out = (float*)d_out; a.ws = (unsigned char*)d_ws;
    hipLaunchKernelGGL(mk::mk_fwd, dim3(grid), dim3(mk::NT), mk::LDS_BYTES, stream, a);
    const hipError_t e = hipPeekAtLastError();
    if (e != hipSuccess) fprintf(stderr, "kernel_launch: launch failed: %s (grid %d)\n", hipGetErrorString(e), grid);
}
```

```cpp
#include <hip/hip_runtime.h>
#include <cstdio>
#include <cstdint>
__device__ __forceinline__ int lane_id() { int l; asm volatile("v_mbcnt_lo_u32_b32 %0, -1, 0\n\tv_mbcnt_hi_u32_b32 %0, -1, %0" : "=v"(l)); return l; }
namespace pg8 {
#define PG8_LAS __attribute__((address_space(3)))
typedef unsigned short bf16_t;
typedef short bf16x8 __attribute__((ext_vector_type(8)));
typedef float f32x4 __attribute__((ext_vector_type(4)));
typedef unsigned u32x4 __attribute__((ext_vector_type(4)));
constexpr int BM = 256, BK = 64, HALF = 128, HTB = HALF * BK * 2  , STAGE_BYTES = 8 * HTB, NXCD = 8, WGM = 8;

__host__ __device__ __forceinline__ int lds_byte(int r, int c) { const int st = (r >> 4) * 2 + (c >> 5), rr = r & 15, cc = c & 31, ob = rr * 64 + cc * 2; return st * 1024 + (ob ^ (((ob >> 9) & 1) << 5)); }
__host__ __device__ __forceinline__ void stage_rc(int b, int& R, int& C) { const int st = b / 1024, sb = b % 1024, swz = sb ^ (((sb >> 9) & 1) << 5); R = (st >> 1) * 16 + swz / 64; C = (st & 1) * 32 + (swz % 64) / 2; }
__host__ __device__ __forceinline__ int perm32(int rho) { const int n = rho >> 4, i = rho & 15; return 8 * (i >> 2) + 4 * n + (i & 3); }

struct Unit { int pm, pn, arow, idx; };
struct Gemm { const bf16_t* A; const bf16_t* Bt; int M, N, K; };

struct StaticOrder {
    int nM, nN, nwg, G, c, mstride, moff;
    __host__ __device__ void init(int nM_, int nN_, int G_, int c_, int mstride_ = 256, int moff_ = 0) { nM = nM_; nN = nN_; nwg = nM * nN; G = G_; c = c_; mstride = mstride_; moff = moff_; }
    __host__ __device__ bool next(int i, Unit& u) const {
        const long L = (long)i * G + c; if (L >= nwg) return false;
        int wgid = (int)L; { const int q = nwg / NXCD, r = nwg % NXCD, xcd = wgid % NXCD, off = wgid / NXCD; wgid = (xcd < r ? xcd * (q + 1) : r * (q + 1) + (xcd - r) * q) + off; }
        const int nig = WGM * nN, gid = wgid / nig, fm = gid * WGM, gsz = (nM - fm) < WGM ? (nM - fm) : WGM;
        u.pm = fm + ((wgid % nig) % gsz); u.pn = (wgid % nig) / gsz; u.arow = u.pm * mstride + moff; u.idx = i; return true;
    }
    __device__ __forceinline__ void a_ready(const Unit&) const {}
    __device__ __forceinline__ void done(const Unit&) const {}
};

__device__ __forceinline__ unsigned cvt_pk_bf16(float lo, float hi) { unsigned r; asm volatile("v_cvt_pk_bf16_f32 %0, %1, %2" : "=v"(r) : "v"(lo), "v"(hi)); return r; }
typedef float f32x2 __attribute__((ext_vector_type(2)));
typedef float f32x2 __attribute__((ext_vector_type(2)));
template <class Epi, class Sched, bool ALIGN_EPI = false, bool SP2 = false>
__device__ __forceinline__ void gemm_phase(PG8_LAS unsigned char* lds, const Gemm g, const Sched& S, const Epi& E, int wave_sgpr) {
    const int wid = wave_sgpr, lane = lane_id(), tid = wid * 64 + lane, wr = wid >> 2, wc = wid & 3, fr = lane & 15, fq = lane >> 4;
    const int K = g.K, nt = K / BK;
    unsigned voffA[2], voffB[2];
#pragma unroll
    for (int i = 0; i < 2; ++i) { int R, C; stage_rc(tid * 16 + i * 8192, R, C); const int Rb = Epi::PERM ? ((R & ~31) + perm32(R & 31)) : R;
        voffA[i] = (unsigned)(R * K + C) * 2u; voffB[i] = (unsigned)(Rb * K + C) * 2u; }
    const size_t kstep = (size_t)(BK * 2);
    const size_t hstep = (size_t)HALF * K * 2;
    const size_t tstep = 2 * hstep;
    const unsigned ldsw = (unsigned)wid * 1024u;
    const int aoff = lds_byte(wr * 64 + fr, fq * 8), boff = lds_byte(wc * 32 + fr, fq * 8);
#define PG8_SA(b, h) (((b) * 2 + (h)) * HTB)
#define PG8_SB(b, h) ((4 + (b) * 2 + (h)) * HTB)
#define PG8_STAGE(bufoff, gbase, voff) do { _Pragma("unroll") for (int _i = 0; _i < 2; ++_i) \
        __builtin_amdgcn_global_load_lds((const unsigned*)((const char*)(gbase) + (voff)[_i]), (PG8_LAS unsigned*)(lds + (bufoff) + ldsw + _i * 8192), 16, 0, 0); } while (0)
#define PG8_LDA(dst, b, h) do { _Pragma("unroll") for (int m = 0; m < 4; ++m) _Pragma("unroll") for (int k = 0; k < 2; ++k) dst[m][k] = *(const PG8_LAS bf16x8*)(lds + PG8_SA(b, h) + aoff + m * 2048 + k * 1024); } while (0)
#define PG8_LDB(dst, b, h) do { _Pragma("unroll") for (int n = 0; n < 2; ++n) _Pragma("unroll") for (int k = 0; k < 2; ++k) dst[n][k] = *(const PG8_LAS bf16x8*)(lds + PG8_SB(b, h) + boff + n * 2048 + k * 1024); } while (0)
#define PG8_MMA(ai, bj, At, Bt) do { __builtin_amdgcn_s_setprio(1); _Pragma("unroll") for (int m = 0; m < 4; ++m) _Pragma("unroll") for (int n = 0; n < 2; ++n) _Pragma("unroll") for (int k = 0; k < 2; ++k) \
        acc[ai][bj][m][n] = __builtin_amdgcn_mfma_f32_16x16x32_bf16(Bt[n][k], At[m][k], acc[ai][bj][m][n], 0, 0, 0); __builtin_amdgcn_s_setprio(0); } while (0)
#define PG8_WAIT_V(n) asm volatile("s_waitcnt vmcnt(" #n ")" ::: "memory")
#define PG8_WAIT_L(n) asm volatile("s_waitcnt lgkmcnt(" #n ")" ::: "memory")
#define PG8_BAR __builtin_amdgcn_s_barrier()
#define PG8_SCHED __builtin_amdgcn_sched_barrier(0)
    Unit cur, nxt; int ui = 0;
    if (!S.next(0, cur)) return;
    f32x4 acc[2][2][4][2];
#pragma unroll
    for (int a = 0; a < 2; ++a)
#pragma unroll
        for (int b = 0; b < 2; ++b)
#pragma unroll
            for (int m = 0; m < 4; ++m)
#pragma unroll
                for (int n = 0; n < 2; ++n) acc[a][b][m][n] = (f32x4){0.f, 0.f, 0.f, 0.f};
    bf16x8 At[4][2], B0[2][2], B1[2][2];
    const char* cA = (const char*)g.A + (long)cur.arow * (long)(K * 2); const char* cB = (const char*)g.Bt + (size_t)cur.pn * tstep;
    S.a_ready(cur);
    if constexpr (SP2) {
        PG8_STAGE(PG8_SB(0, 0), cB, voffB); PG8_STAGE(PG8_SB(0, 1), cB + hstep, voffB); PG8_STAGE(PG8_SA(0, 0), cA, voffA); PG8_STAGE(PG8_SA(0, 1), cA + hstep, voffA);
        if (wr == 1) PG8_BAR;
        PG8_WAIT_V(2); PG8_BAR;
        PG8_STAGE(PG8_SB(1, 0), cB + kstep, voffB); PG8_STAGE(PG8_SA(1, 0), cA + kstep, voffA); PG8_STAGE(PG8_SB(1, 1), cB + hstep + kstep, voffB);
        PG8_WAIT_V(6); PG8_BAR;
    } else {
        PG8_STAGE(PG8_SB(0, 0), cB, voffB); PG8_STAGE(PG8_SA(0, 0), cA, voffA); PG8_STAGE(PG8_SB(0, 1), cB + hstep, voffB); PG8_STAGE(PG8_SA(0, 1), cA + hstep, voffA);
        if (wr == 1) PG8_BAR;
        PG8_WAIT_V(4); PG8_BAR;
        PG8_STAGE(PG8_SB(1, 0), cB + kstep, voffB); PG8_STAGE(PG8_SA(1, 0), cA + kstep, voffA); PG8_STAGE(PG8_SB(1, 1), cB + hstep + kstep, voffB);
        PG8_WAIT_V(6); PG8_BAR;
    }
    for (;;) {
        const bool has_next = S.next(ui + 1, nxt);
        const char* nA = has_next ? (const char*)g.A + (long)nxt.arow * (long)(K * 2) : cA; const char* nB = has_next ? (const char*)g.Bt + (size_t)nxt.pn * tstep : cB;
        for (int t = 0; t < nt; t += 2) {
            const bool last = (t == nt - 2);
            const char* a1 = cA + (size_t)(t + 1) * kstep;
            const char* a2 = last ? nA : cA + (size_t)(t + 2) * kstep; const char* b2 = last ? nB : cB + (size_t)(t + 2) * kstep;
            const char* a3 = a2 + kstep; const char* b3 = b2 + kstep;
            if (last && has_next) S.a_ready(nxt);
            if constexpr (SP2) {
            PG8_LDB(B0, 0, 0); PG8_LDB(B1, 0, 1); PG8_SCHED; PG8_LDA(At, 0, 0); PG8_STAGE(PG8_SA(1, 1), a1 + hstep, voffA);
            PG8_WAIT_V(8); PG8_WAIT_L(0); PG8_BAR; PG8_MMA(0, 0, At, B0); PG8_MMA(0, 1, At, B1); PG8_BAR; PG8_SCHED;
            PG8_LDA(At, 0, 1); PG8_STAGE(PG8_SB(0, 0), b2, voffB); PG8_STAGE(PG8_SB(0, 1), b2 + hstep, voffB); PG8_STAGE(PG8_SA(0, 0), a2, voffA);
            PG8_WAIT_V(8); PG8_WAIT_L(0); PG8_BAR; PG8_MMA(1, 0, At, B0); PG8_MMA(1, 1, At, B1); PG8_BAR; PG8_SCHED;
            PG8_LDB(B0, 1, 0); PG8_LDB(B1, 1, 1); PG8_SCHED; PG8_LDA(At, 1, 0); PG8_STAGE(PG8_SA(0, 1), a2 + hstep, voffA);
            PG8_WAIT_V(8); PG8_WAIT_L(0); PG8_BAR; PG8_MMA(0, 0, At, B0); PG8_MMA(0, 1, At, B1); PG8_BAR; PG8_SCHED;
            PG8_LDA(At, 1, 1); PG8_STAGE(PG8_SB(1, 0), b3, voffB); PG8_STAGE(PG8_SB(1, 1), b3 + hstep, voffB); PG8_STAGE(PG8_SA(1, 0), a3, voffA);
            PG8_WAIT_V(8); PG8_WAIT_L(0); PG8_BAR; PG8_MMA(1, 0, At, B0); PG8_MMA(1, 1, At, B1); PG8_BAR; PG8_SCHED;
            } else {
            PG8_LDB(B0, 0, 0); PG8_SCHED; PG8_LDA(At, 0, 0); PG8_STAGE(PG8_SA(1, 1), a1 + hstep, voffA);
            PG8_WAIT_L(8); PG8_BAR; PG8_WAIT_L(0); PG8_MMA(0, 0, At, B0); PG8_BAR; PG8_SCHED;
            PG8_LDB(B1, 0, 1); PG8_STAGE(PG8_SB(0, 0), b2, voffB);
            PG8_BAR; PG8_WAIT_L(0); PG8_MMA(0, 1, At, B1); PG8_BAR;
            PG8_LDA(At, 0, 1); PG8_STAGE(PG8_SA(0, 0), a2, voffA);
            PG8_BAR; PG8_WAIT_L(0); PG8_MMA(1, 0, At, B0); PG8_BAR; PG8_SCHED;
            PG8_STAGE(PG8_SB(0, 1), b2 + hstep, voffB);
            PG8_WAIT_V(6); PG8_BAR; PG8_MMA(1, 1, At, B1); PG8_BAR;
            PG8_LDB(B0, 1, 0); PG8_SCHED; PG8_LDA(At, 1, 0); PG8_STAGE(PG8_SA(0, 1), a2 + hstep, voffA);
            PG8_WAIT_L(8); PG8_BAR; PG8_WAIT_L(0); PG8_MMA(0, 0, At, B0); PG8_BAR; PG8_SCHED;
            PG8_LDB(B1, 1, 1); PG8_STAGE(PG8_SB(1, 0), b3, voffB);
            PG8_BAR; PG8_WAIT_L(0); PG8_MMA(0, 1, At, B1); PG8_BAR;
            PG8_LDA(At, 1, 1); PG8_STAGE(PG8_SA(1, 0), a3, voffA);
            PG8_BAR; PG8_WAIT_L(0); PG8_MMA(1, 0, At, B0); PG8_BAR; PG8_SCHED;
            PG8_STAGE(PG8_SB(1, 1), b3 + hstep, voffB);
            PG8_WAIT_V(6); PG8_BAR; PG8_MMA(1, 1, At, B1); PG8_BAR;
            }
        }
        if constexpr (ALIGN_EPI) { if (wr == 0) PG8_BAR; }
        if constexpr (!Epi::AFTER_DRAIN) { E(acc, cur, wr, wc, fr, fq); S.done(cur); }
        if (!has_next) break;
#pragma unroll
        for (int a = 0; a < 2; ++a)
#pragma unroll
            for (int b = 0; b < 2; ++b)
#pragma unroll
                for (int m = 0; m < 4; ++m)
#pragma unroll
                    for (int n = 0; n < 2; ++n) acc[a][b][m][n] = (f32x4){0.f, 0.f, 0.f, 0.f};
        cur = nxt; cA = nA; cB = nB; ++ui;
        if constexpr (ALIGN_EPI) { if (wr == 1) PG8_BAR; }
    }
    PG8_WAIT_V(0);
    if constexpr (!ALIGN_EPI) { if (wr == 0) PG8_BAR; }
    PG8_BAR;
    if constexpr (Epi::AFTER_DRAIN) { E.fused(acc, cur, wr, wc, fr, fq, lds, wid, lane); S.done(cur); }
#undef PG8_SA
#undef PG8_SB
#undef PG8_STAGE
#undef PG8_LDA
#undef PG8_LDB
#undef PG8_MMA
#undef PG8_WAIT_V
#undef PG8_WAIT_L
#undef PG8_BAR
#undef PG8_SCHED
}
}
namespace pg8 {
constexpr float RMS_EPS = 1e-6f;
typedef unsigned u32x2 __attribute__((ext_vector_type(2)));
template <int CTRL> __device__ __forceinline__ float dpp_mov(float old, float src) {
    return __builtin_bit_cast(float, __builtin_amdgcn_update_dpp(__builtin_bit_cast(int, old), __builtin_bit_cast(int, src), CTRL, 0xf, 0xf, false)); }
__device__ __forceinline__ float bf_lo(unsigned w) { return __builtin_bit_cast(float, w << 16); }
__device__ __forceinline__ float bf_hi(unsigned w) { return __builtin_bit_cast(float, w & 0xffff0000u); }

struct EpiScaleBf16 {
    static constexpr bool PERM = true, AFTER_DRAIN = false;
    bf16_t* O; int ldc; const float* rs;
    __device__ __forceinline__ void operator()(const f32x4 (&acc)[2][2][4][2], const Unit& u, int wr, int wc, int fr, int fq) const {
        const int row0 = u.pm * BM + wr * 64 + fr, col0 = u.pn * BM + wc * 32 + 8 * fq;
        float sc[2][4];
#pragma unroll
        for (int ai = 0; ai < 2; ++ai)
#pragma unroll
            for (int m = 0; m < 4; ++m) sc[ai][m] = rs[row0 + ai * HALF + m * 16];
#pragma unroll
        for (int ai = 0; ai < 2; ++ai)
#pragma unroll
            for (int m = 0; m < 4; ++m) { const int r = row0 + ai * HALF + m * 16; const float s = sc[ai][m]; bf16_t* rowp = O + (size_t)r * ldc + col0;
#pragma unroll
                for (int bj = 0; bj < 2; ++bj) { const f32x4 v0 = acc[ai][bj][m][0] * s, v1 = acc[ai][bj][m][1] * s;
                    u32x4 w; w.x = cvt_pk_bf16(v0[0], v0[1]); w.y = cvt_pk_bf16(v0[2], v0[3]); w.z = cvt_pk_bf16(v1[0], v1[1]); w.w = cvt_pk_bf16(v1[2], v1[3]);
                    *(u32x4*)(rowp + bj * HALF) = w; } }
    }
};
struct EpiProj {
    static constexpr bool PERM = true, AFTER_DRAIN = false;
    bf16_t* O; int ldc; const float* rs; const float* gq; const float* gk; PG8_LAS float* part;
    __device__ __forceinline__ void operator()(f32x4 (&acc)[2][2][4][2], const Unit& u, int wr, int wc, int fr, int fq) const {
        const int row0 = u.pm * BM + wr * 64 + fr, col0 = u.pn * BM + wc * 32 + 8 * fq;
        float sc[2][4];
#pragma unroll
        for (int ai = 0; ai < 2; ++ai)
#pragma unroll
            for (int m = 0; m < 4; ++m) sc[ai][m] = rs[row0 + ai * HALF + m * 16];
        const bool fox = (u.pn >= 6 && u.pn < 10);
        if (!fox) {
#pragma unroll
            for (int ai = 0; ai < 2; ++ai)
#pragma unroll
                for (int m = 0; m < 4; ++m) { const int r = row0 + ai * HALF + m * 16; const float s = sc[ai][m]; bf16_t* rowp = O + (size_t)r * ldc + col0;
#pragma unroll
                    for (int bj = 0; bj < 2; ++bj) { const f32x4 v0 = acc[ai][bj][m][0] * s, v1 = acc[ai][bj][m][1] * s;
                        u32x4 w; w.x = cvt_pk_bf16(v0[0], v0[1]); w.y = cvt_pk_bf16(v0[2], v0[3]); w.z = cvt_pk_bf16(v1[0], v1[1]); w.w = cvt_pk_bf16(v1[2], v1[3]);
                        *(u32x4*)(rowp + bj * HALF) = w; } }
        } else {
#pragma unroll
            for (int ai = 0; ai < 2; ++ai)
#pragma unroll
                for (int m = 0; m < 4; ++m) { const float s = sc[ai][m]; const int rl = ai * HALF + wr * 64 + m * 16 + fr;
#pragma unroll
                    for (int bj = 0; bj < 2; ++bj) { acc[ai][bj][m][0] *= s; acc[ai][bj][m][1] *= s; const f32x4 v0 = acc[ai][bj][m][0], v1 = acc[ai][bj][m][1];
                        float q = (v0[0] * v0[0] + v0[1] * v0[1]) + (v0[2] * v0[2] + v0[3] * v0[3]) + (v1[0] * v1[0] + v1[1] * v1[1]) + (v1[2] * v1[2] + v1[3] * v1[3]);
                        q += __shfl_xor(q, 16); q += __shfl_xor(q, 32);
                        if (fq == 0) part[(wc * 2 + bj) * 256 + rl] = q; } }
            const float* gp = (u.pn < 8 ? gq : gk) + 32 * (wc & 1) + 8 * fq; const f32x4 g0 = *(const f32x4*)gp, g1 = *(const f32x4*)(gp + 4);
            asm volatile("s_waitcnt lgkmcnt(0)\n\ts_barrier" ::: "memory");
            const float mul = u.pn < 8 ? 0.125f * 1.4426950408889634f : 1.f;
#pragma unroll
            for (int ai = 0; ai < 2; ++ai)
#pragma unroll
                for (int m = 0; m < 4; ++m) { const int rl = ai * HALF + wr * 64 + m * 16 + fr; bf16_t* rowp = O + (size_t)(u.pm * BM + rl) * ldc + col0;
#pragma unroll
                    for (int bj = 0; bj < 2; ++bj) { const float tot = part[(wc * 2 + bj) * 256 + rl] + part[((wc ^ 1) * 2 + bj) * 256 + rl];
                        const float r = rsqrtf(tot * (1.f / 64.f) + RMS_EPS) * mul; const f32x4 v0 = acc[ai][bj][m][0] * r * g0, v1 = acc[ai][bj][m][1] * r * g1;
                        u32x4 w; w.x = cvt_pk_bf16(v0[0], v0[1]); w.y = cvt_pk_bf16(v0[2], v0[3]); w.z = cvt_pk_bf16(v1[0], v1[1]); w.w = cvt_pk_bf16(v1[2], v1[3]);
                        *(u32x4*)(rowp + bj * HALF) = w; } }
        }
    }
};
template <int BASE> struct EpiRes {
    static constexpr bool PERM = true, AFTER_DRAIN = false;
    const float* basef; const bf16_t* baseb; bf16_t* outb; float* ss; int ldc;
    __device__ __forceinline__ void operator()(const f32x4 (&acc)[2][2][4][2], const Unit& u, int wr, int wc, int fr, int fq) const {
        const int row0 = u.pm * BM + wr * 64 + fr, col0 = u.pn * BM + wc * 32 + 8 * fq;
        u32x4 preb[2][4][2];
        if (BASE == 2) {
#pragma unroll
            for (int ai = 0; ai < 2; ++ai)
#pragma unroll
                for (int m = 0; m < 4; ++m)
#pragma unroll
                    for (int bj = 0; bj < 2; ++bj) preb[ai][m][bj] = *(const u32x4*)(baseb + (size_t)(row0 + ai * HALF + m * 16) * ldc + col0 + bj * HALF);
            asm volatile("" ::: "memory");
        }
#pragma unroll
        for (int ai = 0; ai < 2; ++ai)
#pragma unroll
          for (int mp = 0; mp < 2; ++mp) {
            f32x4 pre[2][2][2];
            if (BASE == 1) {
#pragma unroll
                for (int mm = 0; mm < 2; ++mm)
#pragma unroll
                    for (int bj = 0; bj < 2; ++bj) { const size_t off = (size_t)(row0 + ai * HALF + (2 * mp + mm) * 16) * ldc + col0 + bj * HALF;
                        pre[mm][bj][0] = *(const f32x4*)(basef + off); pre[mm][bj][1] = *(const f32x4*)(basef + off + 4); }
                asm volatile("" ::: "memory");
            }
#pragma unroll
            for (int mm = 0; mm < 2; ++mm) { const int m = 2 * mp + mm; const int r = row0 + ai * HALF + m * 16; float q = 0.f;
#pragma unroll
                for (int bj = 0; bj < 2; ++bj) { const size_t off = (size_t)r * ldc + col0 + bj * HALF;
                    f32x4 v0 = acc[ai][bj][m][0], v1 = acc[ai][bj][m][1];
                    if (BASE == 1) { v0 += pre[mm][bj][0]; v1 += pre[mm][bj][1]; }
                    if (BASE == 2) { const u32x4 b = preb[ai][m][bj]; v0 += (f32x4){bf_lo(b.x), bf_hi(b.x), bf_lo(b.y), bf_hi(b.y)}; v1 += (f32x4){bf_lo(b.z), bf_hi(b.z), bf_lo(b.w), bf_hi(b.w)}; }
                    u32x4 w; w.x = cvt_pk_bf16(v0[0], v0[1]); w.y = cvt_pk_bf16(v0[2], v0[3]); w.z = cvt_pk_bf16(v1[0], v1[1]); w.w = cvt_pk_bf16(v1[2], v1[3]);
                    *(u32x4*)(outb + off) = w;
                    q += (v0[0] * v0[0] + v0[1] * v0[1]) + (v0[2] * v0[2] + v0[3] * v0[3]) + (v1[0] * v1[0] + v1[1] * v1[1]) + (v1[2] * v1[2] + v1[3] * v1[3]); }
                q += __shfl_xor(q, 16); q += __shfl_xor(q, 32);
                if (fq == 0) atomicAdd(ss + r, q); }
          }
    }
};
struct EpiGate {
    static constexpr bool PERM = true, AFTER_DRAIN = false;
    const bf16_t* x2; float* out; const bf16_t* E; const float* ss3; const float* ssE; const float* bpg; const float* peg; int ldc;
    __device__ __forceinline__ void operator()(const f32x4 (&acc)[2][2][4][2], const Unit& u, int wr, int wc, int fr, int fq) const {
        const int row0 = u.pm * BM + wr * 64 + fr, col0 = u.pn * BM + wc * 32 + 8 * fq;
        f32x4 bp[2][2], pg[2][2];
#pragma unroll
        for (int bj = 0; bj < 2; ++bj)
#pragma unroll
            for (int n = 0; n < 2; ++n) { bp[bj][n] = *(const f32x4*)(bpg + col0 + bj * HALF + 4 * n); pg[bj][n] = *(const f32x4*)(peg + col0 + bj * HALF + 4 * n); }
#pragma unroll
        for (int ai = 0; ai < 2; ++ai)
#pragma unroll
            for (int mp = 0; mp < 2; ++mp) {
                u32x4 xw[2][2]; u32x4 ew[2][2];
                float s3[2], sE[2];
#pragma unroll
                for (int mm = 0; mm < 2; ++mm) { const int r = row0 + ai * HALF + (2 * mp + mm) * 16; s3[mm] = ss3[r]; sE[mm] = ssE[r]; }
#pragma unroll
                for (int mm = 0; mm < 2; ++mm)
#pragma unroll
                    for (int bj = 0; bj < 2; ++bj) { const size_t off = (size_t)(row0 + ai * HALF + (2 * mp + mm) * 16) * ldc + col0 + bj * HALF;
                        xw[mm][bj] = *(const u32x4*)(x2 + off); ew[mm][bj] = *(const u32x4*)(E + off); }
                asm volatile("" ::: "memory");
#pragma unroll
                for (int mm = 0; mm < 2; ++mm) { const int m = 2 * mp + mm; const int r = row0 + ai * HALF + m * 16;
                    const float r3 = rsqrtf(s3[mm] * (1.f / 1024.f) + RMS_EPS), rE = rsqrtf(sE[mm] * (1.f / 1024.f) + RMS_EPS);
#pragma unroll
                    for (int bj = 0; bj < 2; ++bj) { const size_t off = (size_t)r * ldc + col0 + bj * HALF; const u32x4 w = ew[mm][bj];
                        const float ev[8] = {bf_lo(w.x), bf_hi(w.x), bf_lo(w.y), bf_hi(w.y), bf_lo(w.z), bf_hi(w.z), bf_lo(w.w), bf_hi(w.w)};
                        const u32x4 xq = xw[mm][bj]; const float xv8[8] = {bf_lo(xq.x), bf_hi(xq.x), bf_lo(xq.y), bf_hi(xq.y), bf_lo(xq.z), bf_hi(xq.z), bf_lo(xq.w), bf_hi(xq.w)};
#pragma unroll
                        for (int n = 0; n < 2; ++n) { f32x4 o;
#pragma unroll
                            for (int i = 0; i < 4; ++i) { const float z = acc[ai][bj][m][n][i] * r3 + bp[bj][n][i]; const float g = __builtin_amdgcn_rcpf(1.f + __expf(-z));
                                o[i] = xv8[4 * n + i] + g * (ev[4 * n + i] * rE * pg[bj][n][i]); }
                            *(f32x4*)(out + off + 4 * n) = o; } } }
                asm volatile("" ::: "memory");
            }
    }
};
struct EpiUp {
    static constexpr bool PERM = true, AFTER_DRAIN = false;
    bf16_t* act; const float* ss2; const float* cw; const float* cb; PG8_LAS float* xch; PG8_LAS float* taps; PG8_LAS float* rsl;
    __device__ __forceinline__ void operator()(f32x4 (&acc)[2][2][4][2], const Unit& u, int wr, int wc, int fr, int fq) const {
        constexpr int FF = 2816, MROWS = 16384;
        const int tid_ = (wr * 4 + wc) * 64 + fq * 16 + fr; f32x4 tapv;
        if (tid_ < 256) { const int r = tid_ >> 5, c4 = tid_ & 31, kind = r & 3, half = r >> 2;
            tapv = *(const f32x4*)((kind < 3 ? cw + kind * 2 * FF : cb) + half * FF + u.pn * HALF + 4 * c4); }
#pragma unroll
        for (int ai = 0; ai < 2; ++ai)
#pragma unroll
            for (int m = 0; m < 4; ++m) { const int rt_ = ai * HALF + wr * 64 + m * 16 + fr, gr = u.arow + rt_;
                float s;
                if (u.idx < 6) s = rsl[u.idx * 256 + rt_];
                else s = (gr >= 0 && gr < MROWS) ? rsqrtf(ss2[gr] * (1.f / 1024.f) + RMS_EPS) : 0.f;
#pragma unroll
                for (int bj = 0; bj < 2; ++bj)
#pragma unroll
                    for (int n = 0; n < 2; ++n) acc[ai][bj][m][n] *= s; }
        const int cl0 = wc * 32 + 8 * fq;
        if (fr >= 14) {
#pragma unroll
            for (int ai = 0; ai < 2; ++ai)
#pragma unroll
                for (int bj = 0; bj < 2; ++bj)
#pragma unroll
                    for (int n = 0; n < 2; ++n) *(PG8_LAS f32x4*)(xch + ((ai * 2 + wr) * 2 + (fr - 14)) * 256 + bj * HALF + cl0 + 4 * n) = acc[ai][bj][3][n];
        }
        if (tid_ < 256) *(PG8_LAS f32x4*)(taps + (tid_ >> 5) * 128 + 4 * (tid_ & 31)) = tapv;
        asm volatile("s_waitcnt lgkmcnt(0)\n\ts_barrier" ::: "memory");
        const int ch0 = u.pn * HALF + cl0;
        const bool seqstart = ((u.arow - 1 + 2047 + 2048) / 2048) <= ((u.arow + 255 + 2048) / 2048);
#pragma unroll
        for (int n = 0; n < 2; ++n) {
            f32x4 w0[2], w1[2], w2[2], bb[2];
#pragma unroll
            for (int bj = 0; bj < 2; ++bj) { const PG8_LAS float* tp = taps + bj * 512 + cl0 + 4 * n;
                w0[bj] = *(const PG8_LAS f32x4*)tp; w1[bj] = *(const PG8_LAS f32x4*)(tp + 128); w2[bj] = *(const PG8_LAS f32x4*)(tp + 256); bb[bj] = *(const PG8_LAS f32x4*)(tp + 384); }
#pragma unroll
            for (int ai = 0; ai < 2; ++ai) {
                const int g = ai * 2 + wr;
#pragma unroll
                for (int m = 0; m < 4; ++m) {
                    const int rt = ai * HALF + wr * 64 + m * 16 + fr, gr = u.arow + rt, t = gr & 2047;
                    f32x4 cv[2];
#pragma unroll
                    for (int bj = 0; bj < 2; ++bj) {
                        const f32x4 cur = acc[ai][bj][m][n]; f32x4 prev;
                        if (m > 0) prev = acc[ai][bj][m - 1][n];
                        else { prev = (f32x4){0.f, 0.f, 0.f, 0.f}; if (g > 0 && fr >= 14) prev = *(const PG8_LAS f32x4*)(xch + ((g - 1) * 2 + (fr - 14)) * 256 + bj * HALF + cl0 + 4 * n); }
                        f32x4 p1, p2;
#pragma unroll
                        for (int i = 0; i < 4; ++i) {
                            const float r1 = dpp_mov<0x121>(0.f, prev[i]), r2 = dpp_mov<0x122>(0.f, prev[i]);
                            p1[i] = dpp_mov<0x111>(r1, cur[i]); p2[i] = dpp_mov<0x112>(r2, cur[i]);
                        }
                        if (seqstart) { if (t == 0) { p1 = (f32x4){0.f, 0.f, 0.f, 0.f}; } if (t <= 1) { p2 = (f32x4){0.f, 0.f, 0.f, 0.f}; } }
                        cv[bj] = bb[bj] + w2[bj] * cur + w1[bj] * p1 + w0[bj] * p2;
                    }
                    float a4[4];
#pragma unroll
                    for (int i = 0; i < 4; ++i) { const float gv = cv[0][i]; a4[i] = gv * __builtin_amdgcn_rcpf(1.f + __expf(-gv)) * cv[1][i]; }
                    u32x2 w; w.x = cvt_pk_bf16(a4[0], a4[1]); w.y = cvt_pk_bf16(a4[2], a4[3]);
                    if (rt >= 2 && gr < MROWS) *(u32x2*)(act + (size_t)gr * FF + ch0 + 4 * n) = w;
                }
            }
        }
    }
};
}
#include <hip/hip_bf16.h>
#include <cmath>
namespace attn_body {
using bf16=__hip_bfloat16;
using bf16x8=__attribute__((ext_vector_type(8)))short;
using s16x4=__attribute__((ext_vector_type(4)))short;
using f32x16=__attribute__((ext_vector_type(16)))float;
using u32x4=__attribute__((ext_vector_type(4)))unsigned;
constexpr int BATCH=8,NHEAD=8,SEQ=2048,D=64,DM=3072,OM=1024;
constexpr int NW=8,QBLK=32,QB=QBLK*NW,KVBLK=64,NQB=SEQ/QB;
constexpr int ATTN_PITCH=DM, ATTN_UNIT_ROWS=QB;
__device__ __forceinline__ int crow(int r,int hi){return (r&3)+8*(r>>2)+4*hi;}
#define SBAR() __builtin_amdgcn_sched_barrier(0)
__device__ __forceinline__ void cmask(f32x16&p0,f32x16&p1,int jb,int qrel,int hi){
  const float NEG=-INFINITY; int kb=64*jb+4*hi;
  #pragma unroll
  for(int r=0;r<16;++r){int kv=kb+(r&3)+8*(r>>2); if(kv>qrel)p0[r]=NEG; if(kv+32>qrel)p1[r]=NEG;}
}

constexpr int NSLOT=3, SLOTB=8192;
constexpr int LDS_K=0, LDS_V=NSLOT*SLOTB, LDS_WS=2*NSLOT*SLOTB, LDS_OST=LDS_WS+NW*64*4, LDS_CB=LDS_OST+NW*4096, LDS_BYTES=LDS_CB+8192;
constexpr float C2=0.125f*1.4426950408889634f;
__device__ __forceinline__ void glds16(const void*gsrc,unsigned lds_dst){unsigned keep;
  asm volatile("s_mov_b32 %0, m0\n\ts_mov_b32 m0, %2\n\ts_nop 0\n\tglobal_load_lds_dwordx4 %1, off\n\ts_mov_b32 m0, %0":"=&s"(keep):"v"(gsrc),"s"(lds_dst):"memory");}
__device__ __forceinline__ float max3f(float a,float b,float c){float r;asm("v_max3_f32 %0, %1, %2, %3":"=v"(r):"v"(a),"v"(b),"v"(c));return r;}
__device__ __forceinline__ float max2f(float a,float b){float r;asm("v_max_f32_e32 %0, %1, %2":"=v"(r):"v"(a),"v"(b));return r;}
__device__ __forceinline__ float fadd_s(float a,float b){float r;asm("v_add_f32_e32 %0, %1, %2":"=v"(r):"v"(a),"v"(b));return r;}
__device__ __forceinline__ float fsub_s(float a,float b){float r;asm("v_sub_f32_e32 %0, %1, %2":"=v"(r):"v"(a),"v"(b));return r;}
typedef float f32x2_t __attribute__((ext_vector_type(2))); typedef __bf16 bf16x2_t __attribute__((ext_vector_type(2)));
__device__ __forceinline__ unsigned cvtpk_s(float lo,float hi){f32x2_t v={lo,hi};bf16x2_t b=__builtin_convertvector(v,bf16x2_t);return __builtin_bit_cast(unsigned,b);}
#define WAIT_BAR(N) asm volatile("s_waitcnt vmcnt(" #N ") lgkmcnt(0)\n\ts_barrier":::"memory")

__device__ __forceinline__ void qkt(f32x16&p0,f32x16&p1,const char*Kslot,const bf16x8*qr,const f32x16&negm,int r32,int hi){
  const char*kb=Kslot+hi*1024+r32*16;
  #pragma unroll
  for(int d0=0;d0<4;++d0){
    const bf16x8 b0=*reinterpret_cast<const bf16x8*>(kb+d0*2048);
    const bf16x8 b1=*reinterpret_cast<const bf16x8*>(kb+d0*2048+512);
    if(d0==0){p0=__builtin_amdgcn_mfma_f32_32x32x16_bf16(b0,qr[0],negm,0,0,0);p1=__builtin_amdgcn_mfma_f32_32x32x16_bf16(b1,qr[0],negm,0,0,0);}
    else{p0=__builtin_amdgcn_mfma_f32_32x32x16_bf16(b0,qr[d0],p0,0,0,0);p1=__builtin_amdgcn_mfma_f32_32x32x16_bf16(b1,qr[d0],p1,0,0,0);}}
}
typedef __attribute__((address_space(3))) const char* lds_cptr;
typedef short v4i16_t __attribute__((ext_vector_type(4)));
__device__ __forceinline__ void kload8(bf16x8*kf,lds_cptr kp){
  kf[0]=*(const __attribute__((address_space(3))) bf16x8*)(kp);      kf[1]=*(const __attribute__((address_space(3))) bf16x8*)(kp+512);
  kf[2]=*(const __attribute__((address_space(3))) bf16x8*)(kp+2048); kf[3]=*(const __attribute__((address_space(3))) bf16x8*)(kp+2560);
  kf[4]=*(const __attribute__((address_space(3))) bf16x8*)(kp+4096); kf[5]=*(const __attribute__((address_space(3))) bf16x8*)(kp+4608);
  kf[6]=*(const __attribute__((address_space(3))) bf16x8*)(kp+6144); kf[7]=*(const __attribute__((address_space(3))) bf16x8*)(kp+6656);
}
__device__ __forceinline__ void kload2(bf16x8*kf,lds_cptr kp,int j){ kf[2*j]=*(const __attribute__((address_space(3))) bf16x8*)(kp+j*2048); kf[2*j+1]=*(const __attribute__((address_space(3))) bf16x8*)(kp+j*2048+512); }
__device__ __forceinline__ s16x4 vtr(lds_cptr p){ return __builtin_bit_cast(s16x4,__builtin_amdgcn_ds_read_tr16_b64_v4i16((__attribute__((address_space(3))) v4i16_t*)p)); }
__device__ __forceinline__ float rowmax(const f32x16&p0,const f32x16&p1){
  float a=max3f(p0[0],p0[1],p1[0]),b=max3f(p0[2],p0[3],p1[1]);a=max3f(a,p1[2],p1[3]);
  #pragma unroll
  for(int r=4;r<16;r+=4){a=max3f(a,p0[r],p0[r+1]);b=max3f(b,p0[r+2],p0[r+3]);a=max3f(a,p1[r],p1[r+1]);b=max3f(b,p1[r+2],p1[r+3]);}
  const float m=max2f(a,b);
  auto rr=__builtin_amdgcn_permlane32_swap(__float_as_uint(m),__float_as_uint(m),false,false);
  return max2f(__uint_as_float(rr[0]),__uint_as_float(rr[1]));
}
__device__ __forceinline__ void pv(f32x16*o,int vb,bf16x8 pa0,bf16x8 pa1,bf16x8 pa2,bf16x8 pa3){
  #pragma unroll
  for(int d0=0;d0<2;++d0){s16x4 lo[4],hi[4];
    #pragma unroll
    for(int ks=0;ks<4;++ks){
      asm volatile("ds_read_b64_tr_b16 %0,%1 offset:%c2":"=&v"(lo[ks]):"v"(vb),"i"(d0*4096+ks*1024):"memory");
      asm volatile("ds_read_b64_tr_b16 %0,%1 offset:%c2":"=&v"(hi[ks]):"v"(vb),"i"(d0*4096+ks*1024+512):"memory");}
    asm volatile("s_waitcnt lgkmcnt(0)":::"memory");SBAR();
    #define PK(k) (bf16x8){lo[k][0],lo[k][1],lo[k][2],lo[k][3],hi[k][0],hi[k][1],hi[k][2],hi[k][3]}
    o[d0]=__builtin_amdgcn_mfma_f32_32x32x16_bf16(pa0,PK(0),o[d0],0,0,0);
    o[d0]=__builtin_amdgcn_mfma_f32_32x32x16_bf16(pa1,PK(1),o[d0],0,0,0);
    o[d0]=__builtin_amdgcn_mfma_f32_32x32x16_bf16(pa2,PK(2),o[d0],0,0,0);
    o[d0]=__builtin_amdgcn_mfma_f32_32x32x16_bf16(pa3,PK(3),o[d0],0,0,0);
    #undef PK
  }
}

#ifndef ATTN_STORE16
#define ATTN_STORE16(p,v) (*(u32x4*)(p)=(v))
#endif
template<int THRL> __device__ __forceinline__ void attn_unit(int b,int h,int qb,const bf16*Q,const bf16*__restrict__ K,const bf16*__restrict__ V,bf16*O,const float*__restrict__ CB,float thr,char*shm){
  const int tid=threadIdx.x,lane=tid&63,r32=lane&31,hi=lane>>5; const int wid=__builtin_amdgcn_readfirstlane(tid>>6);
  const long rowbase=(long)b*SEQ; const int q0=qb*QB;
  const float*cgp_=CB+(long)(b*NHEAD+h)*SEQ; const float cref_=cgp_[q0];
  const int nt4_=(q0+QB)/KVBLK-4;
  const bool need_=((threadIdx.x&63)<nt4_) && ((cgp_[64*(threadIdx.x&63)+63]-cref_)<=thr);
  const int tn_=nt4_-__popcll(__ballot(need_));
  const int t0_=__builtin_amdgcn_readfirstlane(tn_&~1);
  const bf16*Qw=Q+(rowbase+q0+wid*QBLK)*DM+h*D;
  const bf16*Kh=K+(rowbase+64*t0_)*DM+h*D,*Vh=V+(rowbase+64*t0_)*DM+h*D;
  const lds_cptr shm3=(lds_cptr)shm; const unsigned lds0=(unsigned)(uintptr_t)shm;
  float*wsf=(float*)(shm+LDS_WS)+wid*64;
  const bf16*ksrc=Kh+(long)lane*DM+wid*8;
  const bf16*vsrc=Vh+(long)(16*(wid&3)+(lane>>2))*DM+(wid>>2)*32+(lane&3)*8;
  const unsigned kdst=lds0+LDS_K+wid*1024, vdst=lds0+LDS_V+wid*1024;
  #define DMA_K(t,slot) glds16(ksrc+(long)(t)*KVBLK*DM,(unsigned)__builtin_amdgcn_readfirstlane(kdst+(slot)))
  #define DMA_V(t,slot) glds16(vsrc+(long)(t)*KVBLK*DM,(unsigned)__builtin_amdgcn_readfirstlane(vdst+(slot)))
  const int vb0=(int)(lds0+LDS_V)+((lane>>4)&1)*32+(lane&3)*8+(4*hi+((lane&15)>>2))*64;
  const char*Kbase=shm+LDS_K; bf16x8 kf[8];
  const lds_cptr kp0=shm3+LDS_K+hi*1024+r32*16; const lds_cptr vp0=shm3+LDS_V+((lane>>4)&1)*32+(lane&3)*8+(4*hi+((lane&15)>>2))*64;
  const int NT=(q0+QB)/KVBLK-t0_;
  typedef __attribute__((address_space(3))) float* lds_fptr; typedef float f32x4_t __attribute__((ext_vector_type(4)));
  const lds_fptr cbl=(lds_fptr)(shm3+LDS_CB);
  { const float*cg_=cgp_+64*t0_; const float cref=cref_;
    for(int i_=tid;i_<(q0+QB-64*t0_)/4;i_+=NW*64){ f32x4_t v_=*(const f32x4_t*)(cg_+4*i_); v_-=cref; *(__attribute__((address_space(3))) f32x4_t*)(cbl+4*i_)=v_; } }
  #define INITC(C,ptr) do{ const lds_fptr ip_=(ptr); \
    _Pragma("unroll") for(int g_=0;g_<4;++g_){ const f32x4_t c_=*(const __attribute__((address_space(3))) f32x4_t*)(ip_+8*g_); \
      _Pragma("unroll") for(int i_=0;i_<4;++i_){ C[4*g_+i_]=nmh_-c_[i_]; } } }while(0)
  #define BIAS(P0,P1,t) do{ const lds_fptr cp_=cbl+64*(t)+4*hi; \
    _Pragma("unroll") for(int g_=0;g_<4;++g_){ { const f32x4_t c0_=*(const __attribute__((address_space(3))) f32x4_t*)(cp_+8*g_)+mhat; \
      _Pragma("unroll") for(int i_=0;i_<4;++i_){ P0[4*g_+i_]-=c0_[i_]; } } asm volatile("":::"memory"); \
      { const f32x4_t c1_=*(const __attribute__((address_space(3))) f32x4_t*)(cp_+32+8*g_)+mhat; \
      _Pragma("unroll") for(int i_=0;i_<4;++i_){ P1[4*g_+i_]-=c1_[i_]; } } asm volatile("":::"memory"); } }while(0)
  DMA_K(0,0);DMA_V(0,0);DMA_K(1,SLOTB);
  bf16x8 qr[4];
  #pragma unroll
  for(int d0=0;d0<4;++d0)qr[d0]=*reinterpret_cast<const bf16x8*>(&Qw[(long)r32*DM+d0*16+hi*8]);
  float mhat=0.f,l_reg=0.f;f32x16 o[2];o[0]=f32x16{};o[1]=f32x16{};f32x16 negm=f32x16{}; const f32x16 zero16=f32x16{};
  const int qrel=wid*QBLK+r32;
  #define CMASK(P0,P1,t) do{int jb_=(t)-(NT-4); if(jb_>=0)cmask(P0,P1,jb_,qrel,hi);}while(0)
  bool resc=false;
  #define START(P0,P1) do{ const float rm=rowmax(P0,P1); resc=false; \
    { const float dl=rm; mhat=fadd_s(mhat,dl); \
      _Pragma("unroll") for(int r=0;r<16;++r){P0[r]=fsub_s(P0[r],dl);P1[r]=fsub_s(P1[r],dl);} \
      _Pragma("unroll") for(int r=0;r<16;++r)negm[r]=-mhat;  } \
    _Pragma("unroll") for(int r=0;r<16;++r)P0[r]=__builtin_amdgcn_exp2f(P0[r]); }while(0)
  #define RESC() do{ if(resc){ asm volatile("s_waitcnt lgkmcnt(0)":::"memory"); \
      _Pragma("unroll") for(int d_=0;d_<2;++d_) _Pragma("unroll") for(int r=0;r<16;++r)o[d_][r]*=wsf[crow(r,hi)]; } }while(0)
  f32x16 pA0,pA1,pB0,pB1;
  int sl_prev=0,sl_cur=0,sl_next=SLOTB;
  #define ROT() do{sl_prev=sl_cur;sl_cur=sl_next;sl_next=(sl_next==(NSLOT-1)*SLOTB)?0:sl_next+SLOTB;}while(0)
  DMA_K(2,2*SLOTB);
  WAIT_BAR(3);
  qkt(pA0,pA1,Kbase,qr,zero16,r32,hi);asm volatile("s_nop 15\n\ts_nop 7":"+v"(pA0),"+v"(pA1));BIAS(pA0,pA1,0);CMASK(pA0,pA1,0);
  START(pA0,pA1);
  _Pragma("unroll") for(int r=0;r<16;++r)pA1[r]=__builtin_amdgcn_exp2f(pA1[r]);
  WAIT_BAR(0);
  DMA_K(3,0);DMA_V(1,SLOTB);
  ROT();
  kload8(kf,kp0+sl_cur);
  WAIT_BAR(2);
  s16x4 vlo[8],vhi[8]; u32x4 pw0,pw1,pw2,pw3;
  #define PKW(P,B) cvtpk_s(P[B],P[B+1])
  #define PAF(k) __builtin_bit_cast(bf16x8,pw##k)
  #define VFR(i) (bf16x8){vlo[i][0],vlo[i][1],vlo[i][2],vlo[i][3],vhi[i][0],vhi[i][1],vhi[i][2],vhi[i][3]}
  #define PIN(x) asm volatile("":"+v"(x))
  #define MX3(a,b,c) __builtin_fmaxf(__builtin_fmaxf((a),(b)),(c))
  #define GAPA(MF,A0,A1,A2,A3,W0,W1,PW) do{ MF; sacc+=A0; sacc+=A1; sacc+=A2; sacc+=A3; PIN(sacc); W0; W1; PIN(PW); SBAR(); }while(0)
  #define EX(v) __builtin_amdgcn_exp2f(v)
  #define GAPB(MF,X,B) do{ MF; X[B]=EX(X[B]); X[B+1]=EX(X[B+1]); X[B+2]=EX(X[B+2]); X[B+3]=EX(X[B+3]); PIN(X); SBAR(); }while(0)
  #define VRD(i) do{ vlo[i]=vtr(vp_+(((i)>>2)*4096+((i)&3)*1024)); vhi[i]=vtr(vp_+(((i)>>2)*4096+((i)&3)*1024+512)); }while(0)
  #define KRD(G,j) do{ if(G){ kload2(kf,kp0+sl_next,j); SBAR(); } }while(0)
  #define STEP(C0,C1,P0,P1,t,GK,GV,GL) do{ SBAR(); \
    const lds_cptr vp_=vp0+sl_prev; \
    const float nmh_=-mhat; INITC(C0,cbl+64*(t)+4*hi); SBAR(); \
    VRD(0); SBAR(); float sacc=(P0[0]+P0[1]); \
    GAPA(C0=__builtin_amdgcn_mfma_f32_32x32x16_bf16(kf[0],qr[0],C0,0,0,0), P0[2],P0[3],P0[4],P0[5],     pw0[0]=PKW(P0,0), pw0[1]=PKW(P0,2), pw0); \
    INITC(C1,cbl+64*(t)+32+4*hi); SBAR(); \
    VRD(4); SBAR(); GAPA(C1=__builtin_amdgcn_mfma_f32_32x32x16_bf16(kf[1],qr[0],C1,0,0,0), P0[6],P0[7],P0[8],P0[9],     pw0[2]=PKW(P0,4), pw0[3]=PKW(P0,6), pw0); \
    VRD(1); SBAR(); GAPA(C0=__builtin_amdgcn_mfma_f32_32x32x16_bf16(kf[2],qr[1],C0,0,0,0),   P0[10],P0[11],P0[12],P0[13], pw1[0]=PKW(P0,8), pw1[1]=PKW(P0,10), pw1); \
    VRD(5); SBAR(); GAPA(C1=__builtin_amdgcn_mfma_f32_32x32x16_bf16(kf[3],qr[1],C1,0,0,0),   P0[14],P0[15],P1[0],P1[1],   pw1[2]=PKW(P0,12),pw1[3]=PKW(P0,14), pw1); \
    VRD(2); SBAR(); GAPA(C0=__builtin_amdgcn_mfma_f32_32x32x16_bf16(kf[4],qr[2],C0,0,0,0),   P1[2],P1[3],P1[4],P1[5],     pw2[0]=PKW(P1,0), pw2[1]=PKW(P1,2), pw2); \
    VRD(6); SBAR(); GAPA(C1=__builtin_amdgcn_mfma_f32_32x32x16_bf16(kf[5],qr[2],C1,0,0,0),   P1[6],P1[7],P1[8],P1[9],     pw2[2]=PKW(P1,4), pw2[3]=PKW(P1,6), pw2); \
    VRD(3); SBAR(); GAPA(C0=__builtin_amdgcn_mfma_f32_32x32x16_bf16(kf[6],qr[3],C0,0,0,0),   P1[10],P1[11],P1[12],P1[13], pw3[0]=PKW(P1,8), pw3[1]=PKW(P1,10), pw3); \
    VRD(7); SBAR(); GAPA(C1=__builtin_amdgcn_mfma_f32_32x32x16_bf16(kf[7],qr[3],C1,0,0,0),   P1[14],P1[15],0.f,0.f,       pw3[2]=PKW(P1,12),pw3[3]=PKW(P1,14), pw3); \
    l_reg+=sacc; \
    if(GK){DMA_K((t)+3,sl_cur);} if(GV){DMA_V((t)+1,sl_next);} \
    CMASK(C0,C1,t); \
    { float a=MX3(C0[0],C0[1],C1[0]),b=MX3(C0[2],C0[3],C1[1]); a=MX3(a,C1[2],C1[3]); \
      _Pragma("unroll") for(int r=4;r<16;r+=4){a=MX3(a,C0[r],C0[r+1]);b=MX3(b,C0[r+2],C0[r+3]);a=MX3(a,C1[r],C1[r+1]);b=MX3(b,C1[r+2],C1[r+3]);} \
      float rm=__builtin_fmaxf(a,b); { auto rr=__builtin_amdgcn_permlane32_swap(__float_as_uint(rm),__float_as_uint(rm),false,false); rm=__builtin_fmaxf(__uint_as_float(rr[0]),__uint_as_float(rr[1])); } \
      resc=false; \
      if(__builtin_expect(__any(rm>(float)THRL),0)){ const float dl=__builtin_fmaxf(rm,0.f); mhat+=dl; \
        _Pragma("unroll") for(int r=0;r<16;++r){C0[r]-=dl;C1[r]-=dl;} \
        _Pragma("unroll") for(int r=0;r<16;++r)negm[r]=-mhat;  \
        const float f=__builtin_amdgcn_exp2f(-dl); l_reg*=f; if(hi==0)wsf[r32]=f; resc=true; } } \
    SBAR(); \
    GAPB(o[0]=__builtin_amdgcn_mfma_f32_32x32x16_bf16(PAF(0),VFR(0),o[0],0,0,0), C0,0); \
    GAPB(o[1]=__builtin_amdgcn_mfma_f32_32x32x16_bf16(PAF(0),VFR(4),o[1],0,0,0), C0,4); \
    KRD(GL,0); GAPB(o[0]=__builtin_amdgcn_mfma_f32_32x32x16_bf16(PAF(1),VFR(1),o[0],0,0,0), C0,8); \
    KRD(GL,1); GAPB(o[1]=__builtin_amdgcn_mfma_f32_32x32x16_bf16(PAF(1),VFR(5),o[1],0,0,0), C0,12); \
    KRD(GL,2); GAPB(o[0]=__builtin_amdgcn_mfma_f32_32x32x16_bf16(PAF(2),VFR(2),o[0],0,0,0), C1,0); \
    KRD(GL,3); GAPB(o[1]=__builtin_amdgcn_mfma_f32_32x32x16_bf16(PAF(2),VFR(6),o[1],0,0,0), C1,4); \
    GAPB(o[0]=__builtin_amdgcn_mfma_f32_32x32x16_bf16(PAF(3),VFR(3),o[0],0,0,0), C1,8); \
    GAPB(o[1]=__builtin_amdgcn_mfma_f32_32x32x16_bf16(PAF(3),VFR(7),o[1],0,0,0), C1,12); \
    }while(0)
  int t=1;
  #undef CMASK
  #define CMASK(P0,P1,t) do{}while(0)
  for(;t+5<NT;t+=2){
    STEP(pB0,pB1,pA0,pA1,t,true,true,true);     WAIT_BAR(2); RESC(); ROT();
    STEP(pA0,pA1,pB0,pB1,t+1,true,true,true);   WAIT_BAR(2); RESC(); ROT();
  }
  #undef CMASK
  #define CMASK(P0,P1,t) do{int jb_=(t)-(NT-4); if(jb_>=0)cmask(P0,P1,jb_,qrel,hi);}while(0)
  #define ENDW(tt) do{ if((tt)+3<NT){WAIT_BAR(2);} else if((tt)+2<NT){WAIT_BAR(1);} else {WAIT_BAR(0);} }while(0)
  for(;t+1<NT;t+=2){
    STEP(pB0,pB1,pA0,pA1,t,(t+3<NT),(t+1<NT),(t+1<NT));       ENDW(t);   RESC(); ROT();
    STEP(pA0,pA1,pB0,pB1,t+1,(t+4<NT),(t+2<NT),(t+2<NT));     ENDW(t+1); RESC(); ROT();
  }
  STEP(pB0,pB1,pA0,pA1,NT-1,false,false,false); RESC();
  { float sacc=pB0[0]+pB0[1]; _Pragma("unroll") for(int r=2;r<16;++r)sacc+=pB0[r]; _Pragma("unroll") for(int r=0;r<16;++r)sacc+=pB1[r]; l_reg+=sacc;
    pw0=(u32x4){PKW(pB0,0),PKW(pB0,2),PKW(pB0,4),PKW(pB0,6)};pw1=(u32x4){PKW(pB0,8),PKW(pB0,10),PKW(pB0,12),PKW(pB0,14)};pw2=(u32x4){PKW(pB1,0),PKW(pB1,2),PKW(pB1,4),PKW(pB1,6)};pw3=(u32x4){PKW(pB1,8),PKW(pB1,10),PKW(pB1,12),PKW(pB1,14)};
    SBAR(); pv(o,vb0+sl_cur,PAF(0),PAF(1),PAF(2),PAF(3)); }
  #undef PKW
  #undef PAF
  #undef VFR
  #undef PIN
  #undef MX3
  #undef GAPA
  #undef GAPB
  #undef EX
  #undef VRD
  #undef KRD
  #undef STEP
  #undef ENDW
  {auto rr=__builtin_amdgcn_permlane32_swap(__float_as_uint(l_reg),__float_as_uint(l_reg),false,false);l_reg=__uint_as_float(rr[0])+__uint_as_float(rr[1]);}
  if(hi==0)wsf[32+r32]=l_reg;asm volatile("s_waitcnt lgkmcnt(0)":::"memory");
  float rli[16];
  #pragma unroll
  for(int r=0;r<16;++r)rli[r]=__builtin_amdgcn_rcpf(wsf[32+crow(r,hi)]);
  bf16*Ow=O+(rowbase+q0+wid*QBLK)*OM+h*D;
  { bf16*stg=(bf16*)(shm+LDS_OST)+wid*2048;
    #pragma unroll
    for(int r=0;r<16;++r){const int orow=crow(r,hi);
      #pragma unroll
      for(int d0=0;d0<2;++d0)stg[orow*64+d0*32+r32]=__float2bfloat16(o[d0][r]*rli[r]);}
    asm volatile("s_waitcnt lgkmcnt(0)":::"memory");
    #pragma unroll
    for(int i=0;i<4;++i){const int row=i*8+(lane>>3),ch=lane&7; const u32x4 v=*(const u32x4*)(stg+row*64+ch*8); ATTN_STORE16(Ow+(long)row*OM+ch*8,v);} }
  asm volatile("s_waitcnt lgkmcnt(0)\n\ts_barrier":::"memory");
  #undef DMA_K
  #undef DMA_V
  #undef CMASK
  #undef START
  #undef RESC
  #undef ROT
  #undef BIAS
  #undef INITC
}
constexpr int ATTN_LDS_BYTES=LDS_BYTES;
struct AttnTensors { const bf16* Q; const bf16* K; const bf16* V; bf16* O; const float* CB; float thr; };
struct AttnUnit { int bh; int qb; };
struct StaticOrder {
  int vcu,G;
  __device__ __forceinline__ explicit StaticOrder(int grid,int v):vcu(v),G(grid){}
  __device__ __forceinline__ bool next(int i,AttnUnit&u)const{ const int p=vcu+(i>>1)*G; if(p>=256)return false; const int s=p&3; u.bh=p>>2; u.qb=(i&1)?7-s:s; return true; }
  __device__ __forceinline__ void a_ready(const AttnUnit&)const{}
  __device__ __forceinline__ void done(const AttnUnit&)const{}
};
template<class Sched,int THRL=8> __device__ __forceinline__ void attn_phase(char*lds,const AttnTensors&T,const Sched&S){
  AttnUnit u;
  for(int i=0;S.next(i,u);++i){ S.a_ready(u); attn_unit<THRL>(u.bh/NHEAD,u.bh%NHEAD,u.qb,T.Q,T.K,T.V,T.O,T.CB,T.thr,lds); S.done(u); }
}
#undef SBAR
#undef WAIT_BAR
}
#define LAS __attribute__((address_space(3)))
namespace mk {
typedef unsigned short bf16;
typedef unsigned u32x4 __attribute__((ext_vector_type(4)));
typedef unsigned u32x2 __attribute__((ext_vector_type(2)));
typedef float f32x4 __attribute__((ext_vector_type(4)));
typedef float f32x2 __attribute__((ext_vector_type(2)));
typedef float f32x16 __attribute__((ext_vector_type(16)));
typedef short bf16x8 __attribute__((ext_vector_type(8)));
typedef unsigned v4u __attribute__((ext_vector_type(4)));
constexpr int NWAVES = 8, NT = 512;
constexpr int M = 16384, SEQ = 2048, DM = 1024, INW = 3096, PROJW = 3072, FF = 2816, PLE = 256;
constexpr float EPS = 1e-6f, LOG2E = 1.4426950408889634f, C2 = 0.125f * LOG2E;
constexpr size_t MiB = 1u << 20;
constexpr size_t WS_WIN = 1 * MiB, WS_WSK = 7 * MiB, WS_WO = 8 * MiB, WS_WUP = 10 * MiB, WS_WD = 21 * MiB, WS_WPG = 27 * MiB, WS_WPE = 29 * MiB;
constexpr size_t WS_SMALL = 30 * MiB;
constexpr size_t WS_LRF = 31 * MiB, WS_PB = 33 * MiB, WS_QE = 41 * MiB, WS_XB = 50 * MiB  , WS_MIX = 83 * MiB, WS_PROJ = 115 * MiB, WS_END = 228 * MiB;
constexpr size_t WS_SPREV = 212 * MiB  , WS_E = WS_MIX, WS_ACT = WS_PROJ;
constexpr int LDS_BYTES = 151552, XCH_OFF = 131072, RSL_OFF = XCH_OFF + 12544;

typedef __bf16 hwbf16x2 __attribute__((ext_vector_type(2)));
__device__ __forceinline__ unsigned pk2(float lo, float hi) { f32x2 v = {lo, hi}; return __builtin_bit_cast(unsigned, __builtin_convertvector(v, hwbf16x2)); }
__device__ __forceinline__ unsigned f2bf(float f) { return pk2(f, 0.f) & 0xffffu; }
__device__ __forceinline__ float bf2f(unsigned short h) { return __builtin_bit_cast(float, (unsigned)h << 16); }
__device__ __forceinline__ float bflo(unsigned w) { return __builtin_bit_cast(float, w << 16); }
__device__ __forceinline__ float bfhi(unsigned w) { return __builtin_bit_cast(float, w & 0xffff0000u); }
__device__ __forceinline__ float logsig(float z) { return fminf(z, 0.f) - __logf(1.f + __expf(-fabsf(z))); }
__device__ __forceinline__ int crow(int r, int hi) { return (r & 3) + 8 * (r >> 2) + 4 * hi; }
__device__ __forceinline__ float wave_sum(float v) {
#pragma unroll
    for (int o = 1; o < 64; o <<= 1) v += __shfl_xor(v, o);
    return v;
}
#define LDS_WAIT() asm volatile("s_waitcnt lgkmcnt(0)" ::: "memory")
#define LDS_SYNC() asm volatile("s_waitcnt lgkmcnt(0)\n\ts_barrier" ::: "memory")

struct Args { const float* in[21]; float* out; unsigned char* ws; };

template <bool HAS_GAIN>
__device__ __forceinline__ void tr_item(const float* W, int ldw, int k0, int srccol, const float* gain, bf16* WT, int ldk, int dstrow0, LAS float* scr, int lane) {
    const int sc = srccol < 0 ? 0 : srccol; const float msk = srccol < 0 ? 0.f : 1.f;
    const float* wp = W + (size_t)(k0 + (lane >> 5)) * ldw + sc;
    float v[32], gv[32];
#pragma unroll
    for (int i = 0; i < 32; ++i) v[i] = __builtin_nontemporal_load(wp + (size_t)(2 * i) * ldw);
    if (HAS_GAIN) {
#pragma unroll
        for (int i = 0; i < 32; ++i) gv[i] = gain[k0 + 2 * i + (lane >> 5)];
    }
#pragma unroll
    for (int i = 0; i < 32; ++i) scr[(2 * i + (lane >> 5)) * 33 + (lane & 31)] = HAS_GAIN ? v[i] * gv[i] * msk : v[i] * msk;
    LDS_WAIT();
    const int c = lane & 7;
#pragma unroll
    for (int j = 0; j < 4; ++j) { const int n = (lane >> 3) + 8 * j; const LAS float* s = scr + (8 * c) * 33 + n;
        u32x4 o; o.x = pk2(s[0 * 33], s[1 * 33]); o.y = pk2(s[2 * 33], s[3 * 33]); o.z = pk2(s[4 * 33], s[5 * 33]); o.w = pk2(s[6 * 33], s[7 * 33]);
        *(u32x4*)(WT + (size_t)(dstrow0 + n) * ldk + k0 + 8 * c) = o; }
    LDS_WAIT();
}

__device__ __forceinline__ void p0_prologue(const Args& a, LAS unsigned char* lds, int vcu, int G, int wave, int lane, int tid) {
    unsigned char* ws = a.ws;
    LAS float* scr = (LAS float*)(lds + wave * 16384);
    const int gw = vcu * NWAVES + wave, NGW = G * NWAVES;
    constexpr int I_IN = 16 * 96, I_SK = 16, I_O = 16 * 32, I_UP = 16 * 176, I_D = 44 * 32, I_PG = 16 * 32, I_PE = 4 * 32;
    constexpr int NITEMS = I_IN + I_SK + I_O + I_UP + I_PE;
    for (int it = gw; it < NITEMS; it += NGW) {
        int r = it; const int nl = lane & 31;
        if (r < I_IN) { const int kb = r / 96, nb = r % 96, n0 = 32 * nb; tr_item<true>(a.in[3], INW, 64 * kb, n0 + (n0 >= 1536 ? 16 : 0) + nl, a.in[2], (bf16*)(ws + WS_WIN), DM, n0, scr, lane); continue; } r -= I_IN;
        if (r < I_SK) { const int sc = nl < 16 ? 1536 + nl : (nl < 24 ? 3088 + nl - 16 : -1); tr_item<true>(a.in[3], INW, 64 * r, sc, a.in[2], (bf16*)(ws + WS_WSK), DM, 0, scr, lane); continue; } r -= I_SK;
        if (r < I_O) { const int kb = r / 32, nb = r % 32; tr_item<false>(a.in[10], DM, 64 * kb, 32 * nb + nl, nullptr, (bf16*)(ws + WS_WO), DM, 32 * nb, scr, lane); continue; } r -= I_O;
        if (r < I_UP) { const int kb = r / 176, nb = r % 176, pn = nb >> 3, wi = nb & 7; const int sc0 = wi < 4 ? 128 * pn + 32 * wi : FF + 128 * pn + 32 * (wi - 4);
            tr_item<true>(a.in[12], 2 * FF, 64 * kb, sc0 + nl, a.in[11], (bf16*)(ws + WS_WUP), DM, 32 * nb, scr, lane); continue; } r -= I_UP;
        { const int kb = r / 32, nb = r % 32; tr_item<false>(a.in[17], DM, 64 * kb, 32 * nb + nl, nullptr, (bf16*)(ws + WS_WPE), PLE, 32 * nb, scr, lane); }
    }
    float* rstd1 = (float*)(ws + WS_SMALL); bf16* xb = (bf16*)(ws + WS_XB); bf16* pb = (bf16*)(ws + WS_PB);
    for (int m0 = gw; m0 < M; m0 += 2 * NGW) {
        f32x4 v[2][4], pv[2];
#pragma unroll
        for (int q = 0; q < 2; ++q) { const int m = m0 + q * NGW; const f32x4* xr = (const f32x4*)(a.in[0] + (size_t)m * DM) + lane;
#pragma unroll
            for (int j = 0; j < 4; ++j) v[q][j] = __builtin_nontemporal_load(xr + 64 * j);
            pv[q] = __builtin_nontemporal_load((const f32x4*)(a.in[1] + (size_t)m * PLE) + lane); }
#pragma unroll
        for (int q = 0; q < 2; ++q) { const int m = m0 + q * NGW; float s = 0.f;
#pragma unroll
            for (int j = 0; j < 4; ++j) s += (v[q][j].x * v[q][j].x + v[q][j].y * v[q][j].y) + (v[q][j].z * v[q][j].z + v[q][j].w * v[q][j].w);
            s = wave_sum(s); if (lane == 0) rstd1[m] = rsqrtf(s * (1.f / DM) + EPS);
            u32x2* o8 = (u32x2*)(xb + (size_t)m * DM) + lane;
#pragma unroll
            for (int j = 0; j < 4; ++j) o8[64 * j] = (u32x2){pk2(v[q][j].x, v[q][j].y), pk2(v[q][j].z, v[q][j].w)};
            *((u32x2*)(pb + (size_t)m * PLE) + lane) = (u32x2){pk2(pv[q].x, pv[q].y), pk2(pv[q].z, pv[q].w)}; }
    }
    float* ssz = (float*)(ws + WS_SMALL) + M;
    for (int i = vcu * NT + tid; i < 3 * M; i += G * NT) ssz[i] = 0.f;
}

__device__ __forceinline__ void p6_late_weights(const Args& a, LAS unsigned char* lds, int cl, int nl, int wave, int lane) {
    unsigned char* ws = a.ws; LAS float* scr = (LAS float*)(lds + wave * 16384); const int nl32 = lane & 31;
    constexpr int I_D = 44 * 32, I_PG = 16 * 32;
    for (int it = cl * NWAVES + wave; it < I_D + I_PG; it += nl * NWAVES) {
        if (it < I_D) { const int kb = it / 32, nb = it % 32; tr_item<false>(a.in[15], DM, 64 * kb, 32 * nb + nl32, nullptr, (bf16*)(ws + WS_WD), FF, 32 * nb, scr, lane); }
        else { const int r = it - I_D, kb = r / 32, nb = r % 32; tr_item<true>(a.in[19], DM, 64 * kb, 32 * nb + nl32, a.in[16], (bf16*)(ws + WS_WPG), DM, 32 * nb, scr, lane); }
    }
}

__device__ __forceinline__ void p1_skinny(const Args& a, LAS unsigned char* lds, int vcu, int G, int wave, int lane, int tid) {
    const bf16* xb = (const bf16*)(a.ws + WS_XB); const bf16* wsk = (const bf16*)(a.ws + WS_WSK); const float* rstd1 = (const float*)(a.ws + WS_SMALL); float* lrf = (float*)(a.ws + WS_LRF);
    LAS float* red = (LAS float*)lds;
    const int r32 = lane & 31, hi = lane >> 5;
    for (int rg = vcu; rg < M / 64; rg += G) {
        const int row0 = rg * 64; f32x16 acc0 = {}, acc1 = {};
#pragma unroll
        for (int ks = 0; ks < 8; ++ks) { const int k = wave * 128 + ks * 16 + 8 * hi;
            const bf16x8 a0 = *(const bf16x8*)(xb + (size_t)(row0 + r32) * DM + k), a1 = *(const bf16x8*)(xb + (size_t)(row0 + 32 + r32) * DM + k), b = *(const bf16x8*)(wsk + (size_t)r32 * DM + k);
            acc0 = __builtin_amdgcn_mfma_f32_32x32x16_bf16(a0, b, acc0, 0, 0, 0); acc1 = __builtin_amdgcn_mfma_f32_32x32x16_bf16(a1, b, acc1, 0, 0, 0); }
#pragma unroll
        for (int r = 0; r < 16; ++r) { red[(wave * 64 + crow(r, hi)) * 32 + r32] = acc0[r]; red[(wave * 64 + 32 + crow(r, hi)) * 32 + r32] = acc1[r]; }
        LDS_SYNC();
        { const int row = tid >> 3, c4 = tid & 7; f32x4 s = {0.f, 0.f, 0.f, 0.f};
#pragma unroll
            for (int w = 0; w < 8; ++w) s += *(const LAS f32x4*)(red + (w * 64 + row) * 32 + c4 * 4);
            s *= rstd1[row0 + row];
            if (c4 == 4 || c4 == 5) { const f32x4 bf = *(const f32x4*)(a.in[7] + (c4 - 4) * 4); s = (f32x4){logsig(s.x + bf.x), logsig(s.y + bf.y), logsig(s.z + bf.z), logsig(s.w + bf.w)}; }
            *(f32x4*)(lrf + (size_t)(row0 + row) * 32 + c4 * 4) = s; }
        LDS_SYNC();
    }
}

__device__ __forceinline__ bf16x8 ldfrag(const LAS bf16* base, int row, int ks, int hi) { return *(const LAS bf16x8*)(base + row * 72 + ks * 16 + 8 * hi); }
#define PK16(a_, b_) ((unsigned)(a_) | ((unsigned)(b_) << 16))
struct GlaIn { f32x4 lrq; unsigned qp[8], kp[8], vv2[16]; };
__device__ __forceinline__ void gla_local_load(GlaIn& I, const Args& a, int task0, int wave, int tid) {
    const bf16* proj = (const bf16*)(a.ws + WS_PROJ); const float* lrf = (const float*)(a.ws + WS_LRF);
    const int hb = wave >> 2, t256 = tid & 255, task = task0 + hb;
    const int bh = task >> 5, n = task & 31, b = bh >> 2, h = bh & 3, tok0 = b * SEQ + n * 64;
    const int kp = t256 & 31, seg = t256 >> 5, vp = t256 & 63, sg = t256 >> 6;
    I.lrq = *(const f32x4*)(lrf + (size_t)(tok0 + (t256 >> 2)) * 32 + (t256 & 3) * 4);
#pragma unroll
    for (int i = 0; i < 8; ++i) { const bf16* pr = proj + (size_t)(tok0 + seg * 8 + i) * PROJW + h * 64 + 2 * kp; I.qp[i] = *(const unsigned*)pr; I.kp[i] = *(const unsigned*)(pr + 256); }
#pragma unroll
    for (int i = 0; i < 16; ++i) I.vv2[i] = *(const unsigned*)(proj + (size_t)(tok0 + sg * 16 + i) * PROJW + 512 + h * 128 + 2 * vp);
}
__device__ __forceinline__ void gla_local2(const GlaIn& I, const f32x2 (&w)[16], f32x2 bias, const Args& a, LAS unsigned char* lds_all, int task0, int wave, int lane, int tid) {
    unsigned char* ws = a.ws;
    bf16* qeg = (bf16*)(ws + WS_QE);
    float* decay = (float*)(ws + WS_SMALL) + 4 * M; float* ointra = a.out; float* dS = a.out + (size_t)M * 512;
    const int hb = wave >> 2, w4 = wave & 3, t256 = tid & 255, task = task0 + hb;
    const int bh = task >> 5, n = task & 31, b = bh >> 2, h = bh & 3, tok0 = b * SEQ + n * 64;
    LAS unsigned char* lds = lds_all + hb * 61440;
    LAS bf16* QE = (LAS bf16*)lds; LAS bf16* KE = QE + 64 * 72; LAS bf16* KDT = KE + 64 * 72; LAS bf16* VT = KDT + 64 * 72; LAS bf16* AT = VT + 128 * 72;
    LAS float* SEG = (LAS float*)(AT + 64 * 72); LAS float* LR = SEG + 512;
    const int r32 = lane & 31, hi = lane >> 5;
    const int kp = t256 & 31, seg = t256 >> 5;
    const int vp = t256 & 63, sg = t256 >> 6;
    *(LAS f32x4*)(LR + (t256 >> 2) * 16 + (t256 & 3) * 4) = I.lrq;
    LDS_SYNC();
    f32x2 bl[8]; f32x2 run = {0.f, 0.f};
#pragma unroll
    for (int i = 0; i < 8; ++i) { const LAS f32x4* lr = (const LAS f32x4*)(LR + (seg * 8 + i) * 16); f32x2 z = bias;
#pragma unroll
        for (int j = 0; j < 4; ++j) { const f32x4 l4 = lr[j]; z += (w[4 * j] * l4.x + w[4 * j + 1] * l4.y) + (w[4 * j + 2] * l4.z + w[4 * j + 3] * l4.w); }
        run += (f32x2){logsig(z.x), logsig(z.y)} * (1.f / 16.f); bl[i] = run; }
    *(LAS f32x2*)(SEG + seg * 64 + 2 * kp) = run;
    {
        unsigned lo[8], hh[8];
#pragma unroll
        for (int q = 0; q < 8; ++q) { const unsigned x0 = I.vv2[2 * q], x1 = I.vv2[2 * q + 1]; lo[q] = (x0 & 0xffffu) | (x1 << 16); hh[q] = (x0 >> 16) | (x1 & 0xffff0000u); }
        *(LAS u32x4*)(VT + (2 * vp) * 72 + sg * 16) = (u32x4){lo[0], lo[1], lo[2], lo[3]}; *(LAS u32x4*)(VT + (2 * vp) * 72 + sg * 16 + 8) = (u32x4){lo[4], lo[5], lo[6], lo[7]};
        *(LAS u32x4*)(VT + (2 * vp + 1) * 72 + sg * 16) = (u32x4){hh[0], hh[1], hh[2], hh[3]}; *(LAS u32x4*)(VT + (2 * vp + 1) * 72 + sg * 16 + 8) = (u32x4){hh[4], hh[5], hh[6], hh[7]}; }
    LDS_SYNC();
    {   f32x2 prefix = {0.f, 0.f}, total = {0.f, 0.f};
#pragma unroll
        for (int s2 = 0; s2 < 8; ++s2) { const f32x2 sv = *(const LAS f32x2*)(SEG + s2 * 64 + 2 * kp); total += sv; if (s2 < seg) prefix += sv; }
        float kd0[8], kd1[8];
#pragma unroll
        for (int i = 0; i < 8; ++i) { const int t = seg * 8 + i; const f32x2 bb = bl[i] + prefix;
            const float q0 = bflo(I.qp[i]), q1 = bfhi(I.qp[i]), k0 = bflo(I.kp[i]), k1 = bfhi(I.kp[i]);
            const unsigned qe = pk2(q0 * 0.125f * __expf(bb.x), q1 * 0.125f * __expf(bb.y));
            *(LAS unsigned*)(QE + t * 72 + 2 * kp) = qe; *(LAS unsigned*)(KE + t * 72 + 2 * kp) = pk2(k0 * __expf(-bb.x), k1 * __expf(-bb.y));
            *(unsigned*)(qeg + (size_t)(tok0 + t) * 256 + h * 64 + 2 * kp) = qe;
            kd0[i] = k0 * __expf(total.x - bb.x); kd1[i] = k1 * __expf(total.y - bb.y); }
        *(LAS u32x4*)(KDT + (2 * kp) * 72 + seg * 8) = (u32x4){pk2(kd0[0], kd0[1]), pk2(kd0[2], kd0[3]), pk2(kd0[4], kd0[5]), pk2(kd0[6], kd0[7])};
        *(LAS u32x4*)(KDT + (2 * kp + 1) * 72 + seg * 8) = (u32x4){pk2(kd1[0], kd1[1]), pk2(kd1[2], kd1[3]), pk2(kd1[4], kd1[5]), pk2(kd1[6], kd1[7])};
        if (seg == 0) *(f32x2*)(decay + task * 64 + 2 * kp) = (f32x2){__expf(total.x), __expf(total.y)};
    }
    LDS_SYNC();
    {
        const int ti = w4 >> 1, si = w4 & 1; f32x16 acc = {};
        if (si <= ti) {
#pragma unroll
            for (int ks = 0; ks < 4; ++ks) acc = __builtin_amdgcn_mfma_f32_32x32x16_bf16(ldfrag(QE, ti * 32 + r32, ks, hi), ldfrag(KE, si * 32 + r32, ks, hi), acc, 0, 0, 0);
        }
#pragma unroll
        for (int r = 0; r < 16; ++r) { const int trow = ti * 32 + crow(r, hi), scol = si * 32 + r32; AT[trow * 72 + scol] = (unsigned short)f2bf(scol <= trow ? acc[r] : 0.f); }
    }
    LDS_SYNC();
    {
        const int ti = w4 >> 1;
#pragma unroll
        for (int q = 0; q < 2; ++q) { const int vi = (w4 & 1) * 2 + q; f32x16 o = {}, ds = {};
#pragma unroll
            for (int ks = 0; ks < 4; ++ks) { const bf16x8 vb = ldfrag(VT, vi * 32 + r32, ks, hi);
                o = __builtin_amdgcn_mfma_f32_32x32x16_bf16(ldfrag(AT, ti * 32 + r32, ks, hi), vb, o, 0, 0, 0);
                ds = __builtin_amdgcn_mfma_f32_32x32x16_bf16(ldfrag(KDT, ti * 32 + r32, ks, hi), vb, ds, 0, 0, 0); }
#pragma unroll
            for (int r = 0; r < 16; ++r) { const int row = ti * 32 + crow(r, hi);
                ointra[(size_t)(tok0 + row) * 512 + h * 128 + vi * 32 + r32] = o[r];
                dS[(size_t)task * 8192 + row * 128 + vi * 32 + r32] = ds[r]; } }
    }
    LDS_SYNC();
}
__device__ __forceinline__ void gla_w_load(f32x2 (&w)[16], f32x2& bias, const Args& a, int h, int kp) {
#pragma unroll
    for (int j = 0; j < 16; ++j) w[j] = *(const f32x2*)(a.in[4] + j * 256 + h * 64 + 2 * kp);
    bias = *(const f32x2*)(a.in[5] + h * 64 + 2 * kp);
}
__device__ __forceinline__ void gla_local_all(const Args& a, LAS unsigned char* lds, int vcu, int G, int wave, int lane, int tid) {
    const int t0 = 2 * vcu; if (t0 >= 1024) return;
    const int kp = tid & 31;
    f32x2 w[16]; f32x2 bias; gla_w_load(w, bias, a, ((t0 + (wave >> 2)) >> 5) & 3, kp);
    const int t1 = t0 + 2 * G; const bool has1 = t1 < 1024;
    {   GlaIn A, B; gla_local_load(A, a, t0, wave, tid);
        if (has1) gla_local_load(B, a, t1, wave, tid);
        gla_local2(A, w, bias, a, lds, t0, wave, lane, tid);
        if (has1) {
            if ((2 * G) % 128 != 0) gla_w_load(w, bias, a, ((t1 + (wave >> 2)) >> 5) & 3, kp);
            gla_local2(B, w, bias, a, lds, t1, wave, lane, tid); } }
    for (int task = t0 + 4 * G; task < 1024; task += 2 * G) {
        gla_w_load(w, bias, a, ((task + (wave >> 2)) >> 5) & 3, kp);
        GlaIn C; gla_local_load(C, a, task, wave, tid); gla_local2(C, w, bias, a, lds, task, wave, lane, tid); }
}

__device__ __forceinline__ void fox_prep(const Args& a, LAS unsigned char* lds, int vcu, int G, int wave, int lane, int tid) {
    const float* lrf = (const float*)(a.ws + WS_LRF); float* cb = (float*)(a.ws + WS_SMALL) + 4 * M + 65536; LAS float* wt = (LAS float*)lds;
    for (int bh = vcu; bh < 64; bh += G) {
        const int b = bh >> 3, h = bh & 7; float v[4];
#pragma unroll
        for (int i = 0; i < 4; ++i) v[i] = lrf[(size_t)(b * SEQ + tid * 4 + i) * 32 + 16 + h];
        v[1] += v[0]; v[2] += v[1]; v[3] += v[2];
        float inc = v[3];
#pragma unroll
        for (int o = 1; o < 64; o <<= 1) { const float t = __shfl_up(inc, o); if (lane >= o) inc += t; }
        if (lane == 63) wt[wave] = inc;
        LDS_SYNC();
        float pre = inc - v[3];
#pragma unroll
        for (int w = 0; w < 8; ++w) { const float x = wt[w]; if (w < wave) pre += x; }
        *(f32x4*)(cb + (size_t)bh * SEQ + tid * 4) = (f32x4){(pre + v[0]) * LOG2E, (pre + v[1]) * LOG2E, (pre + v[2]) * LOG2E, (pre + v[3]) * LOG2E};
        LDS_SYNC();
    }
}

__device__ __forceinline__ void gla_scan(const Args& a, int vcu, int G, int tid) {
    const float* decay = (const float*)(a.ws + WS_SMALL) + 4 * M; const float* dS = a.out + (size_t)M * 512; bf16* sprev = (bf16*)(a.ws + WS_SPREV);
    for (int e = (vcu * NT + tid) * 2; e < 32 * 8192; e += G * NT * 2) {
        const int j = e >> 13, bh = (j & 1) + 2 * (j >> 2) + 16 * ((j >> 1) & 1), kv = e & 8191, k = kv >> 7; f32x2 st = {0.f, 0.f};
#pragma unroll
        for (int n = 0; n < 32; ++n) { const int task = bh * 32 + n; const size_t idx = (size_t)task * 8192 + kv;
            *(unsigned*)(sprev + idx) = pk2(st.x, st.y); const float d = decay[task * 64 + k]; const f32x2 ds = *(const f32x2*)(dS + idx); st = st * d + ds; }
    }
}

__device__ __forceinline__ void gla_final2(const Args& a, LAS unsigned char* lds_all, int task0, int wave, int lane, int tid) {
    unsigned char* ws = a.ws;
    const bf16* proj = (const bf16*)(ws + WS_PROJ); const bf16* qeg = (const bf16*)(ws + WS_QE); const bf16* sprev = (const bf16*)(ws + WS_SPREV);
    const float* ointra = a.out; bf16* mix = (bf16*)(ws + WS_MIX);
    const int hb = wave >> 2, w4 = wave & 3, t256 = tid & 255, task = task0 + hb;
    const int bh = task >> 5, n = task & 31, b = bh >> 2, h = bh & 3, tok0 = b * SEQ + n * 64;
    LAS unsigned char* lds = lds_all + hb * 61440;
    LAS bf16* QE = (LAS bf16*)lds; LAS bf16* ST = QE + 64 * 72; LAS float* OL = (LAS float*)(lds + 27648);
    const int r32 = lane & 31, hi = lane >> 5, ti = w4 >> 1;
    const int rr = t256 >> 4, c16 = t256 & 15;
    u32x4 qv[2];
#pragma unroll
    for (int q = 0; q < 2; ++q) { const int e = t256 + 256 * q; qv[q] = *(const u32x4*)(qeg + (size_t)(tok0 + (e >> 3)) * 256 + h * 64 + (e & 7) * 8); }
    unsigned f2[16];
    { const int vp = t256 & 63, kg = t256 >> 6;
#pragma unroll
        for (int i = 0; i < 16; ++i) f2[i] = *(const unsigned*)(sprev + (size_t)task * 8192 + (kg * 16 + i) * 128 + 2 * vp); }
    f32x4 oiv[4][2]; u32x4 gw[4];
#pragma unroll
    for (int p = 0; p < 4; ++p) { const size_t tok = (size_t)(tok0 + p * 16 + rr);
        oiv[p][0] = *(const f32x4*)(ointra + tok * 512 + h * 128 + c16 * 8); oiv[p][1] = *(const f32x4*)(ointra + tok * 512 + h * 128 + c16 * 8 + 4);
        gw[p] = *(const u32x4*)(proj + tok * PROJW + 1024 + h * 128 + c16 * 8); }
    const f32x4 gn0 = *(const f32x4*)(a.in[6] + c16 * 8), gn1 = *(const f32x4*)(a.in[6] + c16 * 8 + 4);
#pragma unroll
    for (int q = 0; q < 2; ++q) { const int e = t256 + 256 * q; *(LAS u32x4*)(QE + (e >> 3) * 72 + (e & 7) * 8) = qv[q]; }
    { const int vp = t256 & 63, kg = t256 >> 6; unsigned lo[8], hh[8];
#pragma unroll
        for (int q = 0; q < 8; ++q) { const unsigned x0 = f2[2 * q], x1 = f2[2 * q + 1]; lo[q] = (x0 & 0xffffu) | (x1 << 16); hh[q] = (x0 >> 16) | (x1 & 0xffff0000u); }
        *(LAS u32x4*)(ST + (2 * vp) * 72 + kg * 16) = (u32x4){lo[0], lo[1], lo[2], lo[3]}; *(LAS u32x4*)(ST + (2 * vp) * 72 + kg * 16 + 8) = (u32x4){lo[4], lo[5], lo[6], lo[7]};
        *(LAS u32x4*)(ST + (2 * vp + 1) * 72 + kg * 16) = (u32x4){hh[0], hh[1], hh[2], hh[3]}; *(LAS u32x4*)(ST + (2 * vp + 1) * 72 + kg * 16 + 8) = (u32x4){hh[4], hh[5], hh[6], hh[7]}; }
    LDS_SYNC();
#pragma unroll
    for (int q = 0; q < 2; ++q) { const int vi = (w4 & 1) * 2 + q; f32x16 acc = {};
#pragma unroll
        for (int ks = 0; ks < 4; ++ks) acc = __builtin_amdgcn_mfma_f32_32x32x16_bf16(ldfrag(QE, ti * 32 + r32, ks, hi), ldfrag(ST, vi * 32 + r32, ks, hi), acc, 0, 0, 0);
#pragma unroll
        for (int r = 0; r < 16; ++r) { const int row = ti * 32 + crow(r, hi), col = vi * 32 + r32; OL[row * 132 + col] = acc[r]; } }
    LDS_SYNC();
#pragma unroll
    for (int p = 0; p < 4; ++p) { const int t = p * 16 + rr;
        const f32x4 o0 = *(const LAS f32x4*)(OL + t * 132 + c16 * 8) + oiv[p][0], o1 = *(const LAS f32x4*)(OL + t * 132 + c16 * 8 + 4) + oiv[p][1];
        float ssq = (o0.x * o0.x + o0.y * o0.y) + (o0.z * o0.z + o0.w * o0.w) + (o1.x * o1.x + o1.y * o1.y) + (o1.z * o1.z + o1.w * o1.w);
        ssq += __shfl_xor(ssq, 1); ssq += __shfl_xor(ssq, 2); ssq += __shfl_xor(ssq, 4); ssq += __shfl_xor(ssq, 8);
        const float r = rsqrtf(ssq * (1.f / 128.f) + EPS);
        const u32x4 g = gw[p]; const float og[8] = {bflo(g.x), bfhi(g.x), bflo(g.y), bfhi(g.y), bflo(g.z), bfhi(g.z), bflo(g.w), bfhi(g.w)};
        float y[8];
#pragma unroll
        for (int c = 0; c < 4; ++c) { const float g0 = og[c], g1 = og[4 + c];
            y[c] = o0[c] * r * gn0[c] * (g0 * __builtin_amdgcn_rcpf(1.f + __expf(-g0))); y[4 + c] = o1[c] * r * gn1[c] * (g1 * __builtin_amdgcn_rcpf(1.f + __expf(-g1))); }
        u32x4 pk; pk.x = pk2(y[0], y[1]); pk.y = pk2(y[2], y[3]); pk.z = pk2(y[4], y[5]); pk.w = pk2(y[6], y[7]);
        *(u32x4*)(mix + (size_t)(tok0 + t) * DM + h * 128 + c16 * 8) = pk; }
    LDS_SYNC();
}

#define XB_TMO      128
#define XB_XCNT(j)  (256  + 64 * (j))
#define XB_XSUB(j)  (1280 + 64 * (j))
#define XB_XGEN(j)  (2304 + 64 * (j))
#define XB_TOP      3328
#define XB_TOPGEN   3392
#define XCD_BAR_WORDS 3456
#define XB_SPIN_CAP (1u << 18)

__device__ __forceinline__ unsigned xb_ld(unsigned* p)              { return __hip_atomic_load(p, __ATOMIC_RELAXED, __HIP_MEMORY_SCOPE_AGENT); }
__device__ __forceinline__ unsigned xb_add(unsigned* p, unsigned v) { return __hip_atomic_fetch_add(p, v, __ATOMIC_RELAXED, __HIP_MEMORY_SCOPE_AGENT); }
__device__ __forceinline__ unsigned xb_xcc_id() { return (unsigned)__builtin_amdgcn_s_getreg((3 << 11) | 20) & 0xFu; }
#define XB_SPIN(cond, bar) do { unsigned _sp = 0; while (cond) { __builtin_amdgcn_s_sleep(1); \
    if ((++_sp & 255u) == 0u) { if (xb_ld(&(bar)[XB_TMO])) break; if (_sp > XB_SPIN_CAP) { atomicAdd(&(bar)[XB_TMO], 1u); break; } } } } while (0)

struct XcdBarrier {
    unsigned* bar; unsigned x;
    volatile LAS unsigned* st;
};

__device__ __forceinline__ XcdBarrier xcd_barrier_post(unsigned* bar, volatile LAS unsigned* st, bool leader) {
    XcdBarrier b; b.bar = bar; b.x = xb_xcc_id(); b.st = st;
    if (leader) (void)xb_add(&bar[XB_XCNT(b.x)], 1u);
    return b;
}
__device__ __forceinline__ void xcd_barrier_complete(unsigned* bar, unsigned x, unsigned& nloc, unsigned& nx) {
    const unsigned G = gridDim.x * gridDim.y * gridDim.z;
    unsigned sum, cnt, mine, sp = 0u;
    for (;;) {
        sum = 0u; cnt = 0u; mine = 0u;
#pragma unroll
        for (unsigned j = 0; j < 16; ++j) { const unsigned c = xb_ld(&bar[XB_XCNT(j)]); sum += c; cnt += (c > 0u) ? 1u : 0u; mine = (j == x) ? c : mine; }
        if (sum == G) break;
        __builtin_amdgcn_s_sleep(1);
        if ((++sp & 255u) == 0u) { if (xb_ld(&bar[XB_TMO])) break; if (sp > XB_SPIN_CAP) { atomicAdd(&bar[XB_TMO], 1u); break; } }
    }
    nloc = mine > 0u ? mine : 1u; nx = cnt > 0u ? cnt : 1u;
}

__device__ __forceinline__ void xcd_barrier(const XcdBarrier& b, bool leader) {
    asm volatile("s_waitcnt vmcnt(0)" ::: "memory");
    __syncthreads();
    if (leader) {
        unsigned* bar = b.bar;
        __builtin_amdgcn_s_waitcnt(0);
        unsigned nloc = b.st[0], nx = b.st[1];
        if (nloc == 0u) { xcd_barrier_complete(bar, b.x, nloc, nx); b.st[0] = nloc; b.st[1] = nx; }
        const unsigned old = xb_add(&bar[XB_XSUB(b.x)], 1u);
        const unsigned gen = old / nloc;
        if (old + 1u == (gen + 1u) * nloc) {
            __builtin_amdgcn_fence(__ATOMIC_RELEASE, "agent");
            asm volatile("s_waitcnt vmcnt(0)" ::: "memory");
            const unsigned og = xb_add(&bar[XB_TOP], 1u);
            const unsigned tg = og / nx;
            if (og + 1u == (tg + 1u) * nx) xb_add(&bar[XB_TOPGEN], 1u);
            else XB_SPIN(xb_ld(&bar[XB_TOPGEN]) == tg, bar);
            __builtin_amdgcn_fence(__ATOMIC_ACQUIRE, "agent");
            xb_add(&bar[XB_XGEN(b.x)], 1u);
            asm volatile("s_waitcnt vmcnt(0)" ::: "memory");
        } else {
            XB_SPIN(xb_ld(&bar[XB_XGEN(b.x)]) == gen, bar);
            __builtin_amdgcn_fence(__ATOMIC_ACQUIRE, "agent");
            asm volatile("s_waitcnt vmcnt(0)" ::: "memory");
        }
    }
    __syncthreads();
}

__device__ __forceinline__ void sb_arrive(const XcdBarrier& b, int set, bool leader) {
    asm volatile("s_waitcnt vmcnt(0)" ::: "memory"); __syncthreads();
    if (leader) { unsigned* w = b.bar + 4096 + 2048 * set; const unsigned nloc = b.st[0], nx = b.st[1];
        const unsigned old = xb_add(&w[64 * b.x], 1u);
        if (old + 1u == nloc) { __builtin_amdgcn_fence(__ATOMIC_RELEASE, "agent"); asm volatile("s_waitcnt vmcnt(0)" ::: "memory");
            const unsigned og = xb_add(&w[1024], 1u); if (og + 1u == nx) xb_add(&w[1088], 1u); } }
}
__device__ __forceinline__ void sb_wait(const XcdBarrier& b, int set, bool leader) {
    if (leader) { unsigned* w = b.bar + 4096 + 2048 * set; XB_SPIN(xb_ld(&w[1088]) == 0u, b.bar);
        __builtin_amdgcn_fence(__ATOMIC_ACQUIRE, "agent"); asm volatile("s_waitcnt vmcnt(0)" ::: "memory"); }
    __syncthreads();
}
#ifndef MK_SKIP
#define MK_SKIP 0
#endif
#define RUN(k) (!((MK_SKIP >> (k)) & 1))
#ifndef REP_SYNC
#define REP_SYNC 1
#endif
#ifndef REP_P0
#define REP_P0 1
#endif
#ifndef REP_P1
#define REP_P1 1
#endif
#ifndef REP_GL
#define REP_GL 1
#endif
#ifndef REP_SC
#define REP_SC 1
#endif
#ifndef REP_AT
#define REP_AT 1
#endif
#ifndef REP_GF
#define REP_GF 1
#endif
#ifndef REP_P5
#define REP_P5 1
#endif
#ifndef REP_P7
#define REP_P7 1
#endif
#ifndef REP_P8
#define REP_P8 1
#endif
#ifndef REP_FP
#define REP_FP 1
#endif
#ifndef REP_P6
#define REP_P6 1
#endif
#ifndef STAMP_K
#define STAMP_K -1
#endif
#define GSYNC() do { for (int s_ = 0; s_ < REP_SYNC; ++s_) xcd_barrier(xbar, wave == 0 && lane_id() == 0); \
    if (STAMP_K >= 0) { if (bx == 0 && wave == 0 && lane_id() == 0) { ((unsigned long long*)(ws + 65536))[n_stamp] = __builtin_amdgcn_s_memrealtime(); } ++n_stamp; } } while (0)
__global__ void __launch_bounds__(NT, 2) mk_fwd(Args a) {
    extern __shared__ __attribute__((aligned(16))) unsigned char lds_raw[];
    LAS unsigned char* lds = (LAS unsigned char*)lds_raw;
    const int wave = __builtin_amdgcn_readfirstlane(threadIdx.x >> 6);
#define lane (lane_id())
#define tid (wave * 64 + lane_id())
    const int G = gridDim.x, bx = blockIdx.x, vcu = (G % 8 == 0) ? (bx % 8) * (G / 8) + bx / 8 : bx;
    unsigned char* ws = a.ws;
    bf16* xb = (bf16*)(ws + WS_XB); float* small = (float*)(ws + WS_SMALL);
    float* ss2 = small + M; float* ss3 = small + 2 * M; float* ssE = small + 3 * M;
    volatile LAS unsigned* xst = (volatile LAS unsigned*)(lds + XCH_OFF + 8192);
    if (wave == 0 && lane_id() == 0) { xst[0] = 0u; xst[1] = 0u; }
    __syncthreads();
    int n_stamp = 1; if (STAMP_K >= 0 && bx == 0 && wave == 0 && lane_id() == 0) ((unsigned long long*)(ws + 65536))[0] = __builtin_amdgcn_s_memrealtime();
    const XcdBarrier xbar = xcd_barrier_post((unsigned*)ws, xst, wave == 0 && lane_id() == 0);

    for (int rep_ = 0; rep_ < REP_P0; ++rep_) if (RUN(0)) p0_prologue(a, lds, vcu, G, wave, lane, tid);
    GSYNC();
    for (int rep_ = 0; rep_ < REP_P1; ++rep_) if (RUN(1)) {   pg8::Gemm g{xb, (const bf16*)(ws + WS_WIN), M, PROJW, DM}; pg8::StaticOrder S; S.init(M / 256, PROJW / 256, G, bx);
        pg8::EpiProj E{(bf16*)(ws + WS_PROJ), PROJW, small, a.in[8], a.in[9], (LAS float*)(lds + XCH_OFF)};
        pg8::gemm_phase<pg8::EpiProj, pg8::StaticOrder, true, true>(lds, g, S, E, wave);
        p1_skinny(a, lds, vcu, G, wave, lane, tid);
    }
    GSYNC();
    {
#ifndef STAMP2_K
#define STAMP2_K -1
#endif
#define SUBSTAMP(i) do { if (STAMP2_K >= 0 && bx == 0 && wave == 0 && lane_id() == 0) ((unsigned long long*)(ws + 65536 + 1024))[i] = __builtin_amdgcn_s_memrealtime(); } while (0)
        SUBSTAMP(0);
        if (RUN(9)) fox_prep(a, lds, vcu, G, wave, lane, tid);
        sb_arrive(xbar, 0, wave == 0 && lane_id() == 0);
        for (int rep_ = 0; rep_ < REP_GL; ++rep_) if (RUN(2)) gla_local_all(a, lds, vcu, G, wave, lane, tid);
        sb_arrive(xbar, 1, wave == 0 && lane_id() == 0); SUBSTAMP(1);
        sb_wait(xbar, 0, wave == 0 && lane_id() == 0); SUBSTAMP(2);
        const attn_body::bf16* pj = (const attn_body::bf16*)(ws + WS_PROJ);
        float gqm = 0.f, gkm = 0.f;
        for (int i = 0; i < 64; ++i) { gqm = fmaxf(gqm, fabsf(a.in[8][i])); gkm = fmaxf(gkm, fabsf(a.in[9][i])); }
#ifndef ATTN_PRUNE
#define ATTN_PRUNE 1
#endif
        const float thr = ATTN_PRUNE ? 2.f * (64.f * gqm * gkm * C2 * 1.02f) + 48.f : 1e30f;
        const attn_body::AttnTensors AT{pj + 1536, pj + 2048, pj + 2560, (attn_body::bf16*)(ws + WS_MIX) + 512, small + 4 * M + 65536, thr};
        const attn_body::StaticOrder S(G, vcu);
        attn_body::AttnUnit u; bool scanned = false;
        for (int i = 0; S.next(i, u); ++i) {
            if (i == 1) { SUBSTAMP(3); sb_wait(xbar, 1, wave == 0 && lane_id() == 0); SUBSTAMP(4); gla_scan(a, vcu, G, tid); sb_arrive(xbar, 2, wave == 0 && lane_id() == 0); scanned = true; SUBSTAMP(5); }
            if (RUN(3)) attn_body::attn_unit<8>(u.bh / attn_body::NHEAD, u.bh % attn_body::NHEAD, u.qb, AT.Q, AT.K, AT.V, AT.O, AT.CB, AT.thr, (char*)lds_raw);
        }
        if (!scanned) { sb_wait(xbar, 1, wave == 0 && lane_id() == 0); gla_scan(a, vcu, G, tid); sb_arrive(xbar, 2, wave == 0 && lane_id() == 0); }
        SUBSTAMP(6); sb_wait(xbar, 2, wave == 0 && lane_id() == 0); SUBSTAMP(7);
        for (int rep_ = 0; rep_ < REP_GF; ++rep_) if (RUN(4)) for (int task = 2 * vcu; task < 1024; task += 2 * G) gla_final2(a, lds, task, wave, lane, tid);
        SUBSTAMP(8);
    }
    GSYNC();
    SUBSTAMP(9);
    if (RUN(5)) {   pg8::Gemm g{(const bf16*)(ws + WS_MIX), (const bf16*)(ws + WS_WO), M, DM, DM}; pg8::StaticOrder S; S.init(M / 256, DM / 256, G, bx);
        pg8::EpiRes<2> E{nullptr, xb, xb, ss2, DM};
        pg8::gemm_phase<pg8::EpiRes<2>, pg8::StaticOrder, true, true>(lds, g, S, E, wave);
    }
    GSYNC();
    for (int rep_ = 0; rep_ < REP_P6; ++rep_) if (RUN(6)) {   pg8::Gemm g{xb, (const bf16*)(ws + WS_WUP), M, 2 * FF, DM}; pg8::StaticOrder S; S.init(65, 2 * FF / 256, G, bx, 254, -2);
        {   LAS float* rsl = (LAS float*)(lds + RSL_OFF); pg8::Unit uu;
            for (int i = 0; i < 6 && S.next(i, uu); ++i) { const int r = tid; if (r < 256) { const int gr = uu.arow + r; rsl[i * 256 + r] = (gr >= 0 && gr < M) ? rsqrtf(ss2[gr] * (1.f / 1024.f) + EPS) : 0.f; } }
            LDS_SYNC(); }
        pg8::EpiUp E{(bf16*)(ws + WS_ACT), ss2, a.in[13], a.in[14], (LAS float*)(lds + XCH_OFF), (LAS float*)(lds + XCH_OFF + 8192 + 256), (LAS float*)(lds + RSL_OFF)};
        pg8::gemm_phase<pg8::EpiUp, pg8::StaticOrder, true, true>(lds, g, S, E, wave);
        {   const int nwg6 = 65 * (2 * FF / 256), rem = nwg6 % G, nl = rem ? G - rem : G, cl = rem ? bx - rem : bx;
            if (cl >= 0) { pg8::Gemm g2{(const bf16*)(ws + WS_PB), (const bf16*)(ws + WS_WPE), M, DM, PLE}; pg8::StaticOrder S2; S2.init(M / 256, DM / 256, nl, cl);
                pg8::EpiRes<0> E2{nullptr, nullptr, (bf16*)(ws + WS_E), ssE, DM};
                pg8::gemm_phase<pg8::EpiRes<0>, pg8::StaticOrder, true, true>(lds, g2, S2, E2, wave);
                p6_late_weights(a, lds, cl, nl, wave, lane); } }
    }
    GSYNC();
    if (RUN(7)) {   pg8::Gemm g{(const bf16*)(ws + WS_ACT), (const bf16*)(ws + WS_WD), M, DM, FF}; pg8::StaticOrder S; S.init(M / 256, DM / 256, G, bx);
        pg8::EpiRes<2> E{nullptr, xb, xb, ss3, DM};
        pg8::gemm_phase<pg8::EpiRes<2>, pg8::StaticOrder, true, true>(lds, g, S, E, wave);
    }
    GSYNC();
    if (RUN(8)) {   pg8::Gemm g{xb, (const bf16*)(ws + WS_WPG), M, DM, DM}; pg8::StaticOrder S; S.init(M / 256, DM / 256, G, bx);
        for (int rep_ = REP_P8 - 1; rep_ > 0; --rep_) { pg8::EpiGate Ed{xb, (float*)(ws + WS_PROJ), (const bf16*)(ws + WS_E), ss3, ssE, a.in[20], a.in[18], DM}; pg8::gemm_phase<pg8::EpiGate, pg8::StaticOrder, true, true>(lds, g, S, Ed, wave); }
        pg8::EpiGate E{xb, a.out, (const bf16*)(ws + WS_E), ss3, ssE, a.in[20], a.in[18], DM};
        pg8::gemm_phase<pg8::EpiGate, pg8::StaticOrder, true, true>(lds, g, S, E, wave);
    }
    if (STAMP2_K >= 0) { xcd_barrier(xbar, wave == 0 && lane_id() == 0);
        if (bx == 0 && wave == 0 && lane_id() == 0) { const unsigned long long* ts = (const unsigned long long*)(ws + 65536 + 1024);
            a.out[0] += 0.25f + (float)(ts[STAMP2_K + 1] - ts[STAMP2_K]) * 1e-4f; } }
    if (STAMP_K >= 0) { GSYNC();
        if (bx == 0 && wave == 0 && lane_id() == 0) { const unsigned long long* ts = (const unsigned long long*)(ws + 65536);
            a.out[0] += (float)(ts[STAMP_K + 1] - ts[STAMP_K]) * 1e-4f; } }
#undef lane
#undef tid
}
}

extern "C" void kernel_launch(void* const* d_in, const int* in_sizes, int n_in, void* d_out, int out_size, void* d_ws, size_t ws_size, hipStream_t stream) {
    static int grid = 0;
    if (grid == 0) {
        int dev = 0, cus = 0, per_cu = 0;
        hipGetDevice(&dev); hipDeviceGetAttribute(&cus, hipDeviceAttributeMultiprocessorCount, dev);
        hipFuncSetAttribute((const void*)mk::mk_fwd, hipFuncAttributeMaxDynamicSharedMemorySize, mk::LDS_BYTES);
        hipOccupancyMaxActiveBlocksPerMultiprocessor(&per_cu, (const void*)mk::mk_fwd, mk::NT, mk::LDS_BYTES);
        if (per_cu < 1) { fprintf(stderr, "kernel_launch: occupancy query says %d blocks per CU\n", per_cu); per_cu = 1; }
        grid = cus * per_cu;
        if (n_in != 21 || ws_size < mk::WS_END) { fprintf(stderr, "kernel_launch: unexpected n_in %d / ws %zu\n", n_in, ws_size); grid = -1; }
    }
    if (grid < 0) return;
#ifdef PROBE_MEMSET2
    (void)hipMemsetAsync((char*)d_ws + 131072, 0, 65536, stream);
#endif
    if (hipMemsetAsync(d_ws, 0, 65536, stream) != hipSuccess) { fprintf(stderr, "kernel_launch: memset of the barrier words failed\n"); return; }
    mk::Args a{};
    for (int i = 0; i < 21; ++i) a.in[i] = (const float*)d_in[i];
    a.out = (float*)d_out; a.ws = (unsigned char*)d_ws;
    hipLaunchKernelGGL(mk::mk_fwd, dim3(grid), dim3(mk::NT), mk::LDS_BYTES, stream, a);
    const hipError_t e = hipPeekAtLastError();
    if (e != hipSuccess) fprintf(stderr, "kernel_launch: launch failed: %s (grid %d)\n", hipGetErrorString(e), grid);
}
```

```cpp
#include <hip/hip_runtime.h>
#include <cstdio>
#include <cstdint>
__device__ __forceinline__ int lane_id() { int l; asm volatile("v_mbcnt_lo_u32_b32 %0, -1, 0\n\tv_mbcnt_hi_u32_b32 %0, -1, %0" : "=v"(l)); return l; }
namespace pg8 {
#define PG8_LAS __attribute__((address_space(3)))
typedef unsigned short bf16_t;
typedef short bf16x8 __attribute__((ext_vector_type(8)));
typedef float f32x4 __attribute__((ext_vector_type(4)));
typedef unsigned u32x4 __attribute__((ext_vector_type(4)));
constexpr int BM = 256, BK = 64, HALF = 128, HTB = HALF * BK * 2  , STAGE_BYTES = 8 * HTB, NXCD = 8, WGM = 8;

__host__ __device__ __forceinline__ int lds_byte(int r, int c) { const int st = (r >> 4) * 2 + (c >> 5), rr = r & 15, cc = c & 31, ob = rr * 64 + cc * 2; return st * 1024 + (ob ^ (((ob >> 9) & 1) << 5)); }
__host__ __device__ __forceinline__ void stage_rc(int b, int& R, int& C) { const int st = b / 1024, sb = b % 1024, swz = sb ^ (((sb >> 9) & 1) << 5); R = (st >> 1) * 16 + swz / 64; C = (st & 1) * 32 + (swz % 64) / 2; }
__host__ __device__ __forceinline__ int perm32(int rho) { const int n = rho >> 4, i = rho & 15; return 8 * (i >> 2) + 4 * n + (i & 3); }

struct Unit { int pm, pn, arow, idx; };
struct Gemm { const bf16_t* A; const bf16_t* Bt; int M, N, K; };

struct StaticOrder {
    int nM, nN, nwg, G, c, mstride, moff;
    __host__ __device__ void init(int nM_, int nN_, int G_, int c_, int mstride_ = 256, int moff_ = 0) { nM = nM_; nN = nN_; nwg = nM * nN; G = G_; c = c_; mstride = mstride_; moff = moff_; }
    __host__ __device__ bool next(int i, Unit& u) const {
        const long L = (long)i * G + c; if (L >= nwg) return false;
        int wgid = (int)L; { const int q = nwg / NXCD, r = nwg % NXCD, xcd = wgid % NXCD, off = wgid / NXCD; wgid = (xcd < r ? xcd * (q + 1) : r * (q + 1) + (xcd - r) * q) + off; }
        const int nig = WGM * nN, gid = wgid / nig, fm = gid * WGM, gsz = (nM - fm) < WGM ? (nM - fm) : WGM;
        u.pm = fm + ((wgid % nig) % gsz); u.pn = (wgid % nig) / gsz; u.arow = u.pm * mstride + moff; u.idx = i; return true;
    }
    __device__ __forceinline__ void a_ready(const Unit&) const {}
    __device__ __forceinline__ void done(const Unit&) const {}
};

__device__ __forceinline__ unsigned cvt_pk_bf16(float lo, float hi) { unsigned r; asm volatile("v_cvt_pk_bf16_f32 %0, %1, %2" : "=v"(r) : "v"(lo), "v"(hi)); return r; }
typedef float f32x2 __attribute__((ext_vector_type(2)));
typedef float f32x2 __attribute__((ext_vector_type(2)));
template <class Epi, class Sched, bool ALIGN_EPI = false, bool SP2 = false>
__device__ __forceinline__ void gemm_phase(PG8_LAS unsigned char* lds, const Gemm g, const Sched& S, const Epi& E, int wave_sgpr) {
    const int wid = wave_sgpr, lane = lane_id(), tid = wid * 64 + lane, wr = wid >> 2, wc = wid & 3, fr = lane & 15, fq = lane >> 4;
    const int K = g.K, nt = K / BK;
    unsigned voffA[2], voffB[2];
#pragma unroll
    for (int i = 0; i < 2; ++i) { int R, C; stage_rc(tid * 16 + i * 8192, R, C); const int Rb = Epi::PERM ? ((R & ~31) + perm32(R & 31)) : R;
        voffA[i] = (unsigned)(R * K + C) * 2u; voffB[i] = (unsigned)(Rb * K + C) * 2u; }
    const size_t kstep = (size_t)(BK * 2);
    const size_t hstep = (size_t)HALF * K * 2;
    const size_t tstep = 2 * hstep;
    const unsigned ldsw = (unsigned)wid * 1024u;
    const int aoff = lds_byte(wr * 64 + fr, fq * 8), boff = lds_byte(wc * 32 + fr, fq * 8);
#define PG8_SA(b, h) (((b) * 2 + (h)) * HTB)
#define PG8_SB(b, h) ((4 + (b) * 2 + (h)) * HTB)
#define PG8_STAGE(bufoff, gbase, voff) do { _Pragma("unroll") for (int _i = 0; _i < 2; ++_i) \
        __builtin_amdgcn_global_load_lds((const unsigned*)((const char*)(gbase) + (voff)[_i]), (PG8_LAS unsigned*)(lds + (bufoff) + ldsw + _i * 8192), 16, 0, 0); } while (0)
#define PG8_LDA(dst, b, h) do { _Pragma("unroll") for (int m = 0; m < 4; ++m) _Pragma("unroll") for (int k = 0; k < 2; ++k) dst[m][k] = *(const PG8_LAS bf16x8*)(lds + PG8_SA(b, h) + aoff + m * 2048 + k * 1024); } while (0)
#define PG8_LDB(dst, b, h) do { _Pragma("unroll") for (int n = 0; n < 2; ++n) _Pragma("unroll") for (int k = 0; k < 2; ++k) dst[n][k] = *(const PG8_LAS bf16x8*)(lds + PG8_SB(b, h) + boff + n * 2048 + k * 1024); } while (0)
#define PG8_MMA(ai, bj, At, Bt) do { __builtin_amdgcn_s_setprio(1); _Pragma("unroll") for (int m = 0; m < 4; ++m) _Pragma("unroll") for (int n = 0; n < 2; ++n) _Pragma("unroll") for (int k = 0; k < 2; ++k) \
        acc[ai][bj][m][n] = __builtin_amdgcn_mfma_f32_16x16x32_bf16(Bt[n][k], At[m][k], acc[ai][bj][m][n], 0, 0, 0); __builtin_amdgcn_s_setprio(0); } while (0)
#define PG8_WAIT_V(n) asm volatile("s_waitcnt vmcnt(" #n ")" ::: "memory")
#define PG8_WAIT_L(n) asm volatile("s_waitcnt lgkmcnt(" #n ")" ::: "memory")
#define PG8_BAR __builtin_amdgcn_s_barrier()
#define PG8_SCHED __builtin_amdgcn_sched_barrier(0)
    Unit cur, nxt; int ui = 0;
    if (!S.next(0, cur)) return;
    f32x4 acc[2][2][4][2];
#pragma unroll
    for (int a = 0; a < 2; ++a)
#pragma unroll
        for (int b = 0; b < 2; ++b)
#pragma unroll
            for (int m = 0; m < 4; ++m)
#pragma unroll
                for (int n = 0; n < 2; ++n) acc[a][b][m][n] = (f32x4){0.f, 0.f, 0.f, 0.f};
    bf16x8 At[4][2], B0[2][2], B1[2][2];
    const char* cA = (const char*)g.A + (long)cur.arow * (long)(K * 2); const char* cB = (const char*)g.Bt + (size_t)cur.pn * tstep;
    S.a_ready(cur);
    if constexpr (SP2) {
        PG8_STAGE(PG8_SB(0, 0), cB, voffB); PG8_STAGE(PG8_SB(0, 1), cB + hstep, voffB); PG8_STAGE(PG8_SA(0, 0), cA, voffA); PG8_STAGE(PG8_SA(0, 1), cA + hstep, voffA);
        if (wr == 1) PG8_BAR;
        PG8_WAIT_V(2); PG8_BAR;
        PG8_STAGE(PG8_SB(1, 0), cB + kstep, voffB); PG8_STAGE(PG8_SA(1, 0), cA + kstep, voffA); PG8_STAGE(PG8_SB(1, 1), cB + hstep + kstep, voffB);
        PG8_WAIT_V(6); PG8_BAR;
    } else {
        PG8_STAGE(PG8_SB(0, 0), cB, voffB); PG8_STAGE(PG8_SA(0, 0), cA, voffA); PG8_STAGE(PG8_SB(0, 1), cB + hstep, voffB); PG8_STAGE(PG8_SA(0, 1), cA + hstep, voffA);
        if (wr == 1) PG8_BAR;
        PG8_WAIT_V(4); PG8_BAR;
        PG8_STAGE(PG8_SB(1, 0), cB + kstep, voffB); PG8_STAGE(PG8_SA(1, 0), cA + kstep, voffA); PG8_STAGE(PG8_SB(1, 1), cB + hstep + kstep, voffB);
        PG8_WAIT_V(6); PG8_BAR;
    }
    for (;;) {
        const bool has_next = S.next(ui + 1, nxt);
        const char* nA = has_next ? (const char*)g.A + (long)nxt.arow * (long)(K * 2) : cA; const char* nB = has_next ? (const char*)g.Bt + (size_t)nxt.pn * tstep : cB;
        for (int t = 0; t < nt; t += 2) {
            const bool last = (t == nt - 2);
            const char* a1 = cA + (size_t)(t + 1) * kstep;
            const char* a2 = last ? nA : cA + (size_t)(t + 2) * kstep; const char* b2 = last ? nB : cB + (size_t)(t + 2) * kstep;
            const char* a3 = a2 + kstep; const char* b3 = b2 + kstep;
            if (last && has_next) S.a_ready(nxt);
            if constexpr (SP2) {
            PG8_LDB(B0, 0, 0); PG8_LDB(B1, 0, 1); PG8_SCHED; PG8_LDA(At, 0, 0); PG8_STAGE(PG8_SA(1, 1), a1 + hstep, voffA);
            PG8_WAIT_V(8); PG8_WAIT_L(0); PG8_BAR; PG8_MMA(0, 0, At, B0); PG8_MMA(0, 1, At, B1); PG8_BAR; PG8_SCHED;
            PG8_LDA(At, 0, 1); PG8_STAGE(PG8_SB(0, 0), b2, voffB); PG8_STAGE(PG8_SB(0, 1), b2 + hstep, voffB); PG8_STAGE(PG8_SA(0, 0), a2, voffA);
            PG8_WAIT_V(8); PG8_WAIT_L(0); PG8_BAR; PG8_MMA(1, 0, At, B0); PG8_MMA(1, 1, At, B1); PG8_BAR; PG8_SCHED;
            PG8_LDB(B0, 1, 0); PG8_LDB(B1, 1, 1); PG8_SCHED; PG8_LDA(At, 1, 0); PG8_STAGE(PG8_SA(0, 1), a2 + hstep, voffA);
            PG8_WAIT_V(8); PG8_WAIT_L(0); PG8_BAR; PG8_MMA(0, 0, At, B0); PG8_MMA(0, 1, At, B1); PG8_BAR; PG8_SCHED;
            PG8_LDA(At, 1, 1); PG8_STAGE(PG8_SB(1, 0), b3, voffB); PG8_STAGE(PG8_SB(1, 1), b3 + hstep, voffB); PG8_STAGE(PG8_SA(1, 0), a3, voffA);
            PG8_WAIT_V(8); PG8_WAIT_L(0); PG8_BAR; PG8_MMA(1, 0, At, B0); PG8_MMA(1, 1, At, B1); PG8_BAR; PG8_SCHED;
            } else {
            PG8_LDB(B0, 0, 0); PG8_SCHED; PG8_LDA(At, 0, 0); PG8_STAGE(PG8_SA(1, 1), a1 + hstep, voffA);
            PG8_WAIT_L(8); PG8_BAR; PG8_WAIT_L(0); PG8_MMA(0, 0, At, B0); PG8_BAR; PG8_SCHED;
            PG8_LDB(B1, 0, 1); PG8_STAGE(PG8_SB(0, 0), b2, voffB);
            PG8_BAR; PG8_WAIT_L(0); PG8_MMA(0, 1, At, B1); PG8_BAR;
            PG8_LDA(At, 0, 1); PG8_STAGE(PG8_SA(0, 0), a2, voffA);
            PG8_BAR; PG8_WAIT_L(0); PG8_MMA(1, 0, At, B0); PG8_BAR; PG8_SCHED;
            PG8_STAGE(PG8_SB(0, 1), b2 + hstep, voffB);
            PG8_WAIT_V(6); PG8_BAR; PG8_MMA(1, 1, At, B1); PG8_BAR;
            PG8_LDB(B0, 1, 0); PG8_SCHED; PG8_LDA(At, 1, 0); PG8_STAGE(PG8_SA(0, 1), a2 + hstep, voffA);
            PG8_WAIT_L(8); PG8_BAR; PG8_WAIT_L(0); PG8_MMA(0, 0, At, B0); PG8_BAR; PG8_SCHED;
            PG8_LDB(B1, 1, 1); PG8_STAGE(PG8_SB(1, 0), b3, voffB);
            PG8_BAR; PG8_WAIT_L(0); PG8_MMA(0, 1, At, B1); PG8_BAR;
            PG8_LDA(At, 1, 1); PG8_STAGE(PG8_SA(1, 0), a3, voffA);
            PG8_BAR; PG8_WAIT_L(0); PG8_MMA(1, 0, At, B0); PG8_BAR; PG8_SCHED;
            PG8_STAGE(PG8_SB(1, 1), b3 + hstep, voffB);
            PG8_WAIT_V(6); PG8_BAR; PG8_MMA(1, 1, At, B1); PG8_BAR;
            }
        }
        if constexpr (ALIGN_EPI) { if (wr == 0) PG8_BAR; }
        if constexpr (!Epi::AFTER_DRAIN) { E(acc, cur, wr, wc, fr, fq); S.done(cur); }
        if (!has_next) break;
#pragma unroll
        for (int a = 0; a < 2; ++a)
#pragma unroll
            for (int b = 0; b < 2; ++b)
#pragma unroll
                for (int m = 0; m < 4; ++m)
#pragma unroll
                    for (int n = 0; n < 2; ++n) acc[a][b][m][n] = (f32x4){0.f, 0.f, 0.f, 0.f};
        cur = nxt; cA = nA; cB = nB; ++ui;
        if constexpr (ALIGN_EPI) { if (wr == 1) PG8_BAR; }
    }
    PG8_WAIT_V(0);
    if constexpr (!ALIGN_EPI) { if (wr == 0) PG8_BAR; }
    PG8_BAR;
    if constexpr (Epi::AFTER_DRAIN) { E.fused(acc, cur, wr, wc, fr, fq, lds, wid, lane); S.done(cur); }
#undef PG8_SA
#undef PG8_SB
#undef PG8_STAGE
#undef PG8_LDA
#undef PG8_LDB
#undef PG8_MMA
#undef PG8_WAIT_V
#undef PG8_WAIT_L
#undef PG8_BAR
#undef PG8_SCHED
}
}
namespace pg8 {
constexpr float RMS_EPS = 1e-6f;
typedef unsigned u32x2 __attribute__((ext_vector_type(2)));
template <int CTRL> __device__ __forceinline__ float dpp_mov(float old, float src) {
    return __builtin_bit_cast(float, __builtin_amdgcn_update_dpp(__builtin_bit_cast(int, old), __builtin_bit_cast(int, src), CTRL, 0xf, 0xf, false)); }
__device__ __forceinline__ float bf_lo(unsigned w) { return __builtin_bit_cast(float, w << 16); }
__device__ __forceinline__ float bf_hi(unsigned w) { return __builtin_bit_cast(float, w & 0xffff0000u); }

struct EpiScaleBf16 {
    static constexpr bool PERM = true, AFTER_DRAIN = false;
    bf16_t* O; int ldc; const float* rs;
    __device__ __forceinline__ void operator()(const f32x4 (&acc)[2][2][4][2], const Unit& u, int wr, int wc, int fr, int fq) const {
        const int row0 = u.pm * BM + wr * 64 + fr, col0 = u.pn * BM + wc * 32 + 8 * fq;
        float sc[2][4];
#pragma unroll
        for (int ai = 0; ai < 2; ++ai)
#pragma unroll
            for (int m = 0; m < 4; ++m) sc[ai][m] = rs[row0 + ai * HALF + m * 16];
#pragma unroll
        for (int ai = 0; ai < 2; ++ai)
#pragma unroll
            for (int m = 0; m < 4; ++m) { const int r = row0 + ai * HALF + m * 16; const float s = sc[ai][m]; bf16_t* rowp = O + (size_t)r * ldc + col0;
#pragma unroll
                for (int bj = 0; bj < 2; ++bj) { const f32x4 v0 = acc[ai][bj][m][0] * s, v1 = acc[ai][bj][m][1] * s;
                    u32x4 w; w.x = cvt_pk_bf16(v0[0], v0[1]); w.y = cvt_pk_bf16(v0[2], v0[3]); w.z = cvt_pk_bf16(v1[0], v1[1]); w.w = cvt_pk_bf16(v1[2], v1[3]);
                    *(u32x4*)(rowp + bj * HALF) = w; } }
    }
};
struct EpiProj {
    static constexpr bool PERM = true, AFTER_DRAIN = false;
    bf16_t* O; int ldc; const float* rs; const float* gq; const float* gk; PG8_LAS float* part;
    __device__ __forceinline__ void operator()(f32x4 (&acc)[2][2][4][2], const Unit& u, int wr, int wc, int fr, int fq) const {
        const int row0 = u.pm * BM + wr * 64 + fr, col0 = u.pn * BM + wc * 32 + 8 * fq;
        float sc[2][4];
#pragma unroll
        for (int ai = 0; ai < 2; ++ai)
#pragma unroll
            for (int m = 0; m < 4; ++m) sc[ai][m] = rs[row0 + ai * HALF + m * 16];
        const bool fox = (u.pn >= 6 && u.pn < 10);
        if (!fox) {
#pragma unroll
            for (int ai = 0; ai < 2; ++ai)
#pragma unroll
                for (int m = 0; m < 4; ++m) { const int r = row0 + ai * HALF + m * 16; const float s = sc[ai][m]; bf16_t* rowp = O + (size_t)r * ldc + col0;
#pragma unroll
                    for (int bj = 0; bj < 2; ++bj) { const f32x4 v0 = acc[ai][bj][m][0] * s, v1 = acc[ai][bj][m][1] * s;
                        u32x4 w; w.x = cvt_pk_bf16(v0[0], v0[1]); w.y = cvt_pk_bf16(v0[2], v0[3]); w.z = cvt_pk_bf16(v1[0], v1[1]); w.w = cvt_pk_bf16(v1[2], v1[3]);
                        *(u32x4*)(rowp + bj * HALF) = w; } }
        } else {
#pragma unroll
            for (int ai = 0; ai < 2; ++ai)
#pragma unroll
                for (int m = 0; m < 4; ++m) { const float s = sc[ai][m]; const int rl = ai * HALF + wr * 64 + m * 16 + fr;
#pragma unroll
                    for (int bj = 0; bj < 2; ++bj) { acc[ai][bj][m][0] *= s; acc[ai][bj][m][1] *= s; const f32x4 v0 = acc[ai][bj][m][0], v1 = acc[ai][bj][m][1];
                        float q = (v0[0] * v0[0] + v0[1] * v0[1]) + (v0[2] * v0[2] + v0[3] * v0[3]) + (v1[0] * v1[0] + v1[1] * v1[1]) + (v1[2] * v1[2] + v1[3] * v1[3]);
                        q += __shfl_xor(q, 16); q += __shfl_xor(q, 32);
                        if (fq == 0) part[(wc * 2 + bj) * 256 + rl] = q; } }
            const float* gp = (u.pn < 8 ? gq : gk) + 32 * (wc & 1) + 8 * fq; const f32x4 g0 = *(const f32x4*)gp, g1 = *(const f32x4*)(gp + 4);
            asm volatile("s_waitcnt lgkmcnt(0)\n\ts_barrier" ::: "memory");
            const float mul = u.pn < 8 ? 0.125f * 1.4426950408889634f : 1.f;
#pragma unroll
            for (int ai = 0; ai < 2; ++ai)
#pragma unroll
                for (int m = 0; m < 4; ++m) { const int rl = ai * HALF + wr * 64 + m * 16 + fr; bf16_t* rowp = O + (size_t)(u.pm * BM + rl) * ldc + col0;
#pragma unroll
                    for (int bj = 0; bj < 2; ++bj) { const float tot = part[(wc * 2 + bj) * 256 + rl] + part[((wc ^ 1) * 2 + bj) * 256 + rl];
                        const float r = rsqrtf(tot * (1.f / 64.f) + RMS_EPS) * mul; const f32x4 v0 = acc[ai][bj][m][0] * r * g0, v1 = acc[ai][bj][m][1] * r * g1;
                        u32x4 w; w.x = cvt_pk_bf16(v0[0], v0[1]); w.y = cvt_pk_bf16(v0[2], v0[3]); w.z = cvt_pk_bf16(v1[0], v1[1]); w.w = cvt_pk_bf16(v1[2], v1[3]);
                        *(u32x4*)(rowp + bj * HALF) = w; } }
        }
    }
};
template <int BASE> struct EpiRes {
    static constexpr bool PERM = true, AFTER_DRAIN = false;
    const float* basef; const bf16_t* baseb; bf16_t* outb; float* ss; int ldc;
    __device__ __forceinline__ void operator()(const f32x4 (&acc)[2][2][4][2], const Unit& u, int wr, int wc, int fr, int fq) const {
        const int row0 = u.pm * BM + wr * 64 + fr, col0 = u.pn * BM + wc * 32 + 8 * fq;
        u32x4 preb[2][4][2];
        if (BASE == 2) {
#pragma unroll
            for (int ai = 0; ai < 2; ++ai)
#pragma unroll
                for (int m = 0; m < 4; ++m)
#pragma unroll
                    for (int bj = 0; bj < 2; ++bj) preb[ai][m][bj] = __builtin_nontemporal_load((const u32x4*)(baseb + (size_t)(row0 + ai * HALF + m * 16) * ldc + col0 + bj * HALF));
            asm volatile("" ::: "memory");
        }
#pragma unroll
        for (int ai = 0; ai < 2; ++ai)
#pragma unroll
          for (int mp = 0; mp < 2; ++mp) {
            f32x4 pre[2][2][2];
            if (BASE == 1) {
#pragma unroll
                for (int mm = 0; mm < 2; ++mm)
#pragma unroll
                    for (int bj = 0; bj < 2; ++bj) { const size_t off = (size_t)(row0 + ai * HALF + (2 * mp + mm) * 16) * ldc + col0 + bj * HALF;
                        pre[mm][bj][0] = *(const f32x4*)(basef + off); pre[mm][bj][1] = *(const f32x4*)(basef + off + 4); }
                asm volatile("" ::: "memory");
            }
#pragma unroll
            for (int mm = 0; mm < 2; ++mm) { const int m = 2 * mp + mm; const int r = row0 + ai * HALF + m * 16; float q = 0.f;
#pragma unroll
                for (int bj = 0; bj < 2; ++bj) { const size_t off = (size_t)r * ldc + col0 + bj * HALF;
                    f32x4 v0 = acc[ai][bj][m][0], v1 = acc[ai][bj][m][1];
                    if (BASE == 1) { v0 += pre[mm][bj][0]; v1 += pre[mm][bj][1]; }
                    if (BASE == 2) { const u32x4 b = preb[ai][m][bj]; v0 += (f32x4){bf_lo(b.x), bf_hi(b.x), bf_lo(b.y), bf_hi(b.y)}; v1 += (f32x4){bf_lo(b.z), bf_hi(b.z), bf_lo(b.w), bf_hi(b.w)}; }
                    u32x4 w; w.x = cvt_pk_bf16(v0[0], v0[1]); w.y = cvt_pk_bf16(v0[2], v0[3]); w.z = cvt_pk_bf16(v1[0], v1[1]); w.w = cvt_pk_bf16(v1[2], v1[3]);
                    *(u32x4*)(outb + off) = w;
                    q += (v0[0] * v0[0] + v0[1] * v0[1]) + (v0[2] * v0[2] + v0[3] * v0[3]) + (v1[0] * v1[0] + v1[1] * v1[1]) + (v1[2] * v1[2] + v1[3] * v1[3]); }
                q += __shfl_xor(q, 16); q += __shfl_xor(q, 32);
                if (fq == 0) atomicAdd(ss + r, q); }
          }
    }
};
struct EpiGate {
    static constexpr bool PERM = true, AFTER_DRAIN = false;
    const bf16_t* x2; float* out; const bf16_t* E; const float* ss3; const float* ssE; const float* bpg; const float* peg; int ldc;
    __device__ __forceinline__ void operator()(const f32x4 (&acc)[2][2][4][2], const Unit& u, int wr, int wc, int fr, int fq) const {
        const int row0 = u.pm * BM + wr * 64 + fr, col0 = u.pn * BM + wc * 32 + 8 * fq;
        f32x4 bp[2][2], pg[2][2];
#pragma unroll
        for (int bj = 0; bj < 2; ++bj)
#pragma unroll
            for (int n = 0; n < 2; ++n) { bp[bj][n] = *(const f32x4*)(bpg + col0 + bj * HALF + 4 * n); pg[bj][n] = *(const f32x4*)(peg + col0 + bj * HALF + 4 * n); }
#pragma unroll
        for (int ai = 0; ai < 2; ++ai)
#pragma unroll
            for (int mp = 0; mp < 2; ++mp) {
                u32x4 xw[2][2]; u32x4 ew[2][2];
                float s3[2], sE[2];
#pragma unroll
                for (int mm = 0; mm < 2; ++mm) { const int r = row0 + ai * HALF + (2 * mp + mm) * 16; s3[mm] = ss3[r]; sE[mm] = ssE[r]; }
#pragma unroll
                for (int mm = 0; mm < 2; ++mm)
#pragma unroll
                    for (int bj = 0; bj < 2; ++bj) { const size_t off = (size_t)(row0 + ai * HALF + (2 * mp + mm) * 16) * ldc + col0 + bj * HALF;
                        xw[mm][bj] = *(const u32x4*)(x2 + off); ew[mm][bj] = __builtin_nontemporal_load((const u32x4*)(E + off)); }
                asm volatile("" ::: "memory");
#pragma unroll
                for (int mm = 0; mm < 2; ++mm) { const int m = 2 * mp + mm; const int r = row0 + ai * HALF + m * 16;
                    const float r3 = rsqrtf(s3[mm] * (1.f / 1024.f) + RMS_EPS), rE = rsqrtf(sE[mm] * (1.f / 1024.f) + RMS_EPS);
#pragma unroll
                    for (int bj = 0; bj < 2; ++bj) { const size_t off = (size_t)r * ldc + col0 + bj * HALF; const u32x4 w = ew[mm][bj];
                        const float ev[8] = {bf_lo(w.x), bf_hi(w.x), bf_lo(w.y), bf_hi(w.y), bf_lo(w.z), bf_hi(w.z), bf_lo(w.w), bf_hi(w.w)};
                        const u32x4 xq = xw[mm][bj]; const float xv8[8] = {bf_lo(xq.x), bf_hi(xq.x), bf_lo(xq.y), bf_hi(xq.y), bf_lo(xq.z), bf_hi(xq.z), bf_lo(xq.w), bf_hi(xq.w)};
#pragma unroll
                        for (int n = 0; n < 2; ++n) { f32x4 o;
#pragma unroll
                            for (int i = 0; i < 4; ++i) { const float z = acc[ai][bj][m][n][i] * r3 + bp[bj][n][i]; const float g = __builtin_amdgcn_rcpf(1.f + __expf(-z));
                                o[i] = xv8[4 * n + i] + g * (ev[4 * n + i] * rE * pg[bj][n][i]); }
                            *(f32x4*)(out + off + 4 * n) = o; } } }
                asm volatile("" ::: "memory");
            }
    }
};
struct EpiUp {
    static constexpr bool PERM = true, AFTER_DRAIN = false;
    bf16_t* act; const float* ss2; const float* cw; const float* cb; PG8_LAS float* xch; PG8_LAS float* taps; PG8_LAS float* rsl;
    __device__ __forceinline__ void operator()(f32x4 (&acc)[2][2][4][2], const Unit& u, int wr, int wc, int fr, int fq) const {
        constexpr int FF = 2816, MROWS = 16384;
        const int tid_ = (wr * 4 + wc) * 64 + fq * 16 + fr; f32x4 tapv;
        if (tid_ < 256) { const int r = tid_ >> 5, c4 = tid_ & 31, kind = r & 3, half = r >> 2;
            tapv = *(const f32x4*)((kind < 3 ? cw + kind * 2 * FF : cb) + half * FF + u.pn * HALF + 4 * c4); }
#pragma unroll
        for (int ai = 0; ai < 2; ++ai)
#pragma unroll
            for (int m = 0; m < 4; ++m) { const int rt_ = ai * HALF + wr * 64 + m * 16 + fr, gr = u.arow + rt_;
                float s;
                if (u.idx < 6) s = rsl[u.idx * 256 + rt_];
                else s = (gr >= 0 && gr < MROWS) ? rsqrtf(ss2[gr] * (1.f / 1024.f) + RMS_EPS) : 0.f;
#pragma unroll
                for (int bj = 0; bj < 2; ++bj)
#pragma unroll
                    for (int n = 0; n < 2; ++n) acc[ai][bj][m][n] *= s; }
        const int cl0 = wc * 32 + 8 * fq;
        if (fr >= 14) {
#pragma unroll
            for (int ai = 0; ai < 2; ++ai)
#pragma unroll
                for (int bj = 0; bj < 2; ++bj)
#pragma unroll
                    for (int n = 0; n < 2; ++n) *(PG8_LAS f32x4*)(xch + ((ai * 2 + wr) * 2 + (fr - 14)) * 256 + bj * HALF + cl0 + 4 * n) = acc[ai][bj][3][n];
        }
        if (tid_ < 256) *(PG8_LAS f32x4*)(taps + (tid_ >> 5) * 128 + 4 * (tid_ & 31)) = tapv;
        asm volatile("s_waitcnt lgkmcnt(0)\n\ts_barrier" ::: "memory");
        const int ch0 = u.pn * HALF + cl0;
        const bool seqstart = ((u.arow - 1 + 2047 + 2048) / 2048) <= ((u.arow + 255 + 2048) / 2048);
#pragma unroll
        for (int n = 0; n < 2; ++n) {
            f32x4 w0[2], w1[2], w2[2], bb[2];
#pragma unroll
            for (int bj = 0; bj < 2; ++bj) { const PG8_LAS float* tp = taps + bj * 512 + cl0 + 4 * n;
                w0[bj] = *(const PG8_LAS f32x4*)tp; w1[bj] = *(const PG8_LAS f32x4*)(tp + 128); w2[bj] = *(const PG8_LAS f32x4*)(tp + 256); bb[bj] = *(const PG8_LAS f32x4*)(tp + 384); }
#pragma unroll
            for (int ai = 0; ai < 2; ++ai) {
                const int g = ai * 2 + wr;
#pragma unroll
                for (int m = 0; m < 4; ++m) {
                    const int rt = ai * HALF + wr * 64 + m * 16 + fr, gr = u.arow + rt, t = gr & 2047;
                    f32x4 cv[2];
#pragma unroll
                    for (int bj = 0; bj < 2; ++bj) {
                        const f32x4 cur = acc[ai][bj][m][n]; f32x4 prev;
                        if (m > 0) prev = acc[ai][bj][m - 1][n];
                        else { prev = (f32x4){0.f, 0.f, 0.f, 0.f}; if (g > 0 && fr >= 14) prev = *(const PG8_LAS f32x4*)(xch + ((g - 1) * 2 + (fr - 14)) * 256 + bj * HALF + cl0 + 4 * n); }
                        f32x4 p1, p2;
#pragma unroll
                        for (int i = 0; i < 4; ++i) {
                            const float r1 = dpp_mov<0x121>(0.f, prev[i]), r2 = dpp_mov<0x122>(0.f, prev[i]);
                            p1[i] = dpp_mov<0x111>(r1, cur[i]); p2[i] = dpp_mov<0x112>(r2, cur[i]);
                        }
                        if (seqstart) { if (t == 0) { p1 = (f32x4){0.f, 0.f, 0.f, 0.f}; } if (t <= 1) { p2 = (f32x4){0.f, 0.f, 0.f, 0.f}; } }
                        cv[bj] = bb[bj] + w2[bj] * cur + w1[bj] * p1 + w0[bj] * p2;
                    }
                    float a4[4];
#pragma unroll
                    for (int i = 0; i < 4; ++i) { const float gv = cv[0][i]; a4[i] = gv * __builtin_amdgcn_rcpf(1.f + __expf(-gv)) * cv[1][i]; }
                    u32x2 w; w.x = cvt_pk_bf16(a4[0], a4[1]); w.y = cvt_pk_bf16(a4[2], a4[3]);
                    if (rt >= 2 && gr < MROWS) *(u32x2*)(act + (size_t)gr * FF + ch0 + 4 * n) = w;
                }
            }
        }
    }
};
}
#include <hip/hip_bf16.h>
#include <cmath>
namespace attn_body {
using bf16=__hip_bfloat16;
using bf16x8=__attribute__((ext_vector_type(8)))short;
using s16x4=__attribute__((ext_vector_type(4)))short;
using f32x16=__attribute__((ext_vector_type(16)))float;
using u32x4=__attribute__((ext_vector_type(4)))unsigned;
constexpr int BATCH=8,NHEAD=8,SEQ=2048,D=64,DM=3072,OM=1024;
constexpr int NW=8,QBLK=32,QB=QBLK*NW,KVBLK=64,NQB=SEQ/QB;
constexpr int ATTN_PITCH=DM, ATTN_UNIT_ROWS=QB;
__device__ __forceinline__ int crow(int r,int hi){return (r&3)+8*(r>>2)+4*hi;}
#define SBAR() __builtin_amdgcn_sched_barrier(0)
__device__ __forceinline__ void cmask(f32x16&p0,f32x16&p1,int jb,int qrel,int hi){
  const float NEG=-INFINITY; int kb=64*jb+4*hi;
  #pragma unroll
  for(int r=0;r<16;++r){int kv=kb+(r&3)+8*(r>>2); if(kv>qrel)p0[r]=NEG; if(kv+32>qrel)p1[r]=NEG;}
}

constexpr int NSLOT=3, SLOTB=8192;
constexpr int LDS_K=0, LDS_V=NSLOT*SLOTB, LDS_WS=2*NSLOT*SLOTB, LDS_OST=LDS_WS+NW*64*4, LDS_CB=LDS_OST+NW*4096, LDS_BYTES=LDS_CB+8192;
constexpr float C2=0.125f*1.4426950408889634f;
__device__ __forceinline__ void glds16(const void*gsrc,unsigned lds_dst){unsigned keep;
  asm volatile("s_mov_b32 %0, m0\n\ts_mov_b32 m0, %2\n\ts_nop 0\n\tglobal_load_lds_dwordx4 %1, off\n\ts_mov_b32 m0, %0":"=&s"(keep):"v"(gsrc),"s"(lds_dst):"memory");}
__device__ __forceinline__ float max3f(float a,float b,float c){float r;asm("v_max3_f32 %0, %1, %2, %3":"=v"(r):"v"(a),"v"(b),"v"(c));return r;}
__device__ __forceinline__ float max2f(float a,float b){float r;asm("v_max_f32_e32 %0, %1, %2":"=v"(r):"v"(a),"v"(b));return r;}
__device__ __forceinline__ float fadd_s(float a,float b){float r;asm("v_add_f32_e32 %0, %1, %2":"=v"(r):"v"(a),"v"(b));return r;}
__device__ __forceinline__ float fsub_s(float a,float b){float r;asm("v_sub_f32_e32 %0, %1, %2":"=v"(r):"v"(a),"v"(b));return r;}
typedef float f32x2_t __attribute__((ext_vector_type(2))); typedef __bf16 bf16x2_t __attribute__((ext_vector_type(2)));
__device__ __forceinline__ unsigned cvtpk_s(float lo,float hi){f32x2_t v={lo,hi};bf16x2_t b=__builtin_convertvector(v,bf16x2_t);return __builtin_bit_cast(unsigned,b);}
#define WAIT_BAR(N) asm volatile("s_waitcnt vmcnt(" #N ") lgkmcnt(0)\n\ts_barrier":::"memory")

__device__ __forceinline__ void qkt(f32x16&p0,f32x16&p1,const char*Kslot,const bf16x8*qr,const f32x16&negm,int r32,int hi){
  const char*kb=Kslot+hi*1024+r32*16;
  #pragma unroll
  for(int d0=0;d0<4;++d0){
    const bf16x8 b0=*reinterpret_cast<const bf16x8*>(kb+d0*2048);
    const bf16x8 b1=*reinterpret_cast<const bf16x8*>(kb+d0*2048+512);
    if(d0==0){p0=__builtin_amdgcn_mfma_f32_32x32x16_bf16(b0,qr[0],negm,0,0,0);p1=__builtin_amdgcn_mfma_f32_32x32x16_bf16(b1,qr[0],negm,0,0,0);}
    else{p0=__builtin_amdgcn_mfma_f32_32x32x16_bf16(b0,qr[d0],p0,0,0,0);p1=__builtin_amdgcn_mfma_f32_32x32x16_bf16(b1,qr[d0],p1,0,0,0);}}
}
typedef __attribute__((address_space(3))) const char* lds_cptr;
typedef short v4i16_t __attribute__((ext_vector_type(4)));
__device__ __forceinline__ void kload8(bf16x8*kf,lds_cptr kp){
  kf[0]=*(const __attribute__((address_space(3))) bf16x8*)(kp);      kf[1]=*(const __attribute__((address_space(3))) bf16x8*)(kp+512);
  kf[2]=*(const __attribute__((address_space(3))) bf16x8*)(kp+2048); kf[3]=*(const __attribute__((address_space(3))) bf16x8*)(kp+2560);
  kf[4]=*(const __attribute__((address_space(3))) bf16x8*)(kp+4096); kf[5]=*(const __attribute__((address_space(3))) bf16x8*)(kp+4608);
  kf[6]=*(const __attribute__((address_space(3))) bf16x8*)(kp+6144); kf[7]=*(const __attribute__((address_space(3))) bf16x8*)(kp+6656);
}
__device__ __forceinline__ void kload2(bf16x8*kf,lds_cptr kp,int j){ kf[2*j]=*(const __attribute__((address_space(3))) bf16x8*)(kp+j*2048); kf[2*j+1]=*(const __attribute__((address_space(3))) bf16x8*)(kp+j*2048+512); }
__device__ __forceinline__ s16x4 vtr(lds_cptr p){ return __builtin_bit_cast(s16x4,__builtin_amdgcn_ds_read_tr16_b64_v4i16((__attribute__((address_space(3))) v4i16_t*)p)); }
__device__ __forceinline__ float rowmax(const f32x16&p0,const f32x16&p1){
  float a=max3f(p0[0],p0[1],p1[0]),b=max3f(p0[2],p0[3],p1[1]);a=max3f(a,p1[2],p1[3]);
  #pragma unroll
  for(int r=4;r<16;r+=4){a=max3f(a,p0[r],p0[r+1]);b=max3f(b,p0[r+2],p0[r+3]);a=max3f(a,p1[r],p1[r+1]);b=max3f(b,p1[r+2],p1[r+3]);}
  const float m=max2f(a,b);
  auto rr=__builtin_amdgcn_permlane32_swap(__float_as_uint(m),__float_as_uint(m),false,false);
  return max2f(__uint_as_float(rr[0]),__uint_as_float(rr[1]));
}
__device__ __forceinline__ void pv(f32x16*o,int vb,bf16x8 pa0,bf16x8 pa1,bf16x8 pa2,bf16x8 pa3){
  #pragma unroll
  for(int d0=0;d0<2;++d0){s16x4 lo[4],hi[4];
    #pragma unroll
    for(int ks=0;ks<4;++ks){
      asm volatile("ds_read_b64_tr_b16 %0,%1 offset:%c2":"=&v"(lo[ks]):"v"(vb),"i"(d0*4096+ks*1024):"memory");
      asm volatile("ds_read_b64_tr_b16 %0,%1 offset:%c2":"=&v"(hi[ks]):"v"(vb),"i"(d0*4096+ks*1024+512):"memory");}
    asm volatile("s_waitcnt lgkmcnt(0)":::"memory");SBAR();
    #define PK(k) (bf16x8){lo[k][0],lo[k][1],lo[k][2],lo[k][3],hi[k][0],hi[k][1],hi[k][2],hi[k][3]}
    o[d0]=__builtin_amdgcn_mfma_f32_32x32x16_bf16(pa0,PK(0),o[d0],0,0,0);
    o[d0]=__builtin_amdgcn_mfma_f32_32x32x16_bf16(pa1,PK(1),o[d0],0,0,0);
    o[d0]=__builtin_amdgcn_mfma_f32_32x32x16_bf16(pa2,PK(2),o[d0],0,0,0);
    o[d0]=__builtin_amdgcn_mfma_f32_32x32x16_bf16(pa3,PK(3),o[d0],0,0,0);
    #undef PK
  }
}

#ifndef ATTN_STORE16
#define ATTN_STORE16(p,v) (*(u32x4*)(p)=(v))
#endif
template<int THRL> __device__ __forceinline__ void attn_unit(int b,int h,int qb,const bf16*Q,const bf16*__restrict__ K,const bf16*__restrict__ V,bf16*O,const float*__restrict__ CB,float thr,char*shm){
  const int tid=threadIdx.x,lane=tid&63,r32=lane&31,hi=lane>>5; const int wid=__builtin_amdgcn_readfirstlane(tid>>6);
  const long rowbase=(long)b*SEQ; const int q0=qb*QB;
  const float*cgp_=CB+(long)(b*NHEAD+h)*SEQ; const float cref_=cgp_[q0];
  const int nt4_=(q0+QB)/KVBLK-4;
  const bool need_=((threadIdx.x&63)<nt4_) && ((cgp_[64*(threadIdx.x&63)+63]-cref_)<=thr);
  const int tn_=nt4_-__popcll(__ballot(need_));
  const int t0_=__builtin_amdgcn_readfirstlane(tn_&~1);
  const bf16*Qw=Q+(rowbase+q0+wid*QBLK)*DM+h*D;
  const bf16*Kh=K+(rowbase+64*t0_)*DM+h*D,*Vh=V+(rowbase+64*t0_)*DM+h*D;
  const lds_cptr shm3=(lds_cptr)shm; const unsigned lds0=(unsigned)(uintptr_t)shm;
  float*wsf=(float*)(shm+LDS_WS)+wid*64;
  const bf16*ksrc=Kh+(long)lane*DM+wid*8;
  const bf16*vsrc=Vh+(long)(16*(wid&3)+(lane>>2))*DM+(wid>>2)*32+(lane&3)*8;
  const unsigned kdst=lds0+LDS_K+wid*1024, vdst=lds0+LDS_V+wid*1024;
  #define DMA_K(t,slot) glds16(ksrc+(long)(t)*KVBLK*DM,(unsigned)__builtin_amdgcn_readfirstlane(kdst+(slot)))
  #define DMA_V(t,slot) glds16(vsrc+(long)(t)*KVBLK*DM,(unsigned)__builtin_amdgcn_readfirstlane(vdst+(slot)))
  const int vb0=(int)(lds0+LDS_V)+((lane>>4)&1)*32+(lane&3)*8+(4*hi+((lane&15)>>2))*64;
  const char*Kbase=shm+LDS_K; bf16x8 kf[8];
  const lds_cptr kp0=shm3+LDS_K+hi*1024+r32*16; const lds_cptr vp0=shm3+LDS_V+((lane>>4)&1)*32+(lane&3)*8+(4*hi+((lane&15)>>2))*64;
  const int NT=(q0+QB)/KVBLK-t0_;
  typedef __attribute__((address_space(3))) float* lds_fptr; typedef float f32x4_t __attribute__((ext_vector_type(4)));
  const lds_fptr cbl=(lds_fptr)(shm3+LDS_CB);
  { const float*cg_=cgp_+64*t0_; const float cref=cref_;
    for(int i_=tid;i_<(q0+QB-64*t0_)/4;i_+=NW*64){ f32x4_t v_=*(const f32x4_t*)(cg_+4*i_); v_-=cref; *(__attribute__((address_space(3))) f32x4_t*)(cbl+4*i_)=v_; } }
  #define INITC(C,ptr) do{ const lds_fptr ip_=(ptr); \
    _Pragma("unroll") for(int g_=0;g_<4;++g_){ const f32x4_t c_=*(const __attribute__((address_space(3))) f32x4_t*)(ip_+8*g_); \
      _Pragma("unroll") for(int i_=0;i_<4;++i_){ C[4*g_+i_]=nmh_-c_[i_]; } } }while(0)
  #define BIAS(P0,P1,t) do{ const lds_fptr cp_=cbl+64*(t)+4*hi; \
    _Pragma("unroll") for(int g_=0;g_<4;++g_){ { const f32x4_t c0_=*(const __attribute__((address_space(3))) f32x4_t*)(cp_+8*g_)+mhat; \
      _Pragma("unroll") for(int i_=0;i_<4;++i_){ P0[4*g_+i_]-=c0_[i_]; } } asm volatile("":::"memory"); \
      { const f32x4_t c1_=*(const __attribute__((address_space(3))) f32x4_t*)(cp_+32+8*g_)+mhat; \
      _Pragma("unroll") for(int i_=0;i_<4;++i_){ P1[4*g_+i_]-=c1_[i_]; } } asm volatile("":::"memory"); } }while(0)
  DMA_K(0,0);DMA_V(0,0);DMA_K(1,SLOTB);
  bf16x8 qr[4];
  #pragma unroll
  for(int d0=0;d0<4;++d0)qr[d0]=*reinterpret_cast<const bf16x8*>(&Qw[(long)r32*DM+d0*16+hi*8]);
  float mhat=0.f,l_reg=0.f;f32x16 o[2];o[0]=f32x16{};o[1]=f32x16{};f32x16 negm=f32x16{}; const f32x16 zero16=f32x16{};
  const int qrel=wid*QBLK+r32;
  #define CMASK(P0,P1,t) do{int jb_=(t)-(NT-4); if(jb_>=0)cmask(P0,P1,jb_,qrel,hi);}while(0)
  bool resc=false;
  #define START(P0,P1) do{ const float rm=rowmax(P0,P1); resc=false; \
    { const float dl=rm; mhat=fadd_s(mhat,dl); \
      _Pragma("unroll") for(int r=0;r<16;++r){P0[r]=fsub_s(P0[r],dl);P1[r]=fsub_s(P1[r],dl);} \
      _Pragma("unroll") for(int r=0;r<16;++r)negm[r]=-mhat;  } \
    _Pragma("unroll") for(int r=0;r<16;++r)P0[r]=__builtin_amdgcn_exp2f(P0[r]); }while(0)
  #define RESC() do{ if(resc){ asm volatile("s_waitcnt lgkmcnt(0)":::"memory"); \
      _Pragma("unroll") for(int d_=0;d_<2;++d_) _Pragma("unroll") for(int r=0;r<16;++r)o[d_][r]*=wsf[crow(r,hi)]; } }while(0)
  f32x16 pA0,pA1,pB0,pB1;
  int sl_prev=0,sl_cur=0,sl_next=SLOTB;
  #define ROT() do{sl_prev=sl_cur;sl_cur=sl_next;sl_next=(sl_next==(NSLOT-1)*SLOTB)?0:sl_next+SLOTB;}while(0)
  DMA_K(2,2*SLOTB);
  WAIT_BAR(3);
  qkt(pA0,pA1,Kbase,qr,zero16,r32,hi);asm volatile("s_nop 15\n\ts_nop 7":"+v"(pA0),"+v"(pA1));BIAS(pA0,pA1,0);CMASK(pA0,pA1,0);
  START(pA0,pA1);
  _Pragma("unroll") for(int r=0;r<16;++r)pA1[r]=__builtin_amdgcn_exp2f(pA1[r]);
  WAIT_BAR(0);
  DMA_K(3,0);DMA_V(1,SLOTB);
  ROT();
  kload8(kf,kp0+sl_cur);
  WAIT_BAR(2);
  s16x4 vlo[8],vhi[8]; u32x4 pw0,pw1,pw2,pw3;
  #define PKW(P,B) cvtpk_s(P[B],P[B+1])
  #define PAF(k) __builtin_bit_cast(bf16x8,pw##k)
  #define VFR(i) (bf16x8){vlo[i][0],vlo[i][1],vlo[i][2],vlo[i][3],vhi[i][0],vhi[i][1],vhi[i][2],vhi[i][3]}
  #define PIN(x) asm volatile("":"+v"(x))
  #define MX3(a,b,c) __builtin_fmaxf(__builtin_fmaxf((a),(b)),(c))
  #define GAPA(MF,A0,A1,A2,A3,W0,W1,PW) do{ MF; sacc+=A0; sacc+=A1; sacc+=A2; sacc+=A3; PIN(sacc); W0; W1; PIN(PW); SBAR(); }while(0)
  #define EX(v) __builtin_amdgcn_exp2f(v)
  #define GAPB(MF,X,B) do{ MF; X[B]=EX(X[B]); X[B+1]=EX(X[B+1]); X[B+2]=EX(X[B+2]); X[B+3]=EX(X[B+3]); PIN(X); SBAR(); }while(0)
  #define VRD(i) do{ vlo[i]=vtr(vp_+(((i)>>2)*4096+((i)&3)*1024)); vhi[i]=vtr(vp_+(((i)>>2)*4096+((i)&3)*1024+512)); }while(0)
  #define KRD(G,j) do{ if(G){ kload2(kf,kp0+sl_next,j); SBAR(); } }while(0)
  #define STEP(C0,C1,P0,P1,t,GK,GV,GL) do{ SBAR(); \
    const lds_cptr vp_=vp0+sl_prev; \
    const float nmh_=-mhat; INITC(C0,cbl+64*(t)+4*hi); SBAR(); \
    VRD(0); SBAR(); float sacc=(P0[0]+P0[1]); \
    GAPA(C0=__builtin_amdgcn_mfma_f32_32x32x16_bf16(kf[0],qr[0],C0,0,0,0), P0[2],P0[3],P0[4],P0[5],     pw0[0]=PKW(P0,0), pw0[1]=PKW(P0,2), pw0); \
    INITC(C1,cbl+64*(t)+32+4*hi); SBAR(); \
    VRD(4); SBAR(); GAPA(C1=__builtin_amdgcn_mfma_f32_32x32x16_bf16(kf[1],qr[0],C1,0,0,0), P0[6],P0[7],P0[8],P0[9],     pw0[2]=PKW(P0,4), pw0[3]=PKW(P0,6), pw0); \
    VRD(1); SBAR(); GAPA(C0=__builtin_amdgcn_mfma_f32_32x32x16_bf16(kf[2],qr[1],C0,0,0,0),   P0[10],P0[11],P0[12],P0[13], pw1[0]=PKW(P0,8), pw1[1]=PKW(P0,10), pw1); \
    VRD(5); SBAR(); GAPA(C1=__builtin_amdgcn_mfma_f32_32x32x16_bf16(kf[3],qr[1],C1,0,0,0),   P0[14],P0[15],P1[0],P1[1],   pw1[2]=PKW(P0,12),pw1[3]=PKW(P0,14), pw1); \
    VRD(2); SBAR(); GAPA(C0=__builtin_amdgcn_mfma_f32_32x32x16_bf16(kf[4],qr[2],C0,0,0,0),   P1[2],P1[3],P1[4],P1[5],     pw2[0]=PKW(P1,0), pw2[1]=PKW(P1,2), pw2); \
    VRD(6); SBAR(); GAPA(C1=__builtin_amdgcn_mfma_f32_32x32x16_bf16(kf[5],qr[2],C1,0,0,0),   P1[6],P1[7],P1[8],P1[9],     pw2[2]=PKW(P1,4), pw2[3]=PKW(P1,6), pw2); \
    VRD(3); SBAR(); GAPA(C0=__builtin_amdgcn_mfma_f32_32x32x16_bf16(kf[6],qr[3],C0,0,0,0),   P1[10],P1[11],P1[12],P1[13], pw3[0]=PKW(P1,8), pw3[1]=PKW(P1,10), pw3); \
    VRD(7); SBAR(); GAPA(C1=__builtin_amdgcn_mfma_f32_32x32x16_bf16(kf[7],qr[3],C1,0,0,0),   P1[14],P1[15],0.f,0.f,       pw3[2]=PKW(P1,12),pw3[3]=PKW(P1,14), pw3); \
    l_reg+=sacc; \
    if(GK){DMA_K((t)+3,sl_cur);} if(GV){DMA_V((t)+1,sl_next);} \
    CMASK(C0,C1,t); \
    { float a=MX3(C0[0],C0[1],C1[0]),b=MX3(C0[2],C0[3],C1[1]); a=MX3(a,C1[2],C1[3]); \
      _Pragma("unroll") for(int r=4;r<16;r+=4){a=MX3(a,C0[r],C0[r+1]);b=MX3(b,C0[r+2],C0[r+3]);a=MX3(a,C1[r],C1[r+1]);b=MX3(b,C1[r+2],C1[r+3]);} \
      float rm=__builtin_fmaxf(a,b); { auto rr=__builtin_amdgcn_permlane32_swap(__float_as_uint(rm),__float_as_uint(rm),false,false); rm=__builtin_fmaxf(__uint_as_float(rr[0]),__uint_as_float(rr[1])); } \
      resc=false; \
      if(__builtin_expect(__any(rm>(float)THRL),0)){ const float dl=__builtin_fmaxf(rm,0.f); mhat+=dl; \
        _Pragma("unroll") for(int r=0;r<16;++r){C0[r]-=dl;C1[r]-=dl;} \
        _Pragma("unroll") for(int r=0;r<16;++r)negm[r]=-mhat;  \
        const float f=__builtin_amdgcn_exp2f(-dl); l_reg*=f; if(hi==0)wsf[r32]=f; resc=true; } } \
    SBAR(); \
    GAPB(o[0]=__builtin_amdgcn_mfma_f32_32x32x16_bf16(PAF(0),VFR(0),o[0],0,0,0), C0,0); \
    GAPB(o[1]=__builtin_amdgcn_mfma_f32_32x32x16_bf16(PAF(0),VFR(4),o[1],0,0,0), C0,4); \
    KRD(GL,0); GAPB(o[0]=__builtin_amdgcn_mfma_f32_32x32x16_bf16(PAF(1),VFR(1),o[0],0,0,0), C0,8); \
    KRD(GL,1); GAPB(o[1]=__builtin_amdgcn_mfma_f32_32x32x16_bf16(PAF(1),VFR(5),o[1],0,0,0), C0,12); \
    KRD(GL,2); GAPB(o[0]=__builtin_amdgcn_mfma_f32_32x32x16_bf16(PAF(2),VFR(2),o[0],0,0,0), C1,0); \
    KRD(GL,3); GAPB(o[1]=__builtin_amdgcn_mfma_f32_32x32x16_bf16(PAF(2),VFR(6),o[1],0,0,0), C1,4); \
    GAPB(o[0]=__builtin_amdgcn_mfma_f32_32x32x16_bf16(PAF(3),VFR(3),o[0],0,0,0), C1,8); \
    GAPB(o[1]=__builtin_amdgcn_mfma_f32_32x32x16_bf16(PAF(3),VFR(7),o[1],0,0,0), C1,12); \
    }while(0)
  int t=1;
  #undef CMASK
  #define CMASK(P0,P1,t) do{}while(0)
  for(;t+5<NT;t+=2){
    STEP(pB0,pB1,pA0,pA1,t,true,true,true);     WAIT_BAR(2); RESC(); ROT();
    STEP(pA0,pA1,pB0,pB1,t+1,true,true,true);   WAIT_BAR(2); RESC(); ROT();
  }
  #undef CMASK
  #define CMASK(P0,P1,t) do{int jb_=(t)-(NT-4); if(jb_>=0)cmask(P0,P1,jb_,qrel,hi);}while(0)
  #define ENDW(tt) do{ if((tt)+3<NT){WAIT_BAR(2);} else if((tt)+2<NT){WAIT_BAR(1);} else {WAIT_BAR(0);} }while(0)
  for(;t+1<NT;t+=2){
    STEP(pB0,pB1,pA0,pA1,t,(t+3<NT),(t+1<NT),(t+1<NT));       ENDW(t);   RESC(); ROT();
    STEP(pA0,pA1,pB0,pB1,t+1,(t+4<NT),(t+2<NT),(t+2<NT));     ENDW(t+1); RESC(); ROT();
  }
  STEP(pB0,pB1,pA0,pA1,NT-1,false,false,false); RESC();
  { float sacc=pB0[0]+pB0[1]; _Pragma("unroll") for(int r=2;r<16;++r)sacc+=pB0[r]; _Pragma("unroll") for(int r=0;r<16;++r)sacc+=pB1[r]; l_reg+=sacc;
    pw0=(u32x4){PKW(pB0,0),PKW(pB0,2),PKW(pB0,4),PKW(pB0,6)};pw1=(u32x4){PKW(pB0,8),PKW(pB0,10),PKW(pB0,12),PKW(pB0,14)};pw2=(u32x4){PKW(pB1,0),PKW(pB1,2),PKW(pB1,4),PKW(pB1,6)};pw3=(u32x4){PKW(pB1,8),PKW(pB1,10),PKW(pB1,12),PKW(pB1,14)};
    SBAR(); pv(o,vb0+sl_cur,PAF(0),PAF(1),PAF(2),PAF(3)); }
  #undef PKW
  #undef PAF
  #undef VFR
  #undef PIN
  #undef MX3
  #undef GAPA
  #undef GAPB
  #undef EX
  #undef VRD
  #undef KRD
  #undef STEP
  #undef ENDW
  {auto rr=__builtin_amdgcn_permlane32_swap(__float_as_uint(l_reg),__float_as_uint(l_reg),false,false);l_reg=__uint_as_float(rr[0])+__uint_as_float(rr[1]);}
  if(hi==0)wsf[32+r32]=l_reg;asm volatile("s_waitcnt lgkmcnt(0)":::"memory");
  float rli[16];
  #pragma unroll
  for(int r=0;r<16;++r)rli[r]=__builtin_amdgcn_rcpf(wsf[32+crow(r,hi)]);
  bf16*Ow=O+(rowbase+q0+wid*QBLK)*OM+h*D;
  { bf16*stg=(bf16*)(shm+LDS_OST)+wid*2048;
    #pragma unroll
    for(int r=0;r<16;++r){const int orow=crow(r,hi);
      #pragma unroll
      for(int d0=0;d0<2;++d0)stg[orow*64+d0*32+r32]=__float2bfloat16(o[d0][r]*rli[r]);}
    asm volatile("s_waitcnt lgkmcnt(0)":::"memory");
    #pragma unroll
    for(int i=0;i<4;++i){const int row=i*8+(lane>>3),ch=lane&7; const u32x4 v=*(const u32x4*)(stg+row*64+ch*8); ATTN_STORE16(Ow+(long)row*OM+ch*8,v);} }
  asm volatile("s_waitcnt lgkmcnt(0)\n\ts_barrier":::"memory");
  #undef DMA_K
  #undef DMA_V
  #undef CMASK
  #undef START
  #undef RESC
  #undef ROT
  #undef BIAS
  #undef INITC
}
constexpr int ATTN_LDS_BYTES=LDS_BYTES;
struct AttnTensors { const bf16* Q; const bf16* K; const bf16* V; bf16* O; const float* CB; float thr; };
struct AttnUnit { int bh; int qb; };
struct StaticOrder {
  int vcu,G;
  __device__ __forceinline__ explicit StaticOrder(int grid,int v):vcu(v),G(grid){}
  __device__ __forceinline__ bool next(int i,AttnUnit&u)const{ const int p=vcu+(i>>1)*G; if(p>=256)return false; const int s=p&3; u.bh=p>>2; u.qb=(i&1)?7-s:s; return true; }
  __device__ __forceinline__ void a_ready(const AttnUnit&)const{}
  __device__ __forceinline__ void done(const AttnUnit&)const{}
};
template<class Sched,int THRL=8> __device__ __forceinline__ void attn_phase(char*lds,const AttnTensors&T,const Sched&S){
  AttnUnit u;
  for(int i=0;S.next(i,u);++i){ S.a_ready(u); attn_unit<THRL>(u.bh/NHEAD,u.bh%NHEAD,u.qb,T.Q,T.K,T.V,T.O,T.CB,T.thr,lds); S.done(u); }
}
#undef SBAR
#undef WAIT_BAR
}
#define LAS __attribute__((address_space(3)))
namespace mk {
typedef unsigned short bf16;
typedef unsigned u32x4 __attribute__((ext_vector_type(4)));
typedef unsigned u32x2 __attribute__((ext_vector_type(2)));
typedef float f32x4 __attribute__((ext_vector_type(4)));
typedef float f32x2 __attribute__((ext_vector_type(2)));
typedef float f32x16 __attribute__((ext_vector_type(16)));
typedef short bf16x8 __attribute__((ext_vector_type(8)));
typedef unsigned v4u __attribute__((ext_vector_type(4)));
constexpr int NWAVES = 8, NT = 512;
constexpr int M = 16384, SEQ = 2048, DM = 1024, INW = 3096, PROJW = 3072, FF = 2816, PLE = 256;
constexpr float EPS = 1e-6f, LOG2E = 1.4426950408889634f, C2 = 0.125f * LOG2E;
constexpr size_t MiB = 1u << 20;
constexpr size_t WS_WIN = 1 * MiB, WS_WSK = 7 * MiB, WS_WO = 8 * MiB, WS_WUP = 10 * MiB, WS_WD = 21 * MiB, WS_WPG = 27 * MiB, WS_WPE = 29 * MiB;
constexpr size_t WS_SMALL = 30 * MiB;
constexpr size_t WS_LRF = 31 * MiB, WS_PB = 33 * MiB, WS_QE = 41 * MiB, WS_XB = 50 * MiB  , WS_MIX = 83 * MiB, WS_PROJ = 115 * MiB, WS_END = 228 * MiB;
constexpr size_t WS_SPREV = 212 * MiB  , WS_E = WS_MIX, WS_ACT = WS_PROJ;
constexpr int LDS_BYTES = 151552, XCH_OFF = 131072, RSL_OFF = XCH_OFF + 12544;

typedef __bf16 hwbf16x2 __attribute__((ext_vector_type(2)));
__device__ __forceinline__ unsigned pk2(float lo, float hi) { f32x2 v = {lo, hi}; return __builtin_bit_cast(unsigned, __builtin_convertvector(v, hwbf16x2)); }
__device__ __forceinline__ unsigned f2bf(float f) { return pk2(f, 0.f) & 0xffffu; }
__device__ __forceinline__ float bf2f(unsigned short h) { return __builtin_bit_cast(float, (unsigned)h << 16); }
__device__ __forceinline__ float bflo(unsigned w) { return __builtin_bit_cast(float, w << 16); }
__device__ __forceinline__ float bfhi(unsigned w) { return __builtin_bit_cast(float, w & 0xffff0000u); }
__device__ __forceinline__ float logsig(float z) { return fminf(z, 0.f) - __logf(1.f + __expf(-fabsf(z))); }
__device__ __forceinline__ int crow(int r, int hi) { return (r & 3) + 8 * (r >> 2) + 4 * hi; }
__device__ __forceinline__ float wave_sum(float v) {
#pragma unroll
    for (int o = 1; o < 64; o <<= 1) v += __shfl_xor(v, o);
    return v;
}
#define LDS_WAIT() asm volatile("s_waitcnt lgkmcnt(0)" ::: "memory")
#define LDS_SYNC() asm volatile("s_waitcnt lgkmcnt(0)\n\ts_barrier" ::: "memory")

struct Args { const float* in[21]; float* out; unsigned char* ws; };

template <bool HAS_GAIN>
__device__ __forceinline__ void tr_item(const float* W, int ldw, int k0, int srccol, const float* gain, bf16* WT, int ldk, int dstrow0, LAS float* scr, int lane) {
    const int sc = srccol < 0 ? 0 : srccol; const float msk = srccol < 0 ? 0.f : 1.f;
    const float* wp = W + (size_t)(k0 + (lane >> 5)) * ldw + sc;
    float v[32], gv[32];
#pragma unroll
    for (int i = 0; i < 32; ++i) v[i] = __builtin_nontemporal_load(wp + (size_t)(2 * i) * ldw);
    if (HAS_GAIN) {
#pragma unroll
        for (int i = 0; i < 32; ++i) gv[i] = gain[k0 + 2 * i + (lane >> 5)];
    }
#pragma unroll
    for (int i = 0; i < 32; ++i) scr[(2 * i + (lane >> 5)) * 33 + (lane & 31)] = HAS_GAIN ? v[i] * gv[i] * msk : v[i] * msk;
    LDS_WAIT();
    const int c = lane & 7;
#pragma unroll
    for (int j = 0; j < 4; ++j) { const int n = (lane >> 3) + 8 * j; const LAS float* s = scr + (8 * c) * 33 + n;
        u32x4 o; o.x = pk2(s[0 * 33], s[1 * 33]); o.y = pk2(s[2 * 33], s[3 * 33]); o.z = pk2(s[4 * 33], s[5 * 33]); o.w = pk2(s[6 * 33], s[7 * 33]);
        *(u32x4*)(WT + (size_t)(dstrow0 + n) * ldk + k0 + 8 * c) = o; }
    LDS_WAIT();
}

__device__ __forceinline__ void p0_prologue(const Args& a, LAS unsigned char* lds, int vcu, int G, int wave, int lane, int tid) {
    unsigned char* ws = a.ws;
    LAS float* scr = (LAS float*)(lds + wave * 16384);
    const int gw = vcu * NWAVES + wave, NGW = G * NWAVES;
    constexpr int I_IN = 16 * 96, I_SK = 16, I_O = 16 * 32, I_UP = 16 * 176, I_D = 44 * 32, I_PG = 16 * 32, I_PE = 4 * 32;
    constexpr int NITEMS = I_IN + I_SK + I_O + I_UP + I_PE;
    for (int it = gw; it < NITEMS; it += NGW) {
        int r = it; const int nl = lane & 31;
        if (r < I_IN) { const int kb = r / 96, nb = r % 96, n0 = 32 * nb; tr_item<true>(a.in[3], INW, 64 * kb, n0 + (n0 >= 1536 ? 16 : 0) + nl, a.in[2], (bf16*)(ws + WS_WIN), DM, n0, scr, lane); continue; } r -= I_IN;
        if (r < I_SK) { const int sc = nl < 16 ? 1536 + nl : (nl < 24 ? 3088 + nl - 16 : -1); tr_item<true>(a.in[3], INW, 64 * r, sc, a.in[2], (bf16*)(ws + WS_WSK), DM, 0, scr, lane); continue; } r -= I_SK;
        if (r < I_O) { const int kb = r / 32, nb = r % 32; tr_item<false>(a.in[10], DM, 64 * kb, 32 * nb + nl, nullptr, (bf16*)(ws + WS_WO), DM, 32 * nb, scr, lane); continue; } r -= I_O;
        if (r < I_UP) { const int kb = r / 176, nb = r % 176, pn = nb >> 3, wi = nb & 7; const int sc0 = wi < 4 ? 128 * pn + 32 * wi : FF + 128 * pn + 32 * (wi - 4);
            tr_item<true>(a.in[12], 2 * FF, 64 * kb, sc0 + nl, a.in[11], (bf16*)(ws + WS_WUP), DM, 32 * nb, scr, lane); continue; } r -= I_UP;
        { const int kb = r / 32, nb = r % 32; tr_item<false>(a.in[17], DM, 64 * kb, 32 * nb + nl, nullptr, (bf16*)(ws + WS_WPE), PLE, 32 * nb, scr, lane); }
    }
    float* rstd1 = (float*)(ws + WS_SMALL); bf16* xb = (bf16*)(ws + WS_XB); bf16* pb = (bf16*)(ws + WS_PB);
    for (int m0 = gw; m0 < M; m0 += 2 * NGW) {
        f32x4 v[2][4], pv[2];
#pragma unroll
        for (int q = 0; q < 2; ++q) { const int m = m0 + q * NGW; const f32x4* xr = (const f32x4*)(a.in[0] + (size_t)m * DM) + lane;
#pragma unroll
            for (int j = 0; j < 4; ++j) v[q][j] = __builtin_nontemporal_load(xr + 64 * j);
            pv[q] = __builtin_nontemporal_load((const f32x4*)(a.in[1] + (size_t)m * PLE) + lane); }
#pragma unroll
        for (int q = 0; q < 2; ++q) { const int m = m0 + q * NGW; float s = 0.f;
#pragma unroll
            for (int j = 0; j < 4; ++j) s += (v[q][j].x * v[q][j].x + v[q][j].y * v[q][j].y) + (v[q][j].z * v[q][j].z + v[q][j].w * v[q][j].w);
            s = wave_sum(s); if (lane == 0) rstd1[m] = rsqrtf(s * (1.f / DM) + EPS);
            u32x2* o8 = (u32x2*)(xb + (size_t)m * DM) + lane;
#pragma unroll
            for (int j = 0; j < 4; ++j) o8[64 * j] = (u32x2){pk2(v[q][j].x, v[q][j].y), pk2(v[q][j].z, v[q][j].w)};
            *((u32x2*)(pb + (size_t)m * PLE) + lane) = (u32x2){pk2(pv[q].x, pv[q].y), pk2(pv[q].z, pv[q].w)}; }
    }
    float* ssz = (float*)(ws + WS_SMALL) + M;
    for (int i = vcu * NT + tid; i < 3 * M; i += G * NT) ssz[i] = 0.f;
}

__device__ __forceinline__ void p6_late_weights(const Args& a, LAS unsigned char* lds, int cl, int nl, int wave, int lane) {
    unsigned char* ws = a.ws; LAS float* scr = (LAS float*)(lds + wave * 16384); const int nl32 = lane & 31;
    constexpr int I_D = 44 * 32, I_PG = 16 * 32;
    for (int it = cl * NWAVES + wave; it < I_D + I_PG; it += nl * NWAVES) {
        if (it < I_D) { const int kb = it / 32, nb = it % 32; tr_item<false>(a.in[15], DM, 64 * kb, 32 * nb + nl32, nullptr, (bf16*)(ws + WS_WD), FF, 32 * nb, scr, lane); }
        else { const int r = it - I_D, kb = r / 32, nb = r % 32; tr_item<true>(a.in[19], DM, 64 * kb, 32 * nb + nl32, a.in[16], (bf16*)(ws + WS_WPG), DM, 32 * nb, scr, lane); }
    }
}

__device__ __forceinline__ void p1_skinny(const Args& a, LAS unsigned char* lds, int vcu, int G, int wave, int lane, int tid) {
    const bf16* xb = (const bf16*)(a.ws + WS_XB); const bf16* wsk = (const bf16*)(a.ws + WS_WSK); const float* rstd1 = (const float*)(a.ws + WS_SMALL); float* lrf = (float*)(a.ws + WS_LRF);
    LAS float* red = (LAS float*)lds;
    const int r32 = lane & 31, hi = lane >> 5;
    for (int rg = vcu; rg < M / 64; rg += G) {
        const int row0 = rg * 64; f32x16 acc0 = {}, acc1 = {};
#pragma unroll
        for (int ks = 0; ks < 8; ++ks) { const int k = wave * 128 + ks * 16 + 8 * hi;
            const bf16x8 a0 = *(const bf16x8*)(xb + (size_t)(row0 + r32) * DM + k), a1 = *(const bf16x8*)(xb + (size_t)(row0 + 32 + r32) * DM + k), b = *(const bf16x8*)(wsk + (size_t)r32 * DM + k);
            acc0 = __builtin_amdgcn_mfma_f32_32x32x16_bf16(a0, b, acc0, 0, 0, 0); acc1 = __builtin_amdgcn_mfma_f32_32x32x16_bf16(a1, b, acc1, 0, 0, 0); }
#pragma unroll
        for (int r = 0; r < 16; ++r) { red[(wave * 64 + crow(r, hi)) * 32 + r32] = acc0[r]; red[(wave * 64 + 32 + crow(r, hi)) * 32 + r32] = acc1[r]; }
        LDS_SYNC();
        { const int row = tid >> 3, c4 = tid & 7; f32x4 s = {0.f, 0.f, 0.f, 0.f};
#pragma unroll
            for (int w = 0; w < 8; ++w) s += *(const LAS f32x4*)(red + (w * 64 + row) * 32 + c4 * 4);
            s *= rstd1[row0 + row];
            if (c4 == 4 || c4 == 5) { const f32x4 bf = *(const f32x4*)(a.in[7] + (c4 - 4) * 4); s = (f32x4){logsig(s.x + bf.x), logsig(s.y + bf.y), logsig(s.z + bf.z), logsig(s.w + bf.w)}; }
            *(f32x4*)(lrf + (size_t)(row0 + row) * 32 + c4 * 4) = s; }
        LDS_SYNC();
    }
}

__device__ __forceinline__ bf16x8 ldfrag(const LAS bf16* base, int row, int ks, int hi) { return *(const LAS bf16x8*)(base + row * 72 + ks * 16 + 8 * hi); }
#define PK16(a_, b_) ((unsigned)(a_) | ((unsigned)(b_) << 16))
struct GlaIn { f32x4 lrq; unsigned qp[8], kp[8], vv2[16]; };
__device__ __forceinline__ void gla_local_load(GlaIn& I, const Args& a, int task0, int wave, int tid) {
    const bf16* proj = (const bf16*)(a.ws + WS_PROJ); const float* lrf = (const float*)(a.ws + WS_LRF);
    const int hb = wave >> 2, t256 = tid & 255, task = task0 + hb;
    const int bh = task >> 5, n = task & 31, b = bh >> 2, h = bh & 3, tok0 = b * SEQ + n * 64;
    const int kp = t256 & 31, seg = t256 >> 5, vp = t256 & 63, sg = t256 >> 6;
    I.lrq = *(const f32x4*)(lrf + (size_t)(tok0 + (t256 >> 2)) * 32 + (t256 & 3) * 4);
#pragma unroll
    for (int i = 0; i < 8; ++i) { const bf16* pr = proj + (size_t)(tok0 + seg * 8 + i) * PROJW + h * 64 + 2 * kp; I.qp[i] = *(const unsigned*)pr; I.kp[i] = *(const unsigned*)(pr + 256); }
#pragma unroll
    for (int i = 0; i < 16; ++i) I.vv2[i] = *(const unsigned*)(proj + (size_t)(tok0 + sg * 16 + i) * PROJW + 512 + h * 128 + 2 * vp);
}
__device__ __forceinline__ void gla_local2(const GlaIn& I, const f32x2 (&w)[16], f32x2 bias, const Args& a, LAS unsigned char* lds_all, int task0, int wave, int lane, int tid) {
    unsigned char* ws = a.ws;
    bf16* qeg = (bf16*)(ws + WS_QE);
    float* decay = (float*)(ws + WS_SMALL) + 4 * M; float* ointra = a.out; float* dS = a.out + (size_t)M * 512;
    const int hb = wave >> 2, w4 = wave & 3, t256 = tid & 255, task = task0 + hb;
    const int bh = task >> 5, n = task & 31, b = bh >> 2, h = bh & 3, tok0 = b * SEQ + n * 64;
    LAS unsigned char* lds = lds_all + hb * 61440;
    LAS bf16* QE = (LAS bf16*)lds; LAS bf16* KE = QE + 64 * 72; LAS bf16* KDT = KE + 64 * 72; LAS bf16* VT = KDT + 64 * 72; LAS bf16* AT = VT + 128 * 72;
    LAS float* SEG = (LAS float*)(AT + 64 * 72); LAS float* LR = SEG + 512;
    const int r32 = lane & 31, hi = lane >> 5;
    const int kp = t256 & 31, seg = t256 >> 5;
    const int vp = t256 & 63, sg = t256 >> 6;
    *(LAS f32x4*)(LR + (t256 >> 2) * 16 + (t256 & 3) * 4) = I.lrq;
    LDS_SYNC();
    f32x2 bl[8]; f32x2 run = {0.f, 0.f};
#pragma unroll
    for (int i = 0; i < 8; ++i) { const LAS f32x4* lr = (const LAS f32x4*)(LR + (seg * 8 + i) * 16); f32x2 z = bias;
#pragma unroll
        for (int j = 0; j < 4; ++j) { const f32x4 l4 = lr[j]; z += (w[4 * j] * l4.x + w[4 * j + 1] * l4.y) + (w[4 * j + 2] * l4.z + w[4 * j + 3] * l4.w); }
        run += (f32x2){logsig(z.x), logsig(z.y)} * (1.f / 16.f); bl[i] = run; }
    *(LAS f32x2*)(SEG + seg * 64 + 2 * kp) = run;
    {
        unsigned lo[8], hh[8];
#pragma unroll
        for (int q = 0; q < 8; ++q) { const unsigned x0 = I.vv2[2 * q], x1 = I.vv2[2 * q + 1]; lo[q] = (x0 & 0xffffu) | (x1 << 16); hh[q] = (x0 >> 16) | (x1 & 0xffff0000u); }
        *(LAS u32x4*)(VT + (2 * vp) * 72 + sg * 16) = (u32x4){lo[0], lo[1], lo[2], lo[3]}; *(LAS u32x4*)(VT + (2 * vp) * 72 + sg * 16 + 8) = (u32x4){lo[4], lo[5], lo[6], lo[7]};
        *(LAS u32x4*)(VT + (2 * vp + 1) * 72 + sg * 16) = (u32x4){hh[0], hh[1], hh[2], hh[3]}; *(LAS u32x4*)(VT + (2 * vp + 1) * 72 + sg * 16 + 8) = (u32x4){hh[4], hh[5], hh[6], hh[7]}; }
    LDS_SYNC();
    {   f32x2 prefix = {0.f, 0.f}, total = {0.f, 0.f};
#pragma unroll
        for (int s2 = 0; s2 < 8; ++s2) { const f32x2 sv = *(const LAS f32x2*)(SEG + s2 * 64 + 2 * kp); total += sv; if (s2 < seg) prefix += sv; }
        float kd0[8], kd1[8];
#pragma unroll
        for (int i = 0; i < 8; ++i) { const int t = seg * 8 + i; const f32x2 bb = bl[i] + prefix;
            const float q0 = bflo(I.qp[i]), q1 = bfhi(I.qp[i]), k0 = bflo(I.kp[i]), k1 = bfhi(I.kp[i]);
            const unsigned qe = pk2(q0 * 0.125f * __expf(bb.x), q1 * 0.125f * __expf(bb.y));
            *(LAS unsigned*)(QE + t * 72 + 2 * kp) = qe; *(LAS unsigned*)(KE + t * 72 + 2 * kp) = pk2(k0 * __expf(-bb.x), k1 * __expf(-bb.y));
            *(unsigned*)(qeg + (size_t)(tok0 + t) * 256 + h * 64 + 2 * kp) = qe;
            kd0[i] = k0 * __expf(total.x - bb.x); kd1[i] = k1 * __expf(total.y - bb.y); }
        *(LAS u32x4*)(KDT + (2 * kp) * 72 + seg * 8) = (u32x4){pk2(kd0[0], kd0[1]), pk2(kd0[2], kd0[3]), pk2(kd0[4], kd0[5]), pk2(kd0[6], kd0[7])};
        *(LAS u32x4*)(KDT + (2 * kp + 1) * 72 + seg * 8) = (u32x4){pk2(kd1[0], kd1[1]), pk2(kd1[2], kd1[3]), pk2(kd1[4], kd1[5]), pk2(kd1[6], kd1[7])};
        if (seg == 0) *(f32x2*)(decay + task * 64 + 2 * kp) = (f32x2){__expf(total.x), __expf(total.y)};
    }
    LDS_SYNC();
    {
        const int ti = w4 >> 1, si = w4 & 1; f32x16 acc = {};
        if (si <= ti) {
#pragma unroll
            for (int ks = 0; ks < 4; ++ks) acc = __builtin_amdgcn_mfma_f32_32x32x16_bf16(ldfrag(QE, ti * 32 + r32, ks, hi), ldfrag(KE, si * 32 + r32, ks, hi), acc, 0, 0, 0);
        }
#pragma unroll
        for (int r = 0; r < 16; ++r) { const int trow = ti * 32 + crow(r, hi), scol = si * 32 + r32; AT[trow * 72 + scol] = (unsigned short)f2bf(scol <= trow ? acc[r] : 0.f); }
    }
    LDS_SYNC();
    {
        const int ti = w4 >> 1;
#pragma unroll
        for (int q = 0; q < 2; ++q) { const int vi = (w4 & 1) * 2 + q; f32x16 o = {}, ds = {};
#pragma unroll
            for (int ks = 0; ks < 4; ++ks) { const bf16x8 vb = ldfrag(VT, vi * 32 + r32, ks, hi);
                o = __builtin_amdgcn_mfma_f32_32x32x16_bf16(ldfrag(AT, ti * 32 + r32, ks, hi), vb, o, 0, 0, 0);
                ds = __builtin_amdgcn_mfma_f32_32x32x16_bf16(ldfrag(KDT, ti * 32 + r32, ks, hi), vb, ds, 0, 0, 0); }
#pragma unroll
            for (int r = 0; r < 16; ++r) { const int row = ti * 32 + crow(r, hi);
                ointra[(size_t)(tok0 + row) * 512 + h * 128 + vi * 32 + r32] = o[r];
                dS[(size_t)task * 8192 + row * 128 + vi * 32 + r32] = ds[r]; } }
    }
    LDS_SYNC();
}
__device__ __forceinline__ void gla_w_load(f32x2 (&w)[16], f32x2& bias, const Args& a, int h, int kp) {
#pragma unroll
    for (int j = 0; j < 16; ++j) w[j] = *(const f32x2*)(a.in[4] + j * 256 + h * 64 + 2 * kp);
    bias = *(const f32x2*)(a.in[5] + h * 64 + 2 * kp);
}
__device__ __forceinline__ void gla_local_all(const Args& a, LAS unsigned char* lds, int vcu, int G, int wave, int lane, int tid) {
    const int t0 = 2 * vcu; if (t0 >= 1024) return;
    const int kp = tid & 31;
    f32x2 w[16]; f32x2 bias; gla_w_load(w, bias, a, ((t0 + (wave >> 2)) >> 5) & 3, kp);
    const int t1 = t0 + 2 * G; const bool has1 = t1 < 1024;
    {   GlaIn A, B; gla_local_load(A, a, t0, wave, tid);
        if (has1) gla_local_load(B, a, t1, wave, tid);
        gla_local2(A, w, bias, a, lds, t0, wave, lane, tid);
        if (has1) {
            if ((2 * G) % 128 != 0) gla_w_load(w, bias, a, ((t1 + (wave >> 2)) >> 5) & 3, kp);
            gla_local2(B, w, bias, a, lds, t1, wave, lane, tid); } }
    for (int task = t0 + 4 * G; task < 1024; task += 2 * G) {
        gla_w_load(w, bias, a, ((task + (wave >> 2)) >> 5) & 3, kp);
        GlaIn C; gla_local_load(C, a, task, wave, tid); gla_local2(C, w, bias, a, lds, task, wave, lane, tid); }
}

__device__ __forceinline__ void fox_prep(const Args& a, LAS unsigned char* lds, int vcu, int G, int wave, int lane, int tid) {
    const float* lrf = (const float*)(a.ws + WS_LRF); float* cb = (float*)(a.ws + WS_SMALL) + 4 * M + 65536; LAS float* wt = (LAS float*)lds;
    for (int bh = vcu; bh < 64; bh += G) {
        const int b = bh >> 3, h = bh & 7; float v[4];
#pragma unroll
        for (int i = 0; i < 4; ++i) v[i] = lrf[(size_t)(b * SEQ + tid * 4 + i) * 32 + 16 + h];
        v[1] += v[0]; v[2] += v[1]; v[3] += v[2];
        float inc = v[3];
#pragma unroll
        for (int o = 1; o < 64; o <<= 1) { const float t = __shfl_up(inc, o); if (lane >= o) inc += t; }
        if (lane == 63) wt[wave] = inc;
        LDS_SYNC();
        float pre = inc - v[3];
#pragma unroll
        for (int w = 0; w < 8; ++w) { const float x = wt[w]; if (w < wave) pre += x; }
        *(f32x4*)(cb + (size_t)bh * SEQ + tid * 4) = (f32x4){(pre + v[0]) * LOG2E, (pre + v[1]) * LOG2E, (pre + v[2]) * LOG2E, (pre + v[3]) * LOG2E};
        LDS_SYNC();
    }
}

__device__ __forceinline__ void gla_scan(const Args& a, int vcu, int G, int tid) {
    const float* decay = (const float*)(a.ws + WS_SMALL) + 4 * M; const float* dS = a.out + (size_t)M * 512; bf16* sprev = (bf16*)(a.ws + WS_SPREV);
    for (int e = (vcu * NT + tid) * 2; e < 32 * 8192; e += G * NT * 2) {
        const int j = e >> 13, bh = (j & 1) + 2 * (j >> 2) + 16 * ((j >> 1) & 1), kv = e & 8191, k = kv >> 7; f32x2 st = {0.f, 0.f};
#pragma unroll
        for (int n = 0; n < 32; ++n) { const int task = bh * 32 + n; const size_t idx = (size_t)task * 8192 + kv;
            *(unsigned*)(sprev + idx) = pk2(st.x, st.y); const float d = decay[task * 64 + k]; const f32x2 ds = __builtin_nontemporal_load((const f32x2*)(dS + idx)); st = st * d + ds; }
    }
}

__device__ __forceinline__ void gla_final2(const Args& a, LAS unsigned char* lds_all, int task0, int wave, int lane, int tid) {
    unsigned char* ws = a.ws;
    const bf16* proj = (const bf16*)(ws + WS_PROJ); const bf16* qeg = (const bf16*)(ws + WS_QE); const bf16* sprev = (const bf16*)(ws + WS_SPREV);
    const float* ointra = a.out; bf16* mix = (bf16*)(ws + WS_MIX);
    const int hb = wave >> 2, w4 = wave & 3, t256 = tid & 255, task = task0 + hb;
    const int bh = task >> 5, n = task & 31, b = bh >> 2, h = bh & 3, tok0 = b * SEQ + n * 64;
    LAS unsigned char* lds = lds_all + hb * 61440;
    LAS bf16* QE = (LAS bf16*)lds; LAS bf16* ST = QE + 64 * 72; LAS float* OL = (LAS float*)(lds + 27648);
    const int r32 = lane & 31, hi = lane >> 5, ti = w4 >> 1;
    const int rr = t256 >> 4, c16 = t256 & 15;
    u32x4 qv[2];
#pragma unroll
    for (int q = 0; q < 2; ++q) { const int e = t256 + 256 * q; qv[q] = *(const u32x4*)(qeg + (size_t)(tok0 + (e >> 3)) * 256 + h * 64 + (e & 7) * 8); }
    unsigned f2[16];
    { const int vp = t256 & 63, kg = t256 >> 6;
#pragma unroll
        for (int i = 0; i < 16; ++i) f2[i] = __builtin_nontemporal_load((const unsigned*)(sprev + (size_t)task * 8192 + (kg * 16 + i) * 128 + 2 * vp)); }
    f32x4 oiv[4][2]; u32x4 gw[4];
#pragma unroll
    for (int p = 0; p < 4; ++p) { const size_t tok = (size_t)(tok0 + p * 16 + rr);
        oiv[p][0] = __builtin_nontemporal_load((const f32x4*)(ointra + tok * 512 + h * 128 + c16 * 8)); oiv[p][1] = __builtin_nontemporal_load((const f32x4*)(ointra + tok * 512 + h * 128 + c16 * 8 + 4));
        gw[p] = *(const u32x4*)(proj + tok * PROJW + 1024 + h * 128 + c16 * 8); }
    const f32x4 gn0 = *(const f32x4*)(a.in[6] + c16 * 8), gn1 = *(const f32x4*)(a.in[6] + c16 * 8 + 4);
#pragma unroll
    for (int q = 0; q < 2; ++q) { const int e = t256 + 256 * q; *(LAS u32x4*)(QE + (e >> 3) * 72 + (e & 7) * 8) = qv[q]; }
    { const int vp = t256 & 63, kg = t256 >> 6; unsigned lo[8], hh[8];
#pragma unroll
        for (int q = 0; q < 8; ++q) { const unsigned x0 = f2[2 * q], x1 = f2[2 * q + 1]; lo[q] = (x0 & 0xffffu) | (x1 << 16); hh[q] = (x0 >> 16) | (x1 & 0xffff0000u); }
        *(LAS u32x4*)(ST + (2 * vp) * 72 + kg * 16) = (u32x4){lo[0], lo[1], lo[2], lo[3]}; *(LAS u32x4*)(ST + (2 * vp) * 72 + kg * 16 + 8) = (u32x4){lo[4], lo[5], lo[6], lo[7]};
        *(LAS u32x4*)(ST + (2 * vp + 1) * 72 + kg * 16) = (u32x4){hh[0], hh[1], hh[2], hh[3]}; *(LAS u32x4*)(ST + (2 * vp + 1) * 72 + kg * 16 + 8) = (u32x4){hh[4], hh[5], hh[6], hh[7]}; }
    LDS_SYNC();
#pragma unroll
    for (int q = 0; q < 2; ++q) { const int vi = (w4 & 1) * 2 + q; f32x16 acc = {};
#pragma unroll
        for (int ks = 0; ks < 4; ++ks) acc = __builtin_amdgcn_mfma_f32_32x32x16_bf16(ldfrag(QE, ti * 32 + r32, ks, hi), ldfrag(ST, vi * 32 + r32, ks, hi), acc, 0, 0, 0);
#pragma unroll
        for (int r = 0; r < 16; ++r) { const int row = ti * 32 + crow(r, hi), col = vi * 32 + r32; OL[row * 132 + col] = acc[r]; } }
    LDS_SYNC();
#pragma unroll
    for (int p = 0; p < 4; ++p) { const int t = p * 16 + rr;
        const f32x4 o0 = *(const LAS f32x4*)(OL + t * 132 + c16 * 8) + oiv[p][0], o1 = *(const LAS f32x4*)(OL + t * 132 + c16 * 8 + 4) + oiv[p][1];
        float ssq = (o0.x * o0.x + o0.y * o0.y) + (o0.z * o0.z + o0.w * o0.w) + (o1.x * o1.x + o1.y * o1.y) + (o1.z * o1.z + o1.w * o1.w);
        ssq += __shfl_xor(ssq, 1); ssq += __shfl_xor(ssq, 2); ssq += __shfl_xor(ssq, 4); ssq += __shfl_xor(ssq, 8);
        const float r = rsqrtf(ssq * (1.f / 128.f) + EPS);
        const u32x4 g = gw[p]; const float og[8] = {bflo(g.x), bfhi(g.x), bflo(g.y), bfhi(g.y), bflo(g.z), bfhi(g.z), bflo(g.w), bfhi(g.w)};
        float y[8];
#pragma unroll
        for (int c = 0; c < 4; ++c) { const float g0 = og[c], g1 = og[4 + c];
            y[c] = o0[c] * r * gn0[c] * (g0 * __builtin_amdgcn_rcpf(1.f + __expf(-g0))); y[4 + c] = o1[c] * r * gn1[c] * (g1 * __builtin_amdgcn_rcpf(1.f + __expf(-g1))); }
        u32x4 pk; pk.x = pk2(y[0], y[1]); pk.y = pk2(y[2], y[3]); pk.z = pk2(y[4], y[5]); pk.w = pk2(y[6], y[7]);
        *(u32x4*)(mix + (size_t)(tok0 + t) * DM + h * 128 + c16 * 8) = pk; }
    LDS_SYNC();
}

#define XB_TMO      128
#define XB_XCNT(j)  (256  + 64 * (j))
#define XB_XSUB(j)  (1280 + 64 * (j))
#define XB_XGEN(j)  (2304 + 64 * (j))
#define XB_TOP      3328
#define XB_TOPGEN   3392
#define XCD_BAR_WORDS 3456
#define XB_SPIN_CAP (1u << 18)

__device__ __forceinline__ unsigned xb_ld(unsigned* p)              { return __hip_atomic_load(p, __ATOMIC_RELAXED, __HIP_MEMORY_SCOPE_AGENT); }
__device__ __forceinline__ unsigned xb_add(unsigned* p, unsigned v) { return __hip_atomic_fetch_add(p, v, __ATOMIC_RELAXED, __HIP_MEMORY_SCOPE_AGENT); }
__device__ __forceinline__ unsigned xb_xcc_id() { return (unsigned)__builtin_amdgcn_s_getreg((3 << 11) | 20) & 0xFu; }
#define XB_SPIN(cond, bar) do { unsigned _sp = 0; while (cond) { __builtin_amdgcn_s_sleep(1); \
    if ((++_sp & 255u) == 0u) { if (xb_ld(&(bar)[XB_TMO])) break; if (_sp > XB_SPIN_CAP) { atomicAdd(&(bar)[XB_TMO], 1u); break; } } } } while (0)

struct XcdBarrier {
    unsigned* bar; unsigned x;
    volatile LAS unsigned* st;
};

__device__ __forceinline__ XcdBarrier xcd_barrier_post(unsigned* bar, volatile LAS unsigned* st, bool leader) {
    XcdBarrier b; b.bar = bar; b.x = xb_xcc_id(); b.st = st;
    if (leader) (void)xb_add(&bar[XB_XCNT(b.x)], 1u);
    return b;
}
__device__ __forceinline__ void xcd_barrier_complete(unsigned* bar, unsigned x, unsigned& nloc, unsigned& nx) {
    const unsigned G = gridDim.x * gridDim.y * gridDim.z;
    unsigned sum, cnt, mine, sp = 0u;
    for (;;) {
        sum = 0u; cnt = 0u; mine = 0u;
#pragma unroll
        for (unsigned j = 0; j < 16; ++j) { const unsigned c = xb_ld(&bar[XB_XCNT(j)]); sum += c; cnt += (c > 0u) ? 1u : 0u; mine = (j == x) ? c : mine; }
        if (sum == G) break;
        __builtin_amdgcn_s_sleep(1);
        if ((++sp & 255u) == 0u) { if (xb_ld(&bar[XB_TMO])) break; if (sp > XB_SPIN_CAP) { atomicAdd(&bar[XB_TMO], 1u); break; } }
    }
    nloc = mine > 0u ? mine : 1u; nx = cnt > 0u ? cnt : 1u;
}

__device__ __forceinline__ void xcd_barrier(const XcdBarrier& b, bool leader) {
    asm volatile("s_waitcnt vmcnt(0)" ::: "memory");
    __syncthreads();
    if (leader) {
        unsigned* bar = b.bar;
        __builtin_amdgcn_s_waitcnt(0);
        unsigned nloc = b.st[0], nx = b.st[1];
        if (nloc == 0u) { xcd_barrier_complete(bar, b.x, nloc, nx); b.st[0] = nloc; b.st[1] = nx; }
        const unsigned old = xb_add(&bar[XB_XSUB(b.x)], 1u);
        const unsigned gen = old / nloc;
        if (old + 1u == (gen + 1u) * nloc) {
            __builtin_amdgcn_fence(__ATOMIC_RELEASE, "agent");
            asm volatile("s_waitcnt vmcnt(0)" ::: "memory");
            const unsigned og = xb_add(&bar[XB_TOP], 1u);
            const unsigned tg = og / nx;
            if (og + 1u == (tg + 1u) * nx) xb_add(&bar[XB_TOPGEN], 1u);
            else XB_SPIN(xb_ld(&bar[XB_TOPGEN]) == tg, bar);
            __builtin_amdgcn_fence(__ATOMIC_ACQUIRE, "agent");
            xb_add(&bar[XB_XGEN(b.x)], 1u);
            asm volatile("s_waitcnt vmcnt(0)" ::: "memory");
        } else {
            XB_SPIN(xb_ld(&bar[XB_XGEN(b.x)]) == gen, bar);
            __builtin_amdgcn_fence(__ATOMIC_ACQUIRE, "agent");
            asm volatile("s_waitcnt vmcnt(0)" ::: "memory");
        }
    }
    __syncthreads();
}

__device__ __forceinline__ void sb_arrive(const XcdBarrier& b, int set, bool leader) {
    asm volatile("s_waitcnt vmcnt(0)" ::: "memory"); __syncthreads();
    if (leader) { unsigned* w = b.bar + 4096 + 2048 * set; const unsigned nloc = b.st[0], nx = b.st[1];
        const unsigned old = xb_add(&w[64 * b.x], 1u);
        if (old + 1u == nloc) { __builtin_amdgcn_fence(__ATOMIC_RELEASE, "agent"); asm volatile("s_waitcnt vmcnt(0)" ::: "memory");
            const unsigned og = xb_add(&w[1024], 1u); if (og + 1u == nx) xb_add(&w[1088], 1u); } }
}
__device__ __forceinline__ void sb_wait(const XcdBarrier& b, int set, bool leader) {
    if (leader) { unsigned* w = b.bar + 4096 + 2048 * set; XB_SPIN(xb_ld(&w[1088]) == 0u, b.bar);
        __builtin_amdgcn_fence(__ATOMIC_ACQUIRE, "agent"); asm volatile("s_waitcnt vmcnt(0)" ::: "memory"); }
    __syncthreads();
}
#ifndef MK_SKIP
#define MK_SKIP 0
#endif
#define RUN(k) (!((MK_SKIP >> (k)) & 1))
#ifndef REP_SYNC
#define REP_SYNC 1
#endif
#ifndef REP_P0
#define REP_P0 1
#endif
#ifndef REP_P1
#define REP_P1 1
#endif
#ifndef REP_GL
#define REP_GL 1
#endif
#ifndef REP_SC
#define REP_SC 1
#endif
#ifndef REP_AT
#define REP_AT 1
#endif
#ifndef REP_GF
#define REP_GF 1
#endif
#ifndef REP_P5
#define REP_P5 1
#endif
#ifndef REP_P7
#define REP_P7 1
#endif
#ifndef REP_P8
#define REP_P8 1
#endif
#ifndef REP_FP
#define REP_FP 1
#endif
#ifndef REP_P6
#define REP_P6 1
#endif
#ifndef STAMP_K
#define STAMP_K -1
#endif
#define GSYNC() do { for (int s_ = 0; s_ < REP_SYNC; ++s_) xcd_barrier(xbar, wave == 0 && lane_id() == 0); \
    if (STAMP_K >= 0) { if (bx == 0 && wave == 0 && lane_id() == 0) { ((unsigned long long*)(ws + 65536))[n_stamp] = __builtin_amdgcn_s_memrealtime(); } ++n_stamp; } } while (0)
__global__ void __launch_bounds__(NT, 2) mk_fwd(Args a) {
    extern __shared__ __attribute__((aligned(16))) unsigned char lds_raw[];
    LAS unsigned char* lds = (LAS unsigned char*)lds_raw;
    const int wave = __builtin_amdgcn_readfirstlane(threadIdx.x >> 6);
#define lane (lane_id())
#define tid (wave * 64 + lane_id())
    const int G = gridDim.x, bx = blockIdx.x, vcu = (G % 8 == 0) ? (bx % 8) * (G / 8) + bx / 8 : bx;
    unsigned char* ws = a.ws;
    bf16* xb = (bf16*)(ws + WS_XB); float* small = (float*)(ws + WS_SMALL);
    float* ss2 = small + M; float* ss3 = small + 2 * M; float* ssE = small + 3 * M;
    volatile LAS unsigned* xst = (volatile LAS unsigned*)(lds + XCH_OFF + 8192);
    if (wave == 0 && lane_id() == 0) { xst[0] = 0u; xst[1] = 0u; }
    __syncthreads();
    int n_stamp = 1; if (STAMP_K >= 0 && bx == 0 && wave == 0 && lane_id() == 0) ((unsigned long long*)(ws + 65536))[0] = __builtin_amdgcn_s_memrealtime();
    const XcdBarrier xbar = xcd_barrier_post((unsigned*)ws, xst, wave == 0 && lane_id() == 0);

    for (int rep_ = 0; rep_ < REP_P0; ++rep_) if (RUN(0)) p0_prologue(a, lds, vcu, G, wave, lane, tid);
    GSYNC();
    for (int rep_ = 0; rep_ < REP_P1; ++rep_) if (RUN(1)) {   pg8::Gemm g{xb, (const bf16*)(ws + WS_WIN), M, PROJW, DM}; pg8::StaticOrder S; S.init(M / 256, PROJW / 256, G, bx);
        pg8::EpiProj E{(bf16*)(ws + WS_PROJ), PROJW, small, a.in[8], a.in[9], (LAS float*)(lds + XCH_OFF)};
        pg8::gemm_phase<pg8::EpiProj, pg8::StaticOrder, true, true>(lds, g, S, E, wave);
        p1_skinny(a, lds, vcu, G, wave, lane, tid);
    }
    GSYNC();
    {
#ifndef STAMP2_K
#define STAMP2_K -1
#endif
#define SUBSTAMP(i) do { if (STAMP2_K >= 0 && bx == 0 && wave == 0 && lane_id() == 0) ((unsigned long long*)(ws + 65536 + 1024))[i] = __builtin_amdgcn_s_memrealtime(); } while (0)
        SUBSTAMP(0);
        if (RUN(9)) fox_prep(a, lds, vcu, G, wave, lane, tid);
        sb_arrive(xbar, 0, wave == 0 && lane_id() == 0);
        for (int rep_ = 0; rep_ < REP_GL; ++rep_) if (RUN(2)) gla_local_all(a, lds, vcu, G, wave, lane, tid);
        sb_arrive(xbar, 1, wave == 0 && lane_id() == 0); SUBSTAMP(1);
        sb_wait(xbar, 0, wave == 0 && lane_id() == 0); SUBSTAMP(2);
        const attn_body::bf16* pj = (const attn_body::bf16*)(ws + WS_PROJ);
        float gqm = 0.f, gkm = 0.f;
        for (int i = 0; i < 64; ++i) { gqm = fmaxf(gqm, fabsf(a.in[8][i])); gkm = fmaxf(gkm, fabsf(a.in[9][i])); }
#ifndef ATTN_PRUNE
#define ATTN_PRUNE 1
#endif
        const float thr = ATTN_PRUNE ? 2.f * (64.f * gqm * gkm * C2 * 1.02f) + 48.f : 1e30f;
        const attn_body::AttnTensors AT{pj + 1536, pj + 2048, pj + 2560, (attn_body::bf16*)(ws + WS_MIX) + 512, small + 4 * M + 65536, thr};
        const attn_body::StaticOrder S(G, vcu);
        attn_body::AttnUnit u; bool scanned = false;
        for (int i = 0; S.next(i, u); ++i) {
            if (i == 1) { SUBSTAMP(3); sb_wait(xbar, 1, wave == 0 && lane_id() == 0); SUBSTAMP(4); gla_scan(a, vcu, G, tid); sb_arrive(xbar, 2, wave == 0 && lane_id() == 0); scanned = true; SUBSTAMP(5); }
            if (RUN(3)) attn_body::attn_unit<8>(u.bh / attn_body::NHEAD, u.bh % attn_body::NHEAD, u.qb, AT.Q, AT.K, AT.V, AT.O, AT.CB, AT.thr, (char*)lds_raw);
        }
        if (!scanned) { sb_wait(xbar, 1, wave == 0 && lane_id() == 0); gla_scan(a, vcu, G, tid); sb_arrive(xbar, 2, wave == 0 && lane_id() == 0); }
        SUBSTAMP(6); sb_wait(xbar, 2, wave == 0 && lane_id() == 0); SUBSTAMP(7);
        for (int rep_ = 0; rep_ < REP_GF; ++rep_) if (RUN(4)) for (int task = 2 * vcu; task < 1024; task += 2 * G) gla_final2(a, lds, task, wave, lane, tid);
        SUBSTAMP(8);
    }
    GSYNC();
    SUBSTAMP(9);
    if (RUN(5)) {   pg8::Gemm g{(const bf16*)(ws + WS_MIX), (const bf16*)(ws + WS_WO), M, DM, DM}; pg8::StaticOrder S; S.init(M / 256, DM / 256, G, bx);
        pg8::EpiRes<2> E{nullptr, xb, xb, ss2, DM};
        pg8::gemm_phase<pg8::EpiRes<2>, pg8::StaticOrder, true, true>(lds, g, S, E, wave);
    }
    GSYNC();
    for (int rep_ = 0; rep_ < REP_P6; ++rep_) if (RUN(6)) {   pg8::Gemm g{xb, (const bf16*)(ws + WS_WUP), M, 2 * FF, DM}; pg8::StaticOrder S; S.init(65, 2 * FF / 256, G, bx, 254, -2);
        {   LAS float* rsl = (LAS float*)(lds + RSL_OFF); pg8::Unit uu;
            for (int i = 0; i < 6 && S.next(i, uu); ++i) { const int r = tid; if (r < 256) { const int gr = uu.arow + r; rsl[i * 256 + r] = (gr >= 0 && gr < M) ? rsqrtf(ss2[gr] * (1.f / 1024.f) + EPS) : 0.f; } }
            LDS_SYNC(); }
        pg8::EpiUp E{(bf16*)(ws + WS_ACT), ss2, a.in[13], a.in[14], (LAS float*)(lds + XCH_OFF), (LAS float*)(lds + XCH_OFF + 8192 + 256), (LAS float*)(lds + RSL_OFF)};
        pg8::gemm_phase<pg8::EpiUp, pg8::StaticOrder, true, true>(lds, g, S, E, wave);
        {   const int nwg6 = 65 * (2 * FF / 256), rem = nwg6 % G, nl = rem ? G - rem : G, cl = rem ? bx - rem : bx;
            if (cl >= 0) { pg8::Gemm g2{(const bf16*)(ws + WS_PB), (const bf16*)(ws + WS_WPE), M, DM, PLE}; pg8::StaticOrder S2; S2.init(M / 256, DM / 256, nl, cl);
                pg8::EpiRes<0> E2{nullptr, nullptr, (bf16*)(ws + WS_E), ssE, DM};
                pg8::gemm_phase<pg8::EpiRes<0>, pg8::StaticOrder, true, true>(lds, g2, S2, E2, wave);
                p6_late_weights(a, lds, cl, nl, wave, lane); } }
    }
    GSYNC();
    if (RUN(7)) {   pg8::Gemm g{(const bf16*)(ws + WS_ACT), (const bf16*)(ws + WS_WD), M, DM, FF}; pg8::StaticOrder S; S.init(M / 256, DM / 256, G, bx);
        pg8::EpiRes<2> E{nullptr, xb, xb, ss3, DM};
        pg8::gemm_phase<pg8::EpiRes<2>, pg8::StaticOrder, true, true>(lds, g, S, E, wave);
    }
    GSYNC();
    if (RUN(8)) {   pg8::Gemm g{xb, (const bf16*)(ws + WS_WPG), M, DM, DM}; pg8::StaticOrder S; S.init(M / 256, DM / 256, G, bx);
        for (int rep_ = REP_P8 - 1; rep_ > 0; --rep_) { pg8::EpiGate Ed{xb, (float*)(ws + WS_PROJ), (const bf16*)(ws + WS_E), ss3, ssE, a.in[20], a.in[18], DM}; pg8::gemm_phase<pg8::EpiGate, pg8::StaticOrder, true, true>(lds, g, S, Ed, wave); }
        pg8::EpiGate E{xb, a.out, (const bf16*)(ws + WS_E), ss3, ssE, a.in[20], a.in[18], DM};
        pg8::gemm_phase<pg8::EpiGate, pg8::StaticOrder, true, true>(lds, g, S, E, wave);
    }
    if (STAMP2_K >= 0) { xcd_barrier(xbar, wave == 0 && lane_id() == 0);
        if (bx == 0 && wave == 0 && lane_id() == 0) { const unsigned long long* ts = (const unsigned long long*)(ws + 65536 + 1024);
            a.out[0] += 0.25f + (float)(ts[STAMP2_K + 1] - ts[STAMP2_K]) * 1e-4f; } }
    if (STAMP_K >= 0) { GSYNC();
        if (bx == 0 && wave == 0 && lane_id() == 0) { const unsigned long long* ts = (const unsigned long long*)(ws + 65536);
            a.out[0] += (float)(ts[STAMP_K + 1] - ts[STAMP_K]) * 1e-4f; } }
#undef lane
#undef tid
}
}

extern "C" void kernel_launch(void* const* d_in, const int* in_sizes, int n_in, void* d_out, int out_size, void* d_ws, size_t ws_size, hipStream_t stream) {
    static int grid = 0;
    if (grid == 0) {
        int dev = 0, cus = 0, per_cu = 0;
        hipGetDevice(&dev); hipDeviceGetAttribute(&cus, hipDeviceAttributeMultiprocessorCount, dev);
        hipFuncSetAttribute((const void*)mk::mk_fwd, hipFuncAttributeMaxDynamicSharedMemorySize, mk::LDS_BYTES);
        hipOccupancyMaxActiveBlocksPerMultiprocessor(&per_cu, (const void*)mk::mk_fwd, mk::NT, mk::LDS_BYTES);
        if (per_cu < 1) { fprintf(stderr, "kernel_launch: occupancy query says %d blocks per CU\n", per_cu); per_cu = 1; }
        grid = cus * per_cu;
        if (n_in != 21 || ws_size < mk::WS_END) { fprintf(stderr, "kernel_launch: unexpected n_in %d / ws %zu\n", n_in, ws_size); grid = -1; }
    }
    if (grid < 0) return;
#ifdef PROBE_MEMSET2
    (void)hipMemsetAsync((char*)d_ws + 131072, 0, 65536, stream);
#endif
    if (hipMemsetAsync(d_ws, 0, 65536, stream) != hipSuccess) { fprintf(stderr, "kernel_launch: memset of the barrier words failed\n"); return; }
    mk::Args a{};
    for (int i = 0; i < 21; ++i) a.in[i] = (const float*)d_in[i];
    a.out = (float*)d_out; a.ws = (unsigned char*)d_ws;
    hipLaunchKernelGGL(mk::mk_fwd, dim3(grid), dim3(mk::NT), mk::LDS_BYTES, stream, a);
    const hipError_t e = hipPeekAtLastError();
    if (e != hipSuccess) fprintf(stderr, "kernel_launch: launch failed: %s (grid %d)\n", hipGetErrorString(e), grid);
}
```

```cpp
#include <hip/hip_runtime.h>
#include <cstdio>
#include <cstdint>
__device__ __forceinline__ int lane_id() { int l; asm volatile("v_mbcnt_lo_u32_b32 %0, -1, 0\n\tv_mbcnt_hi_u32_b32 %0, -1, %0" : "=v"(l)); return l; }
namespace pg8 {
#define PG8_LAS __attribute__((address_space(3)))
typedef unsigned short bf16_t;
typedef short bf16x8 __attribute__((ext_vector_type(8)));
typedef float f32x4 __attribute__((ext_vector_type(4)));
typedef unsigned u32x4 __attribute__((ext_vector_type(4)));
constexpr int BM = 256, BK = 64, HALF = 128, HTB = HALF * BK * 2  , STAGE_BYTES = 8 * HTB, NXCD = 8, WGM = 8;

__host__ __device__ __forceinline__ int lds_byte(int r, int c) { const int st = (r >> 4) * 2 + (c >> 5), rr = r & 15, cc = c & 31, ob = rr * 64 + cc * 2; return st * 1024 + (ob ^ (((ob >> 9) & 1) << 5)); }
__host__ __device__ __forceinline__ void stage_rc(int b, int& R, int& C) { const int st = b / 1024, sb = b % 1024, swz = sb ^ (((sb >> 9) & 1) << 5); R = (st >> 1) * 16 + swz / 64; C = (st & 1) * 32 + (swz % 64) / 2; }
__host__ __device__ __forceinline__ int perm32(int rho) { const int n = rho >> 4, i = rho & 15; return 8 * (i >> 2) + 4 * n + (i & 3); }

struct Unit { int pm, pn, arow, idx; };
struct Gemm { const bf16_t* A; const bf16_t* Bt; int M, N, K; };

struct StaticOrder {
    int nM, nN, nwg, G, c, mstride, moff;
    __host__ __device__ void init(int nM_, int nN_, int G_, int c_, int mstride_ = 256, int moff_ = 0) { nM = nM_; nN = nN_; nwg = nM * nN; G = G_; c = c_; mstride = mstride_; moff = moff_; }
    __host__ __device__ bool next(int i, Unit& u) const {
        const long L = (long)i * G + c; if (L >= nwg) return false;
        int wgid = (int)L; { const int q = nwg / NXCD, r = nwg % NXCD, xcd = wgid % NXCD, off = wgid / NXCD; wgid = (xcd < r ? xcd * (q + 1) : r * (q + 1) + (xcd - r) * q) + off; }
        const int nig = WGM * nN, gid = wgid / nig, fm = gid * WGM, gsz = (nM - fm) < WGM ? (nM - fm) : WGM;
        u.pm = fm + ((wgid % nig) % gsz); u.pn = (wgid % nig) / gsz; u.arow = u.pm * mstride + moff; u.idx = i; return true;
    }
    __device__ __forceinline__ void a_ready(const Unit&) const {}
    __device__ __forceinline__ void done(const Unit&) const {}
};

__device__ __forceinline__ unsigned cvt_pk_bf16(float lo, float hi) { unsigned r; asm volatile("v_cvt_pk_bf16_f32 %0, %1, %2" : "=v"(r) : "v"(lo), "v"(hi)); return r; }
typedef float f32x2 __attribute__((ext_vector_type(2)));
typedef float f32x2 __attribute__((ext_vector_type(2)));
template <class Epi, class Sched, bool ALIGN_EPI = false, bool SP2 = false>
__device__ __forceinline__ void gemm_phase(PG8_LAS unsigned char* lds, const Gemm g, const Sched& S, const Epi& E, int wave_sgpr) {
    const int wid = wave_sgpr, lane = lane_id(), tid = wid * 64 + lane, wr = wid >> 2, wc = wid & 3, fr = lane & 15, fq = lane >> 4;
    const int K = g.K, nt = K / BK;
    unsigned voffA[2], voffB[2];
#pragma unroll
    for (int i = 0; i < 2; ++i) { int R, C; stage_rc(tid * 16 + i * 8192, R, C); const int Rb = Epi::PERM ? ((R & ~31) + perm32(R & 31)) : R;
        voffA[i] = (unsigned)(R * K + C) * 2u; voffB[i] = (unsigned)(Rb * K + C) * 2u; }
    const size_t kstep = (size_t)(BK * 2);
    const size_t hstep = (size_t)HALF * K * 2;
    const size_t tstep = 2 * hstep;
    const unsigned ldsw = (unsigned)wid * 1024u;
    const int aoff = lds_byte(wr * 64 + fr, fq * 8), boff = lds_byte(wc * 32 + fr, fq * 8);
#define PG8_SA(b, h) (((b) * 2 + (h)) * HTB)
#define PG8_SB(b, h) ((4 + (b) * 2 + (h)) * HTB)
#define PG8_STAGE(bufoff, gbase, voff) do { _Pragma("unroll") for (int _i = 0; _i < 2; ++_i) \
        __builtin_amdgcn_global_load_lds((const unsigned*)((const char*)(gbase) + (voff)[_i]), (PG8_LAS unsigned*)(lds + (bufoff) + ldsw + _i * 8192), 16, 0, 0); } while (0)
#define PG8_LDA(dst, b, h) do { _Pragma("unroll") for (int m = 0; m < 4; ++m) _Pragma("unroll") for (int k = 0; k < 2; ++k) dst[m][k] = *(const PG8_LAS bf16x8*)(lds + PG8_SA(b, h) + aoff + m * 2048 + k * 1024); } while (0)
#define PG8_LDB(dst, b, h) do { _Pragma("unroll") for (int n = 0; n < 2; ++n) _Pragma("unroll") for (int k = 0; k < 2; ++k) dst[n][k] = *(const PG8_LAS bf16x8*)(lds + PG8_SB(b, h) + boff + n * 2048 + k * 1024); } while (0)
#define PG8_MMA(ai, bj, At, Bt) do { __builtin_amdgcn_s_setprio(1); _Pragma("unroll") for (int m = 0; m < 4; ++m) _Pragma("unroll") for (int n = 0; n < 2; ++n) _Pragma("unroll") for (int k = 0; k < 2; ++k) \
        acc[ai][bj][m][n] = __builtin_amdgcn_mfma_f32_16x16x32_bf16(Bt[n][k], At[m][k], acc[ai][bj][m][n], 0, 0, 0); __builtin_amdgcn_s_setprio(0); } while (0)
#define PG8_WAIT_V(n) asm volatile("s_waitcnt vmcnt(" #n ")" ::: "memory")
#define PG8_WAIT_L(n) asm volatile("s_waitcnt lgkmcnt(" #n ")" ::: "memory")
#define PG8_BAR __builtin_amdgcn_s_barrier()
#define PG8_SCHED __builtin_amdgcn_sched_barrier(0)
    Unit cur, nxt; int ui = 0;
    if (!S.next(0, cur)) return;
    f32x4 acc[2][2][4][2];
#pragma unroll
    for (int a = 0; a < 2; ++a)
#pragma unroll
        for (int b = 0; b < 2; ++b)
#pragma unroll
            for (int m = 0; m < 4; ++m)
#pragma unroll
                for (int n = 0; n < 2; ++n) acc[a][b][m][n] = (f32x4){0.f, 0.f, 0.f, 0.f};
    bf16x8 At[4][2], B0[2][2], B1[2][2];
    const char* cA = (const char*)g.A + (long)cur.arow * (long)(K * 2); const char* cB = (const char*)g.Bt + (size_t)cur.pn * tstep;
    S.a_ready(cur);
    if constexpr (SP2) {
        PG8_STAGE(PG8_SB(0, 0), cB, voffB); PG8_STAGE(PG8_SB(0, 1), cB + hstep, voffB); PG8_STAGE(PG8_SA(0, 0), cA, voffA); PG8_STAGE(PG8_SA(0, 1), cA + hstep, voffA);
        if (wr == 1) PG8_BAR;
        PG8_WAIT_V(2); PG8_BAR;
        PG8_STAGE(PG8_SB(1, 0), cB + kstep, voffB); PG8_STAGE(PG8_SA(1, 0), cA + kstep, voffA); PG8_STAGE(PG8_SB(1, 1), cB + hstep + kstep, voffB);
        PG8_WAIT_V(6); PG8_BAR;
    } else {
        PG8_STAGE(PG8_SB(0, 0), cB, voffB); PG8_STAGE(PG8_SA(0, 0), cA, voffA); PG8_STAGE(PG8_SB(0, 1), cB + hstep, voffB); PG8_STAGE(PG8_SA(0, 1), cA + hstep, voffA);
        if (wr == 1) PG8_BAR;
        PG8_WAIT_V(4); PG8_BAR;
        PG8_STAGE(PG8_SB(1, 0), cB + kstep, voffB); PG8_STAGE(PG8_SA(1, 0), cA + kstep, voffA); PG8_STAGE(PG8_SB(1, 1), cB + hstep + kstep, voffB);
        PG8_WAIT_V(6); PG8_BAR;
    }
    for (;;) {
        const bool has_next = S.next(ui + 1, nxt);
        const char* nA = has_next ? (const char*)g.A + (long)nxt.arow * (long)(K * 2) : cA; const char* nB = has_next ? (const char*)g.Bt + (size_t)nxt.pn * tstep : cB;
        for (int t = 0; t < nt; t += 2) {
            const bool last = (t == nt - 2);
            const char* a1 = cA + (size_t)(t + 1) * kstep;
            const char* a2 = last ? nA : cA + (size_t)(t + 2) * kstep; const char* b2 = last ? nB : cB + (size_t)(t + 2) * kstep;
            const char* a3 = a2 + kstep; const char* b3 = b2 + kstep;
            if (last && has_next) S.a_ready(nxt);
            if constexpr (SP2) {
            PG8_LDB(B0, 0, 0); PG8_LDB(B1, 0, 1); PG8_SCHED; PG8_LDA(At, 0, 0); PG8_STAGE(PG8_SA(1, 1), a1 + hstep, voffA);
            PG8_WAIT_V(8); PG8_WAIT_L(0); PG8_BAR; PG8_MMA(0, 0, At, B0); PG8_MMA(0, 1, At, B1); PG8_BAR; PG8_SCHED;
            PG8_LDA(At, 0, 1); PG8_STAGE(PG8_SB(0, 0), b2, voffB); PG8_STAGE(PG8_SB(0, 1), b2 + hstep, voffB); PG8_STAGE(PG8_SA(0, 0), a2, voffA);
            PG8_WAIT_V(8); PG8_WAIT_L(0); PG8_BAR; PG8_MMA(1, 0, At, B0); PG8_MMA(1, 1, At, B1); PG8_BAR; PG8_SCHED;
            PG8_LDB(B0, 1, 0); PG8_LDB(B1, 1, 1); PG8_SCHED; PG8_LDA(At, 1, 0); PG8_STAGE(PG8_SA(0, 1), a2 + hstep, voffA);
            PG8_WAIT_V(8); PG8_WAIT_L(0); PG8_BAR; PG8_MMA(0, 0, At, B0); PG8_MMA(0, 1, At, B1); PG8_BAR; PG8_SCHED;
            PG8_LDA(At, 1, 1); PG8_STAGE(PG8_SB(1, 0), b3, voffB); PG8_STAGE(PG8_SB(1, 1), b3 + hstep, voffB); PG8_STAGE(PG8_SA(1, 0), a3, voffA);
            PG8_WAIT_V(8); PG8_WAIT_L(0); PG8_BAR; PG8_MMA(1, 0, At, B0); PG8_MMA(1, 1, At, B1); PG8_BAR; PG8_SCHED;
            } else {
            PG8_LDB(B0, 0, 0); PG8_SCHED; PG8_LDA(At, 0, 0); PG8_STAGE(PG8_SA(1, 1), a1 + hstep, voffA);
            PG8_WAIT_L(8); PG8_BAR; PG8_WAIT_L(0); PG8_MMA(0, 0, At, B0); PG8_BAR; PG8_SCHED;
            PG8_LDB(B1, 0, 1); PG8_STAGE(PG8_SB(0, 0), b2, voffB);
            PG8_BAR; PG8_WAIT_L(0); PG8_MMA(0, 1, At, B1); PG8_BAR;
            PG8_LDA(At, 0, 1); PG8_STAGE(PG8_SA(0, 0), a2, voffA);
            PG8_BAR; PG8_WAIT_L(0); PG8_MMA(1, 0, At, B0); PG8_BAR; PG8_SCHED;
            PG8_STAGE(PG8_SB(0, 1), b2 + hstep, voffB);
            PG8_WAIT_V(6); PG8_BAR; PG8_MMA(1, 1, At, B1); PG8_BAR;
            PG8_LDB(B0, 1, 0); PG8_SCHED; PG8_LDA(At, 1, 0); PG8_STAGE(PG8_SA(0, 1), a2 + hstep, voffA);
            PG8_WAIT_L(8); PG8_BAR; PG8_WAIT_L(0); PG8_MMA(0, 0, At, B0); PG8_BAR; PG8_SCHED;
            PG8_LDB(B1, 1, 1); PG8_STAGE(PG8_SB(1, 0), b3, voffB);
            PG8_BAR; PG8_WAIT_L(0); PG8_MMA(0, 1, At, B1); PG8_BAR;
            PG8_LDA(At, 1, 1); PG8_STAGE(PG8_SA(1, 0), a3, voffA);
            PG8_BAR; PG8_WAIT_L(0); PG8_MMA(1, 0, At, B0); PG8_BAR; PG8_SCHED;
            PG8_STAGE(PG8_SB(1, 1), b3 + hstep, voffB);
            PG8_WAIT_V(6); PG8_BAR; PG8_MMA(1, 1, At, B1); PG8_BAR;
            }
        }
        if constexpr (ALIGN_EPI) { if (wr == 0) PG8_BAR; }
        if constexpr (!Epi::AFTER_DRAIN) { E(acc, cur, wr, wc, fr, fq); S.done(cur); }
        if (!has_next) break;
#pragma unroll
        for (int a = 0; a < 2; ++a)
#pragma unroll
            for (int b = 0; b < 2; ++b)
#pragma unroll
                for (int m = 0; m < 4; ++m)
#pragma unroll
                    for (int n = 0; n < 2; ++n) acc[a][b][m][n] = (f32x4){0.f, 0.f, 0.f, 0.f};
        cur = nxt; cA = nA; cB = nB; ++ui;
        if constexpr (ALIGN_EPI) { if (wr == 1) PG8_BAR; }
    }
    PG8_WAIT_V(0);
    if constexpr (!ALIGN_EPI) { if (wr == 0) PG8_BAR; }
    PG8_BAR;
    if constexpr (Epi::AFTER_DRAIN) { E.fused(acc, cur, wr, wc, fr, fq, lds, wid, lane); S.done(cur); }
#undef PG8_SA
#undef PG8_SB
#undef PG8_STAGE
#undef PG8_LDA
#undef PG8_LDB
#undef PG8_MMA
#undef PG8_WAIT_V
#undef PG8_WAIT_L
#undef PG8_BAR
#undef PG8_SCHED
}
}
namespace pg8 {
constexpr float RMS_EPS = 1e-6f;
typedef unsigned u32x2 __attribute__((ext_vector_type(2)));
template <int CTRL> __device__ __forceinline__ float dpp_mov(float old, float src) {
    return __builtin_bit_cast(float, __builtin_amdgcn_update_dpp(__builtin_bit_cast(int, old), __builtin_bit_cast(int, src), CTRL, 0xf, 0xf, false)); }
__device__ __forceinline__ float bf_lo(unsigned w) { return __builtin_bit_cast(float, w << 16); }
__device__ __forceinline__ float bf_hi(unsigned w) { return __builtin_bit_cast(float, w & 0xffff0000u); }

struct EpiScaleBf16 {
    static constexpr bool PERM = true, AFTER_DRAIN = false;
    bf16_t* O; int ldc; const float* rs;
    __device__ __forceinline__ void operator()(const f32x4 (&acc)[2][2][4][2], const Unit& u, int wr, int wc, int fr, int fq) const {
        const int row0 = u.pm * BM + wr * 64 + fr, col0 = u.pn * BM + wc * 32 + 8 * fq;
        float sc[2][4];
#pragma unroll
        for (int ai = 0; ai < 2; ++ai)
#pragma unroll
            for (int m = 0; m < 4; ++m) sc[ai][m] = rs[row0 + ai * HALF + m * 16];
#pragma unroll
        for (int ai = 0; ai < 2; ++ai)
#pragma unroll
            for (int m = 0; m < 4; ++m) { const int r = row0 + ai * HALF + m * 16; const float s = sc[ai][m]; bf16_t* rowp = O + (size_t)r * ldc + col0;
#pragma unroll
                for (int bj = 0; bj < 2; ++bj) { const f32x4 v0 = acc[ai][bj][m][0] * s, v1 = acc[ai][bj][m][1] * s;
                    u32x4 w; w.x = cvt_pk_bf16(v0[0], v0[1]); w.y = cvt_pk_bf16(v0[2], v0[3]); w.z = cvt_pk_bf16(v1[0], v1[1]); w.w = cvt_pk_bf16(v1[2], v1[3]);
                    *(u32x4*)(rowp + bj * HALF) = w; } }
    }
};
struct EpiProj {
    static constexpr bool PERM = true, AFTER_DRAIN = false;
    bf16_t* O; int ldc; const float* rs; const float* gq; const float* gk; PG8_LAS float* part;
    __device__ __forceinline__ void operator()(f32x4 (&acc)[2][2][4][2], const Unit& u, int wr, int wc, int fr, int fq) const {
        const int row0 = u.pm * BM + wr * 64 + fr, col0 = u.pn * BM + wc * 32 + 8 * fq;
        float sc[2][4];
#pragma unroll
        for (int ai = 0; ai < 2; ++ai)
#pragma unroll
            for (int m = 0; m < 4; ++m) sc[ai][m] = rs[row0 + ai * HALF + m * 16];
        const bool fox = (u.pn >= 6 && u.pn < 10);
        if (!fox) {
#pragma unroll
            for (int ai = 0; ai < 2; ++ai)
#pragma unroll
                for (int m = 0; m < 4; ++m) { const int r = row0 + ai * HALF + m * 16; const float s = sc[ai][m]; bf16_t* rowp = O + (size_t)r * ldc + col0;
#pragma unroll
                    for (int bj = 0; bj < 2; ++bj) { const f32x4 v0 = acc[ai][bj][m][0] * s, v1 = acc[ai][bj][m][1] * s;
                        u32x4 w; w.x = cvt_pk_bf16(v0[0], v0[1]); w.y = cvt_pk_bf16(v0[2], v0[3]); w.z = cvt_pk_bf16(v1[0], v1[1]); w.w = cvt_pk_bf16(v1[2], v1[3]);
                        *(u32x4*)(rowp + bj * HALF) = w; } }
        } else {
#pragma unroll
            for (int ai = 0; ai < 2; ++ai)
#pragma unroll
                for (int m = 0; m < 4; ++m) { const float s = sc[ai][m]; const int rl = ai * HALF + wr * 64 + m * 16 + fr;
#pragma unroll
                    for (int bj = 0; bj < 2; ++bj) { acc[ai][bj][m][0] *= s; acc[ai][bj][m][1] *= s; const f32x4 v0 = acc[ai][bj][m][0], v1 = acc[ai][bj][m][1];
                        float q = (v0[0] * v0[0] + v0[1] * v0[1]) + (v0[2] * v0[2] + v0[3] * v0[3]) + (v1[0] * v1[0] + v1[1] * v1[1]) + (v1[2] * v1[2] + v1[3] * v1[3]);
                        q += __shfl_xor(q, 16); q += __shfl_xor(q, 32);
                        if (fq == 0) part[(wc * 2 + bj) * 256 + rl] = q; } }
            const float* gp = (u.pn < 8 ? gq : gk) + 32 * (wc & 1) + 8 * fq; const f32x4 g0 = *(const f32x4*)gp, g1 = *(const f32x4*)(gp + 4);
            asm volatile("s_waitcnt lgkmcnt(0)\n\ts_barrier" ::: "memory");
            const float mul = u.pn < 8 ? 0.125f * 1.4426950408889634f : 1.f;
#pragma unroll
            for (int ai = 0; ai < 2; ++ai)
#pragma unroll
                for (int m = 0; m < 4; ++m) { const int rl = ai * HALF + wr * 64 + m * 16 + fr; bf16_t* rowp = O + (size_t)(u.pm * BM + rl) * ldc + col0;
#pragma unroll
                    for (int bj = 0; bj < 2; ++bj) { const float tot = part[(wc * 2 + bj) * 256 + rl] + part[((wc ^ 1) * 2 + bj) * 256 + rl];
                        const float r = rsqrtf(tot * (1.f / 64.f) + RMS_EPS) * mul; const f32x4 v0 = acc[ai][bj][m][0] * r * g0, v1 = acc[ai][bj][m][1] * r * g1;
                        u32x4 w; w.x = cvt_pk_bf16(v0[0], v0[1]); w.y = cvt_pk_bf16(v0[2], v0[3]); w.z = cvt_pk_bf16(v1[0], v1[1]); w.w = cvt_pk_bf16(v1[2], v1[3]);
                        *(u32x4*)(rowp + bj * HALF) = w; } }
        }
    }
};
template <int BASE> struct EpiRes {
    static constexpr bool PERM = true, AFTER_DRAIN = false;
    const float* basef; const bf16_t* baseb; bf16_t* outb; float* ss; int ldc;
    __device__ __forceinline__ void operator()(const f32x4 (&acc)[2][2][4][2], const Unit& u, int wr, int wc, int fr, int fq) const {
        const int row0 = u.pm * BM + wr * 64 + fr, col0 = u.pn * BM + wc * 32 + 8 * fq;
        u32x4 preb[2][4][2];
        if (BASE == 2) {
#pragma unroll
            for (int ai = 0; ai < 2; ++ai)
#pragma unroll
                for (int m = 0; m < 4; ++m)
#pragma unroll
                    for (int bj = 0; bj < 2; ++bj) preb[ai][m][bj] = __builtin_nontemporal_load((const u32x4*)(baseb + (size_t)(row0 + ai * HALF + m * 16) * ldc + col0 + bj * HALF));
            asm volatile("" ::: "memory");
        }
#pragma unroll
        for (int ai = 0; ai < 2; ++ai)
#pragma unroll
          for (int mp = 0; mp < 2; ++mp) {
            f32x4 pre[2][2][2];
            if (BASE == 1) {
#pragma unroll
                for (int mm = 0; mm < 2; ++mm)
#pragma unroll
                    for (int bj = 0; bj < 2; ++bj) { const size_t off = (size_t)(row0 + ai * HALF + (2 * mp + mm) * 16) * ldc + col0 + bj * HALF;
                        pre[mm][bj][0] = *(const f32x4*)(basef + off); pre[mm][bj][1] = *(const f32x4*)(basef + off + 4); }
                asm volatile("" ::: "memory");
            }
#pragma unroll
            for (int mm = 0; mm < 2; ++mm) { const int m = 2 * mp + mm; const int r = row0 + ai * HALF + m * 16; float q = 0.f;
#pragma unroll
                for (int bj = 0; bj < 2; ++bj) { const size_t off = (size_t)r * ldc + col0 + bj * HALF;
                    f32x4 v0 = acc[ai][bj][m][0], v1 = acc[ai][bj][m][1];
                    if (BASE == 1) { v0 += pre[mm][bj][0]; v1 += pre[mm][bj][1]; }
                    if (BASE == 2) { const u32x4 b = preb[ai][m][bj]; v0 += (f32x4){bf_lo(b.x), bf_hi(b.x), bf_lo(b.y), bf_hi(b.y)}; v1 += (f32x4){bf_lo(b.z), bf_hi(b.z), bf_lo(b.w), bf_hi(b.w)}; }
                    u32x4 w; w.x = cvt_pk_bf16(v0[0], v0[1]); w.y = cvt_pk_bf16(v0[2], v0[3]); w.z = cvt_pk_bf16(v1[0], v1[1]); w.w = cvt_pk_bf16(v1[2], v1[3]);
                    *(u32x4*)(outb + off) = w;
                    q += (v0[0] * v0[0] + v0[1] * v0[1]) + (v0[2] * v0[2] + v0[3] * v0[3]) + (v1[0] * v1[0] + v1[1] * v1[1]) + (v1[2] * v1[2] + v1[3] * v1[3]); }
                q += __shfl_xor(q, 16); q += __shfl_xor(q, 32);
                if (fq == 0) atomicAdd(ss + r, q); }
          }
    }
};
struct EpiGate {
    static constexpr bool PERM = true, AFTER_DRAIN = false;
    const bf16_t* x2; float* out; const bf16_t* E; const float* ss3; const float* ssE; const float* bpg; const float* peg; int ldc;
    __device__ __forceinline__ void operator()(const f32x4 (&acc)[2][2][4][2], const Unit& u, int wr, int wc, int fr, int fq) const {
        const int row0 = u.pm * BM + wr * 64 + fr, col0 = u.pn * BM + wc * 32 + 8 * fq;
        f32x4 bp[2][2], pg[2][2];
#pragma unroll
        for (int bj = 0; bj < 2; ++bj)
#pragma unroll
            for (int n = 0; n < 2; ++n) { bp[bj][n] = *(const f32x4*)(bpg + col0 + bj * HALF + 4 * n); pg[bj][n] = *(const f32x4*)(peg + col0 + bj * HALF + 4 * n); }
#pragma unroll
        for (int ai = 0; ai < 2; ++ai)
#pragma unroll
            for (int mp = 0; mp < 2; ++mp) {
                u32x4 xw[2][2]; u32x4 ew[2][2];
                float s3[2], sE[2];
#pragma unroll
                for (int mm = 0; mm < 2; ++mm) { const int r = row0 + ai * HALF + (2 * mp + mm) * 16; s3[mm] = ss3[r]; sE[mm] = ssE[r]; }
#pragma unroll
                for (int mm = 0; mm < 2; ++mm)
#pragma unroll
                    for (int bj = 0; bj < 2; ++bj) { const size_t off = (size_t)(row0 + ai * HALF + (2 * mp + mm) * 16) * ldc + col0 + bj * HALF;
                        xw[mm][bj] = *(const u32x4*)(x2 + off); ew[mm][bj] = __builtin_nontemporal_load((const u32x4*)(E + off)); }
                asm volatile("" ::: "memory");
#pragma unroll
                for (int mm = 0; mm < 2; ++mm) { const int m = 2 * mp + mm; const int r = row0 + ai * HALF + m * 16;
                    const float r3 = rsqrtf(s3[mm] * (1.f / 1024.f) + RMS_EPS), rE = rsqrtf(sE[mm] * (1.f / 1024.f) + RMS_EPS);
#pragma unroll
                    for (int bj = 0; bj < 2; ++bj) { const size_t off = (size_t)r * ldc + col0 + bj * HALF; const u32x4 w = ew[mm][bj];
                        const float ev[8] = {bf_lo(w.x), bf_hi(w.x), bf_lo(w.y), bf_hi(w.y), bf_lo(w.z), bf_hi(w.z), bf_lo(w.w), bf_hi(w.w)};
                        const u32x4 xq = xw[mm][bj]; const float xv8[8] = {bf_lo(xq.x), bf_hi(xq.x), bf_lo(xq.y), bf_hi(xq.y), bf_lo(xq.z), bf_hi(xq.z), bf_lo(xq.w), bf_hi(xq.w)};
#pragma unroll
                        for (int n = 0; n < 2; ++n) { f32x4 o;
#pragma unroll
                            for (int i = 0; i < 4; ++i) { const float z = acc[ai][bj][m][n][i] * r3 + bp[bj][n][i]; const float g = __builtin_amdgcn_rcpf(1.f + __expf(-z));
                                o[i] = xv8[4 * n + i] + g * (ev[4 * n + i] * rE * pg[bj][n][i]); }
                            *(f32x4*)(out + off + 4 * n) = o; } } }
                asm volatile("" ::: "memory");
            }
    }
};
struct EpiUp {
    static constexpr bool PERM = true, AFTER_DRAIN = false;
    bf16_t* act; const float* ss2; const float* cw; const float* cb; PG8_LAS float* xch; PG8_LAS float* taps; PG8_LAS float* rsl;
    __device__ __forceinline__ void operator()(f32x4 (&acc)[2][2][4][2], const Unit& u, int wr, int wc, int fr, int fq) const {
        constexpr int FF = 2816, MROWS = 16384;
        const int tid_ = (wr * 4 + wc) * 64 + fq * 16 + fr; f32x4 tapv;
        if (tid_ < 256) { const int r = tid_ >> 5, c4 = tid_ & 31, kind = r & 3, half = r >> 2;
            tapv = *(const f32x4*)((kind < 3 ? cw + kind * 2 * FF : cb) + half * FF + u.pn * HALF + 4 * c4); }
#pragma unroll
        for (int ai = 0; ai < 2; ++ai)
#pragma unroll
            for (int m = 0; m < 4; ++m) { const int rt_ = ai * HALF + wr * 64 + m * 16 + fr, gr = u.arow + rt_;
                float s;
                if (u.idx < 6) s = rsl[u.idx * 256 + rt_];
                else s = (gr >= 0 && gr < MROWS) ? rsqrtf(ss2[gr] * (1.f / 1024.f) + RMS_EPS) : 0.f;
#pragma unroll
                for (int bj = 0; bj < 2; ++bj)
#pragma unroll
                    for (int n = 0; n < 2; ++n) acc[ai][bj][m][n] *= s; }
        const int cl0 = wc * 32 + 8 * fq;
        if (fr >= 14) {
#pragma unroll
            for (int ai = 0; ai < 2; ++ai)
#pragma unroll
                for (int bj = 0; bj < 2; ++bj)
#pragma unroll
                    for (int n = 0; n < 2; ++n) *(PG8_LAS f32x4*)(xch + ((ai * 2 + wr) * 2 + (fr - 14)) * 256 + bj * HALF + cl0 + 4 * n) = acc[ai][bj][3][n];
        }
        if (tid_ < 256) *(PG8_LAS f32x4*)(taps + (tid_ >> 5) * 128 + 4 * (tid_ & 31)) = tapv;
        asm volatile("s_waitcnt lgkmcnt(0)\n\ts_barrier" ::: "memory");
        const int ch0 = u.pn * HALF + cl0;
        const bool seqstart = ((u.arow - 1 + 2047 + 2048) / 2048) <= ((u.arow + 255 + 2048) / 2048);
#pragma unroll
        for (int n = 0; n < 2; ++n) {
            f32x4 w0[2], w1[2], w2[2], bb[2];
#pragma unroll
            for (int bj = 0; bj < 2; ++bj) { const PG8_LAS float* tp = taps + bj * 512 + cl0 + 4 * n;
                w0[bj] = *(const PG8_LAS f32x4*)tp; w1[bj] = *(const PG8_LAS f32x4*)(tp + 128); w2[bj] = *(const PG8_LAS f32x4*)(tp + 256); bb[bj] = *(const PG8_LAS f32x4*)(tp + 384); }
#pragma unroll
            for (int ai = 0; ai < 2; ++ai) {
                const int g = ai * 2 + wr;
#pragma unroll
                for (int m = 0; m < 4; ++m) {
                    const int rt = ai * HALF + wr * 64 + m * 16 + fr, gr = u.arow + rt, t = gr & 2047;
                    f32x4 cv[2];
#pragma unroll
                    for (int bj = 0; bj < 2; ++bj) {
                        const f32x4 cur = acc[ai][bj][m][n]; f32x4 prev;
                        if (m > 0) prev = acc[ai][bj][m - 1][n];
                        else { prev = (f32x4){0.f, 0.f, 0.f, 0.f}; if (g > 0 && fr >= 14) prev = *(const PG8_LAS f32x4*)(xch + ((g - 1) * 2 + (fr - 14)) * 256 + bj * HALF + cl0 + 4 * n); }
                        f32x4 p1, p2;
#pragma unroll
                        for (int i = 0; i < 4; ++i) {
                            const float r1 = dpp_mov<0x121>(0.f, prev[i]), r2 = dpp_mov<0x122>(0.f, prev[i]);
                            p1[i] = dpp_mov<0x111>(r1, cur[i]); p2[i] = dpp_mov<0x112>(r2, cur[i]);
                        }
                        if (seqstart) { if (t == 0) { p1 = (f32x4){0.f, 0.f, 0.f, 0.f}; } if (t <= 1) { p2 = (f32x4){0.f, 0.f, 0.f, 0.f}; } }
                        cv[bj] = bb[bj] + w2[bj] * cur + w1[bj] * p1 + w0[bj] * p2;
                    }
                    float a4[4];
#pragma unroll
                    for (int i = 0; i < 4; ++i) { const float gv = cv[0][i]; a4[i] = gv * __builtin_amdgcn_rcpf(1.f + __expf(-gv)) * cv[1][i]; }
                    u32x2 w; w.x = cvt_pk_bf16(a4[0], a4[1]); w.y = cvt_pk_bf16(a4[2], a4[3]);
                    if (rt >= 2 && gr < MROWS) *(u32x2*)(act + (size_t)gr * FF + ch0 + 4 * n) = w;
                }
            }
        }
    }
};
}
#include <hip/hip_bf16.h>
#include <cmath>
namespace attn_body {
using bf16=__hip_bfloat16;
using bf16x8=__attribute__((ext_vector_type(8)))short;
using s16x4=__attribute__((ext_vector_type(4)))short;
using f32x16=__attribute__((ext_vector_type(16)))float;
using u32x4=__attribute__((ext_vector_type(4)))unsigned;
constexpr int BATCH=8,NHEAD=8,SEQ=2048,D=64,DM=3072,OM=1024;
constexpr int NW=8,QBLK=32,QB=QBLK*NW,KVBLK=64,NQB=SEQ/QB;
constexpr int ATTN_PITCH=DM, ATTN_UNIT_ROWS=QB;
__device__ __forceinline__ int crow(int r,int hi){return (r&3)+8*(r>>2)+4*hi;}
#define SBAR() __builtin_amdgcn_sched_barrier(0)
__device__ __forceinline__ void cmask(f32x16&p0,f32x16&p1,int jb,int qrel,int hi){
  const float NEG=-INFINITY; int kb=64*jb+4*hi;
  #pragma unroll
  for(int r=0;r<16;++r){int kv=kb+(r&3)+8*(r>>2); if(kv>qrel)p0[r]=NEG; if(kv+32>qrel)p1[r]=NEG;}
}

constexpr int NSLOT=3, SLOTB=8192;
constexpr int LDS_K=0, LDS_V=NSLOT*SLOTB, LDS_WS=2*NSLOT*SLOTB, LDS_OST=LDS_WS+NW*64*4, LDS_CB=LDS_OST+NW*4096, LDS_BYTES=LDS_CB+8192;
constexpr float C2=0.125f*1.4426950408889634f;
__device__ __forceinline__ void glds16(const void*gsrc,unsigned lds_dst){unsigned keep;
  asm volatile("s_mov_b32 %0, m0\n\ts_mov_b32 m0, %2\n\ts_nop 0\n\tglobal_load_lds_dwordx4 %1, off\n\ts_mov_b32 m0, %0":"=&s"(keep):"v"(gsrc),"s"(lds_dst):"memory");}
__device__ __forceinline__ float max3f(float a,float b,float c){float r;asm("v_max3_f32 %0, %1, %2, %3":"=v"(r):"v"(a),"v"(b),"v"(c));return r;}
__device__ __forceinline__ float max2f(float a,float b){float r;asm("v_max_f32_e32 %0, %1, %2":"=v"(r):"v"(a),"v"(b));return r;}
__device__ __forceinline__ float fadd_s(float a,float b){float r;asm("v_add_f32_e32 %0, %1, %2":"=v"(r):"v"(a),"v"(b));return r;}
__device__ __forceinline__ float fsub_s(float a,float b){float r;asm("v_sub_f32_e32 %0, %1, %2":"=v"(r):"v"(a),"v"(b));return r;}
typedef float f32x2_t __attribute__((ext_vector_type(2))); typedef __bf16 bf16x2_t __attribute__((ext_vector_type(2)));
__device__ __forceinline__ unsigned cvtpk_s(float lo,float hi){f32x2_t v={lo,hi};bf16x2_t b=__builtin_convertvector(v,bf16x2_t);return __builtin_bit_cast(unsigned,b);}
#define WAIT_BAR(N) asm volatile("s_waitcnt vmcnt(" #N ") lgkmcnt(0)\n\ts_barrier":::"memory")

__device__ __forceinline__ void qkt(f32x16&p0,f32x16&p1,const char*Kslot,const bf16x8*qr,const f32x16&negm,int r32,int hi){
  const char*kb=Kslot+hi*1024+r32*16;
  #pragma unroll
  for(int d0=0;d0<4;++d0){
    const bf16x8 b0=*reinterpret_cast<const bf16x8*>(kb+d0*2048);
    const bf16x8 b1=*reinterpret_cast<const bf16x8*>(kb+d0*2048+512);
    if(d0==0){p0=__builtin_amdgcn_mfma_f32_32x32x16_bf16(b0,qr[0],negm,0,0,0);p1=__builtin_amdgcn_mfma_f32_32x32x16_bf16(b1,qr[0],negm,0,0,0);}
    else{p0=__builtin_amdgcn_mfma_f32_32x32x16_bf16(b0,qr[d0],p0,0,0,0);p1=__builtin_amdgcn_mfma_f32_32x32x16_bf16(b1,qr[d0],p1,0,0,0);}}
}
typedef __attribute__((address_space(3))) const char* lds_cptr;
typedef short v4i16_t __attribute__((ext_vector_type(4)));
__device__ __forceinline__ void kload8(bf16x8*kf,lds_cptr kp){
  kf[0]=*(const __attribute__((address_space(3))) bf16x8*)(kp);      kf[1]=*(const __attribute__((address_space(3))) bf16x8*)(kp+512);
  kf[2]=*(const __attribute__((address_space(3))) bf16x8*)(kp+2048); kf[3]=*(const __attribute__((address_space(3))) bf16x8*)(kp+2560);
  kf[4]=*(const __attribute__((address_space(3))) bf16x8*)(kp+4096); kf[5]=*(const __attribute__((address_space(3))) bf16x8*)(kp+4608);
  kf[6]=*(const __attribute__((address_space(3))) bf16x8*)(kp+6144); kf[7]=*(const __attribute__((address_space(3))) bf16x8*)(kp+6656);
}
__device__ __forceinline__ void kload2(bf16x8*kf,lds_cptr kp,int j){ kf[2*j]=*(const __attribute__((address_space(3))) bf16x8*)(kp+j*2048); kf[2*j+1]=*(const __attribute__((address_space(3))) bf16x8*)(kp+j*2048+512); }
__device__ __forceinline__ s16x4 vtr(lds_cptr p){ return __builtin_bit_cast(s16x4,__builtin_amdgcn_ds_read_tr16_b64_v4i16((__attribute__((address_space(3))) v4i16_t*)p)); }
__device__ __forceinline__ float rowmax(const f32x16&p0,const f32x16&p1){
  float a=max3f(p0[0],p0[1],p1[0]),b=max3f(p0[2],p0[3],p1[1]);a=max3f(a,p1[2],p1[3]);
  #pragma unroll
  for(int r=4;r<16;r+=4){a=max3f(a,p0[r],p0[r+1]);b=max3f(b,p0[r+2],p0[r+3]);a=max3f(a,p1[r],p1[r+1]);b=max3f(b,p1[r+2],p1[r+3]);}
  const float m=max2f(a,b);
  auto rr=__builtin_amdgcn_permlane32_swap(__float_as_uint(m),__float_as_uint(m),false,false);
  return max2f(__uint_as_float(rr[0]),__uint_as_float(rr[1]));
}
__device__ __forceinline__ void pv(f32x16*o,int vb,bf16x8 pa0,bf16x8 pa1,bf16x8 pa2,bf16x8 pa3){
  #pragma unroll
  for(int d0=0;d0<2;++d0){s16x4 lo[4],hi[4];
    #pragma unroll
    for(int ks=0;ks<4;++ks){
      asm volatile("ds_read_b64_tr_b16 %0,%1 offset:%c2":"=&v"(lo[ks]):"v"(vb),"i"(d0*4096+ks*1024):"memory");
      asm volatile("ds_read_b64_tr_b16 %0,%1 offset:%c2":"=&v"(hi[ks]):"v"(vb),"i"(d0*4096+ks*1024+512):"memory");}
    asm volatile("s_waitcnt lgkmcnt(0)":::"memory");SBAR();
    #define PK(k) (bf16x8){lo[k][0],lo[k][1],lo[k][2],lo[k][3],hi[k][0],hi[k][1],hi[k][2],hi[k][3]}
    o[d0]=__builtin_amdgcn_mfma_f32_32x32x16_bf16(pa0,PK(0),o[d0],0,0,0);
    o[d0]=__builtin_amdgcn_mfma_f32_32x32x16_bf16(pa1,PK(1),o[d0],0,0,0);
    o[d0]=__builtin_amdgcn_mfma_f32_32x32x16_bf16(pa2,PK(2),o[d0],0,0,0);
    o[d0]=__builtin_amdgcn_mfma_f32_32x32x16_bf16(pa3,PK(3),o[d0],0,0,0);
    #undef PK
  }
}

#ifndef ATTN_STORE16
#define ATTN_STORE16(p,v) (*(u32x4*)(p)=(v))
#endif
template<int THRL> __device__ __forceinline__ void attn_unit(int b,int h,int qb,const bf16*Q,const bf16*__restrict__ K,const bf16*__restrict__ V,bf16*O,const float*__restrict__ CB,float thr,char*shm){
  const int tid=threadIdx.x,lane=tid&63,r32=lane&31,hi=lane>>5; const int wid=__builtin_amdgcn_readfirstlane(tid>>6);
  const long rowbase=(long)b*SEQ; const int q0=qb*QB;
  const float*cgp_=CB+(long)(b*NHEAD+h)*SEQ; const float cref_=cgp_[q0];
  const int nt4_=(q0+QB)/KVBLK-4;
  const bool need_=((threadIdx.x&63)<nt4_) && ((cgp_[64*(threadIdx.x&63)+63]-cref_)<=thr);
  const int tn_=nt4_-__popcll(__ballot(need_));
  const int t0_=__builtin_amdgcn_readfirstlane(tn_&~1);
  const bf16*Qw=Q+(rowbase+q0+wid*QBLK)*DM+h*D;
  const bf16*Kh=K+(rowbase+64*t0_)*DM+h*D,*Vh=V+(rowbase+64*t0_)*DM+h*D;
  const lds_cptr shm3=(lds_cptr)shm; const unsigned lds0=(unsigned)(uintptr_t)shm;
  float*wsf=(float*)(shm+LDS_WS)+wid*64;
  const bf16*ksrc=Kh+(long)lane*DM+wid*8;
  const bf16*vsrc=Vh+(long)(16*(wid&3)+(lane>>2))*DM+(wid>>2)*32+(lane&3)*8;
  const unsigned kdst=lds0+LDS_K+wid*1024, vdst=lds0+LDS_V+wid*1024;
  #define DMA_K(t,slot) glds16(ksrc+(long)(t)*KVBLK*DM,(unsigned)__builtin_amdgcn_readfirstlane(kdst+(slot)))
  #define DMA_V(t,slot) glds16(vsrc+(long)(t)*KVBLK*DM,(unsigned)__builtin_amdgcn_readfirstlane(vdst+(slot)))
  const int vb0=(int)(lds0+LDS_V)+((lane>>4)&1)*32+(lane&3)*8+(4*hi+((lane&15)>>2))*64;
  const char*Kbase=shm+LDS_K; bf16x8 kf[8];
  const lds_cptr kp0=shm3+LDS_K+hi*1024+r32*16; const lds_cptr vp0=shm3+LDS_V+((lane>>4)&1)*32+(lane&3)*8+(4*hi+((lane&15)>>2))*64;
  const int NT=(q0+QB)/KVBLK-t0_;
  typedef __attribute__((address_space(3))) float* lds_fptr; typedef float f32x4_t __attribute__((ext_vector_type(4)));
  const lds_fptr cbl=(lds_fptr)(shm3+LDS_CB);
  { const float*cg_=cgp_+64*t0_; const float cref=cref_;
    for(int i_=tid;i_<(q0+QB-64*t0_)/4;i_+=NW*64){ f32x4_t v_=*(const f32x4_t*)(cg_+4*i_); v_-=cref; *(__attribute__((address_space(3))) f32x4_t*)(cbl+4*i_)=v_; } }
  #define INITC(C,ptr) do{ const lds_fptr ip_=(ptr); \
    _Pragma("unroll") for(int g_=0;g_<4;++g_){ const f32x4_t c_=*(const __attribute__((address_space(3))) f32x4_t*)(ip_+8*g_); \
      _Pragma("unroll") for(int i_=0;i_<4;++i_){ C[4*g_+i_]=nmh_-c_[i_]; } } }while(0)
  #define BIAS(P0,P1,t) do{ const lds_fptr cp_=cbl+64*(t)+4*hi; \
    _Pragma("unroll") for(int g_=0;g_<4;++g_){ { const f32x4_t c0_=*(const __attribute__((address_space(3))) f32x4_t*)(cp_+8*g_)+mhat; \
      _Pragma("unroll") for(int i_=0;i_<4;++i_){ P0[4*g_+i_]-=c0_[i_]; } } asm volatile("":::"memory"); \
      { const f32x4_t c1_=*(const __attribute__((address_space(3))) f32x4_t*)(cp_+32+8*g_)+mhat; \
      _Pragma("unroll") for(int i_=0;i_<4;++i_){ P1[4*g_+i_]-=c1_[i_]; } } asm volatile("":::"memory"); } }while(0)
  DMA_K(0,0);DMA_V(0,0);DMA_K(1,SLOTB);
  bf16x8 qr[4];
  #pragma unroll
  for(int d0=0;d0<4;++d0)qr[d0]=*reinterpret_cast<const bf16x8*>(&Qw[(long)r32*DM+d0*16+hi*8]);
  float mhat=0.f,l_reg=0.f;f32x16 o[2];o[0]=f32x16{};o[1]=f32x16{};f32x16 negm=f32x16{}; const f32x16 zero16=f32x16{};
  const int qrel=wid*QBLK+r32;
  #define CMASK(P0,P1,t) do{int jb_=(t)-(NT-4); if(jb_>=0)cmask(P0,P1,jb_,qrel,hi);}while(0)
  bool resc=false;
  #define START(P0,P1) do{ const float rm=rowmax(P0,P1); resc=false; \
    { const float dl=rm; mhat=fadd_s(mhat,dl); \
      _Pragma("unroll") for(int r=0;r<16;++r){P0[r]=fsub_s(P0[r],dl);P1[r]=fsub_s(P1[r],dl);} \
      _Pragma("unroll") for(int r=0;r<16;++r)negm[r]=-mhat;  } \
    _Pragma("unroll") for(int r=0;r<16;++r)P0[r]=__builtin_amdgcn_exp2f(P0[r]); }while(0)
  #define RESC() do{ if(resc){ asm volatile("s_waitcnt lgkmcnt(0)":::"memory"); \
      _Pragma("unroll") for(int d_=0;d_<2;++d_) _Pragma("unroll") for(int r=0;r<16;++r)o[d_][r]*=wsf[crow(r,hi)]; } }while(0)
  f32x16 pA0,pA1,pB0,pB1;
  int sl_prev=0,sl_cur=0,sl_next=SLOTB;
  #define ROT() do{sl_prev=sl_cur;sl_cur=sl_next;sl_next=(sl_next==(NSLOT-1)*SLOTB)?0:sl_next+SLOTB;}while(0)
  DMA_K(2,2*SLOTB);
  WAIT_BAR(3);
  qkt(pA0,pA1,Kbase,qr,zero16,r32,hi);asm volatile("s_nop 15\n\ts_nop 7":"+v"(pA0),"+v"(pA1));BIAS(pA0,pA1,0);CMASK(pA0,pA1,0);
  START(pA0,pA1);
  _Pragma("unroll") for(int r=0;r<16;++r)pA1[r]=__builtin_amdgcn_exp2f(pA1[r]);
  WAIT_BAR(0);
  DMA_K(3,0);DMA_V(1,SLOTB);
  ROT();
  kload8(kf,kp0+sl_cur);
  WAIT_BAR(2);
  s16x4 vlo[8],vhi[8]; u32x4 pw0,pw1,pw2,pw3;
  #define PKW(P,B) cvtpk_s(P[B],P[B+1])
  #define PAF(k) __builtin_bit_cast(bf16x8,pw##k)
  #define VFR(i) (bf16x8){vlo[i][0],vlo[i][1],vlo[i][2],vlo[i][3],vhi[i][0],vhi[i][1],vhi[i][2],vhi[i][3]}
  #define PIN(x) asm volatile("":"+v"(x))
  #define MX3(a,b,c) __builtin_fmaxf(__builtin_fmaxf((a),(b)),(c))
  #define GAPA(MF,A0,A1,A2,A3,W0,W1,PW) do{ MF; sacc+=A0; sacc+=A1; sacc+=A2; sacc+=A3; PIN(sacc); W0; W1; PIN(PW); SBAR(); }while(0)
  #define EX(v) __builtin_amdgcn_exp2f(v)
  #define GAPB(MF,X,B) do{ MF; X[B]=EX(X[B]); X[B+1]=EX(X[B+1]); X[B+2]=EX(X[B+2]); X[B+3]=EX(X[B+3]); PIN(X); SBAR(); }while(0)
  #define VRD(i) do{ vlo[i]=vtr(vp_+(((i)>>2)*4096+((i)&3)*1024)); vhi[i]=vtr(vp_+(((i)>>2)*4096+((i)&3)*1024+512)); }while(0)
  #define KRD(G,j) do{ if(G){ kload2(kf,kp0+sl_next,j); SBAR(); } }while(0)
  #define STEP(C0,C1,P0,P1,t,GK,GV,GL) do{ SBAR(); \
    const lds_cptr vp_=vp0+sl_prev; \
    const float nmh_=-mhat; INITC(C0,cbl+64*(t)+4*hi); SBAR(); \
    VRD(0); SBAR(); float sacc=(P0[0]+P0[1]); \
    GAPA(C0=__builtin_amdgcn_mfma_f32_32x32x16_bf16(kf[0],qr[0],C0,0,0,0), P0[2],P0[3],P0[4],P0[5],     pw0[0]=PKW(P0,0), pw0[1]=PKW(P0,2), pw0); \
    INITC(C1,cbl+64*(t)+32+4*hi); SBAR(); \
    VRD(4); SBAR(); GAPA(C1=__builtin_amdgcn_mfma_f32_32x32x16_bf16(kf[1],qr[0],C1,0,0,0), P0[6],P0[7],P0[8],P0[9],     pw0[2]=PKW(P0,4), pw0[3]=PKW(P0,6), pw0); \
    VRD(1); SBAR(); GAPA(C0=__builtin_amdgcn_mfma_f32_32x32x16_bf16(kf[2],qr[1],C0,0,0,0),   P0[10],P0[11],P0[12],P0[13], pw1[0]=PKW(P0,8), pw1[1]=PKW(P0,10), pw1); \
    VRD(5); SBAR(); GAPA(C1=__builtin_amdgcn_mfma_f32_32x32x16_bf16(kf[3],qr[1],C1,0,0,0),   P0[14],P0[15],P1[0],P1[1],   pw1[2]=PKW(P0,12),pw1[3]=PKW(P0,14), pw1); \
    VRD(2); SBAR(); GAPA(C0=__builtin_amdgcn_mfma_f32_32x32x16_bf16(kf[4],qr[2],C0,0,0,0),   P1[2],P1[3],P1[4],P1[5],     pw2[0]=PKW(P1,0), pw2[1]=PKW(P1,2), pw2); \
    VRD(6); SBAR(); GAPA(C1=__builtin_amdgcn_mfma_f32_32x32x16_bf16(kf[5],qr[2],C1,0,0,0),   P1[6],P1[7],P1[8],P1[9],     pw2[2]=PKW(P1,4), pw2[3]=PKW(P1,6), pw2); \
    VRD(3); SBAR(); GAPA(C0=__builtin_amdgcn_mfma_f32_32x32x16_bf16(kf[6],qr[3],C0,0,0,0),   P1[10],P1[11],P1[12],P1[13], pw3[0]=PKW(P1,8), pw3[1]=PKW(P1,10), pw3); \
    VRD(7); SBAR(); GAPA(C1=__builtin_amdgcn_mfma_f32_32x32x16_bf16(kf[7],qr[3],C1,0,0,0),   P1[14],P1[15],0.f,0.f,       pw3[2]=PKW(P1,12),pw3[3]=PKW(P1,14), pw3); \
    l_reg+=sacc; \
    if(GK){DMA_K((t)+3,sl_cur);} if(GV){DMA_V((t)+1,sl_next);} \
    CMASK(C0,C1,t); \
    { float a=MX3(C0[0],C0[1],C1[0]),b=MX3(C0[2],C0[3],C1[1]); a=MX3(a,C1[2],C1[3]); \
      _Pragma("unroll") for(int r=4;r<16;r+=4){a=MX3(a,C0[r],C0[r+1]);b=MX3(b,C0[r+2],C0[r+3]);a=MX3(a,C1[r],C1[r+1]);b=MX3(b,C1[r+2],C1[r+3]);} \
      float rm=__builtin_fmaxf(a,b); { auto rr=__builtin_amdgcn_permlane32_swap(__float_as_uint(rm),__float_as_uint(rm),false,false); rm=__builtin_fmaxf(__uint_as_float(rr[0]),__uint_as_float(rr[1])); } \
      resc=false; \
      if(__builtin_expect(__any(rm>(float)THRL),0)){ const float dl=__builtin_fmaxf(rm,0.f); mhat+=dl; \
        _Pragma("unroll") for(int r=0;r<16;++r){C0[r]-=dl;C1[r]-=dl;} \
        _Pragma("unroll") for(int r=0;r<16;++r)negm[r]=-mhat;  \
        const float f=__builtin_amdgcn_exp2f(-dl); l_reg*=f; if(hi==0)wsf[r32]=f; resc=true; } } \
    SBAR(); \
    GAPB(o[0]=__builtin_amdgcn_mfma_f32_32x32x16_bf16(PAF(0),VFR(0),o[0],0,0,0), C0,0); \
    GAPB(o[1]=__builtin_amdgcn_mfma_f32_32x32x16_bf16(PAF(0),VFR(4),o[1],0,0,0), C0,4); \
    KRD(GL,0); GAPB(o[0]=__builtin_amdgcn_mfma_f32_32x32x16_bf16(PAF(1),VFR(1),o[0],0,0,0), C0,8); \
    KRD(GL,1); GAPB(o[1]=__builtin_amdgcn_mfma_f32_32x32x16_bf16(PAF(1),VFR(5),o[1],0,0,0), C0,12); \
    KRD(GL,2); GAPB(o[0]=__builtin_amdgcn_mfma_f32_32x32x16_bf16(PAF(2),VFR(2),o[0],0,0,0), C1,0); \
    KRD(GL,3); GAPB(o[1]=__builtin_amdgcn_mfma_f32_32x32x16_bf16(PAF(2),VFR(6),o[1],0,0,0), C1,4); \
    GAPB(o[0]=__builtin_amdgcn_mfma_f32_32x32x16_bf16(PAF(3),VFR(3),o[0],0,0,0), C1,8); \
    GAPB(o[1]=__builtin_amdgcn_mfma_f32_32x32x16_bf16(PAF(3),VFR(7),o[1],0,0,0), C1,12); \
    }while(0)
  int t=1;
  #undef CMASK
  #define CMASK(P0,P1,t) do{}while(0)
  for(;t+5<NT;t+=2){
    STEP(pB0,pB1,pA0,pA1,t,true,true,true);     WAIT_BAR(2); RESC(); ROT();
    STEP(pA0,pA1,pB0,pB1,t+1,true,true,true);   WAIT_BAR(2); RESC(); ROT();
  }
  #undef CMASK
  #define CMASK(P0,P1,t) do{int jb_=(t)-(NT-4); if(jb_>=0)cmask(P0,P1,jb_,qrel,hi);}while(0)
  #define ENDW(tt) do{ if((tt)+3<NT){WAIT_BAR(2);} else if((tt)+2<NT){WAIT_BAR(1);} else {WAIT_BAR(0);} }while(0)
  for(;t+1<NT;t+=2){
    STEP(pB0,pB1,pA0,pA1,t,(t+3<NT),(t+1<NT),(t+1<NT));       ENDW(t);   RESC(); ROT();
    STEP(pA0,pA1,pB0,pB1,t+1,(t+4<NT),(t+2<NT),(t+2<NT));     ENDW(t+1); RESC(); ROT();
  }
  STEP(pB0,pB1,pA0,pA1,NT-1,false,false,false); RESC();
  { float sacc=pB0[0]+pB0[1]; _Pragma("unroll") for(int r=2;r<16;++r)sacc+=pB0[r]; _Pragma("unroll") for(int r=0;r<16;++r)sacc+=pB1[r]; l_reg+=sacc;
    pw0=(u32x4){PKW(pB0,0),PKW(pB0,2),PKW(pB0,4),PKW(pB0,6)};pw1=(u32x4){PKW(pB0,8),PKW(pB0,10),PKW(pB0,12),PKW(pB0,14)};pw2=(u32x4){PKW(pB1,0),PKW(pB1,2),PKW(pB1,4),PKW(pB1,6)};pw3=(u32x4){PKW(pB1,8),PKW(pB1,10),PKW(pB1,12),PKW(pB1,14)};
    SBAR(); pv(o,vb0+sl_cur,PAF(0),PAF(1),PAF(2),PAF(3)); }
  #undef PKW
  #undef PAF
  #undef VFR
  #undef PIN
  #undef MX3
  #undef GAPA
  #undef GAPB
  #undef EX
  #undef VRD
  #undef KRD
  #undef STEP
  #undef ENDW
  {auto rr=__builtin_amdgcn_permlane32_swap(__float_as_uint(l_reg),__float_as_uint(l_reg),false,false);l_reg=__uint_as_float(rr[0])+__uint_as_float(rr[1]);}
  if(hi==0)wsf[32+r32]=l_reg;asm volatile("s_waitcnt lgkmcnt(0)":::"memory");
  float rli[16];
  #pragma unroll
  for(int r=0;r<16;++r)rli[r]=__builtin_amdgcn_rcpf(wsf[32+crow(r,hi)]);
  bf16*Ow=O+(rowbase+q0+wid*QBLK)*OM+h*D;
  { bf16*stg=(bf16*)(shm+LDS_OST)+wid*2048;
    #pragma unroll
    for(int r=0;r<16;++r){const int orow=crow(r,hi);
      #pragma unroll
      for(int d0=0;d0<2;++d0)stg[orow*64+d0*32+r32]=__float2bfloat16(o[d0][r]*rli[r]);}
    asm volatile("s_waitcnt lgkmcnt(0)":::"memory");
    #pragma unroll
    for(int i=0;i<4;++i){const int row=i*8+(lane>>3),ch=lane&7; const u32x4 v=*(const u32x4*)(stg+row*64+ch*8); ATTN_STORE16(Ow+(long)row*OM+ch*8,v);} }
  asm volatile("s_waitcnt lgkmcnt(0)\n\ts_barrier":::"memory");
  #undef DMA_K
  #undef DMA_V
  #undef CMASK
  #undef START
  #undef RESC
  #undef ROT
  #undef BIAS
  #undef INITC
}
constexpr int ATTN_LDS_BYTES=LDS_BYTES;
struct AttnTensors { const bf16* Q; const bf16* K; const bf16* V; bf16* O; const float* CB; float thr; };
struct AttnUnit { int bh; int qb; };
struct StaticOrder {
  int vcu,G;
  __device__ __forceinline__ explicit StaticOrder(int grid,int v):vcu(v),G(grid){}
  __device__ __forceinline__ bool next(int i,AttnUnit&u)const{ const int p=vcu+(i>>1)*G; if(p>=256)return false; const int s=p&3; u.bh=p>>2; u.qb=(i&1)?7-s:s; return true; }
  __device__ __forceinline__ void a_ready(const AttnUnit&)const{}
  __device__ __forceinline__ void done(const AttnUnit&)const{}
};
template<class Sched,int THRL=8> __device__ __forceinline__ void attn_phase(char*lds,const AttnTensors&T,const Sched&S){
  AttnUnit u;
  for(int i=0;S.next(i,u);++i){ S.a_ready(u); attn_unit<THRL>(u.bh/NHEAD,u.bh%NHEAD,u.qb,T.Q,T.K,T.V,T.O,T.CB,T.thr,lds); S.done(u); }
}
#undef SBAR
#undef WAIT_BAR
}
#define LAS __attribute__((address_space(3)))
namespace mk {
typedef unsigned short bf16;
typedef unsigned u32x4 __attribute__((ext_vector_type(4)));
typedef unsigned u32x2 __attribute__((ext_vector_type(2)));
typedef float f32x4 __attribute__((ext_vector_type(4)));
typedef float f32x2 __attribute__((ext_vector_type(2)));
typedef float f32x16 __attribute__((ext_vector_type(16)));
typedef short bf16x8 __attribute__((ext_vector_type(8)));
typedef unsigned v4u __attribute__((ext_vector_type(4)));
constexpr int NWAVES = 8, NT = 512;
constexpr int M = 16384, SEQ = 2048, DM = 1024, INW = 3096, PROJW = 3072, FF = 2816, PLE = 256;
constexpr float EPS = 1e-6f, LOG2E = 1.4426950408889634f, C2 = 0.125f * LOG2E;
constexpr size_t MiB = 1u << 20;
constexpr size_t WS_WIN = 1 * MiB, WS_WSK = 7 * MiB, WS_WO = 8 * MiB, WS_WUP = 10 * MiB, WS_WD = 21 * MiB, WS_WPG = 27 * MiB, WS_WPE = 29 * MiB;
constexpr size_t WS_SMALL = 30 * MiB;
constexpr size_t WS_LRF = 31 * MiB, WS_PB = 33 * MiB, WS_QE = 41 * MiB, WS_XB = 50 * MiB  , WS_MIX = 83 * MiB, WS_PROJ = 115 * MiB, WS_END = 228 * MiB;
constexpr size_t WS_SPREV = 212 * MiB  , WS_E = WS_MIX, WS_ACT = WS_PROJ;
constexpr int LDS_BYTES = 151552, XCH_OFF = 131072, RSL_OFF = XCH_OFF + 12544;

typedef __bf16 hwbf16x2 __attribute__((ext_vector_type(2)));
__device__ __forceinline__ unsigned pk2(float lo, float hi) { f32x2 v = {lo, hi}; return __builtin_bit_cast(unsigned, __builtin_convertvector(v, hwbf16x2)); }
__device__ __forceinline__ unsigned f2bf(float f) { return pk2(f, 0.f) & 0xffffu; }
__device__ __forceinline__ float bf2f(unsigned short h) { return __builtin_bit_cast(float, (unsigned)h << 16); }
__device__ __forceinline__ float bflo(unsigned w) { return __builtin_bit_cast(float, w << 16); }
__device__ __forceinline__ float bfhi(unsigned w) { return __builtin_bit_cast(float, w & 0xffff0000u); }
__device__ __forceinline__ float logsig(float z) { return fminf(z, 0.f) - __logf(1.f + __expf(-fabsf(z))); }
__device__ __forceinline__ int crow(int r, int hi) { return (r & 3) + 8 * (r >> 2) + 4 * hi; }
__device__ __forceinline__ float wave_sum(float v) {
#pragma unroll
    for (int o = 1; o < 64; o <<= 1) v += __shfl_xor(v, o);
    return v;
}
#define LDS_WAIT() asm volatile("s_waitcnt lgkmcnt(0)" ::: "memory")
#define LDS_SYNC() asm volatile("s_waitcnt lgkmcnt(0)\n\ts_barrier" ::: "memory")

struct Args { const float* in[21]; float* out; unsigned char* ws; };

template <bool HAS_GAIN>
__device__ __forceinline__ void tr_item(const float* W, int ldw, int k0, int srccol, const float* gain, bf16* WT, int ldk, int dstrow0, LAS float* scr, int lane) {
    const int sc = srccol < 0 ? 0 : srccol; const float msk = srccol < 0 ? 0.f : 1.f;
    const float* wp = W + (size_t)(k0 + (lane >> 5)) * ldw + sc;
    float v[32], gv[32];
#pragma unroll
    for (int i = 0; i < 32; ++i) v[i] = __builtin_nontemporal_load(wp + (size_t)(2 * i) * ldw);
    if (HAS_GAIN) {
#pragma unroll
        for (int i = 0; i < 32; ++i) gv[i] = gain[k0 + 2 * i + (lane >> 5)];
    }
#pragma unroll
    for (int i = 0; i < 32; ++i) scr[(2 * i + (lane >> 5)) * 33 + (lane & 31)] = HAS_GAIN ? v[i] * gv[i] * msk : v[i] * msk;
    LDS_WAIT();
    const int c = lane & 7;
#pragma unroll
    for (int j = 0; j < 4; ++j) { const int n = (lane >> 3) + 8 * j; const LAS float* s = scr + (8 * c) * 33 + n;
        u32x4 o; o.x = pk2(s[0 * 33], s[1 * 33]); o.y = pk2(s[2 * 33], s[3 * 33]); o.z = pk2(s[4 * 33], s[5 * 33]); o.w = pk2(s[6 * 33], s[7 * 33]);
        *(u32x4*)(WT + (size_t)(dstrow0 + n) * ldk + k0 + 8 * c) = o; }
    LDS_WAIT();
}

__device__ __forceinline__ void p0_prologue(const Args& a, LAS unsigned char* lds, int vcu, int G, int wave, int lane, int tid) {
    unsigned char* ws = a.ws;
    LAS float* scr = (LAS float*)(lds + wave * 16384);
    const int gw = vcu * NWAVES + wave, NGW = G * NWAVES;
    constexpr int I_IN = 16 * 96, I_SK = 16, I_O = 16 * 32, I_UP = 16 * 176, I_D = 44 * 32, I_PG = 16 * 32, I_PE = 4 * 32;
    constexpr int NITEMS = I_IN + I_SK + I_O + I_UP + I_PE;
    for (int it = gw; it < NITEMS; it += NGW) {
        int r = it; const int nl = lane & 31;
        if (r < I_IN) { const int kb = r / 96, nb = r % 96, n0 = 32 * nb; tr_item<true>(a.in[3], INW, 64 * kb, n0 + (n0 >= 1536 ? 16 : 0) + nl, a.in[2], (bf16*)(ws + WS_WIN), DM, n0, scr, lane); continue; } r -= I_IN;
        if (r < I_SK) { const int sc = nl < 16 ? 1536 + nl : (nl < 24 ? 3088 + nl - 16 : -1); tr_item<true>(a.in[3], INW, 64 * r, sc, a.in[2], (bf16*)(ws + WS_WSK), DM, 0, scr, lane); continue; } r -= I_SK;
        if (r < I_O) { const int kb = r / 32, nb = r % 32; tr_item<false>(a.in[10], DM, 64 * kb, 32 * nb + nl, nullptr, (bf16*)(ws + WS_WO), DM, 32 * nb, scr, lane); continue; } r -= I_O;
        if (r < I_UP) { const int kb = r / 176, nb = r % 176, pn = nb >> 3, wi = nb & 7; const int sc0 = wi < 4 ? 128 * pn + 32 * wi : FF + 128 * pn + 32 * (wi - 4);
            tr_item<true>(a.in[12], 2 * FF, 64 * kb, sc0 + nl, a.in[11], (bf16*)(ws + WS_WUP), DM, 32 * nb, scr, lane); continue; } r -= I_UP;
        { const int kb = r / 32, nb = r % 32; tr_item<false>(a.in[17], DM, 64 * kb, 32 * nb + nl, nullptr, (bf16*)(ws + WS_WPE), PLE, 32 * nb, scr, lane); }
    }
    float* rstd1 = (float*)(ws + WS_SMALL); bf16* xb = (bf16*)(ws + WS_XB); bf16* pb = (bf16*)(ws + WS_PB);
    for (int m0 = gw; m0 < M; m0 += 2 * NGW) {
        f32x4 v[2][4], pv[2];
#pragma unroll
        for (int q = 0; q < 2; ++q) { const int m = m0 + q * NGW; const f32x4* xr = (const f32x4*)(a.in[0] + (size_t)m * DM) + lane;
#pragma unroll
            for (int j = 0; j < 4; ++j) v[q][j] = __builtin_nontemporal_load(xr + 64 * j);
            pv[q] = __builtin_nontemporal_load((const f32x4*)(a.in[1] + (size_t)m * PLE) + lane); }
#pragma unroll
        for (int q = 0; q < 2; ++q) { const int m = m0 + q * NGW; float s = 0.f;
#pragma unroll
            for (int j = 0; j < 4; ++j) s += (v[q][j].x * v[q][j].x + v[q][j].y * v[q][j].y) + (v[q][j].z * v[q][j].z + v[q][j].w * v[q][j].w);
            s = wave_sum(s); if (lane == 0) rstd1[m] = rsqrtf(s * (1.f / DM) + EPS);
            u32x2* o8 = (u32x2*)(xb + (size_t)m * DM) + lane;
#pragma unroll
            for (int j = 0; j < 4; ++j) o8[64 * j] = (u32x2){pk2(v[q][j].x, v[q][j].y), pk2(v[q][j].z, v[q][j].w)};
            *((u32x2*)(pb + (size_t)m * PLE) + lane) = (u32x2){pk2(pv[q].x, pv[q].y), pk2(pv[q].z, pv[q].w)}; }
    }
    float* ssz = (float*)(ws + WS_SMALL) + M;
    for (int i = vcu * NT + tid; i < 3 * M; i += G * NT) ssz[i] = 0.f;
}

__device__ __forceinline__ void p6_late_weights(const Args& a, LAS unsigned char* lds, int cl, int nl, int wave, int lane) {
    unsigned char* ws = a.ws; LAS float* scr = (LAS float*)(lds + wave * 16384); const int nl32 = lane & 31;
    constexpr int I_D = 44 * 32, I_PG = 16 * 32;
    for (int it = cl * NWAVES + wave; it < I_D + I_PG; it += nl * NWAVES) {
        if (it < I_D) { const int kb = it / 32, nb = it % 32; tr_item<false>(a.in[15], DM, 64 * kb, 32 * nb + nl32, nullptr, (bf16*)(ws + WS_WD), FF, 32 * nb, scr, lane); }
        else { const int r = it - I_D, kb = r / 32, nb = r % 32; tr_item<true>(a.in[19], DM, 64 * kb, 32 * nb + nl32, a.in[16], (bf16*)(ws + WS_WPG), DM, 32 * nb, scr, lane); }
    }
}

__device__ __forceinline__ void p1_skinny(const Args& a, LAS unsigned char* lds, int vcu, int G, int wave, int lane, int tid) {
    const bf16* xb = (const bf16*)(a.ws + WS_XB); const bf16* wsk = (const bf16*)(a.ws + WS_WSK); const float* rstd1 = (const float*)(a.ws + WS_SMALL); float* lrf = (float*)(a.ws + WS_LRF);
    LAS float* red = (LAS float*)lds;
    const int r32 = lane & 31, hi = lane >> 5;
    for (int rg = vcu; rg < M / 64; rg += G) {
        const int row0 = rg * 64; f32x16 acc0 = {}, acc1 = {};
#pragma unroll
        for (int ks = 0; ks < 8; ++ks) { const int k = wave * 128 + ks * 16 + 8 * hi;
            const bf16x8 a0 = *(const bf16x8*)(xb + (size_t)(row0 + r32) * DM + k), a1 = *(const bf16x8*)(xb + (size_t)(row0 + 32 + r32) * DM + k), b = *(const bf16x8*)(wsk + (size_t)r32 * DM + k);
            acc0 = __builtin_amdgcn_mfma_f32_32x32x16_bf16(a0, b, acc0, 0, 0, 0); acc1 = __builtin_amdgcn_mfma_f32_32x32x16_bf16(a1, b, acc1, 0, 0, 0); }
#pragma unroll
        for (int r = 0; r < 16; ++r) { red[(wave * 64 + crow(r, hi)) * 32 + r32] = acc0[r]; red[(wave * 64 + 32 + crow(r, hi)) * 32 + r32] = acc1[r]; }
        LDS_SYNC();
        { const int row = tid >> 3, c4 = tid & 7; f32x4 s = {0.f, 0.f, 0.f, 0.f};
#pragma unroll
            for (int w = 0; w < 8; ++w) s += *(const LAS f32x4*)(red + (w * 64 + row) * 32 + c4 * 4);
            s *= rstd1[row0 + row];
            if (c4 == 4 || c4 == 5) { const f32x4 bf = *(const f32x4*)(a.in[7] + (c4 - 4) * 4); s = (f32x4){logsig(s.x + bf.x), logsig(s.y + bf.y), logsig(s.z + bf.z), logsig(s.w + bf.w)}; }
            *(f32x4*)(lrf + (size_t)(row0 + row) * 32 + c4 * 4) = s; }
        LDS_SYNC();
    }
}

__device__ __forceinline__ bf16x8 ldfrag(const LAS bf16* base, int row, int ks, int hi) { return *(const LAS bf16x8*)(base + row * 72 + ks * 16 + 8 * hi); }
#define PK16(a_, b_) ((unsigned)(a_) | ((unsigned)(b_) << 16))
struct GlaIn { f32x4 lrq; unsigned qp[8], kp[8], vv2[16]; };
__device__ __forceinline__ void gla_local_load(GlaIn& I, const Args& a, int task0, int wave, int tid) {
    const bf16* proj = (const bf16*)(a.ws + WS_PROJ); const float* lrf = (const float*)(a.ws + WS_LRF);
    const int hb = wave >> 2, t256 = tid & 255, task = task0 + hb;
    const int bh = task >> 5, n = task & 31, b = bh >> 2, h = bh & 3, tok0 = b * SEQ + n * 64;
    const int kp = t256 & 31, seg = t256 >> 5, vp = t256 & 63, sg = t256 >> 6;
    I.lrq = *(const f32x4*)(lrf + (size_t)(tok0 + (t256 >> 2)) * 32 + (t256 & 3) * 4);
#pragma unroll
    for (int i = 0; i < 8; ++i) { const bf16* pr = proj + (size_t)(tok0 + seg * 8 + i) * PROJW + h * 64 + 2 * kp; I.qp[i] = __builtin_nontemporal_load((const unsigned*)pr); I.kp[i] = __builtin_nontemporal_load((const unsigned*)(pr + 256)); }
#pragma unroll
    for (int i = 0; i < 16; ++i) I.vv2[i] = __builtin_nontemporal_load((const unsigned*)(proj + (size_t)(tok0 + sg * 16 + i) * PROJW + 512 + h * 128 + 2 * vp));
}
__device__ __forceinline__ void gla_local2(const GlaIn& I, const f32x2 (&w)[16], f32x2 bias, const Args& a, LAS unsigned char* lds_all, int task0, int wave, int lane, int tid) {
    unsigned char* ws = a.ws;
    bf16* qeg = (bf16*)(ws + WS_QE);
    float* decay = (float*)(ws + WS_SMALL) + 4 * M; float* ointra = a.out; float* dS = a.out + (size_t)M * 512;
    const int hb = wave >> 2, w4 = wave & 3, t256 = tid & 255, task = task0 + hb;
    const int bh = task >> 5, n = task & 31, b = bh >> 2, h = bh & 3, tok0 = b * SEQ + n * 64;
    LAS unsigned char* lds = lds_all + hb * 61440;
    LAS bf16* QE = (LAS bf16*)lds; LAS bf16* KE = QE + 64 * 72; LAS bf16* KDT = KE + 64 * 72; LAS bf16* VT = KDT + 64 * 72; LAS bf16* AT = VT + 128 * 72;
    LAS float* SEG = (LAS float*)(AT + 64 * 72); LAS float* LR = SEG + 512;
    const int r32 = lane & 31, hi = lane >> 5;
    const int kp = t256 & 31, seg = t256 >> 5;
    const int vp = t256 & 63, sg = t256 >> 6;
    *(LAS f32x4*)(LR + (t256 >> 2) * 16 + (t256 & 3) * 4) = I.lrq;
    LDS_SYNC();
    f32x2 bl[8]; f32x2 run = {0.f, 0.f};
#pragma unroll
    for (int i = 0; i < 8; ++i) { const LAS f32x4* lr = (const LAS f32x4*)(LR + (seg * 8 + i) * 16); f32x2 z = bias;
#pragma unroll
        for (int j = 0; j < 4; ++j) { const f32x4 l4 = lr[j]; z += (w[4 * j] * l4.x + w[4 * j + 1] * l4.y) + (w[4 * j + 2] * l4.z + w[4 * j + 3] * l4.w); }
        run += (f32x2){logsig(z.x), logsig(z.y)} * (1.f / 16.f); bl[i] = run; }
    *(LAS f32x2*)(SEG + seg * 64 + 2 * kp) = run;
    {
        unsigned lo[8], hh[8];
#pragma unroll
        for (int q = 0; q < 8; ++q) { const unsigned x0 = I.vv2[2 * q], x1 = I.vv2[2 * q + 1]; lo[q] = (x0 & 0xffffu) | (x1 << 16); hh[q] = (x0 >> 16) | (x1 & 0xffff0000u); }
        *(LAS u32x4*)(VT + (2 * vp) * 72 + sg * 16) = (u32x4){lo[0], lo[1], lo[2], lo[3]}; *(LAS u32x4*)(VT + (2 * vp) * 72 + sg * 16 + 8) = (u32x4){lo[4], lo[5], lo[6], lo[7]};
        *(LAS u32x4*)(VT + (2 * vp + 1) * 72 + sg * 16) = (u32x4){hh[0], hh[1], hh[2], hh[3]}; *(LAS u32x4*)(VT + (2 * vp + 1) * 72 + sg * 16 + 8) = (u32x4){hh[4], hh[5], hh[6], hh[7]}; }
    LDS_SYNC();
    {   f32x2 prefix = {0.f, 0.f}, total = {0.f, 0.f};
#pragma unroll
        for (int s2 = 0; s2 < 8; ++s2) { const f32x2 sv = *(const LAS f32x2*)(SEG + s2 * 64 + 2 * kp); total += sv; if (s2 < seg) prefix += sv; }
        float kd0[8], kd1[8];
#pragma unroll
        for (int i = 0; i < 8; ++i) { const int t = seg * 8 + i; const f32x2 bb = bl[i] + prefix;
            const float q0 = bflo(I.qp[i]), q1 = bfhi(I.qp[i]), k0 = bflo(I.kp[i]), k1 = bfhi(I.kp[i]);
            const unsigned qe = pk2(q0 * 0.125f * __expf(bb.x), q1 * 0.125f * __expf(bb.y));
            *(LAS unsigned*)(QE + t * 72 + 2 * kp) = qe; *(LAS unsigned*)(KE + t * 72 + 2 * kp) = pk2(k0 * __expf(-bb.x), k1 * __expf(-bb.y));
            *(unsigned*)(qeg + (size_t)(tok0 + t) * 256 + h * 64 + 2 * kp) = qe;
            kd0[i] = k0 * __expf(total.x - bb.x); kd1[i] = k1 * __expf(total.y - bb.y); }
        *(LAS u32x4*)(KDT + (2 * kp) * 72 + seg * 8) = (u32x4){pk2(kd0[0], kd0[1]), pk2(kd0[2], kd0[3]), pk2(kd0[4], kd0[5]), pk2(kd0[6], kd0[7])};
        *(LAS u32x4*)(KDT + (2 * kp + 1) * 72 + seg * 8) = (u32x4){pk2(kd1[0], kd1[1]), pk2(kd1[2], kd1[3]), pk2(kd1[4], kd1[5]), pk2(kd1[6], kd1[7])};
        if (seg == 0) *(f32x2*)(decay + task * 64 + 2 * kp) = (f32x2){__expf(total.x), __expf(total.y)};
    }
    LDS_SYNC();
    {
        const int ti = w4 >> 1, si = w4 & 1; f32x16 acc = {};
        if (si <= ti) {
#pragma unroll
            for (int ks = 0; ks < 4; ++ks) acc = __builtin_amdgcn_mfma_f32_32x32x16_bf16(ldfrag(QE, ti * 32 + r32, ks, hi), ldfrag(KE, si * 32 + r32, ks, hi), acc, 0, 0, 0);
        }
#pragma unroll
        for (int r = 0; r < 16; ++r) { const int trow = ti * 32 + crow(r, hi), scol = si * 32 + r32; AT[trow * 72 + scol] = (unsigned short)f2bf(scol <= trow ? acc[r] : 0.f); }
    }
    LDS_SYNC();
    {
        const int ti = w4 >> 1;
#pragma unroll
        for (int q = 0; q < 2; ++q) { const int vi = (w4 & 1) * 2 + q; f32x16 o = {}, ds = {};
#pragma unroll
            for (int ks = 0; ks < 4; ++ks) { const bf16x8 vb = ldfrag(VT, vi * 32 + r32, ks, hi);
                o = __builtin_amdgcn_mfma_f32_32x32x16_bf16(ldfrag(AT, ti * 32 + r32, ks, hi), vb, o, 0, 0, 0);
                ds = __builtin_amdgcn_mfma_f32_32x32x16_bf16(ldfrag(KDT, ti * 32 + r32, ks, hi), vb, ds, 0, 0, 0); }
#pragma unroll
            for (int r = 0; r < 16; ++r) { const int row = ti * 32 + crow(r, hi);
                ointra[(size_t)(tok0 + row) * 512 + h * 128 + vi * 32 + r32] = o[r];
                dS[(size_t)task * 8192 + row * 128 + vi * 32 + r32] = ds[r]; } }
    }
    LDS_SYNC();
}
__device__ __forceinline__ void gla_w_load(f32x2 (&w)[16], f32x2& bias, const Args& a, int h, int kp) {
#pragma unroll
    for (int j = 0; j < 16; ++j) w[j] = *(const f32x2*)(a.in[4] + j * 256 + h * 64 + 2 * kp);
    bias = *(const f32x2*)(a.in[5] + h * 64 + 2 * kp);
}
__device__ __forceinline__ void gla_local_all(const Args& a, LAS unsigned char* lds, int vcu, int G, int wave, int lane, int tid) {
    const int t0 = 2 * vcu; if (t0 >= 1024) return;
    const int kp = tid & 31;
    f32x2 w[16]; f32x2 bias; gla_w_load(w, bias, a, ((t0 + (wave >> 2)) >> 5) & 3, kp);
    const int t1 = t0 + 2 * G; const bool has1 = t1 < 1024;
    {   GlaIn A, B; gla_local_load(A, a, t0, wave, tid);
        if (has1) gla_local_load(B, a, t1, wave, tid);
        gla_local2(A, w, bias, a, lds, t0, wave, lane, tid);
        if (has1) {
            if ((2 * G) % 128 != 0) gla_w_load(w, bias, a, ((t1 + (wave >> 2)) >> 5) & 3, kp);
            gla_local2(B, w, bias, a, lds, t1, wave, lane, tid); } }
    for (int task = t0 + 4 * G; task < 1024; task += 2 * G) {
        gla_w_load(w, bias, a, ((task + (wave >> 2)) >> 5) & 3, kp);
        GlaIn C; gla_local_load(C, a, task, wave, tid); gla_local2(C, w, bias, a, lds, task, wave, lane, tid); }
}

__device__ __forceinline__ void fox_prep(const Args& a, LAS unsigned char* lds, int vcu, int G, int wave, int lane, int tid) {
    const float* lrf = (const float*)(a.ws + WS_LRF); float* cb = (float*)(a.ws + WS_SMALL) + 4 * M + 65536; LAS float* wt = (LAS float*)lds;
    for (int bh = vcu; bh < 64; bh += G) {
        const int b = bh >> 3, h = bh & 7; float v[4];
#pragma unroll
        for (int i = 0; i < 4; ++i) v[i] = lrf[(size_t)(b * SEQ + tid * 4 + i) * 32 + 16 + h];
        v[1] += v[0]; v[2] += v[1]; v[3] += v[2];
        float inc = v[3];
#pragma unroll
        for (int o = 1; o < 64; o <<= 1) { const float t = __shfl_up(inc, o); if (lane >= o) inc += t; }
        if (lane == 63) wt[wave] = inc;
        LDS_SYNC();
        float pre = inc - v[3];
#pragma unroll
        for (int w = 0; w < 8; ++w) { const float x = wt[w]; if (w < wave) pre += x; }
        *(f32x4*)(cb + (size_t)bh * SEQ + tid * 4) = (f32x4){(pre + v[0]) * LOG2E, (pre + v[1]) * LOG2E, (pre + v[2]) * LOG2E, (pre + v[3]) * LOG2E};
        LDS_SYNC();
    }
}

__device__ __forceinline__ void gla_scan(const Args& a, int vcu, int G, int tid) {
    const float* decay = (const float*)(a.ws + WS_SMALL) + 4 * M; const float* dS = a.out + (size_t)M * 512; bf16* sprev = (bf16*)(a.ws + WS_SPREV);
    for (int e = (vcu * NT + tid) * 2; e < 32 * 8192; e += G * NT * 2) {
        const int j = e >> 13, bh = (j & 1) + 2 * (j >> 2) + 16 * ((j >> 1) & 1), kv = e & 8191, k = kv >> 7; f32x2 st = {0.f, 0.f};
#pragma unroll
        for (int n = 0; n < 32; ++n) { const int task = bh * 32 + n; const size_t idx = (size_t)task * 8192 + kv;
            *(unsigned*)(sprev + idx) = pk2(st.x, st.y); const float d = decay[task * 64 + k]; const f32x2 ds = __builtin_nontemporal_load((const f32x2*)(dS + idx)); st = st * d + ds; }
    }
}

__device__ __forceinline__ void gla_final2(const Args& a, LAS unsigned char* lds_all, int task0, int wave, int lane, int tid) {
    unsigned char* ws = a.ws;
    const bf16* proj = (const bf16*)(ws + WS_PROJ); const bf16* qeg = (const bf16*)(ws + WS_QE); const bf16* sprev = (const bf16*)(ws + WS_SPREV);
    const float* ointra = a.out; bf16* mix = (bf16*)(ws + WS_MIX);
    const int hb = wave >> 2, w4 = wave & 3, t256 = tid & 255, task = task0 + hb;
    const int bh = task >> 5, n = task & 31, b = bh >> 2, h = bh & 3, tok0 = b * SEQ + n * 64;
    LAS unsigned char* lds = lds_all + hb * 61440;
    LAS bf16* QE = (LAS bf16*)lds; LAS bf16* ST = QE + 64 * 72; LAS float* OL = (LAS float*)(lds + 27648);
    const int r32 = lane & 31, hi = lane >> 5, ti = w4 >> 1;
    const int rr = t256 >> 4, c16 = t256 & 15;
    u32x4 qv[2];
#pragma unroll
    for (int q = 0; q < 2; ++q) { const int e = t256 + 256 * q; qv[q] = __builtin_nontemporal_load((const u32x4*)(qeg + (size_t)(tok0 + (e >> 3)) * 256 + h * 64 + (e & 7) * 8)); }
    unsigned f2[16];
    { const int vp = t256 & 63, kg = t256 >> 6;
#pragma unroll
        for (int i = 0; i < 16; ++i) f2[i] = __builtin_nontemporal_load((const unsigned*)(sprev + (size_t)task * 8192 + (kg * 16 + i) * 128 + 2 * vp)); }
    f32x4 oiv[4][2]; u32x4 gw[4];
#pragma unroll
    for (int p = 0; p < 4; ++p) { const size_t tok = (size_t)(tok0 + p * 16 + rr);
        oiv[p][0] = __builtin_nontemporal_load((const f32x4*)(ointra + tok * 512 + h * 128 + c16 * 8)); oiv[p][1] = __builtin_nontemporal_load((const f32x4*)(ointra + tok * 512 + h * 128 + c16 * 8 + 4));
        gw[p] = __builtin_nontemporal_load((const u32x4*)(proj + tok * PROJW + 1024 + h * 128 + c16 * 8)); }
    const f32x4 gn0 = *(const f32x4*)(a.in[6] + c16 * 8), gn1 = *(const f32x4*)(a.in[6] + c16 * 8 + 4);
#pragma unroll
    for (int q = 0; q < 2; ++q) { const int e = t256 + 256 * q; *(LAS u32x4*)(QE + (e >> 3) * 72 + (e & 7) * 8) = qv[q]; }
    { const int vp = t256 & 63, kg = t256 >> 6; unsigned lo[8], hh[8];
#pragma unroll
        for (int q = 0; q < 8; ++q) { const unsigned x0 = f2[2 * q], x1 = f2[2 * q + 1]; lo[q] = (x0 & 0xffffu) | (x1 << 16); hh[q] = (x0 >> 16) | (x1 & 0xffff0000u); }
        *(LAS u32x4*)(ST + (2 * vp) * 72 + kg * 16) = (u32x4){lo[0], lo[1], lo[2], lo[3]}; *(LAS u32x4*)(ST + (2 * vp) * 72 + kg * 16 + 8) = (u32x4){lo[4], lo[5], lo[6], lo[7]};
        *(LAS u32x4*)(ST + (2 * vp + 1) * 72 + kg * 16) = (u32x4){hh[0], hh[1], hh[2], hh[3]}; *(LAS u32x4*)(ST + (2 * vp + 1) * 72 + kg * 16 + 8) = (u32x4){hh[4], hh[5], hh[6], hh[7]}; }
    LDS_SYNC();
#pragma unroll
    for (int q = 0; q < 2; ++q) { const int vi = (w4 & 1) * 2 + q; f32x16 acc = {};
#pragma unroll
        for (int ks = 0; ks < 4; ++ks) acc = __builtin_amdgcn_mfma_f32_32x32x16_bf16(ldfrag(QE, ti * 32 + r32, ks, hi), ldfrag(ST, vi * 32 + r32, ks, hi), acc, 0, 0, 0);
#pragma unroll
        for (int r = 0; r < 16; ++r) { const int row = ti * 32 + crow(r, hi), col = vi * 32 + r32; OL[row * 132 + col] = acc[r]; } }
    LDS_SYNC();
#pragma unroll
    for (int p = 0; p < 4; ++p) { const int t = p * 16 + rr;
        const f32x4 o0 = *(const LAS f32x4*)(OL + t * 132 + c16 * 8) + oiv[p][0], o1 = *(const LAS f32x4*)(OL + t * 132 + c16 * 8 + 4) + oiv[p][1];
        float ssq = (o0.x * o0.x + o0.y * o0.y) + (o0.z * o0.z + o0.w * o0.w) + (o1.x * o1.x + o1.y * o1.y) + (o1.z * o1.z + o1.w * o1.w);
        ssq += __shfl_xor(ssq, 1); ssq += __shfl_xor(ssq, 2); ssq += __shfl_xor(ssq, 4); ssq += __shfl_xor(ssq, 8);
        const float r = rsqrtf(ssq * (1.f / 128.f) + EPS);
        const u32x4 g = gw[p]; const float og[8] = {bflo(g.x), bfhi(g.x), bflo(g.y), bfhi(g.y), bflo(g.z), bfhi(g.z), bflo(g.w), bfhi(g.w)};
        float y[8];
#pragma unroll
        for (int c = 0; c < 4; ++c) { const float g0 = og[c], g1 = og[4 + c];
            y[c] = o0[c] * r * gn0[c] * (g0 * __builtin_amdgcn_rcpf(1.f + __expf(-g0))); y[4 + c] = o1[c] * r * gn1[c] * (g1 * __builtin_amdgcn_rcpf(1.f + __expf(-g1))); }
        u32x4 pk; pk.x = pk2(y[0], y[1]); pk.y = pk2(y[2], y[3]); pk.z = pk2(y[4], y[5]); pk.w = pk2(y[6], y[7]);
        *(u32x4*)(mix + (size_t)(tok0 + t) * DM + h * 128 + c16 * 8) = pk; }
    LDS_SYNC();
}

#define XB_TMO      128
#define XB_XCNT(j)  (256  + 64 * (j))
#define XB_XSUB(j)  (1280 + 64 * (j))
#define XB_XGEN(j)  (2304 + 64 * (j))
#define XB_TOP      3328
#define XB_TOPGEN   3392
#define XCD_BAR_WORDS 3456
#define XB_SPIN_CAP (1u << 18)

__device__ __forceinline__ unsigned xb_ld(unsigned* p)              { return __hip_atomic_load(p, __ATOMIC_RELAXED, __HIP_MEMORY_SCOPE_AGENT); }
__device__ __forceinline__ unsigned xb_add(unsigned* p, unsigned v) { return __hip_atomic_fetch_add(p, v, __ATOMIC_RELAXED, __HIP_MEMORY_SCOPE_AGENT); }
__device__ __forceinline__ unsigned xb_xcc_id() { return (unsigned)__builtin_amdgcn_s_getreg((3 << 11) | 20) & 0xFu; }
#define XB_SPIN(cond, bar) do { unsigned _sp = 0; while (cond) { __builtin_amdgcn_s_sleep(1); \
    if ((++_sp & 255u) == 0u) { if (xb_ld(&(bar)[XB_TMO])) break; if (_sp > XB_SPIN_CAP) { atomicAdd(&(bar)[XB_TMO], 1u); break; } } } } while (0)

struct XcdBarrier {
    unsigned* bar; unsigned x;
    volatile LAS unsigned* st;
};

__device__ __forceinline__ XcdBarrier xcd_barrier_post(unsigned* bar, volatile LAS unsigned* st, bool leader) {
    XcdBarrier b; b.bar = bar; b.x = xb_xcc_id(); b.st = st;
    if (leader) (void)xb_add(&bar[XB_XCNT(b.x)], 1u);
    return b;
}
__device__ __forceinline__ void xcd_barrier_complete(unsigned* bar, unsigned x, unsigned& nloc, unsigned& nx) {
    const unsigned G = gridDim.x * gridDim.y * gridDim.z;
    unsigned sum, cnt, mine, sp = 0u;
    for (;;) {
        sum = 0u; cnt = 0u; mine = 0u;
#pragma unroll
        for (unsigned j = 0; j < 16; ++j) { const unsigned c = xb_ld(&bar[XB_XCNT(j)]); sum += c; cnt += (c > 0u) ? 1u : 0u; mine = (j == x) ? c : mine; }
        if (sum == G) break;
        __builtin_amdgcn_s_sleep(1);
        if ((++sp & 255u) == 0u) { if (xb_ld(&bar[XB_TMO])) break; if (sp > XB_SPIN_CAP) { atomicAdd(&bar[XB_TMO], 1u); break; } }
    }
    nloc = mine > 0u ? mine : 1u; nx = cnt > 0u ? cnt : 1u;
}

__device__ __forceinline__ void xcd_barrier(const XcdBarrier& b, bool leader) {
    asm volatile("s_waitcnt vmcnt(0)" ::: "memory");
    __syncthreads();
    if (leader) {
        unsigned* bar = b.bar;
        __builtin_amdgcn_s_waitcnt(0);
        unsigned nloc = b.st[0], nx = b.st[1];
        if (nloc == 0u) { xcd_barrier_complete(bar, b.x, nloc, nx); b.st[0] = nloc; b.st[1] = nx; }
        const unsigned old = xb_add(&bar[XB_XSUB(b.x)], 1u);
        const unsigned gen = old / nloc;
        if (old + 1u == (gen + 1u) * nloc) {
            __builtin_amdgcn_fence(__ATOMIC_RELEASE, "agent");
            asm volatile("s_waitcnt vmcnt(0)" ::: "memory");
            const unsigned og = xb_add(&bar[XB_TOP], 1u);
            const unsigned tg = og / nx;
            if (og + 1u == (tg + 1u) * nx) xb_add(&bar[XB_TOPGEN], 1u);
            else XB_SPIN(xb_ld(&bar[XB_TOPGEN]) == tg, bar);
            __builtin_amdgcn_fence(__ATOMIC_ACQUIRE, "agent");
            xb_add(&bar[XB_XGEN(b.x)], 1u);
            asm volatile("s_waitcnt vmcnt(0)" ::: "memory");
        } else {
            XB_SPIN(xb_ld(&bar[XB_XGEN(b.x)]) == gen, bar);
            __builtin_amdgcn_fence(__ATOMIC_ACQUIRE, "agent");
            asm volatile("s_waitcnt vmcnt(0)" ::: "memory");
        }
    }
    __syncthreads();
}

__device__ __forceinline__ void sb_arrive(const XcdBarrier& b, int set, bool leader) {
    asm volatile("s_waitcnt vmcnt(0)" ::: "memory"); __syncthreads();
    if (leader) { unsigned* w = b.bar + 4096 + 2048 * set; const unsigned nloc = b.st[0], nx = b.st[1];
        const unsigned old = xb_add(&w[64 * b.x], 1u);
        if (old + 1u == nloc) { __builtin_amdgcn_fence(__ATOMIC_RELEASE, "agent"); asm volatile("s_waitcnt vmcnt(0)" ::: "memory");
            const unsigned og = xb_add(&w[1024], 1u); if (og + 1u == nx) xb_add(&w[1088], 1u); } }
}
__device__ __forceinline__ void sb_wait(const XcdBarrier& b, int set, bool leader) {
    if (leader) { unsigned* w = b.bar + 4096 + 2048 * set; XB_SPIN(xb_ld(&w[1088]) == 0u, b.bar);
        __builtin_amdgcn_fence(__ATOMIC_ACQUIRE, "agent"); asm volatile("s_waitcnt vmcnt(0)" ::: "memory"); }
    __syncthreads();
}
#ifndef MK_SKIP
#define MK_SKIP 0
#endif
#define RUN(k) (!((MK_SKIP >> (k)) & 1))
#ifndef REP_SYNC
#define REP_SYNC 1
#endif
#ifndef REP_P0
#define REP_P0 1
#endif
#ifndef REP_P1
#define REP_P1 1
#endif
#ifndef REP_GL
#define REP_GL 1
#endif
#ifndef REP_SC
#define REP_SC 1
#endif
#ifndef REP_AT
#define REP_AT 1
#endif
#ifndef REP_GF
#define REP_GF 1
#endif
#ifndef REP_P5
#define REP_P5 1
#endif
#ifndef REP_P7
#define REP_P7 1
#endif
#ifndef REP_P8
#define REP_P8 1
#endif
#ifndef REP_FP
#define REP_FP 1
#endif
#ifndef REP_P6
#define REP_P6 1
#endif
#ifndef STAMP_K
#define STAMP_K -1
#endif
#define GSYNC() do { for (int s_ = 0; s_ < REP_SYNC; ++s_) xcd_barrier(xbar, wave == 0 && lane_id() == 0); \
    if (STAMP_K >= 0) { if (bx == 0 && wave == 0 && lane_id() == 0) { ((unsigned long long*)(ws + 65536))[n_stamp] = __builtin_amdgcn_s_memrealtime(); } ++n_stamp; } } while (0)
__global__ void __launch_bounds__(NT, 2) mk_fwd(Args a) {
    extern __shared__ __attribute__((aligned(16))) unsigned char lds_raw[];
    LAS unsigned char* lds = (LAS unsigned char*)lds_raw;
    const int wave = __builtin_amdgcn_readfirstlane(threadIdx.x >> 6);
#define lane (lane_id())
#define tid (wave * 64 + lane_id())
    const int G = gridDim.x, bx = blockIdx.x, vcu = (G % 8 == 0) ? (bx % 8) * (G / 8) + bx / 8 : bx;
    unsigned char* ws = a.ws;
    bf16* xb = (bf16*)(ws + WS_XB); float* small = (float*)(ws + WS_SMALL);
    float* ss2 = small + M; float* ss3 = small + 2 * M; float* ssE = small + 3 * M;
    volatile LAS unsigned* xst = (volatile LAS unsigned*)(lds + XCH_OFF + 8192);
    if (wave == 0 && lane_id() == 0) { xst[0] = 0u; xst[1] = 0u; }
    __syncthreads();
    int n_stamp = 1; if (STAMP_K >= 0 && bx == 0 && wave == 0 && lane_id() == 0) ((unsigned long long*)(ws + 65536))[0] = __builtin_amdgcn_s_memrealtime();
    const XcdBarrier xbar = xcd_barrier_post((unsigned*)ws, xst, wave == 0 && lane_id() == 0);

    for (int rep_ = 0; rep_ < REP_P0; ++rep_) if (RUN(0)) p0_prologue(a, lds, vcu, G, wave, lane, tid);
    GSYNC();
    for (int rep_ = 0; rep_ < REP_P1; ++rep_) if (RUN(1)) {   pg8::Gemm g{xb, (const bf16*)(ws + WS_WIN), M, PROJW, DM}; pg8::StaticOrder S; S.init(M / 256, PROJW / 256, G, bx);
        pg8::EpiProj E{(bf16*)(ws + WS_PROJ), PROJW, small, a.in[8], a.in[9], (LAS float*)(lds + XCH_OFF)};
        pg8::gemm_phase<pg8::EpiProj, pg8::StaticOrder, true, true>(lds, g, S, E, wave);
        p1_skinny(a, lds, vcu, G, wave, lane, tid);
    }
    GSYNC();
    {
#ifndef STAMP2_K
#define STAMP2_K -1
#endif
#define SUBSTAMP(i) do { if (STAMP2_K >= 0 && bx == 0 && wave == 0 && lane_id() == 0) ((unsigned long long*)(ws + 65536 + 1024))[i] = __builtin_amdgcn_s_memrealtime(); } while (0)
        SUBSTAMP(0);
        if (RUN(9)) fox_prep(a, lds, vcu, G, wave, lane, tid);
        sb_arrive(xbar, 0, wave == 0 && lane_id() == 0);
        for (int rep_ = 0; rep_ < REP_GL; ++rep_) if (RUN(2)) gla_local_all(a, lds, vcu, G, wave, lane, tid);
        sb_arrive(xbar, 1, wave == 0 && lane_id() == 0); SUBSTAMP(1);
        sb_wait(xbar, 0, wave == 0 && lane_id() == 0); SUBSTAMP(2);
        const attn_body::bf16* pj = (const attn_body::bf16*)(ws + WS_PROJ);
        float gqm = 0.f, gkm = 0.f;
        for (int i = 0; i < 64; ++i) { gqm = fmaxf(gqm, fabsf(a.in[8][i])); gkm = fmaxf(gkm, fabsf(a.in[9][i])); }
#ifndef ATTN_PRUNE
#define ATTN_PRUNE 1
#endif
        const float thr = ATTN_PRUNE ? 2.f * (64.f * gqm * gkm * C2 * 1.02f) + 48.f : 1e30f;
        const attn_body::AttnTensors AT{pj + 1536, pj + 2048, pj + 2560, (attn_body::bf16*)(ws + WS_MIX) + 512, small + 4 * M + 65536, thr};
        const attn_body::StaticOrder S(G, vcu);
        attn_body::AttnUnit u; bool scanned = false;
        for (int i = 0; S.next(i, u); ++i) {
            if (i == 1) { SUBSTAMP(3); sb_wait(xbar, 1, wave == 0 && lane_id() == 0); SUBSTAMP(4); gla_scan(a, vcu, G, tid); sb_arrive(xbar, 2, wave == 0 && lane_id() == 0); scanned = true; SUBSTAMP(5); }
            if (RUN(3)) attn_body::attn_unit<8>(u.bh / attn_body::NHEAD, u.bh % attn_body::NHEAD, u.qb, AT.Q, AT.K, AT.V, AT.O, AT.CB, AT.thr, (char*)lds_raw);
        }
        if (!scanned) { sb_wait(xbar, 1, wave == 0 && lane_id() == 0); gla_scan(a, vcu, G, tid); sb_arrive(xbar, 2, wave == 0 && lane_id() == 0); }
        SUBSTAMP(6); sb_wait(xbar, 2, wave == 0 && lane_id() == 0); SUBSTAMP(7);
        for (int rep_ = 0; rep_ < REP_GF; ++rep_) if (RUN(4)) for (int task = 2 * vcu; task < 1024; task += 2 * G) gla_final2(a, lds, task, wave, lane, tid);
        SUBSTAMP(8);
    }
    GSYNC();
    SUBSTAMP(9);
    if (RUN(5)) {   pg8::Gemm g{(const bf16*)(ws + WS_MIX), (const bf16*)(ws + WS_WO), M, DM, DM}; pg8::StaticOrder S; S.init(M / 256, DM / 256, G, bx);
        pg8::EpiRes<2> E{nullptr, xb, xb, ss2, DM};
        pg8::gemm_phase<pg8::EpiRes<2>, pg8::StaticOrder, true, true>(lds, g, S, E, wave);
    }
    GSYNC();
    for (int rep_ = 0; rep_ < REP_P6; ++rep_) if (RUN(6)) {   pg8::Gemm g{xb, (const bf16*)(ws + WS_WUP), M, 2 * FF, DM}; pg8::StaticOrder S; S.init(65, 2 * FF / 256, G, bx, 254, -2);
        {   LAS float* rsl = (LAS float*)(lds + RSL_OFF); pg8::Unit uu;
            for (int i = 0; i < 6 && S.next(i, uu); ++i) { const int r = tid; if (r < 256) { const int gr = uu.arow + r; rsl[i * 256 + r] = (gr >= 0 && gr < M) ? rsqrtf(ss2[gr] * (1.f / 1024.f) + EPS) : 0.f; } }
            LDS_SYNC(); }
        pg8::EpiUp E{(bf16*)(ws + WS_ACT), ss2, a.in[13], a.in[14], (LAS float*)(lds + XCH_OFF), (LAS float*)(lds + XCH_OFF + 8192 + 256), (LAS float*)(lds + RSL_OFF)};
        pg8::gemm_phase<pg8::EpiUp, pg8::StaticOrder, true, true>(lds, g, S, E, wave);
        {   const int nwg6 = 65 * (2 * FF / 256), rem = nwg6 % G, nl = rem ? G - rem : G, cl = rem ? bx - rem : bx;
            if (cl >= 0) { pg8::Gemm g2{(const bf16*)(ws + WS_PB), (const bf16*)(ws + WS_WPE), M, DM, PLE}; pg8::StaticOrder S2; S2.init(M / 256, DM / 256, nl, cl);
                pg8::EpiRes<0> E2{nullptr, nullptr, (bf16*)(ws + WS_E), ssE, DM};
                pg8::gemm_phase<pg8::EpiRes<0>, pg8::StaticOrder, true, true>(lds, g2, S2, E2, wave);
                p6_late_weights(a, lds, cl, nl, wave, lane); } }
    }
    GSYNC();
    if (RUN(7)) {   pg8::Gemm g{(const bf16*)(ws + WS_ACT), (const bf16*)(ws + WS_WD), M, DM, FF}; pg8::StaticOrder S; S.init(M / 256, DM / 256, G, bx);
        pg8::EpiRes<2> E{nullptr, xb, xb, ss3, DM};
        pg8::gemm_phase<pg8::EpiRes<2>, pg8::StaticOrder, true, true>(lds, g, S, E, wave);
    }
    GSYNC();
    if (RUN(8)) {   pg8::Gemm g{xb, (const bf16*)(ws + WS_WPG), M, DM, DM}; pg8::StaticOrder S; S.init(M / 256, DM / 256, G, bx);
        for (int rep_ = REP_P8 - 1; rep_ > 0; --rep_) { pg8::EpiGate Ed{xb, (float*)(ws + WS_PROJ), (const bf16*)(ws + WS_E), ss3, ssE, a.in[20], a.in[18], DM}; pg8::gemm_phase<pg8::EpiGate, pg8::StaticOrder, true, true>(lds, g, S, Ed, wave); }
        pg8::EpiGate E{xb, a.out, (const bf16*)(ws + WS_E), ss3, ssE, a.in[20], a.in[18], DM};
        pg8::gemm_phase<pg8::EpiGate, pg8::StaticOrder, true, true>(lds, g, S, E, wave);
    }
    if (STAMP2_K >= 0) { xcd_barrier(xbar, wave == 0 && lane_id() == 0);
        if (bx == 0 && wave == 0 && lane_id() == 0) { const unsigned long long* ts = (const unsigned long long*)(ws + 65536 + 1024);
            a.out[0] += 0.25f + (float)(ts[STAMP2_K + 1] - ts[STAMP2_K]) * 1e-4f; } }
    if (STAMP_K >= 0) { GSYNC();
        if (bx == 0 && wave == 0 && lane_id() == 0) { const unsigned long long* ts = (const unsigned long long*)(ws + 65536);
            a.out[0] += (float)(ts[STAMP_K + 1] - ts[STAMP_K]) * 1e-4f; } }
#undef lane
#undef tid
}
}

extern "C" void kernel_launch(void* const* d_in, const int* in_sizes, int n_in, void* d_out, int out_size, void* d_ws, size_t ws_size, hipStream_t stream) {
    static int grid = 0;
    if (grid == 0) {
        int dev = 0, cus = 0, per_cu = 0;
        hipGetDevice(&dev); hipDeviceGetAttribute(&cus, hipDeviceAttributeMultiprocessorCount, dev);
        hipFuncSetAttribute((const void*)mk::mk_fwd, hipFuncAttributeMaxDynamicSharedMemorySize, mk::LDS_BYTES);
        hipOccupancyMaxActiveBlocksPerMultiprocessor(&per_cu, (const void*)mk::mk_fwd, mk::NT, mk::LDS_BYTES);
        if (per_cu < 1) { fprintf(stderr, "kernel_launch: occupancy query says %d blocks per CU\n", per_cu); per_cu = 1; }
        grid = cus * per_cu;
        if (n_in != 21 || ws_size < mk::WS_END) { fprintf(stderr, "kernel_launch: unexpected n_in %d / ws %zu\n", n_in, ws_size); grid = -1; }
    }
    if (grid < 0) return;
#ifdef PROBE_MEMSET2
    (void)hipMemsetAsync((char*)d_ws + 131072, 0, 65536, stream);
#endif
    if (hipMemsetAsync(d_ws, 0, 65536, stream) != hipSuccess) { fprintf(stderr, "kernel_launch: memset of the barrier words failed\n"); return; }
    mk::Args a{};
    for (int i = 0; i < 21; ++i) a.in[i] = (const float*)d_in[i];
    a.out = (float*)d_out; a.ws = (unsigned char*)d_ws;
    hipLaunchKernelGGL(mk::mk_fwd, dim3(grid), dim3(mk::NT), mk::LDS_BYTES, stream, a);
    const hipError_t e = hipPeekAtLastError();
    if (e != hipSuccess) fprintf(stderr, "kernel_launch: launch failed: %s (grid %d)\n", hipGetErrorString(e), grid);
}
```
